# Optimizing an MI355X kernel written in HIP

```python
import math
import jax
import jax.numpy as jnp
from jax import lax
import numpy as np


D_MODEL = 1024
BATCH = 16
SEQ = 2048
DEPTH = 4

CTX_LEN = 256
GRID_W = 64
EPS = 1e-6
NEG = -1e30
LB_FLOOR = 1e-30
ML_HEADS = 4
ML_HD = 96
ML_W = ML_HEADS * ML_HD
ML_CHUNK = 64
M_INIT = -1e30
HG_HEADS = 4
HG_DV = 64
HG_DK = 128
HG_W = HG_HEADS * HG_DV
HG_FW = HG_HEADS * HG_DK
HG_CHUNK = 32
DA_HEADS = 4
DA_HD = 48
DA_VD = 2 * DA_HD
DA_W = DA_HEADS * DA_VD
Q_BLOCK = 128
ROPE_BASE = 10000.0

D_MIX = ML_W + HG_W + DA_W
D_FF = ((8 * D_MODEL + 3 * 256 - 1) // (3 * 256)) * 256

IN_SIZES = (ML_W, ML_W, ML_W, ML_W, 2 * ML_HEADS, 2 * ML_HEADS,
            HG_FW, 2 * HG_FW, HG_W, HG_W,
            2 * DA_HEADS * DA_HD, 2 * DA_HEADS * DA_HD, DA_W)
D_IN = sum(IN_SIZES)

kernel_name = 'hybrid_mlstm_hgrn2_diffattn_dit_block'


def split_cols(p):
    idx = np.cumsum(IN_SIZES)[:-1].tolist()
    return jnp.split(p, idx, axis=-1)


def rmsnorm(x, g):
    xf = x.astype(jnp.float32)
    y = xf * lax.rsqrt(jnp.mean(xf * xf, axis=-1, keepdims=True) + EPS)
    return (y * g.astype(jnp.float32)).astype(x.dtype)


def head_rmsnorm(h, gain):
    d = h.shape[-1]
    y = h * lax.rsqrt(jnp.mean(h * h, axis=-1, keepdims=True) + EPS)
    return y * gain.astype(jnp.float32).reshape(-1, 1, d)


def to_heads(t, h):
    b, n, _ = t.shape
    return t.reshape(b, n, h, -1).transpose(0, 2, 1, 3)


def from_heads(t):
    b, h, n, d = t.shape
    return t.transpose(0, 2, 1, 3).reshape(b, n, h * d)


def to_chunks(t, size):
    b, h, n = t.shape[:3]
    t = t.reshape(b, h, n // size, size, *t.shape[3:])
    return jnp.moveaxis(t, 2, 0)


def from_chunks(t):
    t = jnp.moveaxis(t, 0, 2)
    return t.reshape(t.shape[0], t.shape[1], -1, *t.shape[4:])


def _flip(t, rev):
    return jnp.flip(t, axis=2) if rev else t


def prefix_bidirectional(scan_fn, ctx_shared, ctx_dir, lat_shared, lat_dir, state0):
    out_c = None
    out_x = None
    for rev in (0, 1):
        oc, st = scan_fn(*[_flip(t, rev) for t in ctx_shared + ctx_dir[rev]], state0)
        ox, _ = scan_fn(*[_flip(t, rev) for t in lat_shared + lat_dir[rev]], st)
        oc = _flip(oc, rev)
        ox = _flip(ox, rev)
        out_c = oc if out_c is None else out_c + oc
        out_x = ox if out_x is None else out_x + ox
    return out_c, out_x


def mlstm_scan(q, k, v, ig, lf, state):
    size = ML_CHUNK
    mask = jnp.tril(jnp.ones((size, size), bool))

    def step(carry, inp):
        S, nv, m = carry
        qc, kc, vc, ic, fc = inp
        b = jnp.cumsum(fc, axis=-1)
        a = b + m[..., None]
        dmat = jnp.where(mask, b[..., :, None] - b[..., None, :] + ic[..., None, :], NEG)
        mt = jnp.maximum(a, jnp.max(dmat, axis=-1))
        w_inter = jnp.exp(a - mt)
        qk = jnp.einsum('bhtd,bhsd->bhts', qc, kc) * jnp.exp(dmat - mt[..., None])
        num = jnp.einsum('bhts,bhsv->bhtv', qk, vc) + w_inter[..., None] * jnp.einsum('bhtd,bhdv->bhtv', qc, S)
        den = jnp.sum(qk, axis=-1) + w_inter * jnp.einsum('bhtd,bhd->bht', qc, nv)
        h = num / jnp.maximum(jnp.abs(den), jnp.exp(-mt))[..., None]
        m_new = mt[..., -1]
        decay = jnp.exp(b[..., -1] + m - m_new)
        wk = jnp.exp(b[..., -1:] - b + ic - m_new[..., None])
        S_new = decay[..., None, None] * S + jnp.einsum('bhs,bhsd,bhsv->bhdv', wk, kc, vc)
        n_new = decay[..., None] * nv + jnp.einsum('bhs,bhsd->bhd', wk, kc)
        return (S_new, n_new, m_new), h

    xs = tuple(to_chunks(t, size) for t in (q, k, v, ig, lf))
    state, h = lax.scan(step, state, xs)
    return from_chunks(h), state


def mlstm_prep(parts, f_bias):
    q, k, v, _, i, f = parts
    b, n, _ = q.shape
    f32 = jnp.float32
    qh = to_heads(q, ML_HEADS).astype(f32)
    kh = to_heads(k, ML_HEADS).astype(f32) * (ML_HD ** -0.5)
    vh = to_heads(v, ML_HEADS).astype(f32)
    gi = i.astype(f32).reshape(b, n, 2, ML_HEADS).transpose(0, 2, 3, 1)
    gf = jax.nn.log_sigmoid((f + f_bias).astype(f32)).reshape(b, n, 2, ML_HEADS).transpose(0, 2, 3, 1)
    return (qh, kh, vh), ((gi[:, 0], gf[:, 0]), (gi[:, 1], gf[:, 1]))


def mlstm_mixer(pc, px, f_bias, gain, with_ctx):
    sc, dc = mlstm_prep(pc, f_bias)
    sx, dx = mlstm_prep(px, f_bias)
    b = sx[0].shape[0]
    state0 = (jnp.zeros((b, ML_HEADS, ML_HD, ML_HD), jnp.float32),
              jnp.zeros((b, ML_HEADS, ML_HD), jnp.float32),
              jnp.full((b, ML_HEADS), M_INIT, jnp.float32))
    hc, hx = prefix_bidirectional(mlstm_scan, sc, dc, sx, dx, state0)

    def finish(h, o):
        y = from_heads(head_rmsnorm(h, gain)) * jax.nn.sigmoid(o.astype(jnp.float32))
        return y.astype(o.dtype)

    yc = finish(hc, pc[3]) if with_ctx else None
    return yc, finish(hx, px[3])


def hgrn2_scan(q, v, k, lf, S):
    size = HG_CHUNK
    mask = jnp.tril(jnp.ones((size, size), bool))[..., None]

    def step(S, inp):
        qc, vc, kc, fc = inp
        bc = jnp.cumsum(fc, axis=2)
        rel = jnp.where(mask, bc[:, :, :, None] - bc[:, :, None], NEG)
        att = jnp.einsum('bhtk,bhtsk->bhts', qc, jnp.exp(rel) * kc[:, :, None])
        o = jnp.einsum('bhts,bhsv->bhtv', att, vc) + jnp.einsum('bhtk,bhkv->bhtv', qc * jnp.exp(bc), S)
        last = bc[:, :, -1:]
        S_new = jnp.exp(last[:, :, 0])[..., None] * S + jnp.einsum('bhsk,bhsv->bhkv', kc * jnp.exp(last - bc), vc)
        return S_new, o

    xs = tuple(to_chunks(t, size) for t in (q, v, k, lf))
    S, o = lax.scan(step, S, xs)
    return from_chunks(o), S


def hgrn2_prep(parts, lb):
    q, f, i, _ = parts
    b, n, _ = q.shape
    f32 = jnp.float32
    qh = to_heads(jax.nn.silu(q.astype(f32)), HG_HEADS)
    vh = to_heads(i.astype(f32), HG_HEADS)
    log_lb = jnp.log(jnp.maximum(lb, LB_FLOOR))
    logf = jnp.logaddexp(log_lb, jnp.log1p(-lb) + jax.nn.log_sigmoid(f.astype(f32)))
    logf = logf.reshape(b, n, 2, HG_HEADS, HG_DK).transpose(0, 2, 3, 1, 4)
    kk = -jnp.expm1(logf)
    return (qh, vh), ((kk[:, 0], logf[:, 0]), (kk[:, 1], logf[:, 1]))


def hgrn2_mixer(pc, px, lb, gain, with_ctx):
    sc, dc = hgrn2_prep(pc, lb)
    sx, dx = hgrn2_prep(px, lb)
    b = sx[0].shape[0]
    state0 = jnp.zeros((b, HG_HEADS, HG_DK, HG_DV), jnp.float32)
    oc, ox = prefix_bidirectional(hgrn2_scan, sc, dc, sx, dx, state0)

    def finish(o, g):
        y = from_heads(head_rmsnorm(o, gain)) * jax.nn.silu(g.astype(jnp.float32))
        return y.astype(g.dtype)

    yc = finish(oc, pc[3]) if with_ctx else None
    return yc, finish(ox, px[3])


def axial_angles(n, d):
    rows = n // GRID_W
    row = jnp.repeat(jnp.arange(rows), GRID_W).astype(jnp.float32)
    col = jnp.tile(jnp.arange(GRID_W), rows).astype(jnp.float32)
    half = d // 2
    inv = ROPE_BASE ** (-jnp.arange(0, half, 2, dtype=jnp.float32) / half)
    return row[:, None] * inv, col[:, None] * inv


def rope_half(x, ang):
    x1, x2 = jnp.split(x.astype(jnp.float32), 2, axis=-1)
    c, s = jnp.cos(ang), jnp.sin(ang)
    return jnp.concatenate([x1 * c - x2 * s, x1 * s + x2 * c], axis=-1)


def axial_rope(x, ang_r, ang_c):
    xr, xc = jnp.split(x, 2, axis=-1)
    return jnp.concatenate([rope_half(xr, ang_r), rope_half(xc, ang_c)], axis=-1).astype(x.dtype)


def diff_heads(t):
    b, n, _ = t.shape
    return t.reshape(b, n, DA_HEADS, 2, DA_HD).transpose(0, 2, 3, 1, 4)


def diff_attn(q, k, v, lam):
    s = jnp.einsum('bhjqd,bhjkd->bhjqk', q, k).astype(jnp.float32) * (DA_HD ** -0.5)
    p = jax.nn.softmax(s, axis=-1)
    a = p[:, :, 0] - lam * p[:, :, 1]
    return jnp.einsum('bhqk,bhkv->bhqv', a.astype(v.dtype), v)


def blocked_diff_attn(q, k, v, lam):
    b, h, _, n, d = q.shape
    qb = jnp.moveaxis(q.reshape(b, h, 2, n // Q_BLOCK, Q_BLOCK, d), 3, 0)
    ob = lax.map(lambda qq: diff_attn(qq, k, v, lam), qb)
    return jnp.moveaxis(ob, 0, 2).reshape(b, h, n, -1)


def diff_mixer(pc, px, lam_vec, gain, lam_init, ang_r, ang_c, with_ctx):
    qc, kc, vc = diff_heads(pc[0]), diff_heads(pc[1]), to_heads(pc[2], DA_HEADS)
    qx = axial_rope(diff_heads(px[0]), ang_r, ang_c)
    kx = axial_rope(diff_heads(px[1]), ang_r, ang_c)
    vx = to_heads(px[2], DA_HEADS)
    lv = lam_vec.astype(jnp.float32)
    lam = jnp.exp(jnp.sum(lv[0] * lv[1])) - jnp.exp(jnp.sum(lv[2] * lv[3])) + lam_init
    k_all = jnp.concatenate([kc, kx], axis=3)
    v_all = jnp.concatenate([vc, vx], axis=2)
    ox = blocked_diff_attn(qx, k_all, v_all, lam)

    def finish(o, dt):
        return (from_heads(head_rmsnorm(o.astype(jnp.float32), gain)) * (1.0 - lam_init)).astype(dt)

    yc = finish(diff_attn(qc, kc, vc, lam), pc[2].dtype) if with_ctx else None
    return yc, finish(ox, px[2].dtype)


def token_mixer(hc, hx, w_in, b_in, w_out, ml_fb, ml_g, lb, hg_g, da_lam, da_g, lam_init, ang_r, ang_c, with_ctx):
    pc = split_cols(hc @ w_in + b_in)
    px = split_cols(hx @ w_in + b_in)
    mc, mx = mlstm_mixer(pc[0:6], px[0:6], ml_fb, ml_g, with_ctx)
    gc, gx = hgrn2_mixer(pc[6:10], px[6:10], lb, hg_g, with_ctx)
    ac, ax = diff_mixer(pc[10:13], px[10:13], da_lam, da_g, lam_init, ang_r, ang_c, with_ctx)
    yx = jnp.concatenate([mx, gx, ax], axis=-1) @ w_out
    yc = jnp.concatenate([mc, gc, ac], axis=-1) @ w_out if with_ctx else None
    return yc, yx


def swiglu(h, wg, wu, wd):
    return (jax.nn.silu(h @ wg) * (h @ wu)) @ wd


def setup_inputs(seed: int = 0) -> dict:
    key = jax.random.key(seed)
    ks = jax.random.split(key, 24)
    f32 = jnp.float32
    L = DEPTH
    D = D_MODEL

    def nrm(k, shape, s):
        return s * jax.random.normal(k, shape, f32)

    return {
        'x': nrm(ks[0], (BATCH, SEQ, D), 1.0),
        'c': nrm(ks[1], (BATCH, D), 1.0),
        'ctx': nrm(ks[2], (BATCH, CTX_LEN, D), 1.0),
        'c_ctx': nrm(ks[3], (D,), 1.0),
        'w_ada': nrm(ks[4], (L, D, 6 * D), 0.5 * D ** -0.5),
        'b_ada': nrm(ks[5], (L, 6 * D), 0.02),
        'g_pre_mix': 1.0 + nrm(ks[6], (L, D), 0.1),
        'g_post_mix': 1.0 + nrm(ks[7], (L, D), 0.1),
        'g_pre_ffn': 1.0 + nrm(ks[8], (L, D), 0.1),
        'g_post_ffn': 1.0 + nrm(ks[9], (L, D), 0.1),
        'w_in': nrm(ks[10], (L, D, D_IN), D ** -0.5),
        'b_in': nrm(ks[11], (L, D_IN), 0.02),
        'w_out': nrm(ks[12], (L, D_MIX, D), D_MIX ** -0.5),
        'ml_f_bias': jnp.linspace(3.0, 6.0, 2 * ML_HEADS, dtype=f32)[None] + nrm(ks[13], (L, 2 * ML_HEADS), 0.1),
        'ml_norm': 1.0 + nrm(ks[14], (L, ML_W), 0.1),
        'hg_lb': nrm(ks[15], (L, 2 * HG_FW), 1.0),
        'hg_norm': 1.0 + nrm(ks[16], (L, HG_W), 0.1),
        'da_lambda': nrm(ks[17], (L, 4, DA_HD), 0.1),
        'da_norm': 1.0 + nrm(ks[18], (L, DA_VD), 0.1),
        'w_ffn_gate': nrm(ks[19], (L, D, D_FF), D ** -0.5),
        'w_ffn_up': nrm(ks[20], (L, D, D_FF), D ** -0.5),
        'w_ffn_down': nrm(ks[21], (L, D_FF, D), D_FF ** -0.5),
    }


def reference(x, c, ctx, c_ctx, w_ada, b_ada, g_pre_mix, g_post_mix, g_pre_ffn, g_post_ffn,
              w_in, b_in, w_out, ml_f_bias, ml_norm, hg_lb, hg_norm, da_lambda, da_norm,
              w_ffn_gate, w_ffn_up, w_ffn_down):
    n = x.shape[1]
    ang_r, ang_c = axial_angles(n, DA_HD)
    sm = jax.nn.softmax(hg_lb.astype(jnp.float32), axis=0)
    lbs = jnp.cumsum(sm, axis=0) - sm[0:1]
    sc_ = jax.nn.silu(c)
    scc = jax.nn.silu(c_ctx)
    for l in range(DEPTH):
        with_ctx = l < DEPTH - 1
        lam_init = 0.8 - 0.6 * math.exp(-0.3 * l)
        mx_ = (sc_ @ w_ada[l] + b_ada[l])[:, None, :]
        mc_ = scc @ w_ada[l] + b_ada[l]
        sx1, ax1, gx1, sx2, ax2, gx2 = jnp.split(mx_, 6, axis=-1)
        sc1, ac1, gc1, sc2, ac2, gc2 = jnp.split(mc_, 6, axis=-1)
        hx = rmsnorm(x, g_pre_mix[l]) * (1.0 + ax1) + sx1
        hc = rmsnorm(ctx, g_pre_mix[l]) * (1.0 + ac1) + sc1
        yc, yx = token_mixer(hc, hx, w_in[l], b_in[l], w_out[l], ml_f_bias[l], ml_norm[l], lbs[l],
                             hg_norm[l], da_lambda[l], da_norm[l], lam_init, ang_r, ang_c, with_ctx)
        x = x + gx1 * rmsnorm(yx, g_post_mix[l])
        hx = rmsnorm(x, g_pre_ffn[l]) * (1.0 + ax2) + sx2
        x = x + gx2 * rmsnorm(swiglu(hx, w_ffn_gate[l], w_ffn_up[l], w_ffn_down[l]), g_post_ffn[l])
        if with_ctx:
            ctx = ctx + gc1 * rmsnorm(yc, g_post_mix[l])
            hcf = rmsnorm(ctx, g_pre_ffn[l]) * (1.0 + ac2) + sc2
            ctx = ctx + gc2 * rmsnorm(swiglu(hcf, w_ffn_gate[l], w_ffn_up[l], w_ffn_down[l]), g_post_ffn[l])
    return x
```

```cpp
#include <hip/hip_runtime.h>
#include <cstdio>
#include <cstdint>
#ifndef MK_PER_PHASE
#define MK_PER_PHASE 1
#endif
namespace pg8 {
#define PG8_LAS __attribute__((address_space(3)))
typedef unsigned short bf16_t;
typedef short bf16x8 __attribute__((ext_vector_type(8)));
typedef float f32x4 __attribute__((ext_vector_type(4)));
typedef unsigned u32x4 __attribute__((ext_vector_type(4)));
constexpr int BM = 256, BK = 64, HALF = 128, HTB = HALF * BK * 2  , STAGE_BYTES = 8 * HTB, NXCD = 8, WGM = 8;

__host__ __device__ __forceinline__ int lds_byte(int r, int c) { const int st = (r >> 4) * 2 + (c >> 5), rr = r & 15, cc = c & 31, ob = rr * 64 + cc * 2; return st * 1024 + (ob ^ (((ob >> 9) & 1) << 5)); }
__host__ __device__ __forceinline__ void stage_rc(int b, int& R, int& C) { const int st = b / 1024, sb = b % 1024, swz = sb ^ (((sb >> 9) & 1) << 5); R = (st >> 1) * 16 + swz / 64; C = (st & 1) * 32 + (swz % 64) / 2; }
__host__ __device__ __forceinline__ int perm32(int rho) { const int n = rho >> 4, i = rho & 15; return 8 * (i >> 2) + 4 * n + (i & 3); }

struct Unit { int pm, pn; };
struct Gemm { const bf16_t* A; const bf16_t* Bt; int M, N, K; };

struct StaticOrder {
    int nM, nN, nwg, G, c;
    __host__ __device__ void init(int M, int N, int G_, int c_) { nM = M / BM; nN = N / BM; nwg = nM * nN; G = G_; c = c_; }
    __host__ __device__ bool next(int i, Unit& u) const {
        const long L = (long)i * G + c; if (L >= nwg) return false;
        int wgid = (int)L; { const int q = nwg / NXCD, r = nwg % NXCD, xcd = wgid % NXCD, off = wgid / NXCD; wgid = (xcd < r ? xcd * (q + 1) : r * (q + 1) + (xcd - r) * q) + off; }
        const int nig = WGM * nN, gid = wgid / nig, fm = gid * WGM, gsz = (nM - fm) < WGM ? (nM - fm) : WGM;
        u.pm = fm + ((wgid % nig) % gsz); u.pn = (wgid % nig) / gsz; return true;
    }
    __device__ __forceinline__ void a_ready(const Unit&) const {}
    __device__ __forceinline__ void done(const Unit&) const {}
};
__device__ __forceinline__ unsigned cvt_pk_bf16(float lo, float hi) { unsigned r; asm volatile("v_cvt_pk_bf16_f32 %0, %1, %2" : "=v"(r) : "v"(lo), "v"(hi)); return r; }
struct EpiF32 {
    static constexpr bool PERM = false, AFTER_DRAIN = false;
    float* C; int ldc;
    __device__ __forceinline__ void operator()(const f32x4 (&acc)[2][2][4][2], const Unit& u, int wr, int wc, int fr, int fq) const {
        const int row0 = u.pm * BM + wr * 64 + fr, col0 = u.pn * BM + wc * 32 + 4 * fq;
#pragma unroll
        for (int ai = 0; ai < 2; ++ai)
#pragma unroll
            for (int m = 0; m < 4; ++m) { float* rowp = C + (size_t)(row0 + ai * HALF + m * 16) * ldc + col0;
#pragma unroll
                for (int bj = 0; bj < 2; ++bj)
#pragma unroll
                    for (int n = 0; n < 2; ++n) *(f32x4*)(rowp + bj * HALF + n * 16) = acc[ai][bj][m][n]; }
    }
};
struct EpiIn {
    static constexpr bool PERM = true, AFTER_DRAIN = false;
    bf16_t* O; int ldc; const float* bias; float* G;
    __device__ __forceinline__ void operator()(const f32x4 (&acc)[2][2][4][2], const Unit& u, int wr, int wc, int fr, int fq) const {
        const int row0 = u.pm * BM + wr * 64 + fr; const int col0 = u.pn * BM + wc * 32 + 8 * fq;
        f32x4 bv[2][2];
#pragma unroll
        for (int bj = 0; bj < 2; ++bj)
#pragma unroll
            for (int n = 0; n < 2; ++n) bv[bj][n] = *(const f32x4*)(bias + col0 + bj * HALF + 4 * n);
        const bool gate_lane = (u.pn == 6) && (wc == 0) && (fq < 2);
#pragma unroll
        for (int ai = 0; ai < 2; ++ai)
#pragma unroll
            for (int m = 0; m < 4; ++m) { const int row = row0 + ai * HALF + m * 16; bf16_t* rowp = O + (size_t)row * ldc + col0;
#pragma unroll
                for (int bj = 0; bj < 2; ++bj) { const f32x4 v0 = acc[ai][bj][m][0] + bv[bj][0], v1 = acc[ai][bj][m][1] + bv[bj][1];
                    u32x4 w; w.x = cvt_pk_bf16(v0[0], v0[1]); w.y = cvt_pk_bf16(v0[2], v0[3]); w.z = cvt_pk_bf16(v1[0], v1[1]); w.w = cvt_pk_bf16(v1[2], v1[3]);
                    *(u32x4*)(rowp + bj * HALF) = w;
                    if (bj == 0 && gate_lane) { float* g = G + (size_t)row * 16 + 8 * fq; *(f32x4*)g = v0; *(f32x4*)(g + 4) = v1; } } }
    }
};
struct EpiSwiglu {
    static constexpr bool PERM = true, AFTER_DRAIN = false;
    bf16_t* O; int ldc;
    __device__ __forceinline__ void operator()(const f32x4 (&acc)[2][2][4][2], const Unit& u, int wr, int wc, int fr, int fq) const {
        const int row0 = u.pm * BM + wr * 64 + fr; const int col0 = u.pn * HALF + wc * 32 + 8 * fq;
#pragma unroll
        for (int ai = 0; ai < 2; ++ai)
#pragma unroll
            for (int m = 0; m < 4; ++m) { bf16_t* rowp = O + (size_t)(row0 + ai * HALF + m * 16) * ldc + col0;
                f32x4 r0, r1;
#pragma unroll
                for (int i = 0; i < 4; ++i) { const float g0 = acc[ai][0][m][0][i], g1 = acc[ai][0][m][1][i];
                    r0[i] = g0 * __builtin_amdgcn_rcpf(1.0f + __expf(-g0)) * acc[ai][1][m][0][i];
                    r1[i] = g1 * __builtin_amdgcn_rcpf(1.0f + __expf(-g1)) * acc[ai][1][m][1][i]; }
                u32x4 w; w.x = cvt_pk_bf16(r0[0], r0[1]); w.y = cvt_pk_bf16(r0[2], r0[3]); w.z = cvt_pk_bf16(r1[0], r1[1]); w.w = cvt_pk_bf16(r1[2], r1[3]);
                *(u32x4*)rowp = w; }
    }
};
template <class Epi, class Sched, bool ALIGN_EPI = false, bool SP2 = false>
__device__ __forceinline__ void gemm_phase(PG8_LAS unsigned char* lds, const Gemm g, const Sched& S, const Epi& E) {
    int tid_ = threadIdx.x; asm volatile("" : "+v"(tid_));
    const int tid = tid_, wid = __builtin_amdgcn_readfirstlane(tid >> 6), lane = tid & 63, wr = wid >> 2, wc = wid & 3, fr = lane & 15, fq = lane >> 4;
    const int K = g.K, nt = K / BK;
    unsigned voffA[2], voffB[2];
#pragma unroll
    for (int i = 0; i < 2; ++i) { int R, C; stage_rc(tid * 16 + i * 8192, R, C); const int Rb = Epi::PERM ? ((R & ~31) + perm32(R & 31)) : R;
        voffA[i] = (unsigned)(R * K + C) * 2u; voffB[i] = (unsigned)(Rb * K + C) * 2u; }
    const size_t kstep = (size_t)(BK * 2);
    const size_t hstep = (size_t)HALF * K * 2;
    const size_t tstep = 2 * hstep;
    const unsigned ldsw = (unsigned)wid * 1024u;
    const int aoff = lds_byte(wr * 64 + fr, fq * 8), boff = lds_byte(wc * 32 + fr, fq * 8);
#define PG8_SA(b, h) (((b) * 2 + (h)) * HTB)
#define PG8_SB(b, h) ((4 + (b) * 2 + (h)) * HTB)
#define PG8_STAGE(bufoff, gbase, voff) do { _Pragma("unroll") for (int _i = 0; _i < 2; ++_i) \
        __builtin_amdgcn_global_load_lds((const unsigned*)((const char*)(gbase) + (voff)[_i]), (PG8_LAS unsigned*)(lds + (bufoff) + ldsw + _i * 8192), 16, 0, 0); } while (0)
#define PG8_LDA(dst, b, h) do { _Pragma("unroll") for (int m = 0; m < 4; ++m) _Pragma("unroll") for (int k = 0; k < 2; ++k) dst[m][k] = *(const PG8_LAS bf16x8*)(lds + PG8_SA(b, h) + aoff + m * 2048 + k * 1024); } while (0)
#define PG8_LDB(dst, b, h) do { _Pragma("unroll") for (int n = 0; n < 2; ++n) _Pragma("unroll") for (int k = 0; k < 2; ++k) dst[n][k] = *(const PG8_LAS bf16x8*)(lds + PG8_SB(b, h) + boff + n * 2048 + k * 1024); } while (0)
#define PG8_MMA(ai, bj, At, Bt) do { __builtin_amdgcn_s_setprio(1); _Pragma("unroll") for (int m = 0; m < 4; ++m) _Pragma("unroll") for (int n = 0; n < 2; ++n) _Pragma("unroll") for (int k = 0; k < 2; ++k) \
        acc[ai][bj][m][n] = __builtin_amdgcn_mfma_f32_16x16x32_bf16(Bt[n][k], At[m][k], acc[ai][bj][m][n], 0, 0, 0); __builtin_amdgcn_s_setprio(0); } while (0)
#define PG8_WAIT_V(n) asm volatile("s_waitcnt vmcnt(" #n ")" ::: "memory")
#define PG8_WAIT_L(n) asm volatile("s_waitcnt lgkmcnt(" #n ")" ::: "memory")
#define PG8_BAR __builtin_amdgcn_s_barrier()
#define PG8_SCHED __builtin_amdgcn_sched_barrier(0)
    Unit cur, nxt; int ui = 0;
    if (!S.next(0, cur)) return;
    f32x4 acc[2][2][4][2];
#pragma unroll
    for (int a = 0; a < 2; ++a)
#pragma unroll
        for (int b = 0; b < 2; ++b)
#pragma unroll
            for (int m = 0; m < 4; ++m)
#pragma unroll
                for (int n = 0; n < 2; ++n) acc[a][b][m][n] = (f32x4){0.f, 0.f, 0.f, 0.f};
    bf16x8 At[4][2], B0[2][2], B1[2][2];
    const char* cA = (const char*)g.A + (size_t)cur.pm * tstep; const char* cB = (const char*)g.Bt + (size_t)cur.pn * tstep;
    S.a_ready(cur);
    if constexpr (SP2) {
        PG8_STAGE(PG8_SB(0, 0), cB, voffB); PG8_STAGE(PG8_SB(0, 1), cB + hstep, voffB); PG8_STAGE(PG8_SA(0, 0), cA, voffA); PG8_STAGE(PG8_SA(0, 1), cA + hstep, voffA);
        if (wr == 1) PG8_BAR;
        PG8_WAIT_V(2); PG8_BAR;
        PG8_STAGE(PG8_SB(1, 0), cB + kstep, voffB); PG8_STAGE(PG8_SA(1, 0), cA + kstep, voffA); PG8_STAGE(PG8_SB(1, 1), cB + hstep + kstep, voffB);
        PG8_WAIT_V(6); PG8_BAR;
    } else {
        PG8_STAGE(PG8_SB(0, 0), cB, voffB); PG8_STAGE(PG8_SA(0, 0), cA, voffA); PG8_STAGE(PG8_SB(0, 1), cB + hstep, voffB); PG8_STAGE(PG8_SA(0, 1), cA + hstep, voffA);
        if (wr == 1) PG8_BAR;
        PG8_WAIT_V(4); PG8_BAR;
        PG8_STAGE(PG8_SB(1, 0), cB + kstep, voffB); PG8_STAGE(PG8_SA(1, 0), cA + kstep, voffA); PG8_STAGE(PG8_SB(1, 1), cB + hstep + kstep, voffB);
        PG8_WAIT_V(6); PG8_BAR;
    }
    for (;;) {
        const bool has_next = S.next(ui + 1, nxt);
        const char* nA = has_next ? (const char*)g.A + (size_t)nxt.pm * tstep : cA; const char* nB = has_next ? (const char*)g.Bt + (size_t)nxt.pn * tstep : cB;
        for (int t = 0; t < nt; t += 2) {
            const bool last = (t == nt - 2);
            const char* a1 = cA + (size_t)(t + 1) * kstep;
            const char* a2 = last ? nA : cA + (size_t)(t + 2) * kstep; const char* b2 = last ? nB : cB + (size_t)(t + 2) * kstep;
            const char* a3 = a2 + kstep; const char* b3 = b2 + kstep;
            if (last && has_next) S.a_ready(nxt);
            if constexpr (SP2) {
            PG8_LDB(B0, 0, 0); PG8_LDB(B1, 0, 1); PG8_SCHED; PG8_LDA(At, 0, 0); PG8_STAGE(PG8_SA(1, 1), a1 + hstep, voffA);
            PG8_WAIT_V(8); PG8_WAIT_L(0); PG8_BAR; PG8_MMA(0, 0, At, B0); PG8_MMA(0, 1, At, B1); PG8_BAR; PG8_SCHED;
            PG8_LDA(At, 0, 1); PG8_STAGE(PG8_SB(0, 0), b2, voffB); PG8_STAGE(PG8_SB(0, 1), b2 + hstep, voffB); PG8_STAGE(PG8_SA(0, 0), a2, voffA);
            PG8_WAIT_V(8); PG8_WAIT_L(0); PG8_BAR; PG8_MMA(1, 0, At, B0); PG8_MMA(1, 1, At, B1); PG8_BAR; PG8_SCHED;
            PG8_LDB(B0, 1, 0); PG8_LDB(B1, 1, 1); PG8_SCHED; PG8_LDA(At, 1, 0); PG8_STAGE(PG8_SA(0, 1), a2 + hstep, voffA);
            PG8_WAIT_V(8); PG8_WAIT_L(0); PG8_BAR; PG8_MMA(0, 0, At, B0); PG8_MMA(0, 1, At, B1); PG8_BAR; PG8_SCHED;
            PG8_LDA(At, 1, 1); PG8_STAGE(PG8_SB(1, 0), b3, voffB); PG8_STAGE(PG8_SB(1, 1), b3 + hstep, voffB); PG8_STAGE(PG8_SA(1, 0), a3, voffA);
            PG8_WAIT_V(8); PG8_WAIT_L(0); PG8_BAR; PG8_MMA(1, 0, At, B0); PG8_MMA(1, 1, At, B1); PG8_BAR; PG8_SCHED;
            } else {
            PG8_LDB(B0, 0, 0); PG8_SCHED; PG8_LDA(At, 0, 0); PG8_STAGE(PG8_SA(1, 1), a1 + hstep, voffA);
            PG8_WAIT_L(8); PG8_BAR; PG8_WAIT_L(0); PG8_MMA(0, 0, At, B0); PG8_BAR; PG8_SCHED;
            PG8_LDB(B1, 0, 1); PG8_STAGE(PG8_SB(0, 0), b2, voffB);
            PG8_BAR; PG8_WAIT_L(0); PG8_MMA(0, 1, At, B1); PG8_BAR;
            PG8_LDA(At, 0, 1); PG8_STAGE(PG8_SA(0, 0), a2, voffA);
            PG8_BAR; PG8_WAIT_L(0); PG8_MMA(1, 0, At, B0); PG8_BAR; PG8_SCHED;
            PG8_STAGE(PG8_SB(0, 1), b2 + hstep, voffB);
            PG8_WAIT_V(6); PG8_BAR; PG8_MMA(1, 1, At, B1); PG8_BAR;
            PG8_LDB(B0, 1, 0); PG8_SCHED; PG8_LDA(At, 1, 0); PG8_STAGE(PG8_SA(0, 1), a2 + hstep, voffA);
            PG8_WAIT_L(8); PG8_BAR; PG8_WAIT_L(0); PG8_MMA(0, 0, At, B0); PG8_BAR; PG8_SCHED;
            PG8_LDB(B1, 1, 1); PG8_STAGE(PG8_SB(1, 0), b3, voffB);
            PG8_BAR; PG8_WAIT_L(0); PG8_MMA(0, 1, At, B1); PG8_BAR;
            PG8_LDA(At, 1, 1); PG8_STAGE(PG8_SA(1, 0), a3, voffA);
            PG8_BAR; PG8_WAIT_L(0); PG8_MMA(1, 0, At, B0); PG8_BAR; PG8_SCHED;
            PG8_STAGE(PG8_SB(1, 1), b3 + hstep, voffB);
            PG8_WAIT_V(6); PG8_BAR; PG8_MMA(1, 1, At, B1); PG8_BAR;
            }
        }
        if constexpr (ALIGN_EPI) { if (wr == 0) PG8_BAR; }
        if constexpr (!Epi::AFTER_DRAIN) { E(acc, cur, wr, wc, fr, fq); S.done(cur); }
        if (!has_next) break;
#pragma unroll
        for (int a = 0; a < 2; ++a)
#pragma unroll
            for (int b = 0; b < 2; ++b)
#pragma unroll
                for (int m = 0; m < 4; ++m)
#pragma unroll
                    for (int n = 0; n < 2; ++n) acc[a][b][m][n] = (f32x4){0.f, 0.f, 0.f, 0.f};
        cur = nxt; cA = nA; cB = nB; ++ui;
        if constexpr (ALIGN_EPI) { if (wr == 1) PG8_BAR; }
    }
    PG8_WAIT_V(0);
    if constexpr (!ALIGN_EPI) { if (wr == 0) PG8_BAR; }
    PG8_BAR;
    if constexpr (Epi::AFTER_DRAIN) { E.fused(acc, cur, wr, wc, fr, fq, lds, wid, lane); S.done(cur); }
#undef PG8_SA
#undef PG8_SB
#undef PG8_STAGE
#undef PG8_LDA
#undef PG8_LDB
#undef PG8_MMA
#undef PG8_WAIT_V
#undef PG8_WAIT_L
#undef PG8_BAR
#undef PG8_SCHED
}
}
constexpr int D = 1024, NB = 16, SEQ = 2048, CTXL = 256, DEPTH = 4;
constexpr int MC = NB * CTXL, ML = NB * SEQ, MT = MC + ML;
constexpr int DIN = 4752, DINP = 4864, DFF = 2816, NGU = 2 * DFF, NMOD = 6 * D;
constexpr int C_MLQ = 0, C_MLK = 384, C_MLV = 768, C_MLO = 1152, C_MLI = 1536, C_MLF = 1544, C_HGQ = 1552, C_HGF = 2064, C_HGI = 3088, C_HGG = 3344, C_DAQ = 3600, C_DAK = 3984, C_DAV = 4368;
constexpr int Y_ML = 0, Y_HG = 384, Y_DA = 640;
constexpr float EPS = 1e-6f;
constexpr int NTOK = CTXL + SEQ;
static_assert(C_MLI == 6 * 256, "gate columns must open GEMM tile 6");

constexpr size_t MiB = 1u << 20;
constexpr size_t WS_CTL = 0, CTL_ZERO_BYTES = 1 * MiB;
constexpr size_t WS_MOD = 1 * MiB;
constexpr size_t WS_MISC = 3 * MiB;
constexpr size_t WS_GATE = 4 * MiB;
constexpr size_t WS_WIN = 8 * MiB, WS_WOUT = WS_WIN + (size_t)DINP * D * 2, WS_WGU = WS_WOUT + (size_t)D * D * 2, WS_WD = WS_WGU + (size_t)NGU * D * 2;
constexpr size_t WS_CTXX = 36 * MiB;
constexpr size_t WS_HB = 52 * MiB;
constexpr size_t WS_RAWM = 124 * MiB, WS_RAWH = 151 * MiB;
constexpr size_t WS_P = 169 * MiB;
constexpr size_t WS_YD = WS_P + 198 * MiB, WS_END = 511 * MiB;
static_assert(WS_WD + (size_t)D * DFF * 2 <= WS_CTXX, "weights fit");
static_assert(WS_RAWM + (size_t)64 * NTOK * 96 * 2 <= WS_RAWH && WS_RAWH + (size_t)64 * NTOK * 64 * 2 <= WS_P, "raw fits");
static_assert(WS_P + (size_t)MT * DINP * 2 <= WS_END && WS_YD + (size_t)MT * D * 4 <= WS_END && (size_t)MT * DFF * 2 <= 198 * MiB, "P region");
constexpr int CW_BAR = 4096;
constexpr int CW_Q = 16384;

constexpr int RING_BYTES = 131072, LDSCTL_OFF = RING_BYTES, LDS_BYTES = 147456;
constexpr int NWAVES = 8, NTHR = 512;

#define GAS __attribute__((address_space(1)))
#define LAS __attribute__((address_space(3)))
typedef unsigned short bf16;
typedef unsigned v4u __attribute__((ext_vector_type(4)));
typedef unsigned v2u __attribute__((ext_vector_type(2)));
typedef float f32x4 __attribute__((ext_vector_type(4)));
typedef float f32x16 __attribute__((ext_vector_type(16)));
typedef short bf16x8 __attribute__((ext_vector_type(8)));
typedef GAS unsigned gu32;
typedef LAS unsigned char* lptr;
#define RLX_AGENT __ATOMIC_RELAXED, __HIP_MEMORY_SCOPE_AGENT
#define LDS_WAIT() asm volatile("s_waitcnt lgkmcnt(0)" ::: "memory")
#define VM_WAIT() asm volatile("s_waitcnt vmcnt(0)" ::: "memory")
__device__ __forceinline__ unsigned f2bf(float f) { unsigned u = __builtin_bit_cast(unsigned, f); return (u + 0x7fffu + ((u >> 16) & 1u)) >> 16; }
__device__ __forceinline__ unsigned pk2(float lo, float hi) { return f2bf(lo) | (f2bf(hi) << 16); }
__device__ __forceinline__ float bflo(unsigned w) { return __builtin_bit_cast(float, w << 16); }
__device__ __forceinline__ float bfhi(unsigned w) { return __builtin_bit_cast(float, w & 0xffff0000u); }
__device__ __forceinline__ float bf2f(bf16 v) { return __builtin_bit_cast(float, (unsigned)v << 16); }
__device__ __forceinline__ float wave_sum(float v) {
#pragma unroll
    for (int o = 1; o < 64; o <<= 1) v += __shfl_xor(v, o);
    return v;
}
#define MFMA32(a, b, c) __builtin_amdgcn_mfma_f32_32x32x16_bf16((a), (b), (c), 0, 0, 0)
#define MFMA16(a, b, c) __builtin_amdgcn_mfma_f32_16x16x32_bf16((a), (b), (c), 0, 0, 0)
__device__ __forceinline__ int tid_opaque() { int t = threadIdx.x; asm volatile("" : "+v"(t)); return t; }
__device__ __forceinline__ bf16x8 lds8(lptr p) { return *(const LAS bf16x8*)p; }

#define XB_TMO      128
#define XB_XCNT(j)  (256  + 64 * (j))
#define XB_XSUB(j)  (1280 + 64 * (j))
#define XB_XGEN(j)  (2304 + 64 * (j))
#define XB_TOP      3328
#define XB_TOPGEN   3392
#define XCD_BAR_WORDS 3456
#define XB_SPIN_CAP (1u << 18)

__device__ __forceinline__ unsigned xb_ld(unsigned* p)              { return __hip_atomic_load(p, __ATOMIC_RELAXED, __HIP_MEMORY_SCOPE_AGENT); }
__device__ __forceinline__ unsigned xb_add(unsigned* p, unsigned v) { return __hip_atomic_fetch_add(p, v, __ATOMIC_RELAXED, __HIP_MEMORY_SCOPE_AGENT); }
__device__ __forceinline__ unsigned xb_xcc_id() { return (unsigned)__builtin_amdgcn_s_getreg((3 << 11) | 20) & 0xFu; }
#define XB_SPIN(cond, bar) do { unsigned _sp = 0; while (cond) { __builtin_amdgcn_s_sleep(1); \
    if ((++_sp & 255u) == 0u) { if (xb_ld(&(bar)[XB_TMO])) break; if (_sp > XB_SPIN_CAP) { atomicAdd(&(bar)[XB_TMO], 1u); break; } } } } while (0)

struct XcdBarrier {
    unsigned* bar; unsigned x;
    volatile LAS unsigned* st;
};

__device__ __forceinline__ XcdBarrier xcd_barrier_post(unsigned* bar, volatile LAS unsigned* st) {
    XcdBarrier b; b.bar = bar; b.x = xb_xcc_id(); b.st = st;
    if (threadIdx.x == 0) (void)xb_add(&bar[XB_XCNT(b.x)], 1u);
    return b;
}
__device__ __forceinline__ void xcd_barrier_complete(unsigned* bar, unsigned x, unsigned& nloc, unsigned& nx) {
    const unsigned G = gridDim.x * gridDim.y * gridDim.z;
    unsigned sum, cnt, mine, sp = 0u;
    for (;;) {
        sum = 0u; cnt = 0u; mine = 0u;
#pragma unroll
        for (unsigned j = 0; j < 16; ++j) { const unsigned c = xb_ld(&bar[XB_XCNT(j)]); sum += c; cnt += (c > 0u) ? 1u : 0u; mine = (j == x) ? c : mine; }
        if (sum == G) break;
        __builtin_amdgcn_s_sleep(1);
        if ((++sp & 255u) == 0u) { if (xb_ld(&bar[XB_TMO])) break; if (sp > XB_SPIN_CAP) { atomicAdd(&bar[XB_TMO], 1u); break; } }
    }
    nloc = mine > 0u ? mine : 1u; nx = cnt > 0u ? cnt : 1u;
}

__device__ __forceinline__ void xcd_barrier(const XcdBarrier& b) {
    asm volatile("s_waitcnt vmcnt(0)" ::: "memory");
    __syncthreads();
    if (threadIdx.x == 0) {
        unsigned* bar = b.bar;
        __builtin_amdgcn_s_waitcnt(0);
        unsigned nloc = b.st[0], nx = b.st[1];
        if (nloc == 0u) { xcd_barrier_complete(bar, b.x, nloc, nx); b.st[0] = nloc; b.st[1] = nx; }
        const unsigned old = xb_add(&bar[XB_XSUB(b.x)], 1u);
        const unsigned gen = old / nloc;
        if (old + 1u == (gen + 1u) * nloc) {
            __builtin_amdgcn_fence(__ATOMIC_RELEASE, "agent");
            asm volatile("s_waitcnt vmcnt(0)" ::: "memory");
            const unsigned og = xb_add(&bar[XB_TOP], 1u);
            const unsigned tg = og / nx;
            if (og + 1u == (tg + 1u) * nx) xb_add(&bar[XB_TOPGEN], 1u);
            else XB_SPIN(xb_ld(&bar[XB_TOPGEN]) == tg, bar);
            __builtin_amdgcn_fence(__ATOMIC_ACQUIRE, "agent");
            xb_add(&bar[XB_XGEN(b.x)], 1u);
            asm volatile("s_waitcnt vmcnt(0)" ::: "memory");
        } else {
            XB_SPIN(xb_ld(&bar[XB_XGEN(b.x)]) == gen, bar);
            __builtin_amdgcn_fence(__ATOMIC_ACQUIRE, "agent");
            asm volatile("s_waitcnt vmcnt(0)" ::: "memory");
        }
    }
    __syncthreads();
}


struct Args { const float* in[22]; float* out; unsigned char* ws; int ph_lo, ph_hi; };
enum { I_X = 0, I_C, I_CTX, I_CCTX, I_WADA, I_BADA, I_GPREMIX, I_GPOSTMIX, I_GPREFFN, I_GPOSTFFN, I_WIN, I_BIN, I_WOUT, I_MLFB, I_MLNORM, I_HGLB, I_HGNORM, I_DALAM, I_DANORM, I_WG, I_WU, I_WD };

__device__ __forceinline__ int wg_pull(unsigned* ctr, volatile LAS int* slot) {
    __syncthreads();
    if (threadIdx.x == 0) *slot = (int)__hip_atomic_fetch_add(ctr, 1u, RLX_AGENT);
    __syncthreads();
    return *slot;
}

__device__ __forceinline__ void p0_phase(lptr lds, const Args& a) {
    const int tid = tid_opaque();
    unsigned char* ws = a.ws;
    LAS float* sil = (LAS float*)lds;
    LAS float* part = (LAS float*)(lds + 69632);
    for (int i = tid; i < 17 * D; i += NTHR) { const int bb = i >> 10, k = i & 1023; const float v = bb < 16 ? a.in[I_C][bb * D + k] : a.in[I_CCTX][k]; sil[i] = v / (1.0f + __expf(-v)); }
    __syncthreads();
    float* mod = (float*)(ws + WS_MOD);
    for (int u = blockIdx.x; u < DEPTH * (NMOD / 32); u += gridDim.x) {
        const int l = u / (NMOD / 32), n0 = (u % (NMOD / 32)) * 32, col = tid & 31, ks = tid >> 5;
        const float* w = a.in[I_WADA] + (size_t)l * D * NMOD + (size_t)(ks * 64) * NMOD + n0 + col;
        float acc[17];
#pragma unroll
        for (int bb = 0; bb < 17; ++bb) acc[bb] = 0.f;
        for (int k = 0; k < 64; k += 4) {
            const float w0 = w[(size_t)k * NMOD], w1 = w[(size_t)(k + 1) * NMOD], w2 = w[(size_t)(k + 2) * NMOD], w3 = w[(size_t)(k + 3) * NMOD];
#pragma unroll
            for (int bb = 0; bb < 17; ++bb) { const f32x4 s = *(const LAS f32x4*)(sil + bb * D + ks * 64 + k); acc[bb] += s[0] * w0 + s[1] * w1 + s[2] * w2 + s[3] * w3; }
        }
#pragma unroll
        for (int bb = 0; bb < 17; ++bb) part[(ks * 17 + bb) * 32 + col] = acc[bb];
        __syncthreads();
        for (int i = tid; i < 17 * 32; i += NTHR) { const int bb = i >> 5, cc = i & 31; float s = 0.f;
#pragma unroll
            for (int k2 = 0; k2 < 16; ++k2) s += part[(k2 * 17 + bb) * 32 + cc];
            mod[((size_t)l * 17 + bb) * NMOD + n0 + cc] = s + a.in[I_BADA][l * NMOD + n0 + cc]; }
        __syncthreads();
    }
    const int gt = blockIdx.x * NTHR + tid, GT = gridDim.x * NTHR;
    float* lbs = (float*)(ws + WS_MISC); float* rope = (float*)(ws + WS_MISC + 16384); float* biasp = (float*)(ws + WS_MISC + 32768); float* lamv = (float*)(ws + WS_MISC + 114688);
    for (int j = gt; j < 1024; j += GT) { const float* hl = a.in[I_HGLB];
        const float v0 = hl[j], v1 = hl[1024 + j], v2 = hl[2048 + j], v3 = hl[3072 + j]; const float mx = fmaxf(fmaxf(v0, v1), fmaxf(v2, v3));
        const float e0 = expf(v0 - mx), e1 = expf(v1 - mx), e2 = expf(v2 - mx), e3 = expf(v3 - mx), inv = 1.0f / (e0 + e1 + e2 + e3);
        lbs[j] = 0.f; lbs[1024 + j] = e1 * inv; lbs[2048 + j] = (e1 + e2) * inv; lbs[3072 + j] = (e1 + e2 + e3) * inv; }
    for (int j = gt; j < 64 * 12; j += GT) { const int pos = j / 12, i = j % 12; const float inv = powf(10000.0f, -(float)(2 * i) / 24.0f); const float ang = (float)pos * inv; rope[2 * j] = cosf(ang); rope[2 * j + 1] = sinf(ang); }
    for (int j = gt; j < DEPTH * DINP; j += GT) { const int l = j / DINP, n = j % DINP; biasp[j] = n < DIN ? a.in[I_BIN][l * DIN + n] : 0.f; }
    if (gt < DEPTH) { const float* lv = a.in[I_DALAM] + gt * 4 * 48; float s01 = 0.f, s23 = 0.f;
        for (int d = 0; d < 48; ++d) { s01 += lv[d] * lv[48 + d]; s23 += lv[96 + d] * lv[144 + d]; }
        const float lam_init = 0.8f - 0.6f * expf(-0.3f * (float)gt);
        lamv[gt] = expf(s01) - expf(s23) + lam_init; }
}

template <bool RES, bool NORM>
__device__ __forceinline__ void thin_phase(int row_lo, const float* xs_lat, const float* xs_ctx, float* xd_lat, float* xd_ctx, bool write_x,
                                           const float* y, const float* mod_r, int goff, const float* gpost,
                                           const float* mod_n, int soff, int aoff, const float* gpre, bf16* hout, int vcu, int G) {
    const int tid = tid_opaque(); const int lane = tid & 63, wave = __builtin_amdgcn_readfirstlane(tid >> 6);
    const int gw = vcu * NWAVES + wave, NGW = G * NWAVES;
    const int nrows = MT - row_lo, rpw = (nrows + NGW - 1) / NGW;
    const int rbeg = row_lo + gw * rpw, rend = (rbeg + rpw < MT) ? rbeg + rpw : MT;
    int cur_bb = -1;
    f32x4 gp[4], ga[4], sh[4];
#pragma unroll
    for (int j = 0; j < 4; ++j) { gp[j] = (f32x4){0.f, 0.f, 0.f, 0.f}; ga[j] = gp[j]; sh[j] = gp[j]; }
    for (int r = rbeg; r < rend; ++r) {
        const bool isctx = r < MC; const int bb = isctx ? 16 : (r - MC) / SEQ;
        if (bb != cur_bb) { cur_bb = bb;
#pragma unroll
            for (int j = 0; j < 4; ++j) { const int e = 4 * lane + 256 * j;
                if (RES) gp[j] = *(const f32x4*)(mod_r + (size_t)bb * NMOD + goff + e) * *(const f32x4*)(gpost + e);
                if (NORM) { ga[j] = *(const f32x4*)(gpre + e) * (*(const f32x4*)(mod_n + (size_t)bb * NMOD + aoff + e) + 1.0f); sh[j] = *(const f32x4*)(mod_n + (size_t)bb * NMOD + soff + e); } } }
        const float* xs = isctx ? xs_ctx + (size_t)r * D : xs_lat + (size_t)(r - MC) * D;
        float* xd = isctx ? xd_ctx + (size_t)r * D : xd_lat + (size_t)(r - MC) * D;
        f32x4 v[4];
#pragma unroll
        for (int j = 0; j < 4; ++j) v[j] = *(const f32x4*)(xs + 4 * lane + 256 * j);
        if (RES) { f32x4 yv[4]; float ss = 0.f;
#pragma unroll
            for (int j = 0; j < 4; ++j) { yv[j] = *(const f32x4*)(y + (size_t)r * D + 4 * lane + 256 * j); ss += (yv[j][0] * yv[j][0] + yv[j][1] * yv[j][1]) + (yv[j][2] * yv[j][2] + yv[j][3] * yv[j][3]); }
            const float rs = 1.0f / sqrtf(wave_sum(ss) * (1.0f / D) + EPS);
#pragma unroll
            for (int j = 0; j < 4; ++j) v[j] += gp[j] * yv[j] * rs; }
        if (write_x) {
#pragma unroll
            for (int j = 0; j < 4; ++j) *(f32x4*)(xd + 4 * lane + 256 * j) = v[j]; }
        if (NORM) { float ss = 0.f;
#pragma unroll
            for (int j = 0; j < 4; ++j) ss += (v[j][0] * v[j][0] + v[j][1] * v[j][1]) + (v[j][2] * v[j][2] + v[j][3] * v[j][3]);
            const float rs = 1.0f / sqrtf(wave_sum(ss) * (1.0f / D) + EPS);
#pragma unroll
            for (int j = 0; j < 4; ++j) { const f32x4 h = v[j] * rs * ga[j] + sh[j]; v2u w; w.x = pk2(h[0], h[1]); w.y = pk2(h[2], h[3]); *(v2u*)(hout + (size_t)r * D + 4 * lane + 256 * j) = w; } }
    }
}

template <int MODE>
__device__ __forceinline__ void tr_item(const float* W, int K, int N, int nblk, bf16* WT, LAS float* scr, int item, int lane) {
    const int kb = item / nblk, nb = item % nblk, k0 = 64 * kb, n0 = 32 * nb;
    const int nn = n0 + (lane & 31); const bool ok = nn < N;
#pragma unroll 8
    for (int i = 0; i < 32; ++i) { const int kk = 2 * i + (lane >> 5); scr[kk * 33 + (lane & 31)] = ok ? W[(size_t)(k0 + kk) * N + nn] : 0.f; }
    LDS_WAIT(); asm volatile("" ::: "memory");
    const int c = lane & 7;
#pragma unroll
    for (int j = 0; j < 4; ++j) { const int n = (lane >> 3) + 8 * j; const LAS float* s = scr + (8 * c) * 33 + n;
        v4u o; o.x = pk2(s[0 * 33], s[1 * 33]); o.y = pk2(s[2 * 33], s[3 * 33]); o.z = pk2(s[4 * 33], s[5 * 33]); o.w = pk2(s[6 * 33], s[7 * 33]);
        const int ng = n0 + n; const int drow = MODE == 0 ? ng : ((ng >> 7) * 256 + (ng & 127) + (MODE == 2 ? 128 : 0));
        *(v4u*)(WT + (size_t)drow * K + k0 + 8 * c) = o; }
    LDS_WAIT(); asm volatile("" ::: "memory");
}
__device__ __forceinline__ void convert_weights(lptr lds, const Args& a, int l, int vcu, int G) {
    const int tid = tid_opaque(); const int lane = tid & 63, wave = __builtin_amdgcn_readfirstlane(tid >> 6);
    LAS float* scr = (LAS float*)(lds + wave * 8448);
    const int gw = vcu * NWAVES + wave, NGW = G * NWAVES;
    unsigned char* ws = a.ws;
    constexpr int I_IN = 16 * (DINP / 32), I_OUT = 16 * 32, I_GU = 16 * (DFF / 32), I_DN = (DFF / 64) * 32;
    constexpr int NITEMS = I_IN + I_OUT + 2 * I_GU + I_DN;
    for (int it = gw; it < NITEMS; it += NGW) {
        int r = it;
        if (r < I_IN) { tr_item<0>(a.in[I_WIN] + (size_t)l * D * DIN, D, DIN, DINP / 32, (bf16*)(ws + WS_WIN), scr, r, lane); continue; } r -= I_IN;
        if (r < I_OUT) { tr_item<0>(a.in[I_WOUT] + (size_t)l * D * D, D, D, 32, (bf16*)(ws + WS_WOUT), scr, r, lane); continue; } r -= I_OUT;
        if (r < I_GU) { tr_item<1>(a.in[I_WG] + (size_t)l * D * DFF, D, DFF, DFF / 32, (bf16*)(ws + WS_WGU), scr, r, lane); continue; } r -= I_GU;
        if (r < I_GU) { tr_item<2>(a.in[I_WU] + (size_t)l * D * DFF, D, DFF, DFF / 32, (bf16*)(ws + WS_WGU), scr, r, lane); continue; } r -= I_GU;
        tr_item<0>(a.in[I_WD] + (size_t)l * DFF * D, DFF, D, 32, (bf16*)(ws + WS_WD), scr, r, lane);
    }
}
constexpr int AT_Q = 0, AT_K0 = 53248, AT_KB = 13312, AT_V0 = 79872, AT_VB = 13824, AT_ROPE = 107520;
constexpr float QSCALE = 0.14433756729740643f * 1.4426950408889634f;

__device__ __forceinline__ void rope24(const v4u (&in)[3], v4u (&out)[3], bool rot, const LAS float* tab, float scale) {
    float v[24];
#pragma unroll
    for (int i = 0; i < 3; ++i) { v[8 * i + 0] = bflo(in[i].x); v[8 * i + 1] = bfhi(in[i].x); v[8 * i + 2] = bflo(in[i].y); v[8 * i + 3] = bfhi(in[i].y);
                                  v[8 * i + 4] = bflo(in[i].z); v[8 * i + 5] = bfhi(in[i].z); v[8 * i + 6] = bflo(in[i].w); v[8 * i + 7] = bfhi(in[i].w); }
    if (rot) {
#pragma unroll
        for (int i = 0; i < 12; ++i) { const float c = tab[2 * i], s = tab[2 * i + 1]; const float x1 = v[i], x2 = v[12 + i]; v[i] = x1 * c - x2 * s; v[12 + i] = x1 * s + x2 * c; } }
#pragma unroll
    for (int i = 0; i < 3; ++i) { out[i].x = pk2(v[8 * i + 0] * scale, v[8 * i + 1] * scale); out[i].y = pk2(v[8 * i + 2] * scale, v[8 * i + 3] * scale);
                                  out[i].z = pk2(v[8 * i + 4] * scale, v[8 * i + 5] * scale); out[i].w = pk2(v[8 * i + 6] * scale, v[8 * i + 7] * scale); }
}
__device__ __forceinline__ int swap23(int k) { return (k & ~12) | ((k & 4) << 1) | ((k & 8) >> 1); }

__device__ __forceinline__ void sm_tile(const f32x16& S, float& m, float& l, float& alpha, bf16x8& p0, bf16x8& p1) {
    float mx = S[0];
#pragma unroll
    for (int r = 1; r < 16; ++r) mx = fmaxf(mx, S[r]);
    mx = fmaxf(mx, __shfl_xor(mx, 32));
    const float mn = fmaxf(m, mx);
    alpha = __builtin_amdgcn_exp2f(m - mn); m = mn;
    float p[16]; float ps = 0.f;
#pragma unroll
    for (int r = 0; r < 16; ++r) { p[r] = __builtin_amdgcn_exp2f(S[r] - mn); ps += p[r]; }
    l = l * alpha + ps;
    v4u a, b;
    a.x = pk2(p[0], p[1]); a.y = pk2(p[2], p[3]); a.z = pk2(p[4], p[5]); a.w = pk2(p[6], p[7]);
    b.x = pk2(p[8], p[9]); b.y = pk2(p[10], p[11]); b.z = pk2(p[12], p[13]); b.w = pk2(p[14], p[15]);
    p0 = __builtin_bit_cast(bf16x8, a); p1 = __builtin_bit_cast(bf16x8, b);
}

__device__ __forceinline__ void attn_item(lptr lds, const bf16* P, bf16* YM, const float* rope_g, const float* danorm, float lam, float out_scale, int b, int h, int qb) {
    const int tid = tid_opaque(), lane = tid & 63, r32 = lane & 31, hi = lane >> 5, wave = __builtin_amdgcn_readfirstlane(tid >> 6);
    const bool lat = qb < 8;
    const int qrow0 = lat ? MC + b * SEQ + qb * 256 : b * CTXL;
    const int nt = lat ? 36 : 4;
    LAS float* ropeL = (LAS float*)(lds + AT_ROPE);
    for (int i = tid; i < 64 * 24; i += NTHR) ropeL[i] = rope_g[i];
    __syncthreads();
    for (int it = tid; it < 1024; it += NTHR) {
        const int row = it >> 2, map = (it >> 1) & 1, half = it & 1;
        const bf16* src = P + (size_t)(qrow0 + row) * DINP + C_DAQ + h * 96 + map * 48 + half * 24;
        v4u in[3], out[3];
#pragma unroll
        for (int i = 0; i < 3; ++i) in[i] = *(const v4u*)(src + 8 * i);
        const int t = qb * 256 + row; const int pos = half ? (t & 63) : (t >> 6);
        rope24(in, out, lat, ropeL + (lat ? pos : 0) * 24, QSCALE);
        lptr dst = lds + AT_Q + (row * 104 + map * 48 + half * 24) * 2;
#pragma unroll
        for (int i = 0; i < 3; ++i) *(LAS v4u*)(dst + 16 * i) = out[i];
    }
    v4u kin[3], vin[2];
    const int kkey = tid >> 2, kmap = (tid >> 1) & 1, khalf = tid & 1;
    const int vkey0 = tid / 12, vcc0 = tid % 12, vkey1 = (tid + 512) / 12, vcc1 = (tid + 512) % 12;
#define AT_TILE_ROW0(tile) (((tile) < 4) ? (b * CTXL + 64 * (tile)) : (MC + b * SEQ + 64 * ((tile) - 4)))
#define AT_LOAD(tile) do { const int row0_ = AT_TILE_ROW0(tile); \
        if (tid < 256) { const bf16* s_ = P + (size_t)(row0_ + kkey) * DINP + C_DAK + h * 96 + kmap * 48 + khalf * 24; kin[0] = *(const v4u*)s_; kin[1] = *(const v4u*)(s_ + 8); kin[2] = *(const v4u*)(s_ + 16); \
                         vin[1] = *(const v4u*)(P + (size_t)(row0_ + vkey1) * DINP + C_DAV + h * 96 + vcc1 * 8); } \
        vin[0] = *(const v4u*)(P + (size_t)(row0_ + vkey0) * DINP + C_DAV + h * 96 + vcc0 * 8); } while (0)
#define AT_VPUT(vt, key, cc, VV) do { const int pos_ = swap23(key); LAS bf16* d_ = (LAS bf16*)(vt) + (cc) * 8 * 72 + pos_; const v4u q_ = (VV); \
        d_[0 * 72] = (bf16)(q_.x & 0xffffu); d_[1 * 72] = (bf16)(q_.x >> 16); d_[2 * 72] = (bf16)(q_.y & 0xffffu); d_[3 * 72] = (bf16)(q_.y >> 16); \
        d_[4 * 72] = (bf16)(q_.z & 0xffffu); d_[5 * 72] = (bf16)(q_.z >> 16); d_[6 * 72] = (bf16)(q_.w & 0xffffu); d_[7 * 72] = (bf16)(q_.w >> 16); } while (0)
#define AT_STORE(tile, buf) do { const bool krot_ = (tile) >= 4; \
        if (tid < 256) { const int t_ = 64 * ((tile) - 4) + kkey; const int pos_k = khalf ? (t_ & 63) : (t_ >> 6); v4u o_[3]; rope24(kin, o_, krot_, ropeL + (krot_ ? pos_k : 0) * 24, 1.0f); \
                         lptr d_k = lds + AT_K0 + (buf) * AT_KB + (kkey * 104 + kmap * 48 + khalf * 24) * 2; *(LAS v4u*)d_k = o_[0]; *(LAS v4u*)(d_k + 16) = o_[1]; *(LAS v4u*)(d_k + 32) = o_[2]; \
                         AT_VPUT(lds + AT_V0 + (buf) * AT_VB, vkey1, vcc1, vin[1]); } \
        AT_VPUT(lds + AT_V0 + (buf) * AT_VB, vkey0, vcc0, vin[0]); } while (0)
    AT_LOAD(0); AT_STORE(0, 0);
    __syncthreads();
    bf16x8 qf[2][3];
#pragma unroll
    for (int map = 0; map < 2; ++map)
#pragma unroll
        for (int ks = 0; ks < 3; ++ks) qf[map][ks] = lds8(lds + AT_Q + ((wave * 32 + r32) * 104 + map * 48 + ks * 16 + hi * 8) * 2);
    f32x16 O0[3], O1[3];
#pragma unroll
    for (int ct = 0; ct < 3; ++ct)
#pragma unroll
        for (int r = 0; r < 16; ++r) { O0[ct][r] = 0.f; O1[ct][r] = 0.f; }
    float m0 = -1e30f, m1 = -1e30f, l0 = 0.f, l1 = 0.f;
    for (int i = 0; i < nt; ++i) {
        const int cur = i & 1;
        if (i + 1 < nt) AT_LOAD(i + 1);
        lptr ks_ = lds + AT_K0 + cur * AT_KB, vt_ = lds + AT_V0 + cur * AT_VB;
#pragma unroll 1
        for (int sub = 0; sub < 2; ++sub) {
            f32x16 S0, S1;
#pragma unroll
            for (int r = 0; r < 16; ++r) { S0[r] = 0.f; S1[r] = 0.f; }
#pragma unroll
            for (int ks = 0; ks < 3; ++ks) {
                const bf16x8 k0 = lds8(ks_ + ((sub * 32 + r32) * 104 + ks * 16 + hi * 8) * 2);
                const bf16x8 k1 = lds8(ks_ + ((sub * 32 + r32) * 104 + 48 + ks * 16 + hi * 8) * 2);
                S0 = MFMA32(k0, qf[0][ks], S0); S1 = MFMA32(k1, qf[1][ks], S1);
            }
            float a0, a1; bf16x8 p00, p01, p10, p11;
            sm_tile(S0, m0, l0, a0, p00, p01);
            sm_tile(S1, m1, l1, a1, p10, p11);
#pragma unroll
            for (int ct = 0; ct < 3; ++ct)
#pragma unroll
                for (int r = 0; r < 16; ++r) { O0[ct][r] *= a0; O1[ct][r] *= a1; }
#pragma unroll
            for (int ct = 0; ct < 3; ++ct) {
                const bf16x8 v0 = lds8(vt_ + ((ct * 32 + r32) * 72 + sub * 32 + hi * 8) * 2);
                const bf16x8 v1 = lds8(vt_ + ((ct * 32 + r32) * 72 + sub * 32 + 16 + hi * 8) * 2);
                O0[ct] = MFMA32(v0, p00, O0[ct]); O1[ct] = MFMA32(v0, p10, O1[ct]);
                O0[ct] = MFMA32(v1, p01, O0[ct]); O1[ct] = MFMA32(v1, p11, O1[ct]);
            }
        }
        if (i + 1 < nt) AT_STORE(i + 1, cur ^ 1);
        __syncthreads();
    }
#undef AT_TILE_ROW0
#undef AT_LOAD
#undef AT_VPUT
#undef AT_STORE
    const float i0 = 1.0f / (l0 + __shfl_xor(l0, 32)), i1 = lam / (l1 + __shfl_xor(l1, 32));
    float ss = 0.f;
#pragma unroll
    for (int ct = 0; ct < 3; ++ct)
#pragma unroll
        for (int r = 0; r < 16; ++r) { const float o = O0[ct][r] * i0 - O1[ct][r] * i1; O0[ct][r] = o; ss += o * o; }
    ss += __shfl_xor(ss, 32);
    const float rs = out_scale / sqrtf(ss * (1.0f / 96.0f) + EPS);
    bf16* orow = YM + (size_t)(qrow0 + wave * 32 + r32) * D + Y_DA + h * 96;
#pragma unroll
    for (int ct = 0; ct < 3; ++ct)
#pragma unroll
        for (int g = 0; g < 4; ++g) { const int c0 = 32 * ct + 8 * g + 4 * hi; const f32x4 gn = *(const f32x4*)(danorm + c0);
            v2u w; w.x = pk2(O0[ct][4 * g] * rs * gn[0], O0[ct][4 * g + 1] * rs * gn[1]); w.y = pk2(O0[ct][4 * g + 2] * rs * gn[2], O0[ct][4 * g + 3] * rs * gn[3]);
            *(v2u*)(orow + c0) = w; }
}
__device__ __forceinline__ int scan_row(int b, int dir, int p, int& slot) {
    if (p < CTXL) { const int t = dir ? CTXL - 1 - p : p; slot = t; return b * CTXL + t; }
    const int pl = p - CTXL; const int t = dir ? SEQ - 1 - pl : pl; slot = CTXL + t; return MC + b * SEQ + t;
}

constexpr int ML_Q = 0, ML_K = 13312, ML_KT = 26624, ML_VT = 40448, ML_QKM = 56576, ML_ST = 65792, ML_GF = 89088;
constexpr float KSCALE = 0.10206207261596577f;

__device__ __forceinline__ void mlstm_item(lptr lds, const bf16* P, const float* G, bf16* YM, bf16* RAW, const float* fbias  , const float* gain  , bool with_ctx, int b, int h) {
    const int tid = tid_opaque(), lane = tid & 63, c16 = lane & 15, rg = lane >> 4, wave = __builtin_amdgcn_readfirstlane(tid >> 6);
    LAS bf16* Qs = (LAS bf16*)(lds + ML_Q); LAS bf16* Ks = (LAS bf16*)(lds + ML_K); LAS bf16* KT = (LAS bf16*)(lds + ML_KT); LAS bf16* VT = (LAS bf16*)(lds + ML_VT);
    LAS bf16* QKM = (LAS bf16*)(lds + ML_QKM); LAS bf16* ST = (LAS bf16*)(lds + ML_ST);
    LAS float* gA = (LAS float*)(lds + ML_GF); LAS float* MxA = gA + 64; LAS float* wA = gA + 128; LAS float* emtA = gA + 192; LAS float* wkA = gA + 256; LAS float* scal = gA + 320;
    for (int i = tid; i < 16 * 72; i += NTHR) VT[96 * 72 + i] = (i < 72) ? (bf16)0x3F80 : (bf16)0;
    bf16* rawb = RAW + (size_t)(b * 4 + h) * NTOK * 96;
    for (int dir = 0; dir < 2; ++dir) {
        const float fb = fbias[dir * 4 + h];
        f32x4 acc[11];
#pragma unroll
        for (int i = 0; i < 11; ++i) acc[i] = (f32x4){0.f, 0.f, 0.f, 0.f};
        float m_prev = -1e30f;
        v4u pre[5]; float gi = 0.f, gf = 0.f;
#define ML_PREFETCH(c) do { \
        _Pragma("unroll") for (int i_ = 0; i_ < 5; ++i_) { const int id_ = tid + NTHR * i_; if (id_ < 2304) { const int t_ = id_ / 36, r_ = id_ % 36, wh_ = r_ / 12, cc_ = r_ % 12; int sl_; \
            const int row_ = scan_row(b, dir, 64 * (c) + t_, sl_); pre[i_] = *(const v4u*)(P + (size_t)row_ * DINP + wh_ * 384 + h * 96 + cc_ * 8); } } \
        if (wave == 0) { int sl_; const int row_ = scan_row(b, dir, 64 * (c) + lane, sl_); gi = G[(size_t)row_ * 16 + dir * 4 + h]; gf = G[(size_t)row_ * 16 + 8 + dir * 4 + h]; } } while (0)
        ML_PREFETCH(0);
        for (int c = 0; c < NTOK / 64; ++c) {
#pragma unroll
            for (int i = 0; i < 5; ++i) { const int id = tid + NTHR * i; if (id < 2304) { const int t = id / 36, r = id % 36, wh = r / 12, cc = r % 12;
                if (wh == 0) *(LAS v4u*)(Qs + t * 104 + cc * 8) = pre[i];
                else if (wh == 1) *(LAS v4u*)(Ks + t * 104 + cc * 8) = pre[i];
                else { LAS bf16* d = VT + (cc * 8) * 72 + t; const v4u w = pre[i];
                    d[0 * 72] = (bf16)(w.x & 0xffffu); d[1 * 72] = (bf16)(w.x >> 16); d[2 * 72] = (bf16)(w.y & 0xffffu); d[3 * 72] = (bf16)(w.y >> 16);
                    d[4 * 72] = (bf16)(w.z & 0xffffu); d[5 * 72] = (bf16)(w.z >> 16); d[6 * 72] = (bf16)(w.w & 0xffffu); d[7 * 72] = (bf16)(w.w >> 16); } } }
            if (wave == 0) {
                const float fp = gf + fb;
                const float lf = fminf(fp, 0.f) - log1pf(__expf(-fabsf(fp)));
                float bs = lf;
#pragma unroll
                for (int o = 1; o < 64; o <<= 1) { const float v = __shfl_up(bs, o); if (lane >= o) bs += v; }
                const float g = gi - bs;
                float cm = g;
#pragma unroll
                for (int o = 1; o < 64; o <<= 1) { const float v = __shfl_up(cm, o); if (lane >= o) cm = fmaxf(cm, v); }
                const float Mx = fmaxf(m_prev, cm);
                const float mt = bs + Mx;
                const float blast = __shfl(bs, 63), m_new = __shfl(mt, 63);
                gA[lane] = g; MxA[lane] = Mx; wA[lane] = __expf(m_prev - Mx); emtA[lane] = __expf(-mt); wkA[lane] = __expf(g + blast - m_new) * KSCALE;
                if (lane == 0) scal[0] = __expf(blast + m_prev - m_new);
                m_prev = m_new;
            }
            if (c + 1 < NTOK / 64) ML_PREFETCH(c + 1);
            __syncthreads();
#pragma unroll
            for (int j = 0; j < 2; ++j) { const int idx = 2 * wave + j, ti = idx >> 2, si = idx & 3;
                f32x4 a4 = (f32x4){0.f, 0.f, 0.f, 0.f};
                if (si <= ti) {
#pragma unroll
                    for (int ks = 0; ks < 3; ++ks) a4 = MFMA16(lds8((lptr)(Qs + (16 * ti + c16) * 104 + 32 * ks + 8 * rg)), lds8((lptr)(Ks + (16 * si + c16) * 104 + 32 * ks + 8 * rg)), a4);
                }
                const int s = 16 * si + c16; const float gs = gA[s];
#pragma unroll
                for (int r = 0; r < 4; ++r) { const int t = 16 * ti + 4 * rg + r; const float v = (s <= t) ? a4[r] * KSCALE * __expf(gs - MxA[t]) : 0.f; QKM[t * 72 + s] = (bf16)f2bf(v); } }
            for (int id = tid; id < 64 * 12; id += NTHR) { const int t = id / 12, cc = id % 12; const v4u w = *(const LAS v4u*)(Ks + t * 104 + cc * 8); const float sc = wkA[t]; LAS bf16* d = KT + (cc * 8) * 72 + t;
                d[0 * 72] = (bf16)f2bf(bflo(w.x) * sc); d[1 * 72] = (bf16)f2bf(bfhi(w.x) * sc); d[2 * 72] = (bf16)f2bf(bflo(w.y) * sc); d[3 * 72] = (bf16)f2bf(bfhi(w.y) * sc);
                d[4 * 72] = (bf16)f2bf(bflo(w.z) * sc); d[5 * 72] = (bf16)f2bf(bfhi(w.z) * sc); d[6 * 72] = (bf16)f2bf(bflo(w.w) * sc); d[7 * 72] = (bf16)f2bf(bfhi(w.w) * sc); }
            if (wave >= 4) { const int sw = wave - 4;
#pragma unroll
                for (int i = 0; i < 11; ++i) { const int j = sw + 4 * i; if (j < 42) { const int di = j / 7, vi = j % 7;
                    v2u w; w.x = pk2(acc[i][0], acc[i][1]); w.y = pk2(acc[i][2], acc[i][3]); *(LAS v2u*)(ST + (16 * vi + c16) * 104 + 16 * di + 4 * rg) = w; } } }
            __syncthreads();
            if (wave < 4) {
                const int ti = wave;
                f32x4 aX[7];
#pragma unroll
                for (int vi = 0; vi < 7; ++vi) aX[vi] = (f32x4){0.f, 0.f, 0.f, 0.f};
#pragma unroll
                for (int ks = 0; ks < 3; ++ks) { const bf16x8 a8 = lds8((lptr)(Qs + (16 * ti + c16) * 104 + 32 * ks + 8 * rg));
#pragma unroll
                    for (int vi = 0; vi < 7; ++vi) aX[vi] = MFMA16(a8, lds8((lptr)(ST + (16 * vi + c16) * 104 + 32 * ks + 8 * rg)), aX[vi]); }
                { const f32x4 w4 = *(const LAS f32x4*)(wA + 16 * ti + 4 * rg);
#pragma unroll
                  for (int vi = 0; vi < 7; ++vi) aX[vi] = aX[vi] * w4; }
#pragma unroll
                for (int ks = 0; ks < 2; ++ks) { const bf16x8 a8 = lds8((lptr)(QKM + (16 * ti + c16) * 72 + 32 * ks + 8 * rg));
#pragma unroll
                    for (int vi = 0; vi < 7; ++vi) aX[vi] = MFMA16(a8, lds8((lptr)(VT + (16 * vi + c16) * 72 + 32 * ks + 8 * rg)), aX[vi]); }
                const bool skip_out = (!with_ctx) && (c < CTXL / 64);
#pragma unroll
                for (int r = 0; r < 4; ++r) { const int t = 16 * ti + 4 * rg + r;
                    const float den = __shfl(aX[6][r], lane & 48);
                    const float inv = 1.0f / fmaxf(fabsf(den), emtA[t]);
                    int slot; const int row = scan_row(b, dir, 64 * c + t, slot);
                    float hv[6];
#pragma unroll
                    for (int vi = 0; vi < 6; ++vi) hv[vi] = aX[vi][r] * inv;
                    bf16* rp = rawb + (size_t)slot * 96 + c16;
                    if (dir == 0) {
#pragma unroll
                        for (int vi = 0; vi < 6; ++vi) rp[16 * vi] = (bf16)f2bf(hv[vi]);
                    } else if (!skip_out) {
                        float ss = 0.f;
#pragma unroll
                        for (int vi = 0; vi < 6; ++vi) { hv[vi] += bf2f(rp[16 * vi]); ss += hv[vi] * hv[vi]; }
                        ss += __shfl_xor(ss, 1); ss += __shfl_xor(ss, 2); ss += __shfl_xor(ss, 4); ss += __shfl_xor(ss, 8);
                        const float rs = 1.0f / sqrtf(ss * (1.0f / 96.0f) + EPS);
                        const bf16* og = P + (size_t)row * DINP + C_MLO + h * 96 + c16; bf16* yo = YM + (size_t)row * D + Y_ML + h * 96 + c16;
#pragma unroll
                        for (int vi = 0; vi < 6; ++vi) { const float o = bf2f(og[16 * vi]); yo[16 * vi] = (bf16)f2bf(hv[vi] * rs * gain[h * 96 + 16 * vi + c16] / (1.0f + __expf(-o))); }
                    } }
            } else {
                const int sw = wave - 4; const float decay = scal[0];
#pragma unroll
                for (int i = 0; i < 11; ++i) { const int j = sw + 4 * i; if (j < 42) { const int di = j / 7, vi = j % 7;
                    acc[i] = acc[i] * decay;
#pragma unroll
                    for (int ks = 0; ks < 2; ++ks) acc[i] = MFMA16(lds8((lptr)(KT + (16 * di + c16) * 72 + 32 * ks + 8 * rg)), lds8((lptr)(VT + (16 * vi + c16) * 72 + 32 * ks + 8 * rg)), acc[i]); } }
            }
            VM_WAIT();
            __syncthreads();
        }
#undef ML_PREFETCH
    }
}

constexpr int HG_QT = 0, HG_KR = 8704, HG_KTT = 17408, HG_VT = 27648, HG_ATT = 32768, HG_SPT = 35328, HG_ER = 52736, HG_TOT = 53248;

__device__ __forceinline__ void hgrn2_item(lptr lds, const bf16* P, bf16* YM, bf16* RAW, const float* lbl  , const float* gain  , bool with_ctx, int b, int h) {
    const int tid = tid_opaque(), lane = tid & 63, c16 = lane & 15, rg = lane >> 4, wave = __builtin_amdgcn_readfirstlane(tid >> 6);
    LAS bf16* QT = (LAS bf16*)(lds + HG_QT); LAS bf16* KR = (LAS bf16*)(lds + HG_KR); LAS bf16* KTT = (LAS bf16*)(lds + HG_KTT); LAS bf16* VT = (LAS bf16*)(lds + HG_VT);
    LAS bf16* ATT = (LAS bf16*)(lds + HG_ATT); LAS bf16* SPT = (LAS bf16*)(lds + HG_SPT); LAS float* ER = (LAS float*)(lds + HG_ER); LAS float* TOT = (LAS float*)(lds + HG_TOT);
    const int kx = tid & 127, tq = tid >> 7;
    const int vc = tid & 63, t4 = tid >> 6;
    bf16* rawb = RAW + (size_t)(b * 4 + h) * NTOK * 64;
    for (int dir = 0; dir < 2; ++dir) {
        const float lb = lbl[dir * 512 + h * 128 + kx];
        const float lbf = fmaxf(lb, 1e-30f), oml = 1.0f - lb;
        f32x4 acc[4];
#pragma unroll
        for (int i = 0; i < 4; ++i) acc[i] = (f32x4){0.f, 0.f, 0.f, 0.f};
        bf16 zr[8], qr[8], vr[4];
#define HG_PREFETCH(c) do { \
        _Pragma("unroll") for (int j_ = 0; j_ < 8; ++j_) { int sl_; const int row_ = scan_row(b, dir, 32 * (c) + 8 * tq + j_, sl_); const bf16* pr_ = P + (size_t)row_ * DINP; \
            zr[j_] = pr_[C_HGF + dir * 512 + h * 128 + kx]; qr[j_] = pr_[C_HGQ + h * 128 + kx]; } \
        _Pragma("unroll") for (int j_ = 0; j_ < 4; ++j_) { int sl_; const int row_ = scan_row(b, dir, 32 * (c) + 4 * t4 + j_, sl_); vr[j_] = P[(size_t)row_ * DINP + C_HGI + h * 64 + vc]; } } while (0)
        HG_PREFETCH(0);
        for (int c = 0; c < NTOK / 32; ++c) {
            float kk[8], cs[8]; float run = 0.f;
#pragma unroll
            for (int j = 0; j < 8; ++j) { const float z = bf2f(zr[j]); const float e = __expf(-fabsf(z)); const float inv = 1.0f / (1.0f + e);
                const float sig = z >= 0.f ? inv : e * inv, nsig = z >= 0.f ? e * inv : inv;
                const float f = lbf + oml * sig; kk[j] = oml * nsig; run += __log2f(f); cs[j] = run; }
            TOT[tq * 128 + kx] = run;
            __syncthreads();
            {
                const float t0 = TOT[kx], t1 = TOT[128 + kx], t2 = TOT[256 + kx], t3 = TOT[384 + kx];
                const float off = (tq > 0 ? t0 : 0.f) + (tq > 1 ? t1 : 0.f) + (tq > 2 ? t2 : 0.f);
                const float rr = 0.5f * ((t0 + t1) + (t2 + t3));
                unsigned kp[8];
#pragma unroll
                for (int j = 0; j < 8; ++j) { float x = off + cs[j] - rr; x = fminf(fmaxf(x, -100.f), 100.f);
                    const float q = bf2f(qr[j]); const float qs = q / (1.0f + __expf(-q));
                    const float qt = qs * __builtin_amdgcn_exp2f(x), kt = kk[j] * __builtin_amdgcn_exp2f(-x);
                    const int t = 8 * tq + j; QT[t * 136 + kx] = (bf16)f2bf(qt); kp[j] = f2bf(kt); KR[t * 136 + kx] = (bf16)kp[j]; }
                v4u w; w.x = kp[0] | (kp[1] << 16); w.y = kp[2] | (kp[3] << 16); w.z = kp[4] | (kp[5] << 16); w.w = kp[6] | (kp[7] << 16);
                *(LAS v4u*)(KTT + kx * 40 + 8 * tq) = w;
                if (tq == 0) ER[kx] = __builtin_amdgcn_exp2f(fmaxf(rr, -100.f));
                v2u wv; wv.x = (unsigned)vr[0] | ((unsigned)vr[1] << 16); wv.y = (unsigned)vr[2] | ((unsigned)vr[3] << 16);
                *(LAS v2u*)(VT + vc * 40 + 4 * t4) = wv;
            }
            if (c + 1 < NTOK / 32) HG_PREFETCH(c + 1);
            __syncthreads();
            if (wave < 4) { const int ti = wave >> 1, si = wave & 1;
                f32x4 a4 = (f32x4){0.f, 0.f, 0.f, 0.f};
                if (si <= ti) {
#pragma unroll
                    for (int ks = 0; ks < 4; ++ks) a4 = MFMA16(lds8((lptr)(QT + (16 * ti + c16) * 136 + 32 * ks + 8 * rg)), lds8((lptr)(KR + (16 * si + c16) * 136 + 32 * ks + 8 * rg)), a4);
                }
                const int s = 16 * si + c16;
#pragma unroll
                for (int r = 0; r < 4; ++r) { const int t = 16 * ti + 4 * rg + r; ATT[t * 40 + s] = (bf16)f2bf(s <= t ? a4[r] : 0.f); } }
            { const f32x4 er = *(const LAS f32x4*)(ER + 16 * wave + 4 * rg);
#pragma unroll
              for (int ci = 0; ci < 4; ++ci) { acc[ci] = acc[ci] * er; v2u w; w.x = pk2(acc[ci][0], acc[ci][1]); w.y = pk2(acc[ci][2], acc[ci][3]);
                  *(LAS v2u*)(SPT + (16 * ci + c16) * 136 + 16 * wave + 4 * rg) = w; } }
            __syncthreads();
            if (wave < 2) { const int ti = wave;
                f32x4 o4[4];
#pragma unroll
                for (int ci = 0; ci < 4; ++ci) o4[ci] = (f32x4){0.f, 0.f, 0.f, 0.f};
                { const bf16x8 a8 = lds8((lptr)(ATT + (16 * ti + c16) * 40 + 8 * rg));
#pragma unroll
                  for (int ci = 0; ci < 4; ++ci) o4[ci] = MFMA16(a8, lds8((lptr)(VT + (16 * ci + c16) * 40 + 8 * rg)), o4[ci]); }
#pragma unroll
                for (int ks = 0; ks < 4; ++ks) { const bf16x8 a8 = lds8((lptr)(QT + (16 * ti + c16) * 136 + 32 * ks + 8 * rg));
#pragma unroll
                    for (int ci = 0; ci < 4; ++ci) o4[ci] = MFMA16(a8, lds8((lptr)(SPT + (16 * ci + c16) * 136 + 32 * ks + 8 * rg)), o4[ci]); }
                const bool skip_out = (!with_ctx) && (c < CTXL / 32);
#pragma unroll
                for (int r = 0; r < 4; ++r) { const int t = 16 * ti + 4 * rg + r; int slot; const int row = scan_row(b, dir, 32 * c + t, slot);
                    bf16* rp = rawb + (size_t)slot * 64 + c16;
                    if (dir == 0) {
#pragma unroll
                        for (int ci = 0; ci < 4; ++ci) rp[16 * ci] = (bf16)f2bf(o4[ci][r]);
                    } else if (!skip_out) {
                        float hv[4]; float ss = 0.f;
#pragma unroll
                        for (int ci = 0; ci < 4; ++ci) { hv[ci] = o4[ci][r] + bf2f(rp[16 * ci]); ss += hv[ci] * hv[ci]; }
                        ss += __shfl_xor(ss, 1); ss += __shfl_xor(ss, 2); ss += __shfl_xor(ss, 4); ss += __shfl_xor(ss, 8);
                        const float rs = 1.0f / sqrtf(ss * (1.0f / 64.0f) + EPS);
                        const bf16* gg = P + (size_t)row * DINP + C_HGG + h * 64 + c16; bf16* yo = YM + (size_t)row * D + Y_HG + h * 64 + c16;
#pragma unroll
                        for (int ci = 0; ci < 4; ++ci) { const float g = bf2f(gg[16 * ci]); yo[16 * ci] = (bf16)f2bf(hv[ci] * rs * gain[h * 64 + 16 * ci + c16] * g / (1.0f + __expf(-g))); }
                    } } }
            { const bf16x8 a8 = lds8((lptr)(KTT + (16 * wave + c16) * 40 + 8 * rg)); const f32x4 er = *(const LAS f32x4*)(ER + 16 * wave + 4 * rg);
#pragma unroll
              for (int ci = 0; ci < 4; ++ci) { acc[ci] = MFMA16(a8, lds8((lptr)(VT + (16 * ci + c16) * 40 + 8 * rg)), acc[ci]); acc[ci] = acc[ci] * er; } }
            VM_WAIT();
            __syncthreads();
        }
#undef HG_PREFETCH
    }
}
#ifndef NO_HG
#define NO_HG 0
#endif
#ifndef NO_ML
#define NO_ML 0
#endif
#ifndef NO_AT
#define NO_AT 0
#endif
#ifndef NO_GEMM
#define NO_GEMM 0
#endif
#ifndef NO_P0
#define NO_P0 0
#endif
constexpr int NPHASE = 2 + 7 * DEPTH;

__global__ void __launch_bounds__(NTHR, 2) fwd(Args a) {
    extern __shared__ __attribute__((aligned(16))) unsigned char lds_raw[];
    lptr lds = (lptr)lds_raw;
    const int tid = threadIdx.x;
    const int G = gridDim.x; const int bx = blockIdx.x; const int vcu = (G % 8 == 0) ? (bx % 8) * (G / 8) + bx / 8 : bx;
    unsigned char* ws = a.ws;
    gu32* ctl = (gu32*)(ws + WS_CTL);
    volatile LAS unsigned* MISC = (volatile LAS unsigned*)(lds + LDSCTL_OFF);
    for (int u = tid; u < (LDS_BYTES - LDSCTL_OFF) / 4; u += NTHR) ((LAS unsigned*)(lds + LDSCTL_OFF))[u] = 0u;
    __syncthreads();
    const int lo = a.ph_lo, hi = a.ph_hi;
    XcdBarrier bar; bar.bar = (unsigned*)ctl + CW_BAR; bar.x = 0; bar.st = nullptr;
    if (hi - lo > 1) bar = xcd_barrier_post((unsigned*)ctl + CW_BAR, MISC + 8);
    volatile LAS int* slot = (volatile LAS int*)(MISC + 16);
#define IN(k) (lo <= (k) && (k) < hi)
#define SEAM(k) do { if (IN(k) && IN((k) + 1)) xcd_barrier(bar); } while (0)

    float* mod = (float*)(ws + WS_MOD);
    const float* lbs = (const float*)(ws + WS_MISC); const float* rope = (const float*)(ws + WS_MISC + 16384); const float* biasp = (const float*)(ws + WS_MISC + 32768); const float* lamv = (const float*)(ws + WS_MISC + 114688);
    float* Gt = (float*)(ws + WS_GATE);
    bf16* Win = (bf16*)(ws + WS_WIN); bf16* Wout = (bf16*)(ws + WS_WOUT); bf16* Wgu = (bf16*)(ws + WS_WGU); bf16* Wd = (bf16*)(ws + WS_WD);
    float* ctxx = (float*)(ws + WS_CTXX); bf16* HB = (bf16*)(ws + WS_HB);
    bf16* RAWM = (bf16*)(ws + WS_RAWM); bf16* RAWH = (bf16*)(ws + WS_RAWH);
    bf16* Pb = (bf16*)(ws + WS_P); float* Y = (float*)(ws + WS_P); bf16* U = (bf16*)(ws + WS_P); float* YD = (float*)(ws + WS_YD);

    if (IN(0)) { if (!NO_P0) p0_phase(lds, a); } SEAM(0);

    for (int l = 0; l < DEPTH; ++l) {
        const int pb = 1 + 7 * l;
        const bool with_ctx = l < DEPTH - 1;
        const float* modl = mod + (size_t)l * 17 * NMOD;
        if (IN(pb)) {
            if (l == 0) thin_phase<false, true>(0, a.in[I_X], a.in[I_CTX], a.out, ctxx, false, nullptr, nullptr, 0, nullptr, modl, 0, D, a.in[I_GPREMIX] + l * D, HB, vcu, G);
            else        thin_phase<true, true>(0, l == 1 ? a.out : a.out, ctxx, a.out, ctxx, true, YD, modl - 17 * NMOD, 5 * D, a.in[I_GPOSTFFN] + (l - 1) * D, modl, 0, D, a.in[I_GPREMIX] + l * D, HB, vcu, G);
            convert_weights(lds, a, l, vcu, G);
        }
        SEAM(pb);
        if (IN(pb + 1)) {
            pg8::Gemm g{HB, Win, MT, DINP, D}; pg8::StaticOrder S; S.init(MT, DINP, G, bx);
            pg8::EpiIn E{Pb, DINP, biasp + l * DINP, Gt};
            if (!NO_GEMM) pg8::gemm_phase<pg8::EpiIn, pg8::StaticOrder, true, true>(lds, g, S, E);
        }
        SEAM(pb + 1);
        if (IN(pb + 2)) {
            unsigned* qh = (unsigned*)ctl + CW_Q + 64 * (3 * l), *qm = qh + 64, *qa = qh + 128;
            for (;;) { const int it = wg_pull(qh, slot); if (it >= 64) break;
                if (!NO_HG) hgrn2_item(lds, Pb, HB, RAWH, lbs + l * 1024, a.in[I_HGNORM] + l * 256, with_ctx, it >> 2, it & 3); }
            for (;;) { const int it = wg_pull(qm, slot); if (it >= 64) break;
                if (!NO_ML) mlstm_item(lds, Pb, Gt, HB, RAWM, a.in[I_MLFB] + l * 8, a.in[I_MLNORM] + l * 384, with_ctx, it >> 2, it & 3); }
            const int na = with_ctx ? 576 : 512;
            const float lam_init = 0.8f - 0.6f * __expf(-0.3f * (float)l);
            for (;;) { const int it = wg_pull(qa, slot); if (it >= na) break;
                const int bh = it < 512 ? it >> 3 : it - 512, qb = it < 512 ? it & 7 : 8;
                if (!NO_AT) attn_item(lds, Pb, HB, rope, a.in[I_DANORM] + l * 96, lamv[l], 1.0f - lam_init, bh >> 2, bh & 3, qb); }
            __syncthreads();
        }
        SEAM(pb + 2);
        const int r0 = with_ctx ? 0 : MC; const int Mg = MT - r0;
        if (IN(pb + 3)) {
            pg8::Gemm g{HB + (size_t)r0 * D, Wout, Mg, D, D}; pg8::StaticOrder S; S.init(Mg, D, G, bx);
            pg8::EpiF32 E{Y + (size_t)r0 * D, D};
            if (!NO_GEMM) pg8::gemm_phase<pg8::EpiF32, pg8::StaticOrder, true, true>(lds, g, S, E);
        }
        SEAM(pb + 3);
        if (IN(pb + 4)) {
            const float* xl = (l == 0) ? a.in[I_X] : a.out; const float* xc = (l == 0) ? a.in[I_CTX] : ctxx;
            thin_phase<true, true>(r0, xl, xc, a.out, ctxx, true, Y, modl, 2 * D, a.in[I_GPOSTMIX] + l * D, modl, 3 * D, 4 * D, a.in[I_GPREFFN] + l * D, HB, vcu, G);
        }
        SEAM(pb + 4);
        if (IN(pb + 5)) {
            pg8::Gemm g{HB + (size_t)r0 * D, Wgu, Mg, NGU, D}; pg8::StaticOrder S; S.init(Mg, NGU, G, bx);
            pg8::EpiSwiglu E{U + (size_t)r0 * DFF, DFF};
            if (!NO_GEMM) pg8::gemm_phase<pg8::EpiSwiglu, pg8::StaticOrder, true, true>(lds, g, S, E);
        }
        SEAM(pb + 5);
        if (IN(pb + 6)) {
            pg8::Gemm g{U + (size_t)r0 * DFF, Wd, Mg, D, DFF}; pg8::StaticOrder S; S.init(Mg, D, G, bx);
            pg8::EpiF32 E{YD + (size_t)r0 * D, D};
            if (!NO_GEMM) pg8::gemm_phase<pg8::EpiF32, pg8::StaticOrder, true, true>(lds, g, S, E);
        }
        SEAM(pb + 6);
    }
    if (IN(NPHASE - 1)) {
        const float* modl = mod + (size_t)(DEPTH - 1) * 17 * NMOD;
        thin_phase<true, false>(MC, a.out, ctxx, a.out, ctxx, true, YD, modl, 5 * D, a.in[I_GPOSTFFN] + (DEPTH - 1) * D, nullptr, 0, 0, nullptr, nullptr, vcu, G);
    }
#undef IN
#undef SEAM
}

extern "C" void kernel_launch(void* const* d_in, const int* in_sizes, int n_in, void* d_out, int out_size, void* d_ws, size_t ws_size, hipStream_t stream) {
    static int grid = 0;
    if (grid == 0) {
        if (n_in != 22 || in_sizes[0] != ML * D || out_size != ML * D || ws_size < WS_END) {
            fprintf(stderr, "kernel_launch: unexpected shapes: n_in %d in0 %d out %d ws %zu (need %zu); nothing launched\n", n_in, n_in > 0 ? in_sizes[0] : -1, out_size, ws_size, (size_t)WS_END); grid = -1; return; }
        int dev = 0, cus = 0, per_cu = 0;
        if (hipGetDevice(&dev) != hipSuccess || hipDeviceGetAttribute(&cus, hipDeviceAttributeMultiprocessorCount, dev) != hipSuccess) { fprintf(stderr, "kernel_launch: device query failed\n"); grid = -1; return; }
        if (hipFuncSetAttribute((const void*)fwd, hipFuncAttributeMaxDynamicSharedMemorySize, LDS_BYTES) != hipSuccess) { fprintf(stderr, "kernel_launch: hipFuncSetAttribute failed\n"); grid = -1; return; }
        if (hipOccupancyMaxActiveBlocksPerMultiprocessor(&per_cu, (const void*)fwd, NTHR, LDS_BYTES) != hipSuccess || per_cu < 1)
            fprintf(stderr, "kernel_launch: note: occupancy query reports %d workgroups per CU\n", per_cu);
        (void)hipGetLastError();
        grid = cus;
    }
    if (grid < 0) return;
    if (hipMemsetAsync((char*)d_ws + WS_CTL, 0, CTL_ZERO_BYTES, stream) != hipSuccess) { fprintf(stderr, "kernel_launch: memset failed\n"); return; }
    Args a{};
    for (int i = 0; i < 22; ++i) a.in[i] = (const float*)d_in[i];
    a.out = (float*)d_out; a.ws = (unsigned char*)d_ws;
#if MK_PER_PHASE
    for (int p = 0; p < NPHASE; ++p) { a.ph_lo = p; a.ph_hi = p + 1; hipLaunchKernelGGL(fwd, dim3(grid), dim3(NTHR), LDS_BYTES, stream, a); }
#else
    a.ph_lo = 0; a.ph_hi = NPHASE;
    hipLaunchKernelGGL(fwd, dim3(grid), dim3(NTHR), LDS_BYTES, stream, a);
#endif
    const hipError_t le = hipPeekAtLastError();
    if (le != hipSuccess) fprintf(stderr, "kernel_launch: launch failed: %s\n", hipGetErrorName(le));
}
```

```cpp
#include <hip/hip_runtime.h>
#include <cstdio>
#include <cstdint>
#ifndef MK_PER_PHASE
#define MK_PER_PHASE 0
#endif
namespace pg8 {
#define PG8_LAS __attribute__((address_space(3)))
typedef unsigned short bf16_t;
typedef short bf16x8 __attribute__((ext_vector_type(8)));
typedef float f32x4 __attribute__((ext_vector_type(4)));
typedef unsigned u32x4 __attribute__((ext_vector_type(4)));
constexpr int BM = 256, BK = 64, HALF = 128, HTB = HALF * BK * 2  , STAGE_BYTES = 8 * HTB, NXCD = 8, WGM = 8;

__host__ __device__ __forceinline__ int lds_byte(int r, int c) { const int st = (r >> 4) * 2 + (c >> 5), rr = r & 15, cc = c & 31, ob = rr * 64 + cc * 2; return st * 1024 + (ob ^ (((ob >> 9) & 1) << 5)); }
__host__ __device__ __forceinline__ void stage_rc(int b, int& R, int& C) { const int st = b / 1024, sb = b % 1024, swz = sb ^ (((sb >> 9) & 1) << 5); R = (st >> 1) * 16 + swz / 64; C = (st & 1) * 32 + (swz % 64) / 2; }
__host__ __device__ __forceinline__ int perm32(int rho) { const int n = rho >> 4, i = rho & 15; return 8 * (i >> 2) + 4 * n + (i & 3); }

struct Unit { int pm, pn; };
struct Gemm { const bf16_t* A; const bf16_t* Bt; int M, N, K; };

struct StaticOrder {
    int nM, nN, nwg, G, c;
    __host__ __device__ void init(int M, int N, int G_, int c_) { nM = M / BM; nN = N / BM; nwg = nM * nN; G = G_; c = c_; }
    __host__ __device__ bool next(int i, Unit& u) const {
        const long L = (long)i * G + c; if (L >= nwg) return false;
        int wgid = (int)L; { const int q = nwg / NXCD, r = nwg % NXCD, xcd = wgid % NXCD, off = wgid / NXCD; wgid = (xcd < r ? xcd * (q + 1) : r * (q + 1) + (xcd - r) * q) + off; }
        const int nig = WGM * nN, gid = wgid / nig, fm = gid * WGM, gsz = (nM - fm) < WGM ? (nM - fm) : WGM;
        u.pm = fm + ((wgid % nig) % gsz); u.pn = (wgid % nig) / gsz; return true;
    }
    __device__ __forceinline__ void a_ready(const Unit&) const {}
    __device__ __forceinline__ void done(const Unit&) const {}
};
__device__ __forceinline__ unsigned cvt_pk_bf16(float lo, float hi) { unsigned r; asm volatile("v_cvt_pk_bf16_f32 %0, %1, %2" : "=v"(r) : "v"(lo), "v"(hi)); return r; }
struct EpiF32 {
    static constexpr bool PERM = false, AFTER_DRAIN = false;
    float* C; int ldc;
    __device__ __forceinline__ void operator()(const f32x4 (&acc)[2][2][4][2], const Unit& u, int wr, int wc, int fr, int fq) const {
        const int row0 = u.pm * BM + wr * 64 + fr, col0 = u.pn * BM + wc * 32 + 4 * fq;
#pragma unroll
        for (int ai = 0; ai < 2; ++ai)
#pragma unroll
            for (int m = 0; m < 4; ++m) { float* rowp = C + (size_t)(row0 + ai * HALF + m * 16) * ldc + col0;
#pragma unroll
                for (int bj = 0; bj < 2; ++bj)
#pragma unroll
                    for (int n = 0; n < 2; ++n) *(f32x4*)(rowp + bj * HALF + n * 16) = acc[ai][bj][m][n]; }
    }
};
struct EpiIn {
    static constexpr bool PERM = true, AFTER_DRAIN = false;
    bf16_t* O; int ldc; const float* bias; float* G;
    __device__ __forceinline__ void operator()(const f32x4 (&acc)[2][2][4][2], const Unit& u, int wr, int wc, int fr, int fq) const {
        const int row0 = u.pm * BM + wr * 64 + fr; const int col0 = u.pn * BM + wc * 32 + 8 * fq;
        f32x4 bv[2][2];
#pragma unroll
        for (int bj = 0; bj < 2; ++bj)
#pragma unroll
            for (int n = 0; n < 2; ++n) bv[bj][n] = *(const f32x4*)(bias + col0 + bj * HALF + 4 * n);
        const bool gate_lane = (u.pn == 6) && (wc == 0) && (fq < 2);
#pragma unroll
        for (int ai = 0; ai < 2; ++ai)
#pragma unroll
            for (int m = 0; m < 4; ++m) { const int row = row0 + ai * HALF + m * 16; bf16_t* rowp = O + (size_t)row * ldc + col0;
#pragma unroll
                for (int bj = 0; bj < 2; ++bj) { const f32x4 v0 = acc[ai][bj][m][0] + bv[bj][0], v1 = acc[ai][bj][m][1] + bv[bj][1];
                    u32x4 w; w.x = cvt_pk_bf16(v0[0], v0[1]); w.y = cvt_pk_bf16(v0[2], v0[3]); w.z = cvt_pk_bf16(v1[0], v1[1]); w.w = cvt_pk_bf16(v1[2], v1[3]);
                    *(u32x4*)(rowp + bj * HALF) = w;
                    if (bj == 0 && gate_lane) { float* g = G + (size_t)row * 16 + 8 * fq; *(f32x4*)g = v0; *(f32x4*)(g + 4) = v1; } } }
    }
};
struct EpiSwiglu {
    static constexpr bool PERM = true, AFTER_DRAIN = false;
    bf16_t* O; int ldc;
    __device__ __forceinline__ void operator()(const f32x4 (&acc)[2][2][4][2], const Unit& u, int wr, int wc, int fr, int fq) const {
        const int row0 = u.pm * BM + wr * 64 + fr; const int col0 = u.pn * HALF + wc * 32 + 8 * fq;
#pragma unroll
        for (int ai = 0; ai < 2; ++ai)
#pragma unroll
            for (int m = 0; m < 4; ++m) { bf16_t* rowp = O + (size_t)(row0 + ai * HALF + m * 16) * ldc + col0;
                f32x4 r0, r1;
#pragma unroll
                for (int i = 0; i < 4; ++i) { const float g0 = acc[ai][0][m][0][i], g1 = acc[ai][0][m][1][i];
                    r0[i] = g0 * __builtin_amdgcn_rcpf(1.0f + __expf(-g0)) * acc[ai][1][m][0][i];
                    r1[i] = g1 * __builtin_amdgcn_rcpf(1.0f + __expf(-g1)) * acc[ai][1][m][1][i]; }
                u32x4 w; w.x = cvt_pk_bf16(r0[0], r0[1]); w.y = cvt_pk_bf16(r0[2], r0[3]); w.z = cvt_pk_bf16(r1[0], r1[1]); w.w = cvt_pk_bf16(r1[2], r1[3]);
                *(u32x4*)rowp = w; }
    }
};
template <class Epi, class Sched, bool ALIGN_EPI = false, bool SP2 = false>
__device__ __forceinline__ void gemm_phase(PG8_LAS unsigned char* lds, const Gemm g, const Sched& S, const Epi& E) {
    int tid_ = threadIdx.x; asm volatile("" : "+v"(tid_));
    const int tid = tid_, wid = __builtin_amdgcn_readfirstlane(tid >> 6), lane = tid & 63, wr = wid >> 2, wc = wid & 3, fr = lane & 15, fq = lane >> 4;
    const int K = g.K, nt = K / BK;
    unsigned voffA[2], voffB[2];
#pragma unroll
    for (int i = 0; i < 2; ++i) { int R, C; stage_rc(tid * 16 + i * 8192, R, C); const int Rb = Epi::PERM ? ((R & ~31) + perm32(R & 31)) : R;
        voffA[i] = (unsigned)(R * K + C) * 2u; voffB[i] = (unsigned)(Rb * K + C) * 2u; }
    const size_t kstep = (size_t)(BK * 2);
    const size_t hstep = (size_t)HALF * K * 2;
    const size_t tstep = 2 * hstep;
    const unsigned ldsw = (unsigned)wid * 1024u;
    const int aoff = lds_byte(wr * 64 + fr, fq * 8), boff = lds_byte(wc * 32 + fr, fq * 8);
#define PG8_SA(b, h) (((b) * 2 + (h)) * HTB)
#define PG8_SB(b, h) ((4 + (b) * 2 + (h)) * HTB)
#define PG8_STAGE(bufoff, gbase, voff) do { _Pragma("unroll") for (int _i = 0; _i < 2; ++_i) \
        __builtin_amdgcn_global_load_lds((const unsigned*)((const char*)(gbase) + (voff)[_i]), (PG8_LAS unsigned*)(lds + (bufoff) + ldsw + _i * 8192), 16, 0, 0); } while (0)
#define PG8_LDA(dst, b, h) do { _Pragma("unroll") for (int m = 0; m < 4; ++m) _Pragma("unroll") for (int k = 0; k < 2; ++k) dst[m][k] = *(const PG8_LAS bf16x8*)(lds + PG8_SA(b, h) + aoff + m * 2048 + k * 1024); } while (0)
#define PG8_LDB(dst, b, h) do { _Pragma("unroll") for (int n = 0; n < 2; ++n) _Pragma("unroll") for (int k = 0; k < 2; ++k) dst[n][k] = *(const PG8_LAS bf16x8*)(lds + PG8_SB(b, h) + boff + n * 2048 + k * 1024); } while (0)
#define PG8_MMA(ai, bj, At, Bt) do { __builtin_amdgcn_s_setprio(1); _Pragma("unroll") for (int m = 0; m < 4; ++m) _Pragma("unroll") for (int n = 0; n < 2; ++n) _Pragma("unroll") for (int k = 0; k < 2; ++k) \
        acc[ai][bj][m][n] = __builtin_amdgcn_mfma_f32_16x16x32_bf16(Bt[n][k], At[m][k], acc[ai][bj][m][n], 0, 0, 0); __builtin_amdgcn_s_setprio(0); } while (0)
#define PG8_WAIT_V(n) asm volatile("s_waitcnt vmcnt(" #n ")" ::: "memory")
#define PG8_WAIT_L(n) asm volatile("s_waitcnt lgkmcnt(" #n ")" ::: "memory")
#define PG8_BAR __builtin_amdgcn_s_barrier()
#define PG8_SCHED __builtin_amdgcn_sched_barrier(0)
    Unit cur, nxt; int ui = 0;
    if (!S.next(0, cur)) return;
    f32x4 acc[2][2][4][2];
#pragma unroll
    for (int a = 0; a < 2; ++a)
#pragma unroll
        for (int b = 0; b < 2; ++b)
#pragma unroll
            for (int m = 0; m < 4; ++m)
#pragma unroll
                for (int n = 0; n < 2; ++n) acc[a][b][m][n] = (f32x4){0.f, 0.f, 0.f, 0.f};
    bf16x8 At[4][2], B0[2][2], B1[2][2];
    const char* cA = (const char*)g.A + (size_t)cur.pm * tstep; const char* cB = (const char*)g.Bt + (size_t)cur.pn * tstep;
    S.a_ready(cur);
    if constexpr (SP2) {
        PG8_STAGE(PG8_SB(0, 0), cB, voffB); PG8_STAGE(PG8_SB(0, 1), cB + hstep, voffB); PG8_STAGE(PG8_SA(0, 0), cA, voffA); PG8_STAGE(PG8_SA(0, 1), cA + hstep, voffA);
        if (wr == 1) PG8_BAR;
        PG8_WAIT_V(2); PG8_BAR;
        PG8_STAGE(PG8_SB(1, 0), cB + kstep, voffB); PG8_STAGE(PG8_SA(1, 0), cA + kstep, voffA); PG8_STAGE(PG8_SB(1, 1), cB + hstep + kstep, voffB);
        PG8_WAIT_V(6); PG8_BAR;
    } else {
        PG8_STAGE(PG8_SB(0, 0), cB, voffB); PG8_STAGE(PG8_SA(0, 0), cA, voffA); PG8_STAGE(PG8_SB(0, 1), cB + hstep, voffB); PG8_STAGE(PG8_SA(0, 1), cA + hstep, voffA);
        if (wr == 1) PG8_BAR;
        PG8_WAIT_V(4); PG8_BAR;
        PG8_STAGE(PG8_SB(1, 0), cB + kstep, voffB); PG8_STAGE(PG8_SA(1, 0), cA + kstep, voffA); PG8_STAGE(PG8_SB(1, 1), cB + hstep + kstep, voffB);
        PG8_WAIT_V(6); PG8_BAR;
    }
    for (;;) {
        const bool has_next = S.next(ui + 1, nxt);
        const char* nA = has_next ? (const char*)g.A + (size_t)nxt.pm * tstep : cA; const char* nB = has_next ? (const char*)g.Bt + (size_t)nxt.pn * tstep : cB;
        for (int t = 0; t < nt; t += 2) {
            const bool last = (t == nt - 2);
            const char* a1 = cA + (size_t)(t + 1) * kstep;
            const char* a2 = last ? nA : cA + (size_t)(t + 2) * kstep; const char* b2 = last ? nB : cB + (size_t)(t + 2) * kstep;
            const char* a3 = a2 + kstep; const char* b3 = b2 + kstep;
            if (last && has_next) S.a_ready(nxt);
            if constexpr (SP2) {
            PG8_LDB(B0, 0, 0); PG8_LDB(B1, 0, 1); PG8_SCHED; PG8_LDA(At, 0, 0); PG8_STAGE(PG8_SA(1, 1), a1 + hstep, voffA);
            PG8_WAIT_V(8); PG8_WAIT_L(0); PG8_BAR; PG8_MMA(0, 0, At, B0); PG8_MMA(0, 1, At, B1); PG8_BAR; PG8_SCHED;
            PG8_LDA(At, 0, 1); PG8_STAGE(PG8_SB(0, 0), b2, voffB); PG8_STAGE(PG8_SB(0, 1), b2 + hstep, voffB); PG8_STAGE(PG8_SA(0, 0), a2, voffA);
            PG8_WAIT_V(8); PG8_WAIT_L(0); PG8_BAR; PG8_MMA(1, 0, At, B0); PG8_MMA(1, 1, At, B1); PG8_BAR; PG8_SCHED;
            PG8_LDB(B0, 1, 0); PG8_LDB(B1, 1, 1); PG8_SCHED; PG8_LDA(At, 1, 0); PG8_STAGE(PG8_SA(0, 1), a2 + hstep, voffA);
            PG8_WAIT_V(8); PG8_WAIT_L(0); PG8_BAR; PG8_MMA(0, 0, At, B0); PG8_MMA(0, 1, At, B1); PG8_BAR; PG8_SCHED;
            PG8_LDA(At, 1, 1); PG8_STAGE(PG8_SB(1, 0), b3, voffB); PG8_STAGE(PG8_SB(1, 1), b3 + hstep, voffB); PG8_STAGE(PG8_SA(1, 0), a3, voffA);
            PG8_WAIT_V(8); PG8_WAIT_L(0); PG8_BAR; PG8_MMA(1, 0, At, B0); PG8_MMA(1, 1, At, B1); PG8_BAR; PG8_SCHED;
            } else {
            PG8_LDB(B0, 0, 0); PG8_SCHED; PG8_LDA(At, 0, 0); PG8_STAGE(PG8_SA(1, 1), a1 + hstep, voffA);
            PG8_WAIT_L(8); PG8_BAR; PG8_WAIT_L(0); PG8_MMA(0, 0, At, B0); PG8_BAR; PG8_SCHED;
            PG8_LDB(B1, 0, 1); PG8_STAGE(PG8_SB(0, 0), b2, voffB);
            PG8_BAR; PG8_WAIT_L(0); PG8_MMA(0, 1, At, B1); PG8_BAR;
            PG8_LDA(At, 0, 1); PG8_STAGE(PG8_SA(0, 0), a2, voffA);
            PG8_BAR; PG8_WAIT_L(0); PG8_MMA(1, 0, At, B0); PG8_BAR; PG8_SCHED;
            PG8_STAGE(PG8_SB(0, 1), b2 + hstep, voffB);
            PG8_WAIT_V(6); PG8_BAR; PG8_MMA(1, 1, At, B1); PG8_BAR;
            PG8_LDB(B0, 1, 0); PG8_SCHED; PG8_LDA(At, 1, 0); PG8_STAGE(PG8_SA(0, 1), a2 + hstep, voffA);
            PG8_WAIT_L(8); PG8_BAR; PG8_WAIT_L(0); PG8_MMA(0, 0, At, B0); PG8_BAR; PG8_SCHED;
            PG8_LDB(B1, 1, 1); PG8_STAGE(PG8_SB(1, 0), b3, voffB);
            PG8_BAR; PG8_WAIT_L(0); PG8_MMA(0, 1, At, B1); PG8_BAR;
            PG8_LDA(At, 1, 1); PG8_STAGE(PG8_SA(1, 0), a3, voffA);
            PG8_BAR; PG8_WAIT_L(0); PG8_MMA(1, 0, At, B0); PG8_BAR; PG8_SCHED;
            PG8_STAGE(PG8_SB(1, 1), b3 + hstep, voffB);
            PG8_WAIT_V(6); PG8_BAR; PG8_MMA(1, 1, At, B1); PG8_BAR;
            }
        }
        if constexpr (ALIGN_EPI) { if (wr == 0) PG8_BAR; }
        if constexpr (!Epi::AFTER_DRAIN) { E(acc, cur, wr, wc, fr, fq); S.done(cur); }
        if (!has_next) break;
#pragma unroll
        for (int a = 0; a < 2; ++a)
#pragma unroll
            for (int b = 0; b < 2; ++b)
#pragma unroll
                for (int m = 0; m < 4; ++m)
#pragma unroll
                    for (int n = 0; n < 2; ++n) acc[a][b][m][n] = (f32x4){0.f, 0.f, 0.f, 0.f};
        cur = nxt; cA = nA; cB = nB; ++ui;
        if constexpr (ALIGN_EPI) { if (wr == 1) PG8_BAR; }
    }
    PG8_WAIT_V(0);
    if constexpr (!ALIGN_EPI) { if (wr == 0) PG8_BAR; }
    PG8_BAR;
    if constexpr (Epi::AFTER_DRAIN) { E.fused(acc, cur, wr, wc, fr, fq, lds, wid, lane); S.done(cur); }
#undef PG8_SA
#undef PG8_SB
#undef PG8_STAGE
#undef PG8_LDA
#undef PG8_LDB
#undef PG8_MMA
#undef PG8_WAIT_V
#undef PG8_WAIT_L
#undef PG8_BAR
#undef PG8_SCHED
}
}
constexpr int D = 1024, NB = 16, SEQ = 2048, CTXL = 256, DEPTH = 4;
constexpr int MC = NB * CTXL, ML = NB * SEQ, MT = MC + ML;
constexpr int DIN = 4752, DINP = 4864, DFF = 2816, NGU = 2 * DFF, NMOD = 6 * D;
constexpr int C_MLQ = 0, C_MLK = 384, C_MLV = 768, C_MLO = 1152, C_MLI = 1536, C_MLF = 1544, C_HGQ = 1552, C_HGF = 2064, C_HGI = 3088, C_HGG = 3344, C_DAQ = 3600, C_DAK = 3984, C_DAV = 4368;
constexpr int Y_ML = 0, Y_HG = 384, Y_DA = 640;
constexpr float EPS = 1e-6f;
constexpr int NTOK = CTXL + SEQ;
static_assert(C_MLI == 6 * 256, "gate columns must open GEMM tile 6");

constexpr size_t MiB = 1u << 20;
constexpr size_t WS_CTL = 0, CTL_ZERO_BYTES = 1 * MiB;
constexpr size_t WS_MOD = 1 * MiB;
constexpr size_t WS_MISC = 3 * MiB;
constexpr size_t WS_GATE = 4 * MiB;
constexpr size_t WS_WIN = 8 * MiB, WS_WOUT = WS_WIN + (size_t)DINP * D * 2, WS_WGU = WS_WOUT + (size_t)D * D * 2, WS_WD = WS_WGU + (size_t)NGU * D * 2;
constexpr size_t WS_CTXX = 36 * MiB;
constexpr size_t WS_HB = 52 * MiB;
constexpr size_t WS_RAWM = 124 * MiB, WS_RAWH = 151 * MiB;
constexpr size_t WS_P = 169 * MiB;
constexpr size_t WS_YD = WS_P + 198 * MiB, WS_END = 511 * MiB;
static_assert(WS_WD + (size_t)D * DFF * 2 <= WS_CTXX, "weights fit");
static_assert(WS_RAWM + (size_t)64 * NTOK * 96 * 2 <= WS_RAWH && WS_RAWH + (size_t)64 * NTOK * 64 * 2 <= WS_P, "raw fits");
static_assert(WS_P + (size_t)MT * DINP * 2 <= WS_END && WS_YD + (size_t)MT * D * 4 <= WS_END && (size_t)MT * DFF * 2 <= 198 * MiB, "P region");
constexpr int CW_BAR = 4096;
constexpr int CW_Q = 16384;

constexpr int RING_BYTES = 131072, LDSCTL_OFF = RING_BYTES, LDS_BYTES = 147456;
constexpr int NWAVES = 8, NTHR = 512;

#define GAS __attribute__((address_space(1)))
#define LAS __attribute__((address_space(3)))
typedef unsigned short bf16;
typedef unsigned v4u __attribute__((ext_vector_type(4)));
typedef unsigned v2u __attribute__((ext_vector_type(2)));
typedef float f32x4 __attribute__((ext_vector_type(4)));
typedef float f32x16 __attribute__((ext_vector_type(16)));
typedef short bf16x8 __attribute__((ext_vector_type(8)));
typedef GAS unsigned gu32;
typedef LAS unsigned char* lptr;
#define RLX_AGENT __ATOMIC_RELAXED, __HIP_MEMORY_SCOPE_AGENT
#define LDS_WAIT() asm volatile("s_waitcnt lgkmcnt(0)" ::: "memory")
#define VM_WAIT() asm volatile("s_waitcnt vmcnt(0)" ::: "memory")
__device__ __forceinline__ unsigned f2bf(float f) { unsigned u = __builtin_bit_cast(unsigned, f); return (u + 0x7fffu + ((u >> 16) & 1u)) >> 16; }
__device__ __forceinline__ unsigned pk2(float lo, float hi) { return f2bf(lo) | (f2bf(hi) << 16); }
__device__ __forceinline__ float bflo(unsigned w) { return __builtin_bit_cast(float, w << 16); }
__device__ __forceinline__ float bfhi(unsigned w) { return __builtin_bit_cast(float, w & 0xffff0000u); }
__device__ __forceinline__ float bf2f(bf16 v) { return __builtin_bit_cast(float, (unsigned)v << 16); }
__device__ __forceinline__ float wave_sum(float v) {
#pragma unroll
    for (int o = 1; o < 64; o <<= 1) v += __shfl_xor(v, o);
    return v;
}
#define MFMA32(a, b, c) __builtin_amdgcn_mfma_f32_32x32x16_bf16((a), (b), (c), 0, 0, 0)
#define MFMA16(a, b, c) __builtin_amdgcn_mfma_f32_16x16x32_bf16((a), (b), (c), 0, 0, 0)
__device__ __forceinline__ int tid_opaque() { int t = threadIdx.x; asm volatile("" : "+v"(t)); return t; }
__device__ __forceinline__ bf16x8 lds8(lptr p) { return *(const LAS bf16x8*)p; }

#define XB_TMO      128
#define XB_XCNT(j)  (256  + 64 * (j))
#define XB_XSUB(j)  (1280 + 64 * (j))
#define XB_XGEN(j)  (2304 + 64 * (j))
#define XB_TOP      3328
#define XB_TOPGEN   3392
#define XCD_BAR_WORDS 3456
#define XB_SPIN_CAP (1u << 18)

__device__ __forceinline__ unsigned xb_ld(unsigned* p)              { return __hip_atomic_load(p, __ATOMIC_RELAXED, __HIP_MEMORY_SCOPE_AGENT); }
__device__ __forceinline__ unsigned xb_add(unsigned* p, unsigned v) { return __hip_atomic_fetch_add(p, v, __ATOMIC_RELAXED, __HIP_MEMORY_SCOPE_AGENT); }
__device__ __forceinline__ unsigned xb_xcc_id() { return (unsigned)__builtin_amdgcn_s_getreg((3 << 11) | 20) & 0xFu; }
#define XB_SPIN(cond, bar) do { unsigned _sp = 0; while (cond) { __builtin_amdgcn_s_sleep(1); \
    if ((++_sp & 255u) == 0u) { if (xb_ld(&(bar)[XB_TMO])) break; if (_sp > XB_SPIN_CAP) { atomicAdd(&(bar)[XB_TMO], 1u); break; } } } } while (0)

struct XcdBarrier {
    unsigned* bar; unsigned x;
    volatile LAS unsigned* st;
};

__device__ __forceinline__ XcdBarrier xcd_barrier_post(unsigned* bar, volatile LAS unsigned* st) {
    XcdBarrier b; b.bar = bar; b.x = xb_xcc_id(); b.st = st;
    if (threadIdx.x == 0) (void)xb_add(&bar[XB_XCNT(b.x)], 1u);
    return b;
}
__device__ __forceinline__ void xcd_barrier_complete(unsigned* bar, unsigned x, unsigned& nloc, unsigned& nx) {
    const unsigned G = gridDim.x * gridDim.y * gridDim.z;
    unsigned sum, cnt, mine, sp = 0u;
    for (;;) {
        sum = 0u; cnt = 0u; mine = 0u;
#pragma unroll
        for (unsigned j = 0; j < 16; ++j) { const unsigned c = xb_ld(&bar[XB_XCNT(j)]); sum += c; cnt += (c > 0u) ? 1u : 0u; mine = (j == x) ? c : mine; }
        if (sum == G) break;
        __builtin_amdgcn_s_sleep(1);
        if ((++sp & 255u) == 0u) { if (xb_ld(&bar[XB_TMO])) break; if (sp > XB_SPIN_CAP) { atomicAdd(&bar[XB_TMO], 1u); break; } }
    }
    nloc = mine > 0u ? mine : 1u; nx = cnt > 0u ? cnt : 1u;
}

__device__ __forceinline__ void xcd_barrier(const XcdBarrier& b) {
    asm volatile("s_waitcnt vmcnt(0)" ::: "memory");
    __syncthreads();
    if (threadIdx.x == 0) {
        unsigned* bar = b.bar;
        __builtin_amdgcn_s_waitcnt(0);
        unsigned nloc = b.st[0], nx = b.st[1];
        if (nloc == 0u) { xcd_barrier_complete(bar, b.x, nloc, nx); b.st[0] = nloc; b.st[1] = nx; }
        const unsigned old = xb_add(&bar[XB_XSUB(b.x)], 1u);
        const unsigned gen = old / nloc;
        if (old + 1u == (gen + 1u) * nloc) {
            __builtin_amdgcn_fence(__ATOMIC_RELEASE, "agent");
            asm volatile("s_waitcnt vmcnt(0)" ::: "memory");
            const unsigned og = xb_add(&bar[XB_TOP], 1u);
            const unsigned tg = og / nx;
            if (og + 1u == (tg + 1u) * nx) xb_add(&bar[XB_TOPGEN], 1u);
            else XB_SPIN(xb_ld(&bar[XB_TOPGEN]) == tg, bar);
            __builtin_amdgcn_fence(__ATOMIC_ACQUIRE, "agent");
            xb_add(&bar[XB_XGEN(b.x)], 1u);
            asm volatile("s_waitcnt vmcnt(0)" ::: "memory");
        } else {
            XB_SPIN(xb_ld(&bar[XB_XGEN(b.x)]) == gen, bar);
            __builtin_amdgcn_fence(__ATOMIC_ACQUIRE, "agent");
            asm volatile("s_waitcnt vmcnt(0)" ::: "memory");
        }
    }
    __syncthreads();
}


struct Args { const float* in[22]; float* out; unsigned char* ws; int ph_lo, ph_hi; };
enum { I_X = 0, I_C, I_CTX, I_CCTX, I_WADA, I_BADA, I_GPREMIX, I_GPOSTMIX, I_GPREFFN, I_GPOSTFFN, I_WIN, I_BIN, I_WOUT, I_MLFB, I_MLNORM, I_HGLB, I_HGNORM, I_DALAM, I_DANORM, I_WG, I_WU, I_WD };

__device__ __forceinline__ int wg_pull(unsigned* ctr, volatile LAS int* slot) {
    __syncthreads();
    if (threadIdx.x == 0) *slot = (int)__hip_atomic_fetch_add(ctr, 1u, RLX_AGENT);
    __syncthreads();
    return *slot;
}

__device__ __forceinline__ void p0_phase(lptr lds, const Args& a) {
    const int tid = tid_opaque();
    unsigned char* ws = a.ws;
    LAS float* sil = (LAS float*)lds;
    LAS float* part = (LAS float*)(lds + 69632);
    for (int i = tid; i < 17 * D; i += NTHR) { const int bb = i >> 10, k = i & 1023; const float v = bb < 16 ? a.in[I_C][bb * D + k] : a.in[I_CCTX][k]; sil[i] = v / (1.0f + __expf(-v)); }
    __syncthreads();
    float* mod = (float*)(ws + WS_MOD);
    for (int u = blockIdx.x; u < DEPTH * (NMOD / 32); u += gridDim.x) {
        const int l = u / (NMOD / 32), n0 = (u % (NMOD / 32)) * 32, col = tid & 31, ks = tid >> 5;
        const float* w = a.in[I_WADA] + (size_t)l * D * NMOD + (size_t)(ks * 64) * NMOD + n0 + col;
        float acc[17];
#pragma unroll
        for (int bb = 0; bb < 17; ++bb) acc[bb] = 0.f;
        for (int k = 0; k < 64; k += 4) {
            const float w0 = w[(size_t)k * NMOD], w1 = w[(size_t)(k + 1) * NMOD], w2 = w[(size_t)(k + 2) * NMOD], w3 = w[(size_t)(k + 3) * NMOD];
#pragma unroll
            for (int bb = 0; bb < 17; ++bb) { const f32x4 s = *(const LAS f32x4*)(sil + bb * D + ks * 64 + k); acc[bb] += s[0] * w0 + s[1] * w1 + s[2] * w2 + s[3] * w3; }
        }
#pragma unroll
        for (int bb = 0; bb < 17; ++bb) part[(ks * 17 + bb) * 32 + col] = acc[bb];
        __syncthreads();
        for (int i = tid; i < 17 * 32; i += NTHR) { const int bb = i >> 5, cc = i & 31; float s = 0.f;
#pragma unroll
            for (int k2 = 0; k2 < 16; ++k2) s += part[(k2 * 17 + bb) * 32 + cc];
            mod[((size_t)l * 17 + bb) * NMOD + n0 + cc] = s + a.in[I_BADA][l * NMOD + n0 + cc]; }
        __syncthreads();
    }
    const int gt = blockIdx.x * NTHR + tid, GT = gridDim.x * NTHR;
    float* lbs = (float*)(ws + WS_MISC); float* rope = (float*)(ws + WS_MISC + 16384); float* biasp = (float*)(ws + WS_MISC + 32768); float* lamv = (float*)(ws + WS_MISC + 114688);
    for (int j = gt; j < 1024; j += GT) { const float* hl = a.in[I_HGLB];
        const float v0 = hl[j], v1 = hl[1024 + j], v2 = hl[2048 + j], v3 = hl[3072 + j]; const float mx = fmaxf(fmaxf(v0, v1), fmaxf(v2, v3));
        const float e0 = expf(v0 - mx), e1 = expf(v1 - mx), e2 = expf(v2 - mx), e3 = expf(v3 - mx), inv = 1.0f / (e0 + e1 + e2 + e3);
        lbs[j] = 0.f; lbs[1024 + j] = e1 * inv; lbs[2048 + j] = (e1 + e2) * inv; lbs[3072 + j] = (e1 + e2 + e3) * inv; }
    for (int j = gt; j < 64 * 12; j += GT) { const int pos = j / 12, i = j % 12; const float inv = powf(10000.0f, -(float)(2 * i) / 24.0f); const float ang = (float)pos * inv; rope[2 * j] = cosf(ang); rope[2 * j + 1] = sinf(ang); }
    for (int j = gt; j < DEPTH * DINP; j += GT) { const int l = j / DINP, n = j % DINP; biasp[j] = n < DIN ? a.in[I_BIN][l * DIN + n] : 0.f; }
    if (gt < DEPTH) { const float* lv = a.in[I_DALAM] + gt * 4 * 48; float s01 = 0.f, s23 = 0.f;
        for (int d = 0; d < 48; ++d) { s01 += lv[d] * lv[48 + d]; s23 += lv[96 + d] * lv[144 + d]; }
        const float lam_init = 0.8f - 0.6f * expf(-0.3f * (float)gt);
        lamv[gt] = expf(s01) - expf(s23) + lam_init; }
}

template <bool RES, bool NORM>
__device__ __forceinline__ void thin_phase(int row_lo, const float* xs_lat, const float* xs_ctx, float* xd_lat, float* xd_ctx, bool write_x,
                                           const float* y, const float* mod_r, int goff, const float* gpost,
                                           const float* mod_n, int soff, int aoff, const float* gpre, bf16* hout, int vcu, int G) {
    const int tid = tid_opaque(); const int lane = tid & 63, wave = __builtin_amdgcn_readfirstlane(tid >> 6);
    const int gw = vcu * NWAVES + wave, NGW = G * NWAVES;
    const int nrows = MT - row_lo, rpw = (nrows + NGW - 1) / NGW;
    const int rbeg = row_lo + gw * rpw, rend = (rbeg + rpw < MT) ? rbeg + rpw : MT;
    int cur_bb = -1;
    f32x4 gp[4], ga[4], sh[4];
#pragma unroll
    for (int j = 0; j < 4; ++j) { gp[j] = (f32x4){0.f, 0.f, 0.f, 0.f}; ga[j] = gp[j]; sh[j] = gp[j]; }
    for (int r = rbeg; r < rend; ++r) {
        const bool isctx = r < MC; const int bb = isctx ? 16 : (r - MC) / SEQ;
        if (bb != cur_bb) { cur_bb = bb;
#pragma unroll
            for (int j = 0; j < 4; ++j) { const int e = 4 * lane + 256 * j;
                if (RES) gp[j] = *(const f32x4*)(mod_r + (size_t)bb * NMOD + goff + e) * *(const f32x4*)(gpost + e);
                if (NORM) { ga[j] = *(const f32x4*)(gpre + e) * (*(const f32x4*)(mod_n + (size_t)bb * NMOD + aoff + e) + 1.0f); sh[j] = *(const f32x4*)(mod_n + (size_t)bb * NMOD + soff + e); } } }
        const float* xs = isctx ? xs_ctx + (size_t)r * D : xs_lat + (size_t)(r - MC) * D;
        float* xd = isctx ? xd_ctx + (size_t)r * D : xd_lat + (size_t)(r - MC) * D;
        f32x4 v[4];
#pragma unroll
        for (int j = 0; j < 4; ++j) v[j] = *(const f32x4*)(xs + 4 * lane + 256 * j);
        if (RES) { f32x4 yv[4]; float ss = 0.f;
#pragma unroll
            for (int j = 0; j < 4; ++j) { yv[j] = *(const f32x4*)(y + (size_t)r * D + 4 * lane + 256 * j); ss += (yv[j][0] * yv[j][0] + yv[j][1] * yv[j][1]) + (yv[j][2] * yv[j][2] + yv[j][3] * yv[j][3]); }
            const float rs = 1.0f / sqrtf(wave_sum(ss) * (1.0f / D) + EPS);
#pragma unroll
            for (int j = 0; j < 4; ++j) v[j] += gp[j] * yv[j] * rs; }
        if (write_x) {
#pragma unroll
            for (int j = 0; j < 4; ++j) *(f32x4*)(xd + 4 * lane + 256 * j) = v[j]; }
        if (NORM) { float ss = 0.f;
#pragma unroll
            for (int j = 0; j < 4; ++j) ss += (v[j][0] * v[j][0] + v[j][1] * v[j][1]) + (v[j][2] * v[j][2] + v[j][3] * v[j][3]);
            const float rs = 1.0f / sqrtf(wave_sum(ss) * (1.0f / D) + EPS);
#pragma unroll
            for (int j = 0; j < 4; ++j) { const f32x4 h = v[j] * rs * ga[j] + sh[j]; v2u w; w.x = pk2(h[0], h[1]); w.y = pk2(h[2], h[3]); *(v2u*)(hout + (size_t)r * D + 4 * lane + 256 * j) = w; } }
    }
}

template <int MODE>
__device__ __forceinline__ void tr_item(const float* W, int K, int N, int nblk, bf16* WT, LAS float* scr, int item, int lane) {
    const int kb = item / nblk, nb = item % nblk, k0 = 64 * kb, n0 = 32 * nb;
    const int nn = n0 + (lane & 31); const bool ok = nn < N;
#pragma unroll 8
    for (int i = 0; i < 32; ++i) { const int kk = 2 * i + (lane >> 5); scr[kk * 33 + (lane & 31)] = ok ? W[(size_t)(k0 + kk) * N + nn] : 0.f; }
    LDS_WAIT(); asm volatile("" ::: "memory");
    const int c = lane & 7;
#pragma unroll
    for (int j = 0; j < 4; ++j) { const int n = (lane >> 3) + 8 * j; const LAS float* s = scr + (8 * c) * 33 + n;
        v4u o; o.x = pk2(s[0 * 33], s[1 * 33]); o.y = pk2(s[2 * 33], s[3 * 33]); o.z = pk2(s[4 * 33], s[5 * 33]); o.w = pk2(s[6 * 33], s[7 * 33]);
        const int ng = n0 + n; const int drow = MODE == 0 ? ng : ((ng >> 7) * 256 + (ng & 127) + (MODE == 2 ? 128 : 0));
        *(v4u*)(WT + (size_t)drow * K + k0 + 8 * c) = o; }
    LDS_WAIT(); asm volatile("" ::: "memory");
}
__device__ __forceinline__ void convert_weights(lptr lds, const Args& a, int l, int vcu, int G) {
    const int tid = tid_opaque(); const int lane = tid & 63, wave = __builtin_amdgcn_readfirstlane(tid >> 6);
    LAS float* scr = (LAS float*)(lds + wave * 8448);
    const int gw = vcu * NWAVES + wave, NGW = G * NWAVES;
    unsigned char* ws = a.ws;
    constexpr int I_IN = 16 * (DINP / 32), I_OUT = 16 * 32, I_GU = 16 * (DFF / 32), I_DN = (DFF / 64) * 32;
    constexpr int NITEMS = I_IN + I_OUT + 2 * I_GU + I_DN;
    for (int it = gw; it < NITEMS; it += NGW) {
        int r = it;
        if (r < I_IN) { tr_item<0>(a.in[I_WIN] + (size_t)l * D * DIN, D, DIN, DINP / 32, (bf16*)(ws + WS_WIN), scr, r, lane); continue; } r -= I_IN;
        if (r < I_OUT) { tr_item<0>(a.in[I_WOUT] + (size_t)l * D * D, D, D, 32, (bf16*)(ws + WS_WOUT), scr, r, lane); continue; } r -= I_OUT;
        if (r < I_GU) { tr_item<1>(a.in[I_WG] + (size_t)l * D * DFF, D, DFF, DFF / 32, (bf16*)(ws + WS_WGU), scr, r, lane); continue; } r -= I_GU;
        if (r < I_GU) { tr_item<2>(a.in[I_WU] + (size_t)l * D * DFF, D, DFF, DFF / 32, (bf16*)(ws + WS_WGU), scr, r, lane); continue; } r -= I_GU;
        tr_item<0>(a.in[I_WD] + (size_t)l * DFF * D, DFF, D, 32, (bf16*)(ws + WS_WD), scr, r, lane);
    }
}
constexpr int AT_Q = 0, AT_K0 = 53248, AT_KB = 13312, AT_V0 = 79872, AT_VB = 13824, AT_ROPE = 107520;
constexpr float QSCALE = 0.14433756729740643f * 1.4426950408889634f;

__device__ __forceinline__ void rope24(const v4u (&in)[3], v4u (&out)[3], bool rot, const LAS float* tab, float scale) {
    float v[24];
#pragma unroll
    for (int i = 0; i < 3; ++i) { v[8 * i + 0] = bflo(in[i].x); v[8 * i + 1] = bfhi(in[i].x); v[8 * i + 2] = bflo(in[i].y); v[8 * i + 3] = bfhi(in[i].y);
                                  v[8 * i + 4] = bflo(in[i].z); v[8 * i + 5] = bfhi(in[i].z); v[8 * i + 6] = bflo(in[i].w); v[8 * i + 7] = bfhi(in[i].w); }
    if (rot) {
#pragma unroll
        for (int i = 0; i < 12; ++i) { const float c = tab[2 * i], s = tab[2 * i + 1]; const float x1 = v[i], x2 = v[12 + i]; v[i] = x1 * c - x2 * s; v[12 + i] = x1 * s + x2 * c; } }
#pragma unroll
    for (int i = 0; i < 3; ++i) { out[i].x = pk2(v[8 * i + 0] * scale, v[8 * i + 1] * scale); out[i].y = pk2(v[8 * i + 2] * scale, v[8 * i + 3] * scale);
                                  out[i].z = pk2(v[8 * i + 4] * scale, v[8 * i + 5] * scale); out[i].w = pk2(v[8 * i + 6] * scale, v[8 * i + 7] * scale); }
}
__device__ __forceinline__ int swap23(int k) { return (k & ~12) | ((k & 4) << 1) | ((k & 8) >> 1); }

__device__ __forceinline__ void sm_tile(const f32x16& S, float& m, float& l, float& alpha, bf16x8& p0, bf16x8& p1) {
    float mx = S[0];
#pragma unroll
    for (int r = 1; r < 16; ++r) mx = fmaxf(mx, S[r]);
    mx = fmaxf(mx, __shfl_xor(mx, 32));
    const float mn = fmaxf(m, mx);
    alpha = __builtin_amdgcn_exp2f(m - mn); m = mn;
    float p[16]; float ps = 0.f;
#pragma unroll
    for (int r = 0; r < 16; ++r) { p[r] = __builtin_amdgcn_exp2f(S[r] - mn); ps += p[r]; }
    l = l * alpha + ps;
    v4u a, b;
    a.x = pk2(p[0], p[1]); a.y = pk2(p[2], p[3]); a.z = pk2(p[4], p[5]); a.w = pk2(p[6], p[7]);
    b.x = pk2(p[8], p[9]); b.y = pk2(p[10], p[11]); b.z = pk2(p[12], p[13]); b.w = pk2(p[14], p[15]);
    p0 = __builtin_bit_cast(bf16x8, a); p1 = __builtin_bit_cast(bf16x8, b);
}

__device__ __forceinline__ void attn_item(lptr lds, const bf16* P, bf16* YM, const float* rope_g, const float* danorm, float lam, float out_scale, int b, int h, int qb) {
    const int tid = tid_opaque(), lane = tid & 63, r32 = lane & 31, hi = lane >> 5, wave = __builtin_amdgcn_readfirstlane(tid >> 6);
    const bool lat = qb < 8;
    const int qrow0 = lat ? MC + b * SEQ + qb * 256 : b * CTXL;
    const int nt = lat ? 36 : 4;
    LAS float* ropeL = (LAS float*)(lds + AT_ROPE);
    for (int i = tid; i < 64 * 24; i += NTHR) ropeL[i] = rope_g[i];
    __syncthreads();
    for (int it = tid; it < 1024; it += NTHR) {
        const int row = it >> 2, map = (it >> 1) & 1, half = it & 1;
        const bf16* src = P + (size_t)(qrow0 + row) * DINP + C_DAQ + h * 96 + map * 48 + half * 24;
        v4u in[3], out[3];
#pragma unroll
        for (int i = 0; i < 3; ++i) in[i] = *(const v4u*)(src + 8 * i);
        const int t = qb * 256 + row; const int pos = half ? (t & 63) : (t >> 6);
        rope24(in, out, lat, ropeL + (lat ? pos : 0) * 24, QSCALE);
        lptr dst = lds + AT_Q + (row * 104 + map * 48 + half * 24) * 2;
#pragma unroll
        for (int i = 0; i < 3; ++i) *(LAS v4u*)(dst + 16 * i) = out[i];
    }
    v4u kin[3], vin[2];
    const int kkey = tid >> 2, kmap = (tid >> 1) & 1, khalf = tid & 1;
    const int vkey0 = tid / 12, vcc0 = tid % 12, vkey1 = (tid + 512) / 12, vcc1 = (tid + 512) % 12;
#define AT_TILE_ROW0(tile) (((tile) < 4) ? (b * CTXL + 64 * (tile)) : (MC + b * SEQ + 64 * ((tile) - 4)))
#define AT_LOAD(tile) do { const int row0_ = AT_TILE_ROW0(tile); \
        if (tid < 256) { const bf16* s_ = P + (size_t)(row0_ + kkey) * DINP + C_DAK + h * 96 + kmap * 48 + khalf * 24; kin[0] = *(const v4u*)s_; kin[1] = *(const v4u*)(s_ + 8); kin[2] = *(const v4u*)(s_ + 16); \
                         vin[1] = *(const v4u*)(P + (size_t)(row0_ + vkey1) * DINP + C_DAV + h * 96 + vcc1 * 8); } \
        vin[0] = *(const v4u*)(P + (size_t)(row0_ + vkey0) * DINP + C_DAV + h * 96 + vcc0 * 8); } while (0)
#define AT_VPUT(vt, key, cc, VV) do { const int pos_ = swap23(key); LAS bf16* d_ = (LAS bf16*)(vt) + (cc) * 8 * 72 + pos_; const v4u q_ = (VV); \
        d_[0 * 72] = (bf16)(q_.x & 0xffffu); d_[1 * 72] = (bf16)(q_.x >> 16); d_[2 * 72] = (bf16)(q_.y & 0xffffu); d_[3 * 72] = (bf16)(q_.y >> 16); \
        d_[4 * 72] = (bf16)(q_.z & 0xffffu); d_[5 * 72] = (bf16)(q_.z >> 16); d_[6 * 72] = (bf16)(q_.w & 0xffffu); d_[7 * 72] = (bf16)(q_.w >> 16); } while (0)
#define AT_STORE(tile, buf) do { const bool krot_ = (tile) >= 4; \
        if (tid < 256) { const int t_ = 64 * ((tile) - 4) + kkey; const int pos_k = khalf ? (t_ & 63) : (t_ >> 6); v4u o_[3]; rope24(kin, o_, krot_, ropeL + (krot_ ? pos_k : 0) * 24, 1.0f); \
                         lptr d_k = lds + AT_K0 + (buf) * AT_KB + (kkey * 104 + kmap * 48 + khalf * 24) * 2; *(LAS v4u*)d_k = o_[0]; *(LAS v4u*)(d_k + 16) = o_[1]; *(LAS v4u*)(d_k + 32) = o_[2]; \
                         AT_VPUT(lds + AT_V0 + (buf) * AT_VB, vkey1, vcc1, vin[1]); } \
        AT_VPUT(lds + AT_V0 + (buf) * AT_VB, vkey0, vcc0, vin[0]); } while (0)
    AT_LOAD(0); AT_STORE(0, 0);
    __syncthreads();
    bf16x8 qf[2][3];
#pragma unroll
    for (int map = 0; map < 2; ++map)
#pragma unroll
        for (int ks = 0; ks < 3; ++ks) qf[map][ks] = lds8(lds + AT_Q + ((wave * 32 + r32) * 104 + map * 48 + ks * 16 + hi * 8) * 2);
    f32x16 O0[3], O1[3];
#pragma unroll
    for (int ct = 0; ct < 3; ++ct)
#pragma unroll
        for (int r = 0; r < 16; ++r) { O0[ct][r] = 0.f; O1[ct][r] = 0.f; }
    float m0 = -1e30f, m1 = -1e30f, l0 = 0.f, l1 = 0.f;
    for (int i = 0; i < nt; ++i) {
        const int cur = i & 1;
        if (i + 1 < nt) AT_LOAD(i + 1);
        lptr ks_ = lds + AT_K0 + cur * AT_KB, vt_ = lds + AT_V0 + cur * AT_VB;
#pragma unroll 1
        for (int sub = 0; sub < 2; ++sub) {
            f32x16 S0, S1;
#pragma unroll
            for (int r = 0; r < 16; ++r) { S0[r] = 0.f; S1[r] = 0.f; }
#pragma unroll
            for (int ks = 0; ks < 3; ++ks) {
                const bf16x8 k0 = lds8(ks_ + ((sub * 32 + r32) * 104 + ks * 16 + hi * 8) * 2);
                const bf16x8 k1 = lds8(ks_ + ((sub * 32 + r32) * 104 + 48 + ks * 16 + hi * 8) * 2);
                S0 = MFMA32(k0, qf[0][ks], S0); S1 = MFMA32(k1, qf[1][ks], S1);
            }
            float a0, a1; bf16x8 p00, p01, p10, p11;
            sm_tile(S0, m0, l0, a0, p00, p01);
            sm_tile(S1, m1, l1, a1, p10, p11);
#pragma unroll
            for (int ct = 0; ct < 3; ++ct)
#pragma unroll
                for (int r = 0; r < 16; ++r) { O0[ct][r] *= a0; O1[ct][r] *= a1; }
#pragma unroll
            for (int ct = 0; ct < 3; ++ct) {
                const bf16x8 v0 = lds8(vt_ + ((ct * 32 + r32) * 72 + sub * 32 + hi * 8) * 2);
                const bf16x8 v1 = lds8(vt_ + ((ct * 32 + r32) * 72 + sub * 32 + 16 + hi * 8) * 2);
                O0[ct] = MFMA32(v0, p00, O0[ct]); O1[ct] = MFMA32(v0, p10, O1[ct]);
                O0[ct] = MFMA32(v1, p01, O0[ct]); O1[ct] = MFMA32(v1, p11, O1[ct]);
            }
        }
        if (i + 1 < nt) AT_STORE(i + 1, cur ^ 1);
        __syncthreads();
    }
#undef AT_TILE_ROW0
#undef AT_LOAD
#undef AT_VPUT
#undef AT_STORE
    const float i0 = 1.0f / (l0 + __shfl_xor(l0, 32)), i1 = lam / (l1 + __shfl_xor(l1, 32));
    float ss = 0.f;
#pragma unroll
    for (int ct = 0; ct < 3; ++ct)
#pragma unroll
        for (int r = 0; r < 16; ++r) { const float o = O0[ct][r] * i0 - O1[ct][r] * i1; O0[ct][r] = o; ss += o * o; }
    ss += __shfl_xor(ss, 32);
    const float rs = out_scale / sqrtf(ss * (1.0f / 96.0f) + EPS);
    bf16* orow = YM + (size_t)(qrow0 + wave * 32 + r32) * D + Y_DA + h * 96;
#pragma unroll
    for (int ct = 0; ct < 3; ++ct)
#pragma unroll
        for (int g = 0; g < 4; ++g) { const int c0 = 32 * ct + 8 * g + 4 * hi; const f32x4 gn = *(const f32x4*)(danorm + c0);
            v2u w; w.x = pk2(O0[ct][4 * g] * rs * gn[0], O0[ct][4 * g + 1] * rs * gn[1]); w.y = pk2(O0[ct][4 * g + 2] * rs * gn[2], O0[ct][4 * g + 3] * rs * gn[3]);
            *(v2u*)(orow + c0) = w; }
}
__device__ __forceinline__ int scan_row(int b, int dir, int p, int& slot) {
    if (p < CTXL) { const int t = dir ? CTXL - 1 - p : p; slot = t; return b * CTXL + t; }
    const int pl = p - CTXL; const int t = dir ? SEQ - 1 - pl : pl; slot = CTXL + t; return MC + b * SEQ + t;
}

constexpr int ML_Q = 0, ML_K = 13312, ML_KT = 26624, ML_VT = 40448, ML_QKM = 56576, ML_ST = 65792, ML_GF = 89088;
constexpr float KSCALE = 0.10206207261596577f;

__device__ __forceinline__ void mlstm_item(lptr lds, const bf16* P, const float* G, bf16* YM, bf16* RAW, const float* fbias  , const float* gain  , bool with_ctx, int b, int h) {
    const int tid = tid_opaque(), lane = tid & 63, c16 = lane & 15, rg = lane >> 4, wave = __builtin_amdgcn_readfirstlane(tid >> 6);
    LAS bf16* Qs = (LAS bf16*)(lds + ML_Q); LAS bf16* Ks = (LAS bf16*)(lds + ML_K); LAS bf16* KT = (LAS bf16*)(lds + ML_KT); LAS bf16* VT = (LAS bf16*)(lds + ML_VT);
    LAS bf16* QKM = (LAS bf16*)(lds + ML_QKM); LAS bf16* ST = (LAS bf16*)(lds + ML_ST);
    LAS float* gA = (LAS float*)(lds + ML_GF); LAS float* MxA = gA + 64; LAS float* wA = gA + 128; LAS float* emtA = gA + 192; LAS float* wkA = gA + 256; LAS float* scal = gA + 320;
    for (int i = tid; i < 16 * 72; i += NTHR) VT[96 * 72 + i] = (i < 72) ? (bf16)0x3F80 : (bf16)0;
    bf16* rawb = RAW + (size_t)(b * 4 + h) * NTOK * 96;
    for (int dir = 0; dir < 2; ++dir) {
        const float fb = fbias[dir * 4 + h];
        f32x4 acc[11];
#pragma unroll
        for (int i = 0; i < 11; ++i) acc[i] = (f32x4){0.f, 0.f, 0.f, 0.f};
        float m_prev = -1e30f;
        v4u pre[5]; float gi = 0.f, gf = 0.f;
#define ML_PREFETCH(c) do { \
        _Pragma("unroll") for (int i_ = 0; i_ < 5; ++i_) { const int id_ = tid + NTHR * i_; if (id_ < 2304) { const int t_ = id_ / 36, r_ = id_ % 36, wh_ = r_ / 12, cc_ = r_ % 12; int sl_; \
            const int row_ = scan_row(b, dir, 64 * (c) + t_, sl_); pre[i_] = *(const v4u*)(P + (size_t)row_ * DINP + wh_ * 384 + h * 96 + cc_ * 8); } } \
        if (wave == 0) { int sl_; const int row_ = scan_row(b, dir, 64 * (c) + lane, sl_); gi = G[(size_t)row_ * 16 + dir * 4 + h]; gf = G[(size_t)row_ * 16 + 8 + dir * 4 + h]; } } while (0)
        ML_PREFETCH(0);
        for (int c = 0; c < NTOK / 64; ++c) {
#pragma unroll
            for (int i = 0; i < 5; ++i) { const int id = tid + NTHR * i; if (id < 2304) { const int t = id / 36, r = id % 36, wh = r / 12, cc = r % 12;
                if (wh == 0) *(LAS v4u*)(Qs + t * 104 + cc * 8) = pre[i];
                else if (wh == 1) *(LAS v4u*)(Ks + t * 104 + cc * 8) = pre[i];
                else { LAS bf16* d = VT + (cc * 8) * 72 + t; const v4u w = pre[i];
                    d[0 * 72] = (bf16)(w.x & 0xffffu); d[1 * 72] = (bf16)(w.x >> 16); d[2 * 72] = (bf16)(w.y & 0xffffu); d[3 * 72] = (bf16)(w.y >> 16);
                    d[4 * 72] = (bf16)(w.z & 0xffffu); d[5 * 72] = (bf16)(w.z >> 16); d[6 * 72] = (bf16)(w.w & 0xffffu); d[7 * 72] = (bf16)(w.w >> 16); } } }
            if (wave == 0) {
                const float fp = gf + fb;
                const float lf = fminf(fp, 0.f) - log1pf(__expf(-fabsf(fp)));
                float bs = lf;
#pragma unroll
                for (int o = 1; o < 64; o <<= 1) { const float v = __shfl_up(bs, o); if (lane >= o) bs += v; }
                const float g = gi - bs;
                float cm = g;
#pragma unroll
                for (int o = 1; o < 64; o <<= 1) { const float v = __shfl_up(cm, o); if (lane >= o) cm = fmaxf(cm, v); }
                const float Mx = fmaxf(m_prev, cm);
                const float mt = bs + Mx;
                const float blast = __shfl(bs, 63), m_new = __shfl(mt, 63);
                gA[lane] = g; MxA[lane] = Mx; wA[lane] = __expf(m_prev - Mx); emtA[lane] = __expf(-mt); wkA[lane] = __expf(g + blast - m_new) * KSCALE;
                if (lane == 0) scal[0] = __expf(blast + m_prev - m_new);
                m_prev = m_new;
            }
            if (c + 1 < NTOK / 64) ML_PREFETCH(c + 1);
            __syncthreads();
#pragma unroll
            for (int j = 0; j < 2; ++j) { const int idx = 2 * wave + j, ti = idx >> 2, si = idx & 3;
                f32x4 a4 = (f32x4){0.f, 0.f, 0.f, 0.f};
                if (si <= ti) {
#pragma unroll
                    for (int ks = 0; ks < 3; ++ks) a4 = MFMA16(lds8((lptr)(Qs + (16 * ti + c16) * 104 + 32 * ks + 8 * rg)), lds8((lptr)(Ks + (16 * si + c16) * 104 + 32 * ks + 8 * rg)), a4);
                }
                const int s = 16 * si + c16; const float gs = gA[s];
#pragma unroll
                for (int r = 0; r < 4; ++r) { const int t = 16 * ti + 4 * rg + r; const float v = (s <= t) ? a4[r] * KSCALE * __expf(gs - MxA[t]) : 0.f; QKM[t * 72 + s] = (bf16)f2bf(v); } }
            for (int id = tid; id < 64 * 12; id += NTHR) { const int t = id / 12, cc = id % 12; const v4u w = *(const LAS v4u*)(Ks + t * 104 + cc * 8); const float sc = wkA[t]; LAS bf16* d = KT + (cc * 8) * 72 + t;
                d[0 * 72] = (bf16)f2bf(bflo(w.x) * sc); d[1 * 72] = (bf16)f2bf(bfhi(w.x) * sc); d[2 * 72] = (bf16)f2bf(bflo(w.y) * sc); d[3 * 72] = (bf16)f2bf(bfhi(w.y) * sc);
                d[4 * 72] = (bf16)f2bf(bflo(w.z) * sc); d[5 * 72] = (bf16)f2bf(bfhi(w.z) * sc); d[6 * 72] = (bf16)f2bf(bflo(w.w) * sc); d[7 * 72] = (bf16)f2bf(bfhi(w.w) * sc); }
            if (wave >= 4) { const int sw = wave - 4;
#pragma unroll
                for (int i = 0; i < 11; ++i) { const int j = sw + 4 * i; if (j < 42) { const int di = j / 7, vi = j % 7;
                    v2u w; w.x = pk2(acc[i][0], acc[i][1]); w.y = pk2(acc[i][2], acc[i][3]); *(LAS v2u*)(ST + (16 * vi + c16) * 104 + 16 * di + 4 * rg) = w; } } }
            __syncthreads();
            if (wave < 4) {
                const int ti = wave;
                f32x4 aX[7];
#pragma unroll
                for (int vi = 0; vi < 7; ++vi) aX[vi] = (f32x4){0.f, 0.f, 0.f, 0.f};
#pragma unroll
                for (int ks = 0; ks < 3; ++ks) { const bf16x8 a8 = lds8((lptr)(Qs + (16 * ti + c16) * 104 + 32 * ks + 8 * rg));
#pragma unroll
                    for (int vi = 0; vi < 7; ++vi) aX[vi] = MFMA16(a8, lds8((lptr)(ST + (16 * vi + c16) * 104 + 32 * ks + 8 * rg)), aX[vi]); }
                { const f32x4 w4 = *(const LAS f32x4*)(wA + 16 * ti + 4 * rg);
#pragma unroll
                  for (int vi = 0; vi < 7; ++vi) aX[vi] = aX[vi] * w4; }
#pragma unroll
                for (int ks = 0; ks < 2; ++ks) { const bf16x8 a8 = lds8((lptr)(QKM + (16 * ti + c16) * 72 + 32 * ks + 8 * rg));
#pragma unroll
                    for (int vi = 0; vi < 7; ++vi) aX[vi] = MFMA16(a8, lds8((lptr)(VT + (16 * vi + c16) * 72 + 32 * ks + 8 * rg)), aX[vi]); }
                const bool skip_out = (!with_ctx) && (c < CTXL / 64);
#pragma unroll
                for (int r = 0; r < 4; ++r) { const int t = 16 * ti + 4 * rg + r;
                    const float den = __shfl(aX[6][r], lane & 48);
                    const float inv = 1.0f / fmaxf(fabsf(den), emtA[t]);
                    int slot; const int row = scan_row(b, dir, 64 * c + t, slot);
                    float hv[6];
#pragma unroll
                    for (int vi = 0; vi < 6; ++vi) hv[vi] = aX[vi][r] * inv;
                    bf16* rp = rawb + (size_t)slot * 96 + c16;
                    if (dir == 0) {
#pragma unroll
                        for (int vi = 0; vi < 6; ++vi) rp[16 * vi] = (bf16)f2bf(hv[vi]);
                    } else if (!skip_out) {
                        float ss = 0.f;
#pragma unroll
                        for (int vi = 0; vi < 6; ++vi) { hv[vi] += bf2f(rp[16 * vi]); ss += hv[vi] * hv[vi]; }
                        ss += __shfl_xor(ss, 1); ss += __shfl_xor(ss, 2); ss += __shfl_xor(ss, 4); ss += __shfl_xor(ss, 8);
                        const float rs = 1.0f / sqrtf(ss * (1.0f / 96.0f) + EPS);
                        const bf16* og = P + (size_t)row * DINP + C_MLO + h * 96 + c16; bf16* yo = YM + (size_t)row * D + Y_ML + h * 96 + c16;
#pragma unroll
                        for (int vi = 0; vi < 6; ++vi) { const float o = bf2f(og[16 * vi]); yo[16 * vi] = (bf16)f2bf(hv[vi] * rs * gain[h * 96 + 16 * vi + c16] / (1.0f + __expf(-o))); }
                    } }
            } else {
                const int sw = wave - 4; const float decay = scal[0];
#pragma unroll
                for (int i = 0; i < 11; ++i) { const int j = sw + 4 * i; if (j < 42) { const int di = j / 7, vi = j % 7;
                    acc[i] = acc[i] * decay;
#pragma unroll
                    for (int ks = 0; ks < 2; ++ks) acc[i] = MFMA16(lds8((lptr)(KT + (16 * di + c16) * 72 + 32 * ks + 8 * rg)), lds8((lptr)(VT + (16 * vi + c16) * 72 + 32 * ks + 8 * rg)), acc[i]); } }
            }
            VM_WAIT();
            __syncthreads();
        }
#undef ML_PREFETCH
    }
}

constexpr int HG_QT = 0, HG_KR = 8704, HG_KTT = 17408, HG_VT = 27648, HG_ATT = 32768, HG_SPT = 35328, HG_ER = 52736, HG_TOT = 53248;

__device__ __forceinline__ void hgrn2_item(lptr lds, const bf16* P, bf16* YM, bf16* RAW, const float* lbl  , const float* gain  , bool with_ctx, int b, int h) {
    const int tid = tid_opaque(), lane = tid & 63, c16 = lane & 15, rg = lane >> 4, wave = __builtin_amdgcn_readfirstlane(tid >> 6);
    LAS bf16* QT = (LAS bf16*)(lds + HG_QT); LAS bf16* KR = (LAS bf16*)(lds + HG_KR); LAS bf16* KTT = (LAS bf16*)(lds + HG_KTT); LAS bf16* VT = (LAS bf16*)(lds + HG_VT);
    LAS bf16* ATT = (LAS bf16*)(lds + HG_ATT); LAS bf16* SPT = (LAS bf16*)(lds + HG_SPT); LAS float* ER = (LAS float*)(lds + HG_ER); LAS float* TOT = (LAS float*)(lds + HG_TOT);
    const int kx = tid & 127, tq = tid >> 7;
    const int vc = tid & 63, t4 = tid >> 6;
    bf16* rawb = RAW + (size_t)(b * 4 + h) * NTOK * 64;
    for (int dir = 0; dir < 2; ++dir) {
        const float lb = lbl[dir * 512 + h * 128 + kx];
        const float lbf = fmaxf(lb, 1e-30f), oml = 1.0f - lb;
        f32x4 acc[4];
#pragma unroll
        for (int i = 0; i < 4; ++i) acc[i] = (f32x4){0.f, 0.f, 0.f, 0.f};
        bf16 zr[8], qr[8], vr[4];
#define HG_PREFETCH(c) do { \
        _Pragma("unroll") for (int j_ = 0; j_ < 8; ++j_) { int sl_; const int row_ = scan_row(b, dir, 32 * (c) + 8 * tq + j_, sl_); const bf16* pr_ = P + (size_t)row_ * DINP; \
            zr[j_] = pr_[C_HGF + dir * 512 + h * 128 + kx]; qr[j_] = pr_[C_HGQ + h * 128 + kx]; } \
        _Pragma("unroll") for (int j_ = 0; j_ < 4; ++j_) { int sl_; const int row_ = scan_row(b, dir, 32 * (c) + 4 * t4 + j_, sl_); vr[j_] = P[(size_t)row_ * DINP + C_HGI + h * 64 + vc]; } } while (0)
        HG_PREFETCH(0);
        for (int c = 0; c < NTOK / 32; ++c) {
            float kk[8], cs[8]; float run = 0.f;
#pragma unroll
            for (int j = 0; j < 8; ++j) { const float z = bf2f(zr[j]); const float e = __expf(-fabsf(z)); const float inv = 1.0f / (1.0f + e);
                const float sig = z >= 0.f ? inv : e * inv, nsig = z >= 0.f ? e * inv : inv;
                const float f = lbf + oml * sig; kk[j] = oml * nsig; run += __log2f(f); cs[j] = run; }
            TOT[tq * 128 + kx] = run;
            __syncthreads();
            {
                const float t0 = TOT[kx], t1 = TOT[128 + kx], t2 = TOT[256 + kx], t3 = TOT[384 + kx];
                const float off = (tq > 0 ? t0 : 0.f) + (tq > 1 ? t1 : 0.f) + (tq > 2 ? t2 : 0.f);
                const float rr = 0.5f * ((t0 + t1) + (t2 + t3));
                unsigned kp[8];
#pragma unroll
                for (int j = 0; j < 8; ++j) { float x = off + cs[j] - rr; x = fminf(fmaxf(x, -100.f), 100.f);
                    const float q = bf2f(qr[j]); const float qs = q / (1.0f + __expf(-q));
                    const float qt = qs * __builtin_amdgcn_exp2f(x), kt = kk[j] * __builtin_amdgcn_exp2f(-x);
                    const int t = 8 * tq + j; QT[t * 136 + kx] = (bf16)f2bf(qt); kp[j] = f2bf(kt); KR[t * 136 + kx] = (bf16)kp[j]; }
                v4u w; w.x = kp[0] | (kp[1] << 16); w.y = kp[2] | (kp[3] << 16); w.z = kp[4] | (kp[5] << 16); w.w = kp[6] | (kp[7] << 16);
                *(LAS v4u*)(KTT + kx * 40 + 8 * tq) = w;
                if (tq == 0) ER[kx] = __builtin_amdgcn_exp2f(fmaxf(rr, -100.f));
                v2u wv; wv.x = (unsigned)vr[0] | ((unsigned)vr[1] << 16); wv.y = (unsigned)vr[2] | ((unsigned)vr[3] << 16);
                *(LAS v2u*)(VT + vc * 40 + 4 * t4) = wv;
            }
            if (c + 1 < NTOK / 32) HG_PREFETCH(c + 1);
            __syncthreads();
            if (wave < 4) { const int ti = wave >> 1, si = wave & 1;
                f32x4 a4 = (f32x4){0.f, 0.f, 0.f, 0.f};
                if (si <= ti) {
#pragma unroll
                    for (int ks = 0; ks < 4; ++ks) a4 = MFMA16(lds8((lptr)(QT + (16 * ti + c16) * 136 + 32 * ks + 8 * rg)), lds8((lptr)(KR + (16 * si + c16) * 136 + 32 * ks + 8 * rg)), a4);
                }
                const int s = 16 * si + c16;
#pragma unroll
                for (int r = 0; r < 4; ++r) { const int t = 16 * ti + 4 * rg + r; ATT[t * 40 + s] = (bf16)f2bf(s <= t ? a4[r] : 0.f); } }
            { const f32x4 er = *(const LAS f32x4*)(ER + 16 * wave + 4 * rg);
#pragma unroll
              for (int ci = 0; ci < 4; ++ci) { acc[ci] = acc[ci] * er; v2u w; w.x = pk2(acc[ci][0], acc[ci][1]); w.y = pk2(acc[ci][2], acc[ci][3]);
                  *(LAS v2u*)(SPT + (16 * ci + c16) * 136 + 16 * wave + 4 * rg) = w; } }
            __syncthreads();
            if (wave < 2) { const int ti = wave;
                f32x4 o4[4];
#pragma unroll
                for (int ci = 0; ci < 4; ++ci) o4[ci] = (f32x4){0.f, 0.f, 0.f, 0.f};
                { const bf16x8 a8 = lds8((lptr)(ATT + (16 * ti + c16) * 40 + 8 * rg));
#pragma unroll
                  for (int ci = 0; ci < 4; ++ci) o4[ci] = MFMA16(a8, lds8((lptr)(VT + (16 * ci + c16) * 40 + 8 * rg)), o4[ci]); }
#pragma unroll
                for (int ks = 0; ks < 4; ++ks) { const bf16x8 a8 = lds8((lptr)(QT + (16 * ti + c16) * 136 + 32 * ks + 8 * rg));
#pragma unroll
                    for (int ci = 0; ci < 4; ++ci) o4[ci] = MFMA16(a8, lds8((lptr)(SPT + (16 * ci + c16) * 136 + 32 * ks + 8 * rg)), o4[ci]); }
                const bool skip_out = (!with_ctx) && (c < CTXL / 32);
#pragma unroll
                for (int r = 0; r < 4; ++r) { const int t = 16 * ti + 4 * rg + r; int slot; const int row = scan_row(b, dir, 32 * c + t, slot);
                    bf16* rp = rawb + (size_t)slot * 64 + c16;
                    if (dir == 0) {
#pragma unroll
                        for (int ci = 0; ci < 4; ++ci) rp[16 * ci] = (bf16)f2bf(o4[ci][r]);
                    } else if (!skip_out) {
                        float hv[4]; float ss = 0.f;
#pragma unroll
                        for (int ci = 0; ci < 4; ++ci) { hv[ci] = o4[ci][r] + bf2f(rp[16 * ci]); ss += hv[ci] * hv[ci]; }
                        ss += __shfl_xor(ss, 1); ss += __shfl_xor(ss, 2); ss += __shfl_xor(ss, 4); ss += __shfl_xor(ss, 8);
                        const float rs = 1.0f / sqrtf(ss * (1.0f / 64.0f) + EPS);
                        const bf16* gg = P + (size_t)row * DINP + C_HGG + h * 64 + c16; bf16* yo = YM + (size_t)row * D + Y_HG + h * 64 + c16;
#pragma unroll
                        for (int ci = 0; ci < 4; ++ci) { const float g = bf2f(gg[16 * ci]); yo[16 * ci] = (bf16)f2bf(hv[ci] * rs * gain[h * 64 + 16 * ci + c16] * g / (1.0f + __expf(-g))); }
                    } } }
            { const bf16x8 a8 = lds8((lptr)(KTT + (16 * wave + c16) * 40 + 8 * rg)); const f32x4 er = *(const LAS f32x4*)(ER + 16 * wave + 4 * rg);
#pragma unroll
              for (int ci = 0; ci < 4; ++ci) { acc[ci] = MFMA16(a8, lds8((lptr)(VT + (16 * ci + c16) * 40 + 8 * rg)), acc[ci]); acc[ci] = acc[ci] * er; } }
            VM_WAIT();
            __syncthreads();
        }
#undef HG_PREFETCH
    }
}
#ifndef NO_HG
#define NO_HG 0
#endif
#ifndef NO_ML
#define NO_ML 0
#endif
#ifndef NO_AT
#define NO_AT 0
#endif
#ifndef NO_GEMM
#define NO_GEMM 0
#endif
#ifndef NO_P0
#define NO_P0 0
#endif
constexpr int NPHASE = 2 + 7 * DEPTH;

__global__ void __launch_bounds__(NTHR, 2) fwd(Args a) {
    extern __shared__ __attribute__((aligned(16))) unsigned char lds_raw[];
    lptr lds = (lptr)lds_raw;
    const int tid = threadIdx.x;
    const int G = gridDim.x; const int bx = blockIdx.x; const int vcu = (G % 8 == 0) ? (bx % 8) * (G / 8) + bx / 8 : bx;
    unsigned char* ws = a.ws;
    gu32* ctl = (gu32*)(ws + WS_CTL);
    volatile LAS unsigned* MISC = (volatile LAS unsigned*)(lds + LDSCTL_OFF);
    for (int u = tid; u < (LDS_BYTES - LDSCTL_OFF) / 4; u += NTHR) ((LAS unsigned*)(lds + LDSCTL_OFF))[u] = 0u;
    __syncthreads();
    const int lo = a.ph_lo, hi = a.ph_hi;
    XcdBarrier bar; bar.bar = (unsigned*)ctl + CW_BAR; bar.x = 0; bar.st = nullptr;
    if (hi - lo > 1) bar = xcd_barrier_post((unsigned*)ctl + CW_BAR, MISC + 8);
    volatile LAS int* slot = (volatile LAS int*)(MISC + 16);
#define IN(k) (lo <= (k) && (k) < hi)
#define SEAM(k) do { if (IN(k) && IN((k) + 1)) xcd_barrier(bar); } while (0)

    float* mod = (float*)(ws + WS_MOD);
    const float* lbs = (const float*)(ws + WS_MISC); const float* rope = (const float*)(ws + WS_MISC + 16384); const float* biasp = (const float*)(ws + WS_MISC + 32768); const float* lamv = (const float*)(ws + WS_MISC + 114688);
    float* Gt = (float*)(ws + WS_GATE);
    bf16* Win = (bf16*)(ws + WS_WIN); bf16* Wout = (bf16*)(ws + WS_WOUT); bf16* Wgu = (bf16*)(ws + WS_WGU); bf16* Wd = (bf16*)(ws + WS_WD);
    float* ctxx = (float*)(ws + WS_CTXX); bf16* HB = (bf16*)(ws + WS_HB);
    bf16* RAWM = (bf16*)(ws + WS_RAWM); bf16* RAWH = (bf16*)(ws + WS_RAWH);
    bf16* Pb = (bf16*)(ws + WS_P); float* Y = (float*)(ws + WS_P); bf16* U = (bf16*)(ws + WS_P); float* YD = (float*)(ws + WS_YD);

    if (IN(0)) { if (!NO_P0) p0_phase(lds, a); } SEAM(0);

    for (int l = 0; l < DEPTH; ++l) {
        const int pb = 1 + 7 * l;
        const bool with_ctx = l < DEPTH - 1;
        const float* modl = mod + (size_t)l * 17 * NMOD;
        if (IN(pb)) {
            if (l == 0) thin_phase<false, true>(0, a.in[I_X], a.in[I_CTX], a.out, ctxx, false, nullptr, nullptr, 0, nullptr, modl, 0, D, a.in[I_GPREMIX] + l * D, HB, vcu, G);
            else        thin_phase<true, true>(0, l == 1 ? a.out : a.out, ctxx, a.out, ctxx, true, YD, modl - 17 * NMOD, 5 * D, a.in[I_GPOSTFFN] + (l - 1) * D, modl, 0, D, a.in[I_GPREMIX] + l * D, HB, vcu, G);
            convert_weights(lds, a, l, vcu, G);
        }
        SEAM(pb);
        if (IN(pb + 1)) {
            pg8::Gemm g{HB, Win, MT, DINP, D}; pg8::StaticOrder S; S.init(MT, DINP, G, bx);
            pg8::EpiIn E{Pb, DINP, biasp + l * DINP, Gt};
            if (!NO_GEMM) pg8::gemm_phase<pg8::EpiIn, pg8::StaticOrder, true, true>(lds, g, S, E);
        }
        SEAM(pb + 1);
        if (IN(pb + 2)) {
            unsigned* qh = (unsigned*)ctl + CW_Q + 64 * (3 * l), *qm = qh + 64, *qa = qh + 128;
            for (;;) { const int it = wg_pull(qh, slot); if (it >= 64) break;
                if (!NO_HG) hgrn2_item(lds, Pb, HB, RAWH, lbs + l * 1024, a.in[I_HGNORM] + l * 256, with_ctx, it >> 2, it & 3); }
            for (;;) { const int it = wg_pull(qm, slot); if (it >= 64) break;
                if (!NO_ML) mlstm_item(lds, Pb, Gt, HB, RAWM, a.in[I_MLFB] + l * 8, a.in[I_MLNORM] + l * 384, with_ctx, it >> 2, it & 3); }
            const int na = with_ctx ? 576 : 512;
            const float lam_init = 0.8f - 0.6f * __expf(-0.3f * (float)l);
            for (;;) { const int it = wg_pull(qa, slot); if (it >= na) break;
                const int bh = it < 512 ? it >> 3 : it - 512, qb = it < 512 ? it & 7 : 8;
                if (!NO_AT) attn_item(lds, Pb, HB, rope, a.in[I_DANORM] + l * 96, lamv[l], 1.0f - lam_init, bh >> 2, bh & 3, qb); }
            __syncthreads();
        }
        SEAM(pb + 2);
        const int r0 = with_ctx ? 0 : MC; const int Mg = MT - r0;
        if (IN(pb + 3)) {
            pg8::Gemm g{HB + (size_t)r0 * D, Wout, Mg, D, D}; pg8::StaticOrder S; S.init(Mg, D, G, bx);
            pg8::EpiF32 E{Y + (size_t)r0 * D, D};
            if (!NO_GEMM) pg8::gemm_phase<pg8::EpiF32, pg8::StaticOrder, true, true>(lds, g, S, E);
        }
        SEAM(pb + 3);
        if (IN(pb + 4)) {
            const float* xl = (l == 0) ? a.in[I_X] : a.out; const float* xc = (l == 0) ? a.in[I_CTX] : ctxx;
            thin_phase<true, true>(r0, xl, xc, a.out, ctxx, true, Y, modl, 2 * D, a.in[I_GPOSTMIX] + l * D, modl, 3 * D, 4 * D, a.in[I_GPREFFN] + l * D, HB, vcu, G);
        }
        SEAM(pb + 4);
        if (IN(pb + 5)) {
            pg8::Gemm g{HB + (size_t)r0 * D, Wgu, Mg, NGU, D}; pg8::StaticOrder S; S.init(Mg, NGU, G, bx);
            pg8::EpiSwiglu E{U + (size_t)r0 * DFF, DFF};
            if (!NO_GEMM) pg8::gemm_phase<pg8::EpiSwiglu, pg8::StaticOrder, true, true>(lds, g, S, E);
        }
        SEAM(pb + 5);
        if (IN(pb + 6)) {
            pg8::Gemm g{U + (size_t)r0 * DFF, Wd, Mg, D, DFF}; pg8::StaticOrder S; S.init(Mg, D, G, bx);
            pg8::EpiF32 E{YD + (size_t)r0 * D, D};
            if (!NO_GEMM) pg8::gemm_phase<pg8::EpiF32, pg8::StaticOrder, true, true>(lds, g, S, E);
        }
        SEAM(pb + 6);
    }
    if (IN(NPHASE - 1)) {
        const float* modl = mod + (size_t)(DEPTH - 1) * 17 * NMOD;
        thin_phase<true, false>(MC, a.out, ctxx, a.out, ctxx, true, YD, modl, 5 * D, a.in[I_GPOSTFFN] + (DEPTH - 1) * D, nullptr, 0, 0, nullptr, nullptr, vcu, G);
    }
#undef IN
#undef SEAM
}

extern "C" void kernel_launch(void* const* d_in, const int* in_sizes, int n_in, void* d_out, int out_size, void* d_ws, size_t ws_size, hipStream_t stream) {
    static int grid = 0;
    if (grid == 0) {
        if (n_in != 22 || in_sizes[0] != ML * D || out_size != ML * D || ws_size < WS_END) {
            fprintf(stderr, "kernel_launch: unexpected shapes: n_in %d in0 %d out %d ws %zu (need %zu); nothing launched\n", n_in, n_in > 0 ? in_sizes[0] : -1, out_size, ws_size, (size_t)WS_END); grid = -1; return; }
        int dev = 0, cus = 0, per_cu = 0;
        if (hipGetDevice(&dev) != hipSuccess || hipDeviceGetAttribute(&cus, hipDeviceAttributeMultiprocessorCount, dev) != hipSuccess) { fprintf(stderr, "kernel_launch: device query failed\n"); grid = -1; return; }
        if (hipFuncSetAttribute((const void*)fwd, hipFuncAttributeMaxDynamicSharedMemorySize, LDS_BYTES) != hipSuccess) { fprintf(stderr, "kernel_launch: hipFuncSetAttribute failed\n"); grid = -1; return; }
        if (hipOccupancyMaxActiveBlocksPerMultiprocessor(&per_cu, (const void*)fwd, NTHR, LDS_BYTES) != hipSuccess || per_cu < 1)
            fprintf(stderr, "kernel_launch: note: occupancy query reports %d workgroups per CU\n", per_cu);
        (void)hipGetLastError();
        grid = cus;
    }
    if (grid < 0) return;
    if (hipMemsetAsync((char*)d_ws + WS_CTL, 0, CTL_ZERO_BYTES, stream) != hipSuccess) { fprintf(stderr, "kernel_launch: memset failed\n"); return; }
    Args a{};
    for (int i = 0; i < 22; ++i) a.in[i] = (const float*)d_in[i];
    a.out = (float*)d_out; a.ws = (unsigned char*)d_ws;
#if MK_PER_PHASE
    for (int p = 0; p < NPHASE; ++p) { a.ph_lo = p; a.ph_hi = p + 1; hipLaunchKernelGGL(fwd, dim3(grid), dim3(NTHR), LDS_BYTES, stream, a); }
#else
    a.ph_lo = 0; a.ph_hi = NPHASE;
    hipLaunchKernelGGL(fwd, dim3(grid), dim3(NTHR), LDS_BYTES, stream, a);
#endif
    const hipError_t le = hipPeekAtLastError();
    if (le != hipSuccess) fprintf(stderr, "kernel_launch: launch failed: %s\n", hipGetErrorName(le));
}
```

```cpp
#include <hip/hip_runtime.h>
#include <cstdio>
#include <cstdint>
#ifndef MK_PER_PHASE
#define MK_PER_PHASE 0
#endif
namespace pg8 {
#define PG8_LAS __attribute__((address_space(3)))
typedef unsigned short bf16_t;
typedef short bf16x8 __attribute__((ext_vector_type(8)));
typedef float f32x4 __attribute__((ext_vector_type(4)));
typedef unsigned u32x4 __attribute__((ext_vector_type(4)));
constexpr int BM = 256, BK = 64, HALF = 128, HTB = HALF * BK * 2  , STAGE_BYTES = 8 * HTB, NXCD = 8, WGM = 8;

__host__ __device__ __forceinline__ int lds_byte(int r, int c) { const int st = (r >> 4) * 2 + (c >> 5), rr = r & 15, cc = c & 31, ob = rr * 64 + cc * 2; return st * 1024 + (ob ^ (((ob >> 9) & 1) << 5)); }
__host__ __device__ __forceinline__ void stage_rc(int b, int& R, int& C) { const int st = b / 1024, sb = b % 1024, swz = sb ^ (((sb >> 9) & 1) << 5); R = (st >> 1) * 16 + swz / 64; C = (st & 1) * 32 + (swz % 64) / 2; }
__host__ __device__ __forceinline__ int perm32(int rho) { const int n = rho >> 4, i = rho & 15; return 8 * (i >> 2) + 4 * n + (i & 3); }

struct Unit { int pm, pn; };
struct Gemm { const bf16_t* A; const bf16_t* Bt; int M, N, K; };

struct StaticOrder {
    int nM, nN, nwg, G, c;
    __host__ __device__ void init(int M, int N, int G_, int c_) { nM = M / BM; nN = N / BM; nwg = nM * nN; G = G_; c = c_; }
    __host__ __device__ bool next(int i, Unit& u) const {
        const long L = (long)i * G + c; if (L >= nwg) return false;
        int wgid = (int)L; { const int q = nwg / NXCD, r = nwg % NXCD, xcd = wgid % NXCD, off = wgid / NXCD; wgid = (xcd < r ? xcd * (q + 1) : r * (q + 1) + (xcd - r) * q) + off; }
        const int nig = WGM * nN, gid = wgid / nig, fm = gid * WGM, gsz = (nM - fm) < WGM ? (nM - fm) : WGM;
        u.pm = fm + ((wgid % nig) % gsz); u.pn = (wgid % nig) / gsz; return true;
    }
    __device__ __forceinline__ void a_ready(const Unit&) const {}
    __device__ __forceinline__ void done(const Unit&) const {}
};
__device__ __forceinline__ unsigned cvt_pk_bf16(float lo, float hi) { unsigned r; asm volatile("v_cvt_pk_bf16_f32 %0, %1, %2" : "=v"(r) : "v"(lo), "v"(hi)); return r; }
struct EpiF32 {
    static constexpr bool PERM = false, AFTER_DRAIN = false;
    float* C; int ldc;
    __device__ __forceinline__ void operator()(const f32x4 (&acc)[2][2][4][2], const Unit& u, int wr, int wc, int fr, int fq) const {
        const int row0 = u.pm * BM + wr * 64 + fr, col0 = u.pn * BM + wc * 32 + 4 * fq;
#pragma unroll
        for (int ai = 0; ai < 2; ++ai)
#pragma unroll
            for (int m = 0; m < 4; ++m) { float* rowp = C + (size_t)(row0 + ai * HALF + m * 16) * ldc + col0;
#pragma unroll
                for (int bj = 0; bj < 2; ++bj)
#pragma unroll
                    for (int n = 0; n < 2; ++n) *(f32x4*)(rowp + bj * HALF + n * 16) = acc[ai][bj][m][n]; }
    }
};
struct EpiIn {
    static constexpr bool PERM = true, AFTER_DRAIN = false;
    bf16_t* O; int ldc; const float* bias; float* G;
    __device__ __forceinline__ void operator()(const f32x4 (&acc)[2][2][4][2], const Unit& u, int wr, int wc, int fr, int fq) const {
        const int row0 = u.pm * BM + wr * 64 + fr; const int col0 = u.pn * BM + wc * 32 + 8 * fq;
        const bool gate_lane = (u.pn == 6) && (wc == 0) && (fq < 2);
#pragma unroll
        for (int bj = 0; bj < 2; ++bj) {
            const f32x4 b0 = *(const f32x4*)(bias + col0 + bj * HALF), b1 = *(const f32x4*)(bias + col0 + bj * HALF + 4);
#pragma unroll
            for (int ai = 0; ai < 2; ++ai)
#pragma unroll
                for (int m = 0; m < 4; ++m) { const int row = row0 + ai * HALF + m * 16; bf16_t* rowp = O + (size_t)row * ldc + col0;
                    const f32x4 v0 = acc[ai][bj][m][0] + b0, v1 = acc[ai][bj][m][1] + b1;
                    u32x4 w; w.x = cvt_pk_bf16(v0[0], v0[1]); w.y = cvt_pk_bf16(v0[2], v0[3]); w.z = cvt_pk_bf16(v1[0], v1[1]); w.w = cvt_pk_bf16(v1[2], v1[3]);
                    *(u32x4*)(rowp + bj * HALF) = w;
                    if (bj == 0 && gate_lane) { float* g = G + (size_t)row * 16 + 8 * fq; *(f32x4*)g = v0; *(f32x4*)(g + 4) = v1; } }
        }
    }
};
struct EpiSwiglu {
    static constexpr bool PERM = true, AFTER_DRAIN = false;
    bf16_t* O; int ldc;
    __device__ __forceinline__ void operator()(const f32x4 (&acc)[2][2][4][2], const Unit& u, int wr, int wc, int fr, int fq) const {
        const int row0 = u.pm * BM + wr * 64 + fr; const int col0 = u.pn * HALF + wc * 32 + 8 * fq;
#pragma unroll
        for (int ai = 0; ai < 2; ++ai)
#pragma unroll
            for (int m = 0; m < 4; ++m) { bf16_t* rowp = O + (size_t)(row0 + ai * HALF + m * 16) * ldc + col0;
                f32x4 r0, r1;
#pragma unroll
                for (int i = 0; i < 4; ++i) { const float g0 = acc[ai][0][m][0][i], g1 = acc[ai][0][m][1][i];
                    r0[i] = g0 * __builtin_amdgcn_rcpf(1.0f + __expf(-g0)) * acc[ai][1][m][0][i];
                    r1[i] = g1 * __builtin_amdgcn_rcpf(1.0f + __expf(-g1)) * acc[ai][1][m][1][i]; }
                u32x4 w; w.x = cvt_pk_bf16(r0[0], r0[1]); w.y = cvt_pk_bf16(r0[2], r0[3]); w.z = cvt_pk_bf16(r1[0], r1[1]); w.w = cvt_pk_bf16(r1[2], r1[3]);
                *(u32x4*)rowp = w; }
    }
};
template <class Epi, class Sched, bool ALIGN_EPI = false, bool SP2 = false>
__device__ __forceinline__ void gemm_phase(PG8_LAS unsigned char* lds, const Gemm g, const Sched& S, const Epi& E) {
    int tid_ = threadIdx.x; asm volatile("" : "+v"(tid_));
    const int tid = tid_, wid = __builtin_amdgcn_readfirstlane(tid >> 6), lane = tid & 63, wr = wid >> 2, wc = wid & 3, fr = lane & 15, fq = lane >> 4;
    const int K = g.K, nt = K / BK;
    unsigned voffA[2], voffB[2];
#pragma unroll
    for (int i = 0; i < 2; ++i) { int R, C; stage_rc(tid * 16 + i * 8192, R, C); const int Rb = Epi::PERM ? ((R & ~31) + perm32(R & 31)) : R;
        voffA[i] = (unsigned)(R * K + C) * 2u; voffB[i] = (unsigned)(Rb * K + C) * 2u; }
    const size_t kstep = (size_t)(BK * 2);
    const size_t hstep = (size_t)HALF * K * 2;
    const size_t tstep = 2 * hstep;
    const unsigned ldsw = (unsigned)wid * 1024u;
    const int aoff = lds_byte(wr * 64 + fr, fq * 8), boff = lds_byte(wc * 32 + fr, fq * 8);
#define PG8_SA(b, h) (((b) * 2 + (h)) * HTB)
#define PG8_SB(b, h) ((4 + (b) * 2 + (h)) * HTB)
#define PG8_STAGE(bufoff, gbase, voff) do { _Pragma("unroll") for (int _i = 0; _i < 2; ++_i) \
        __builtin_amdgcn_global_load_lds((const unsigned*)((const char*)(gbase) + (voff)[_i]), (PG8_LAS unsigned*)(lds + (bufoff) + ldsw + _i * 8192), 16, 0, 0); } while (0)
#define PG8_LDA(dst, b, h) do { _Pragma("unroll") for (int m = 0; m < 4; ++m) _Pragma("unroll") for (int k = 0; k < 2; ++k) dst[m][k] = *(const PG8_LAS bf16x8*)(lds + PG8_SA(b, h) + aoff + m * 2048 + k * 1024); } while (0)
#define PG8_LDB(dst, b, h) do { _Pragma("unroll") for (int n = 0; n < 2; ++n) _Pragma("unroll") for (int k = 0; k < 2; ++k) dst[n][k] = *(const PG8_LAS bf16x8*)(lds + PG8_SB(b, h) + boff + n * 2048 + k * 1024); } while (0)
#define PG8_MMA(ai, bj, At, Bt) do { __builtin_amdgcn_s_setprio(1); _Pragma("unroll") for (int m = 0; m < 4; ++m) _Pragma("unroll") for (int n = 0; n < 2; ++n) _Pragma("unroll") for (int k = 0; k < 2; ++k) \
        acc[ai][bj][m][n] = __builtin_amdgcn_mfma_f32_16x16x32_bf16(Bt[n][k], At[m][k], acc[ai][bj][m][n], 0, 0, 0); __builtin_amdgcn_s_setprio(0); } while (0)
#define PG8_WAIT_V(n) asm volatile("s_waitcnt vmcnt(" #n ")" ::: "memory")
#define PG8_WAIT_L(n) asm volatile("s_waitcnt lgkmcnt(" #n ")" ::: "memory")
#define PG8_BAR __builtin_amdgcn_s_barrier()
#define PG8_SCHED __builtin_amdgcn_sched_barrier(0)
    Unit cur, nxt; int ui = 0;
    if (!S.next(0, cur)) return;
    f32x4 acc[2][2][4][2];
#pragma unroll
    for (int a = 0; a < 2; ++a)
#pragma unroll
        for (int b = 0; b < 2; ++b)
#pragma unroll
            for (int m = 0; m < 4; ++m)
#pragma unroll
                for (int n = 0; n < 2; ++n) acc[a][b][m][n] = (f32x4){0.f, 0.f, 0.f, 0.f};
    bf16x8 At[4][2], B0[2][2], B1[2][2];
    const char* cA = (const char*)g.A + (size_t)cur.pm * tstep; const char* cB = (const char*)g.Bt + (size_t)cur.pn * tstep;
    S.a_ready(cur);
    if constexpr (SP2) {
        PG8_STAGE(PG8_SB(0, 0), cB, voffB); PG8_STAGE(PG8_SB(0, 1), cB + hstep, voffB); PG8_STAGE(PG8_SA(0, 0), cA, voffA); PG8_STAGE(PG8_SA(0, 1), cA + hstep, voffA);
        if (wr == 1) PG8_BAR;
        PG8_WAIT_V(2); PG8_BAR;
        PG8_STAGE(PG8_SB(1, 0), cB + kstep, voffB); PG8_STAGE(PG8_SA(1, 0), cA + kstep, voffA); PG8_STAGE(PG8_SB(1, 1), cB + hstep + kstep, voffB);
        PG8_WAIT_V(6); PG8_BAR;
    } else {
        PG8_STAGE(PG8_SB(0, 0), cB, voffB); PG8_STAGE(PG8_SA(0, 0), cA, voffA); PG8_STAGE(PG8_SB(0, 1), cB + hstep, voffB); PG8_STAGE(PG8_SA(0, 1), cA + hstep, voffA);
        if (wr == 1) PG8_BAR;
        PG8_WAIT_V(4); PG8_BAR;
        PG8_STAGE(PG8_SB(1, 0), cB + kstep, voffB); PG8_STAGE(PG8_SA(1, 0), cA + kstep, voffA); PG8_STAGE(PG8_SB(1, 1), cB + hstep + kstep, voffB);
        PG8_WAIT_V(6); PG8_BAR;
    }
    for (;;) {
        const bool has_next = S.next(ui + 1, nxt);
        const char* nA = has_next ? (const char*)g.A + (size_t)nxt.pm * tstep : cA; const char* nB = has_next ? (const char*)g.Bt + (size_t)nxt.pn * tstep : cB;
        for (int t = 0; t < nt; t += 2) {
            const bool last = (t == nt - 2);
            const char* a1 = cA + (size_t)(t + 1) * kstep;
            const char* a2 = last ? nA : cA + (size_t)(t + 2) * kstep; const char* b2 = last ? nB : cB + (size_t)(t + 2) * kstep;
            const char* a3 = a2 + kstep; const char* b3 = b2 + kstep;
            if (last && has_next) S.a_ready(nxt);
            if constexpr (SP2) {
            PG8_LDB(B0, 0, 0); PG8_LDB(B1, 0, 1); PG8_SCHED; PG8_LDA(At, 0, 0); PG8_STAGE(PG8_SA(1, 1), a1 + hstep, voffA);
            PG8_WAIT_V(8); PG8_WAIT_L(0); PG8_BAR; PG8_MMA(0, 0, At, B0); PG8_MMA(0, 1, At, B1); PG8_BAR; PG8_SCHED;
            PG8_LDA(At, 0, 1); PG8_STAGE(PG8_SB(0, 0), b2, voffB); PG8_STAGE(PG8_SB(0, 1), b2 + hstep, voffB); PG8_STAGE(PG8_SA(0, 0), a2, voffA);
            PG8_WAIT_V(8); PG8_WAIT_L(0); PG8_BAR; PG8_MMA(1, 0, At, B0); PG8_MMA(1, 1, At, B1); PG8_BAR; PG8_SCHED;
            PG8_LDB(B0, 1, 0); PG8_LDB(B1, 1, 1); PG8_SCHED; PG8_LDA(At, 1, 0); PG8_STAGE(PG8_SA(0, 1), a2 + hstep, voffA);
            PG8_WAIT_V(8); PG8_WAIT_L(0); PG8_BAR; PG8_MMA(0, 0, At, B0); PG8_MMA(0, 1, At, B1); PG8_BAR; PG8_SCHED;
            PG8_LDA(At, 1, 1); PG8_STAGE(PG8_SB(1, 0), b3, voffB); PG8_STAGE(PG8_SB(1, 1), b3 + hstep, voffB); PG8_STAGE(PG8_SA(1, 0), a3, voffA);
            PG8_WAIT_V(8); PG8_WAIT_L(0); PG8_BAR; PG8_MMA(1, 0, At, B0); PG8_MMA(1, 1, At, B1); PG8_BAR; PG8_SCHED;
            } else {
            PG8_LDB(B0, 0, 0); PG8_SCHED; PG8_LDA(At, 0, 0); PG8_STAGE(PG8_SA(1, 1), a1 + hstep, voffA);
            PG8_WAIT_L(8); PG8_BAR; PG8_WAIT_L(0); PG8_MMA(0, 0, At, B0); PG8_BAR; PG8_SCHED;
            PG8_LDB(B1, 0, 1); PG8_STAGE(PG8_SB(0, 0), b2, voffB);
            PG8_BAR; PG8_WAIT_L(0); PG8_MMA(0, 1, At, B1); PG8_BAR;
            PG8_LDA(At, 0, 1); PG8_STAGE(PG8_SA(0, 0), a2, voffA);
            PG8_BAR; PG8_WAIT_L(0); PG8_MMA(1, 0, At, B0); PG8_BAR; PG8_SCHED;
            PG8_STAGE(PG8_SB(0, 1), b2 + hstep, voffB);
            PG8_WAIT_V(6); PG8_BAR; PG8_MMA(1, 1, At, B1); PG8_BAR;
            PG8_LDB(B0, 1, 0); PG8_SCHED; PG8_LDA(At, 1, 0); PG8_STAGE(PG8_SA(0, 1), a2 + hstep, voffA);
            PG8_WAIT_L(8); PG8_BAR; PG8_WAIT_L(0); PG8_MMA(0, 0, At, B0); PG8_BAR; PG8_SCHED;
            PG8_LDB(B1, 1, 1); PG8_STAGE(PG8_SB(1, 0), b3, voffB);
            PG8_BAR; PG8_WAIT_L(0); PG8_MMA(0, 1, At, B1); PG8_BAR;
            PG8_LDA(At, 1, 1); PG8_STAGE(PG8_SA(1, 0), a3, voffA);
            PG8_BAR; PG8_WAIT_L(0); PG8_MMA(1, 0, At, B0); PG8_BAR; PG8_SCHED;
            PG8_STAGE(PG8_SB(1, 1), b3 + hstep, voffB);
            PG8_WAIT_V(6); PG8_BAR; PG8_MMA(1, 1, At, B1); PG8_BAR;
            }
        }
        if constexpr (ALIGN_EPI) { if (wr == 0) PG8_BAR; }
        if constexpr (!Epi::AFTER_DRAIN) { E(acc, cur, wr, wc, fr, fq); S.done(cur); }
        if (!has_next) break;
#pragma unroll
        for (int a = 0; a < 2; ++a)
#pragma unroll
            for (int b = 0; b < 2; ++b)
#pragma unroll
                for (int m = 0; m < 4; ++m)
#pragma unroll
                    for (int n = 0; n < 2; ++n) acc[a][b][m][n] = (f32x4){0.f, 0.f, 0.f, 0.f};
        cur = nxt; cA = nA; cB = nB; ++ui;
        if constexpr (ALIGN_EPI) { if (wr == 1) PG8_BAR; }
    }
    PG8_WAIT_V(0);
    if constexpr (!ALIGN_EPI) { if (wr == 0) PG8_BAR; }
    PG8_BAR;
    if constexpr (Epi::AFTER_DRAIN) { E.fused(acc, cur, wr, wc, fr, fq, lds, wid, lane); S.done(cur); }
#undef PG8_SA
#undef PG8_SB
#undef PG8_STAGE
#undef PG8_LDA
#undef PG8_LDB
#undef PG8_MMA
#undef PG8_WAIT_V
#undef PG8_WAIT_L
#undef PG8_BAR
#undef PG8_SCHED
}
}
constexpr int D = 1024, NB = 16, SEQ = 2048, CTXL = 256, DEPTH = 4;
constexpr int MC = NB * CTXL, ML = NB * SEQ, MT = MC + ML;
constexpr int DIN = 4752, DINP = 4864, DFF = 2816, NGU = 2 * DFF, NMOD = 6 * D;
constexpr int C_MLQ = 0, C_MLK = 384, C_MLV = 768, C_MLO = 1152, C_MLI = 1536, C_MLF = 1544, C_HGQ = 1552, C_HGF = 2064, C_HGI = 3088, C_HGG = 3344, C_DAQ = 3600, C_DAK = 3984, C_DAV = 4368;
constexpr int Y_ML = 0, Y_HG = 384, Y_DA = 640;
constexpr float EPS = 1e-6f;
constexpr int NTOK = CTXL + SEQ;
static_assert(C_MLI == 6 * 256, "gate columns must open GEMM tile 6");

constexpr size_t MiB = 1u << 20;
constexpr size_t WS_CTL = 0, CTL_ZERO_BYTES = 1 * MiB;
constexpr size_t WS_MOD = 1 * MiB;
constexpr size_t WS_MISC = 3 * MiB;
constexpr size_t WS_GATE = 4 * MiB;
constexpr size_t WS_WIN = 8 * MiB, WS_WOUT = WS_WIN + (size_t)DINP * D * 2, WS_WGU = WS_WOUT + (size_t)D * D * 2, WS_WD = WS_WGU + (size_t)NGU * D * 2;
constexpr size_t WS_CTXX = 36 * MiB;
constexpr size_t WS_HB = 52 * MiB;
constexpr size_t WS_RAWM = 124 * MiB, WS_RAWH = 151 * MiB;
constexpr size_t WS_P = 169 * MiB;
constexpr size_t WS_YD = WS_P + 198 * MiB, WS_END = 511 * MiB;
static_assert(WS_WD + (size_t)D * DFF * 2 <= WS_CTXX, "weights fit");
static_assert(WS_RAWM + (size_t)64 * NTOK * 96 * 2 <= WS_RAWH && WS_RAWH + (size_t)64 * NTOK * 64 * 2 <= WS_P, "raw fits");
static_assert(WS_P + (size_t)MT * DINP * 2 <= WS_END && WS_YD + (size_t)MT * D * 4 <= WS_END && (size_t)MT * DFF * 2 <= 198 * MiB, "P region");
constexpr int CW_BAR = 4096;
constexpr int CW_Q = 16384;

constexpr int RING_BYTES = 131072, LDSCTL_OFF = RING_BYTES, LDS_BYTES = 147456;
constexpr int NWAVES = 8, NTHR = 512;

#define GAS __attribute__((address_space(1)))
#define LAS __attribute__((address_space(3)))
typedef unsigned short bf16;
typedef unsigned v4u __attribute__((ext_vector_type(4)));
typedef unsigned v2u __attribute__((ext_vector_type(2)));
typedef float f32x4 __attribute__((ext_vector_type(4)));
typedef float f32x16 __attribute__((ext_vector_type(16)));
typedef short bf16x8 __attribute__((ext_vector_type(8)));
typedef GAS unsigned gu32;
typedef LAS unsigned char* lptr;
#define RLX_AGENT __ATOMIC_RELAXED, __HIP_MEMORY_SCOPE_AGENT
#define LDS_WAIT() asm volatile("s_waitcnt lgkmcnt(0)" ::: "memory")
#define VM_WAIT() asm volatile("s_waitcnt vmcnt(0)" ::: "memory")
__device__ __forceinline__ unsigned f2bf(float f) { unsigned u = __builtin_bit_cast(unsigned, f); return (u + 0x7fffu + ((u >> 16) & 1u)) >> 16; }
typedef float f32x2_t __attribute__((ext_vector_type(2))); typedef __bf16 bf16x2_t __attribute__((ext_vector_type(2)));
__device__ __forceinline__ unsigned pk2(float lo, float hi) { f32x2_t v = {lo, hi}; bf16x2_t b = __builtin_convertvector(v, bf16x2_t); return __builtin_bit_cast(unsigned, b); }
__device__ __forceinline__ float bflo(unsigned w) { return __builtin_bit_cast(float, w << 16); }
__device__ __forceinline__ float bfhi(unsigned w) { return __builtin_bit_cast(float, w & 0xffff0000u); }
__device__ __forceinline__ float bf2f(bf16 v) { return __builtin_bit_cast(float, (unsigned)v << 16); }
__device__ __forceinline__ float lx_idx(float v, int src) { return __builtin_bit_cast(float, __builtin_amdgcn_ds_bpermute(src << 2, __builtin_bit_cast(int, v))); }
__device__ __forceinline__ float lx_xor(float v, int mask, int lane) { return lx_idx(v, lane ^ mask); }
__device__ __forceinline__ float lx_up(float v, int d, int lane) { return lx_idx(v, lane >= d ? lane - d : lane); }
__device__ __forceinline__ float wave_sum(float v, int lane) {
#pragma unroll
    for (int o = 1; o < 64; o <<= 1) v += lx_xor(v, o, lane);
    return v;
}
#define MFMA32(a, b, c) __builtin_amdgcn_mfma_f32_32x32x16_bf16((a), (b), (c), 0, 0, 0)
#define MFMA16(a, b, c) __builtin_amdgcn_mfma_f32_16x16x32_bf16((a), (b), (c), 0, 0, 0)
__device__ __forceinline__ int tid_opaque() { int t = threadIdx.x; asm volatile("" : "+v"(t)); return t; }
__device__ __forceinline__ bf16x8 lds8(lptr p) { return *(const LAS bf16x8*)p; }
__device__ __forceinline__ v4u gld16(const void* base, unsigned off) { return *(const v4u*)((const char*)base + off); }
__device__ __forceinline__ void gst8(void* base, unsigned off, v2u v) { *(v2u*)((char*)base + off) = v; }
typedef short v4i16 __attribute__((ext_vector_type(4)));
__device__ __forceinline__ bf16x8 opr(lptr img, int ldb, int r0, int k0, int c16, int rg) { return lds8(img + (r0 + c16) * ldb + (k0 + 8 * rg) * 2); }
__device__ __forceinline__ bf16x8 opt(lptr img, int ldb, int r0, int k0, int lane) {
    const int g = lane >> 4, q = (lane & 15) >> 2, p = lane & 3;
    lptr a = img + (k0 + 8 * g + q) * ldb + (r0 + 4 * p) * 2;
    const v4i16 lo = __builtin_amdgcn_ds_read_tr16_b64_v4i16((LAS v4i16*)a);
    const v4i16 hi = __builtin_amdgcn_ds_read_tr16_b64_v4i16((LAS v4i16*)(a + 4 * ldb));
    return __builtin_shufflevector(lo, hi, 0, 1, 2, 3, 4, 5, 6, 7);
}

#define XB_TMO      128
#define XB_XCNT(j)  (256  + 64 * (j))
#define XB_XSUB(j)  (1280 + 64 * (j))
#define XB_XGEN(j)  (2304 + 64 * (j))
#define XB_TOP      3328
#define XB_TOPGEN   3392
#define XCD_BAR_WORDS 3456
#define XB_SPIN_CAP (1u << 18)

__device__ __forceinline__ unsigned xb_ld(unsigned* p)              { return __hip_atomic_load(p, __ATOMIC_RELAXED, __HIP_MEMORY_SCOPE_AGENT); }
__device__ __forceinline__ unsigned xb_add(unsigned* p, unsigned v) { return __hip_atomic_fetch_add(p, v, __ATOMIC_RELAXED, __HIP_MEMORY_SCOPE_AGENT); }
__device__ __forceinline__ unsigned xb_xcc_id() { return (unsigned)__builtin_amdgcn_s_getreg((3 << 11) | 20) & 0xFu; }
#define XB_SPIN(cond, bar) do { unsigned _sp = 0; while (cond) { __builtin_amdgcn_s_sleep(1); \
    if ((++_sp & 255u) == 0u) { if (xb_ld(&(bar)[XB_TMO])) break; if (_sp > XB_SPIN_CAP) { atomicAdd(&(bar)[XB_TMO], 1u); break; } } } } while (0)

struct XcdBarrier {
    unsigned* bar; unsigned x;
    volatile LAS unsigned* st;
};

__device__ __forceinline__ XcdBarrier xcd_barrier_post(unsigned* bar, volatile LAS unsigned* st) {
    XcdBarrier b; b.bar = bar; b.x = xb_xcc_id(); b.st = st;
    if (threadIdx.x == 0) (void)xb_add(&bar[XB_XCNT(b.x)], 1u);
    return b;
}
__device__ __forceinline__ void xcd_barrier_complete(unsigned* bar, unsigned x, unsigned& nloc, unsigned& nx) {
    const unsigned G = gridDim.x * gridDim.y * gridDim.z;
    unsigned sum, cnt, mine, sp = 0u;
    for (;;) {
        sum = 0u; cnt = 0u; mine = 0u;
#pragma unroll
        for (unsigned j = 0; j < 16; ++j) { const unsigned c = xb_ld(&bar[XB_XCNT(j)]); sum += c; cnt += (c > 0u) ? 1u : 0u; mine = (j == x) ? c : mine; }
        if (sum == G) break;
        __builtin_amdgcn_s_sleep(1);
        if ((++sp & 255u) == 0u) { if (xb_ld(&bar[XB_TMO])) break; if (sp > XB_SPIN_CAP) { atomicAdd(&bar[XB_TMO], 1u); break; } }
    }
    nloc = mine > 0u ? mine : 1u; nx = cnt > 0u ? cnt : 1u;
}

__device__ __forceinline__ void xcd_barrier(const XcdBarrier& b) {
    asm volatile("s_waitcnt vmcnt(0)" ::: "memory");
    __syncthreads();
    if (threadIdx.x == 0) {
        unsigned* bar = b.bar;
        __builtin_amdgcn_s_waitcnt(0);
        unsigned nloc = b.st[0], nx = b.st[1];
        if (nloc == 0u) { xcd_barrier_complete(bar, b.x, nloc, nx); b.st[0] = nloc; b.st[1] = nx; }
        const unsigned old = xb_add(&bar[XB_XSUB(b.x)], 1u);
        const unsigned gen = old / nloc;
        if (old + 1u == (gen + 1u) * nloc) {
            __builtin_amdgcn_fence(__ATOMIC_RELEASE, "agent");
            asm volatile("s_waitcnt vmcnt(0)" ::: "memory");
            const unsigned og = xb_add(&bar[XB_TOP], 1u);
            const unsigned tg = og / nx;
            if (og + 1u == (tg + 1u) * nx) xb_add(&bar[XB_TOPGEN], 1u);
            else XB_SPIN(xb_ld(&bar[XB_TOPGEN]) == tg, bar);
            __builtin_amdgcn_fence(__ATOMIC_ACQUIRE, "agent");
            xb_add(&bar[XB_XGEN(b.x)], 1u);
            asm volatile("s_waitcnt vmcnt(0)" ::: "memory");
        } else {
            XB_SPIN(xb_ld(&bar[XB_XGEN(b.x)]) == gen, bar);
            __builtin_amdgcn_fence(__ATOMIC_ACQUIRE, "agent");
            asm volatile("s_waitcnt vmcnt(0)" ::: "memory");
        }
    }
    __syncthreads();
}


struct Args { const float* in[22]; float* out; unsigned char* ws; int ph_lo, ph_hi; };
enum { I_X = 0, I_C, I_CTX, I_CCTX, I_WADA, I_BADA, I_GPREMIX, I_GPOSTMIX, I_GPREFFN, I_GPOSTFFN, I_WIN, I_BIN, I_WOUT, I_MLFB, I_MLNORM, I_HGLB, I_HGNORM, I_DALAM, I_DANORM, I_WG, I_WU, I_WD };

__device__ __forceinline__ int wg_pull(unsigned* ctr, volatile LAS int* slot) {
    __syncthreads();
    if (threadIdx.x == 0) *slot = (int)__hip_atomic_fetch_add(ctr, 1u, RLX_AGENT);
    __syncthreads();
    return __builtin_amdgcn_readfirstlane(*slot);
}

typedef __attribute__((address_space(4))) const Args* kargs_p;
__device__ __forceinline__ void p0_phase(lptr lds, kargs_p ap) {
    struct { const float* in[22]; unsigned char* ws; } a; a.in[I_C] = ap->in[I_C]; a.in[I_CCTX] = ap->in[I_CCTX]; a.in[I_WADA] = ap->in[I_WADA]; a.in[I_BADA] = ap->in[I_BADA]; a.in[I_HGLB] = ap->in[I_HGLB]; a.in[I_BIN] = ap->in[I_BIN]; a.in[I_DALAM] = ap->in[I_DALAM]; a.ws = ap->ws;
    const int tid = tid_opaque();
    unsigned char* ws = a.ws;
    LAS float* sil = (LAS float*)lds;
    LAS float* part = (LAS float*)(lds + 69632);
    for (int i = tid; i < 17 * D; i += NTHR) { const int bb = i >> 10, k = i & 1023; const float v = bb < 16 ? a.in[I_C][bb * D + k] : a.in[I_CCTX][k]; sil[i] = v / (1.0f + __expf(-v)); }
    __syncthreads();
    float* mod = (float*)(ws + WS_MOD);
    for (int u = blockIdx.x; u < DEPTH * (NMOD / 32); u += gridDim.x) {
        const int l = u / (NMOD / 32), n0 = (u % (NMOD / 32)) * 32, col = tid & 31, ks = tid >> 5;
        const float* w = a.in[I_WADA] + (size_t)l * D * NMOD + (size_t)(ks * 64) * NMOD + n0 + col;
        float acc[17];
#pragma unroll
        for (int bb = 0; bb < 17; ++bb) acc[bb] = 0.f;
        for (int k = 0; k < 64; k += 4) {
            const float w0 = w[(size_t)k * NMOD], w1 = w[(size_t)(k + 1) * NMOD], w2 = w[(size_t)(k + 2) * NMOD], w3 = w[(size_t)(k + 3) * NMOD];
#pragma unroll
            for (int bb = 0; bb < 17; ++bb) { const f32x4 s = *(const LAS f32x4*)(sil + bb * D + ks * 64 + k); acc[bb] += s[0] * w0 + s[1] * w1 + s[2] * w2 + s[3] * w3; }
        }
#pragma unroll
        for (int bb = 0; bb < 17; ++bb) part[(ks * 17 + bb) * 32 + col] = acc[bb];
        __syncthreads();
        for (int i = tid; i < 17 * 32; i += NTHR) { const int bb = i >> 5, cc = i & 31; float s = 0.f;
#pragma unroll
            for (int k2 = 0; k2 < 16; ++k2) s += part[(k2 * 17 + bb) * 32 + cc];
            mod[((size_t)l * 17 + bb) * NMOD + n0 + cc] = s + a.in[I_BADA][l * NMOD + n0 + cc]; }
        __syncthreads();
    }
    const int gt = blockIdx.x * NTHR + tid, GT = gridDim.x * NTHR;
    float* lbs = (float*)(ws + WS_MISC); float* rope = (float*)(ws + WS_MISC + 16384); float* biasp = (float*)(ws + WS_MISC + 32768); float* lamv = (float*)(ws + WS_MISC + 114688);
    for (int j = gt; j < 1024; j += GT) { const float* hl = a.in[I_HGLB];
        const float v0 = hl[j], v1 = hl[1024 + j], v2 = hl[2048 + j], v3 = hl[3072 + j]; const float mx = fmaxf(fmaxf(v0, v1), fmaxf(v2, v3));
        const float e0 = expf(v0 - mx), e1 = expf(v1 - mx), e2 = expf(v2 - mx), e3 = expf(v3 - mx), inv = 1.0f / (e0 + e1 + e2 + e3);
        lbs[j] = 0.f; lbs[1024 + j] = e1 * inv; lbs[2048 + j] = (e1 + e2) * inv; lbs[3072 + j] = (e1 + e2 + e3) * inv; }
    for (int j = gt; j < 64 * 12; j += GT) { const int pos = j / 12, i = j % 12; const float inv = powf(10000.0f, -(float)(2 * i) / 24.0f); const float ang = (float)pos * inv; rope[2 * j] = cosf(ang); rope[2 * j + 1] = sinf(ang); }
    for (int j = gt; j < DEPTH * DINP; j += GT) { const int l = j / DINP, n = j % DINP; biasp[j] = n < DIN ? a.in[I_BIN][l * DIN + n] : 0.f; }
    if (gt < DEPTH) { const float* lv = a.in[I_DALAM] + gt * 4 * 48; float s01 = 0.f, s23 = 0.f;
        for (int d = 0; d < 48; ++d) { s01 += lv[d] * lv[48 + d]; s23 += lv[96 + d] * lv[144 + d]; }
        const float lam_init = 0.8f - 0.6f * expf(-0.3f * (float)gt);
        lamv[gt] = expf(s01) - expf(s23) + lam_init; }
}

template <bool RES, bool NORM>
__device__ __forceinline__ void thin_phase(int row_lo, const float* xs_lat, const float* xs_ctx, float* xd_lat, float* xd_ctx, bool write_x,
                                           const float* y, const float* mod_r, int goff, const float* gpost,
                                           const float* mod_n, int soff, int aoff, const float* gpre, bf16* hout, int vcu, int G) {
    const int tid = tid_opaque(); const int lane = tid & 63, wave = __builtin_amdgcn_readfirstlane(tid >> 6);
    const int gw = vcu * NWAVES + wave, NGW = G * NWAVES;
    const int nrows = MT - row_lo, rpw = (nrows + NGW - 1) / NGW;
    const int rbeg = row_lo + gw * rpw, rend = (rbeg + rpw < MT) ? rbeg + rpw : MT;
    int cur_bb = -1;
    f32x4 gp[4], ga[4], sh[4];
#pragma unroll
    for (int j = 0; j < 4; ++j) { gp[j] = (f32x4){0.f, 0.f, 0.f, 0.f}; ga[j] = gp[j]; sh[j] = gp[j]; }
    for (int r = rbeg; r < rend; ++r) {
        const bool isctx = r < MC; const int bb = isctx ? 16 : (r - MC) / SEQ;
        if (bb != cur_bb) { cur_bb = bb;
#pragma unroll
            for (int j = 0; j < 4; ++j) { const int e = 4 * lane + 256 * j;
                if (RES) gp[j] = *(const f32x4*)(mod_r + (size_t)bb * NMOD + goff + e) * *(const f32x4*)(gpost + e);
                if (NORM) { ga[j] = *(const f32x4*)(gpre + e) * (*(const f32x4*)(mod_n + (size_t)bb * NMOD + aoff + e) + 1.0f); sh[j] = *(const f32x4*)(mod_n + (size_t)bb * NMOD + soff + e); } } }
        const float* xs = isctx ? xs_ctx + (size_t)r * D : xs_lat + (size_t)(r - MC) * D;
        float* xd = isctx ? xd_ctx + (size_t)r * D : xd_lat + (size_t)(r - MC) * D;
        f32x4 v[4];
#pragma unroll
        for (int j = 0; j < 4; ++j) v[j] = *(const f32x4*)(xs + 4 * lane + 256 * j);
        if (RES) { f32x4 yv[4]; float ss = 0.f;
#pragma unroll
            for (int j = 0; j < 4; ++j) { yv[j] = *(const f32x4*)(y + (size_t)r * D + 4 * lane + 256 * j); ss += (yv[j][0] * yv[j][0] + yv[j][1] * yv[j][1]) + (yv[j][2] * yv[j][2] + yv[j][3] * yv[j][3]); }
            const float rs = 1.0f / sqrtf(wave_sum(ss, lane) * (1.0f / D) + EPS);
#pragma unroll
            for (int j = 0; j < 4; ++j) v[j] += gp[j] * yv[j] * rs; }
        if (write_x) {
#pragma unroll
            for (int j = 0; j < 4; ++j) *(f32x4*)(xd + 4 * lane + 256 * j) = v[j]; }
        if (NORM) { float ss = 0.f;
#pragma unroll
            for (int j = 0; j < 4; ++j) ss += (v[j][0] * v[j][0] + v[j][1] * v[j][1]) + (v[j][2] * v[j][2] + v[j][3] * v[j][3]);
            const float rs = 1.0f / sqrtf(wave_sum(ss, lane) * (1.0f / D) + EPS);
#pragma unroll
            for (int j = 0; j < 4; ++j) { const f32x4 h = v[j] * rs * ga[j] + sh[j]; v2u w; w.x = pk2(h[0], h[1]); w.y = pk2(h[2], h[3]); *(v2u*)(hout + (size_t)r * D + 4 * lane + 256 * j) = w; } }
    }
}

template <int MODE>
__device__ __forceinline__ void tr_item(const float* W, int K, int N, int nblk, bf16* WT, LAS float* scr, int item, int lane) {
    const int kb = item / nblk, nb = item % nblk, k0 = 64 * kb, n0 = 32 * nb;
    const int nn = n0 + (lane & 31); const bool ok = nn < N;
#pragma unroll 8
    for (int i = 0; i < 32; ++i) { const int kk = 2 * i + (lane >> 5); scr[kk * 33 + (lane & 31)] = ok ? W[(size_t)(k0 + kk) * N + nn] : 0.f; }
    LDS_WAIT(); asm volatile("" ::: "memory");
    const int c = lane & 7;
#pragma unroll
    for (int j = 0; j < 4; ++j) { const int n = (lane >> 3) + 8 * j; const LAS float* s = scr + (8 * c) * 33 + n;
        v4u o; o.x = pk2(s[0 * 33], s[1 * 33]); o.y = pk2(s[2 * 33], s[3 * 33]); o.z = pk2(s[4 * 33], s[5 * 33]); o.w = pk2(s[6 * 33], s[7 * 33]);
        const int ng = n0 + n; const int drow = MODE == 0 ? ng : ((ng >> 7) * 256 + (ng & 127) + (MODE == 2 ? 128 : 0));
        *(v4u*)(WT + (size_t)drow * K + k0 + 8 * c) = o; }
    LDS_WAIT(); asm volatile("" ::: "memory");
}
__device__ __forceinline__ void convert_weights(lptr lds, kargs_p ap, int l, int vcu, int G) {
    const unsigned char* const wsb = ap->ws; const float* const p_win = ap->in[I_WIN]; const float* const p_wout = ap->in[I_WOUT]; const float* const p_wg = ap->in[I_WG]; const float* const p_wu = ap->in[I_WU]; const float* const p_wd = ap->in[I_WD];
    const int tid = tid_opaque(); const int lane = tid & 63, wave = __builtin_amdgcn_readfirstlane(tid >> 6);
    LAS float* scr = (LAS float*)(lds + wave * 8448);
    const int gw = vcu * NWAVES + wave, NGW = G * NWAVES;
    unsigned char* ws = (unsigned char*)wsb;
    constexpr int I_IN = 16 * (DINP / 32), I_OUT = 16 * 32, I_GU = 16 * (DFF / 32), I_DN = (DFF / 64) * 32;
    constexpr int NITEMS = I_IN + I_OUT + 2 * I_GU + I_DN;
    for (int it = gw; it < NITEMS; it += NGW) {
        int r = it;
        if (r < I_IN) { tr_item<0>(p_win + (size_t)l * D * DIN, D, DIN, DINP / 32, (bf16*)(ws + WS_WIN), scr, r, lane); continue; } r -= I_IN;
        if (r < I_OUT) { tr_item<0>(p_wout + (size_t)l * D * D, D, D, 32, (bf16*)(ws + WS_WOUT), scr, r, lane); continue; } r -= I_OUT;
        if (r < I_GU) { tr_item<1>(p_wg + (size_t)l * D * DFF, D, DFF, DFF / 32, (bf16*)(ws + WS_WGU), scr, r, lane); continue; } r -= I_GU;
        if (r < I_GU) { tr_item<2>(p_wu + (size_t)l * D * DFF, D, DFF, DFF / 32, (bf16*)(ws + WS_WGU), scr, r, lane); continue; } r -= I_GU;
        tr_item<0>(p_wd + (size_t)l * DFF * D, DFF, D, 32, (bf16*)(ws + WS_WD), scr, r, lane);
    }
}
constexpr int AT_Q = 0, AT_K0 = 53248, AT_KB = 13312, AT_V0 = 79872, AT_VB = 12288, AT_ROPE = 107520;
constexpr float AT_THR = 8.0f;
constexpr float QSCALE = 0.14433756729740643f * 1.4426950408889634f;

__device__ __forceinline__ void rope24(const v4u (&in)[3], v4u (&out)[3], bool rot, const LAS float* tab, float scale) {
    float v[24];
#pragma unroll
    for (int i = 0; i < 3; ++i) { v[8 * i + 0] = bflo(in[i].x); v[8 * i + 1] = bfhi(in[i].x); v[8 * i + 2] = bflo(in[i].y); v[8 * i + 3] = bfhi(in[i].y);
                                  v[8 * i + 4] = bflo(in[i].z); v[8 * i + 5] = bfhi(in[i].z); v[8 * i + 6] = bflo(in[i].w); v[8 * i + 7] = bfhi(in[i].w); }
    if (rot) {
#pragma unroll
        for (int i = 0; i < 12; ++i) { const float c = tab[2 * i], s = tab[2 * i + 1]; const float x1 = v[i], x2 = v[12 + i]; v[i] = x1 * c - x2 * s; v[12 + i] = x1 * s + x2 * c; } }
#pragma unroll
    for (int i = 0; i < 3; ++i) { out[i].x = pk2(v[8 * i + 0] * scale, v[8 * i + 1] * scale); out[i].y = pk2(v[8 * i + 2] * scale, v[8 * i + 3] * scale);
                                  out[i].z = pk2(v[8 * i + 4] * scale, v[8 * i + 5] * scale); out[i].w = pk2(v[8 * i + 6] * scale, v[8 * i + 7] * scale); }
}
__device__ __forceinline__ float sm_max(const f32x16& S, int lane) {
    float mx = S[0];
#pragma unroll
    for (int r = 1; r < 16; ++r) mx = fmaxf(mx, S[r]);
    return fmaxf(mx, lx_xor(mx, 32, lane));
}
__device__ __forceinline__ void sm_exp(const f32x16& S, float m, float& l, bf16x8& p0, bf16x8& p1) {
    float p[16]; float ps = 0.f;
#pragma unroll
    for (int r = 0; r < 16; ++r) { p[r] = __builtin_amdgcn_exp2f(S[r] - m); ps += p[r]; }
    l += ps;
    v4u a, b;
    a.x = pk2(p[0], p[1]); a.y = pk2(p[2], p[3]); a.z = pk2(p[4], p[5]); a.w = pk2(p[6], p[7]);
    b.x = pk2(p[8], p[9]); b.y = pk2(p[10], p[11]); b.z = pk2(p[12], p[13]); b.w = pk2(p[14], p[15]);
    p0 = __builtin_bit_cast(bf16x8, a); p1 = __builtin_bit_cast(bf16x8, b);
}
__device__ __forceinline__ bf16x8 vt_frag(lptr vt, int ct, int sub, int sp, int lane) {
    const int h = lane >> 5, blk = (lane >> 4) & 1, q = (lane & 15) >> 2, p = lane & 3;
    lptr a = vt + (32 * sub + 16 * sp + 4 * h + q) * 192 + (32 * ct + 16 * blk + 4 * p) * 2;
    const v4i16 lo = __builtin_amdgcn_ds_read_tr16_b64_v4i16((LAS v4i16*)a);
    const v4i16 hi = __builtin_amdgcn_ds_read_tr16_b64_v4i16((LAS v4i16*)(a + 8 * 192));
    return __builtin_shufflevector(lo, hi, 0, 1, 2, 3, 4, 5, 6, 7);
}

__device__ __forceinline__ void attn_item(lptr lds, const bf16* P, bf16* YM, const float* rope_g, const float* danorm, float lam, float out_scale, int b, int h, int qb) {
    const int tid = tid_opaque(), lane = tid & 63, r32 = lane & 31, hi = lane >> 5, wave = __builtin_amdgcn_readfirstlane(tid >> 6);
    const bool lat = qb < 8;
    const int qrow0 = lat ? MC + b * SEQ + qb * 256 : b * CTXL;
    const int nt = lat ? 36 : 4;
    LAS float* ropeL = (LAS float*)(lds + AT_ROPE);
    for (int i = tid; i < 64 * 24; i += NTHR) ropeL[i] = rope_g[i];
    __syncthreads();
    for (int it = tid; it < 1024; it += NTHR) {
        const int row = it >> 2, map = (it >> 1) & 1, half = it & 1;
        const unsigned so = (unsigned)(qrow0 + row) * (unsigned)(DINP * 2) + (unsigned)(C_DAQ + h * 96 + map * 48 + half * 24) * 2u;
        v4u in[3], out[3];
#pragma unroll
        for (int i = 0; i < 3; ++i) in[i] = gld16(P, so + 16u * i);
        const int t = qb * 256 + row; const int pos = half ? (t & 63) : (t >> 6);
        rope24(in, out, lat, ropeL + (lat ? pos : 0) * 24, QSCALE);
        lptr dst = lds + AT_Q + (row * 104 + map * 48 + half * 24) * 2;
#pragma unroll
        for (int i = 0; i < 3; ++i) *(LAS v4u*)(dst + 16 * i) = out[i];
    }
    v4u kin[3], vin[2];
    const int kkey = tid >> 2, kmap = (tid >> 1) & 1, khalf = tid & 1;
    const int vkey0 = tid / 12, vcc0 = tid % 12, vkey1 = (tid + 512) / 12, vcc1 = (tid + 512) % 12;
#define AT_TILE_ROW0(tile) (((tile) < 4) ? (b * CTXL + 64 * (tile)) : (MC + b * SEQ + 64 * ((tile) - 4)))
#define AT_LOAD(tile) do { const int row0_ = AT_TILE_ROW0(tile); \
        if (tid < 256) { const unsigned s_ = (unsigned)(row0_ + kkey) * (unsigned)(DINP * 2) + (unsigned)(C_DAK + h * 96 + kmap * 48 + khalf * 24) * 2u; kin[0] = gld16(P, s_); kin[1] = gld16(P, s_ + 16u); kin[2] = gld16(P, s_ + 32u); \
                         vin[1] = gld16(P, (unsigned)(row0_ + vkey1) * (unsigned)(DINP * 2) + (unsigned)(C_DAV + h * 96 + vcc1 * 8) * 2u); } \
        vin[0] = gld16(P, (unsigned)(row0_ + vkey0) * (unsigned)(DINP * 2) + (unsigned)(C_DAV + h * 96 + vcc0 * 8) * 2u); } while (0)
#define AT_VPUT(vt, key, cc, VV) do { *(LAS v4u*)((vt) + (key) * 192 + (cc) * 16) = (VV); } while (0)
#define AT_STORE(tile, buf) do { const bool krot_ = (tile) >= 4; \
        if (tid < 256) { const int t_ = 64 * ((tile) - 4) + kkey; const int pos_k = khalf ? (t_ & 63) : (t_ >> 6); v4u o_[3]; rope24(kin, o_, krot_, ropeL + (krot_ ? pos_k : 0) * 24, 1.0f); \
                         lptr d_k = lds + AT_K0 + (buf) * AT_KB + (kkey * 104 + kmap * 48 + khalf * 24) * 2; *(LAS v4u*)d_k = o_[0]; *(LAS v4u*)(d_k + 16) = o_[1]; *(LAS v4u*)(d_k + 32) = o_[2]; \
                         AT_VPUT(lds + AT_V0 + (buf) * AT_VB, vkey1, vcc1, vin[1]); } \
        AT_VPUT(lds + AT_V0 + (buf) * AT_VB, vkey0, vcc0, vin[0]); } while (0)
    AT_LOAD(0); AT_STORE(0, 0);
    __syncthreads();
    bf16x8 qf[2][3];
#pragma unroll
    for (int map = 0; map < 2; ++map)
#pragma unroll
        for (int ks = 0; ks < 3; ++ks) qf[map][ks] = lds8(lds + AT_Q + ((wave * 32 + r32) * 104 + map * 48 + ks * 16 + hi * 8) * 2);
    f32x16 O0[3], O1[3];
#pragma unroll
    for (int ct = 0; ct < 3; ++ct)
#pragma unroll
        for (int r = 0; r < 16; ++r) { O0[ct][r] = 0.f; O1[ct][r] = 0.f; }
    float m0 = -1e30f, m1 = -1e30f, l0 = 0.f, l1 = 0.f;
    for (int i = 0; i < nt; ++i) {
        const int cur = i & 1;
        if (i + 1 < nt) AT_LOAD(i + 1);
        lptr ks_ = lds + AT_K0 + cur * AT_KB, vt_ = lds + AT_V0 + cur * AT_VB;
#pragma unroll 1
        for (int sub = 0; sub < 2; ++sub) {
            f32x16 S0, S1;
#pragma unroll
            for (int r = 0; r < 16; ++r) { S0[r] = 0.f; S1[r] = 0.f; }
#pragma unroll
            for (int ks = 0; ks < 3; ++ks) {
                const bf16x8 k0 = lds8(ks_ + ((sub * 32 + r32) * 104 + ks * 16 + hi * 8) * 2);
                const bf16x8 k1 = lds8(ks_ + ((sub * 32 + r32) * 104 + 48 + ks * 16 + hi * 8) * 2);
                S0 = MFMA32(k0, qf[0][ks], S0); S1 = MFMA32(k1, qf[1][ks], S1);
            }
            const float mx0 = sm_max(S0, lane), mx1 = sm_max(S1, lane);
            if (__any((mx0 > m0 + AT_THR) || (mx1 > m1 + AT_THR))) {
                const float n0 = fmaxf(m0, mx0), n1 = fmaxf(m1, mx1);
                const float a0 = __builtin_amdgcn_exp2f(m0 - n0), a1 = __builtin_amdgcn_exp2f(m1 - n1);
                m0 = n0; m1 = n1; l0 *= a0; l1 *= a1;
#pragma unroll
                for (int ct = 0; ct < 3; ++ct)
#pragma unroll
                    for (int r = 0; r < 16; ++r) { O0[ct][r] *= a0; O1[ct][r] *= a1; }
            }
            bf16x8 p00, p01, p10, p11;
            sm_exp(S0, m0, l0, p00, p01);
            sm_exp(S1, m1, l1, p10, p11);
#pragma unroll
            for (int ct = 0; ct < 3; ++ct) {
                const bf16x8 v0 = vt_frag(vt_, ct, sub, 0, lane);
                const bf16x8 v1 = vt_frag(vt_, ct, sub, 1, lane);
                O0[ct] = MFMA32(v0, p00, O0[ct]); O1[ct] = MFMA32(v0, p10, O1[ct]);
                O0[ct] = MFMA32(v1, p01, O0[ct]); O1[ct] = MFMA32(v1, p11, O1[ct]);
            }
        }
        if (i + 1 < nt) AT_STORE(i + 1, cur ^ 1);
        __syncthreads();
    }
#undef AT_TILE_ROW0
#undef AT_LOAD
#undef AT_VPUT
#undef AT_STORE
    const float i0 = 1.0f / (l0 + lx_xor(l0, 32, lane)), i1 = lam / (l1 + lx_xor(l1, 32, lane));
    float ss = 0.f;
#pragma unroll
    for (int ct = 0; ct < 3; ++ct)
#pragma unroll
        for (int r = 0; r < 16; ++r) { const float o = O0[ct][r] * i0 - O1[ct][r] * i1; O0[ct][r] = o; ss += o * o; }
    ss += lx_xor(ss, 32, lane);
    const float rs = out_scale / sqrtf(ss * (1.0f / 96.0f) + EPS);
    const unsigned oro = ((unsigned)(qrow0 + wave * 32 + r32) * (unsigned)D + (unsigned)(Y_DA + h * 96)) * 2u;
#pragma unroll
    for (int ct = 0; ct < 3; ++ct)
#pragma unroll
        for (int g = 0; g < 4; ++g) { const int c0 = 32 * ct + 8 * g + 4 * hi; const f32x4 gn = *(const f32x4*)(danorm + c0);
            v2u w; w.x = pk2(O0[ct][4 * g] * rs * gn[0], O0[ct][4 * g + 1] * rs * gn[1]); w.y = pk2(O0[ct][4 * g + 2] * rs * gn[2], O0[ct][4 * g + 3] * rs * gn[3]);
            gst8(YM, oro + 2u * c0, w); }
}
__device__ __forceinline__ int scan_row(int b, int dir, int p) {
    if (p < CTXL) { const int t = dir ? CTXL - 1 - p : p; return b * CTXL + t; }
    const int pl = p - CTXL; const int t = dir ? SEQ - 1 - pl : pl; return MC + b * SEQ + t;
}

constexpr int ML_Q = 0, ML_K = 13312, ML_KW = 26624, ML_VA = 40960, ML_QKM = 55296, ML_ST = 64512, ML_GF = 87808;
constexpr int ML_LDQ = 208, ML_LDW = 224, ML_LDM = 144, ML_LDS = 208;
constexpr float KSCALE = 0.10206207261596577f;

__device__ __forceinline__ void mlstm_stream(lptr lds, const bf16* P, const float* G, bf16* dst, int dst_ld, const float* fbias  , int b, int h, int dir) {
    const int tid = tid_opaque(), lane = tid & 63, c16 = lane & 15, rg = lane >> 4, wave = __builtin_amdgcn_readfirstlane(tid >> 6);
    lptr Qs = lds + ML_Q, Ks = lds + ML_K, Kw = lds + ML_KW, Va = lds + ML_VA, QKM = lds + ML_QKM, ST = lds + ML_ST;
    LAS float* gA = (LAS float*)(lds + ML_GF); LAS float* MxA = gA + 64; LAS float* wA = gA + 128; LAS float* emtA = gA + 192; LAS float* wkA = gA + 256; LAS float* scal = gA + 320;
    if (tid < 128) { const int t = tid >> 1, hh = tid & 1; v4u w; w.x = hh ? 0u : 0x3F80u; w.y = 0u; w.z = 0u; w.w = 0u; *(LAS v4u*)(Va + t * ML_LDW + (96 + 8 * hh) * 2) = w; }
    const float fb = fbias[dir * 4 + h];
    f32x4 acc[11];
#pragma unroll
    for (int i = 0; i < 11; ++i) acc[i] = (f32x4){0.f, 0.f, 0.f, 0.f};
    float m_prev = -1e30f;
    v4u pre[5]; float gi = 0.f, gf = 0.f;
#define ML_PREFETCH(c) do { \
    _Pragma("unroll") for (int i_ = 0; i_ < 5; ++i_) { const int id_ = tid + NTHR * i_; if (id_ < 2304) { const int t_ = id_ / 36, r_ = id_ % 36, wh_ = r_ / 12, cc_ = r_ % 12; \
        const unsigned ro_ = (unsigned)scan_row(b, dir, 64 * (c) + t_) * (unsigned)(DINP * 2); pre[i_] = gld16(P, ro_ + (unsigned)(wh_ * 384 + h * 96 + cc_ * 8) * 2u); } } \
    if (wave == 0) { const unsigned go_ = (unsigned)scan_row(b, dir, 64 * (c) + lane) * 64u + (unsigned)(dir * 4 + h) * 4u; gi = *(const float*)((const char*)G + go_); gf = *(const float*)((const char*)G + go_ + 32u); } } while (0)
    ML_PREFETCH(0);
    for (int c = 0; c < NTOK / 64; ++c) {
#pragma unroll
        for (int i = 0; i < 5; ++i) { const int id = tid + NTHR * i; if (id < 2304) { const int t = id / 36, r = id % 36, wh = r / 12, cc = r % 12;
            lptr d = (wh == 0) ? Qs + t * ML_LDQ : (wh == 1) ? Ks + t * ML_LDQ : Va + t * ML_LDW;
            *(LAS v4u*)(d + cc * 16) = pre[i]; } }
        if (wave == 0) {
            const float fp = gf + fb;
            const float lf = fminf(fp, 0.f) - log1pf(__expf(-fabsf(fp)));
            float bs = lf;
#pragma unroll
            for (int o = 1; o < 64; o <<= 1) { const float v = lx_up(bs, o, lane); if (lane >= o) bs += v; }
            const float g = gi - bs;
            float cm = g;
#pragma unroll
            for (int o = 1; o < 64; o <<= 1) { const float v = lx_up(cm, o, lane); if (lane >= o) cm = fmaxf(cm, v); }
            const float Mx = fmaxf(m_prev, cm);
            const float mt = bs + Mx;
            const float blast = lx_idx(bs, 63), m_new = lx_idx(mt, 63);
            gA[lane] = g; MxA[lane] = Mx; wA[lane] = __expf(m_prev - Mx); emtA[lane] = __expf(-mt); wkA[lane] = __expf(g + blast - m_new) * KSCALE;
            if (lane == 0) scal[0] = __expf(blast + m_prev - m_new);
            m_prev = m_new;
        }
        if (c + 1 < NTOK / 64) ML_PREFETCH(c + 1);
        __syncthreads();
#pragma unroll
        for (int j = 0; j < 2; ++j) { const int idx = 2 * wave + j, si = idx & 3, ti = idx >> 2;
            f32x4 a4 = (f32x4){0.f, 0.f, 0.f, 0.f};
            if (si <= ti) {
#pragma unroll
                for (int ks = 0; ks < 3; ++ks) a4 = MFMA16(opr(Ks, ML_LDQ, 16 * si, 32 * ks, c16, rg), opr(Qs, ML_LDQ, 16 * ti, 32 * ks, c16, rg), a4);
            }
            const int t = 16 * ti + c16, s0 = 16 * si + 4 * rg; const float mxt = MxA[t]; const f32x4 g4 = *(const LAS f32x4*)(gA + s0);
            float v[4];
#pragma unroll
            for (int r = 0; r < 4; ++r) v[r] = (s0 + r <= t) ? a4[r] * KSCALE * __expf(g4[r] - mxt) : 0.f;
            v2u w; w.x = pk2(v[0], v[1]); w.y = pk2(v[2], v[3]); *(LAS v2u*)(QKM + t * ML_LDM + s0 * 2) = w; }
        for (int id = tid; id < 64 * 12; id += NTHR) { const int t = id / 12, cc = id % 12; const v4u w = *(const LAS v4u*)(Ks + t * ML_LDQ + cc * 16); const float sc = wkA[t];
            v4u o; o.x = pk2(bflo(w.x) * sc, bfhi(w.x) * sc); o.y = pk2(bflo(w.y) * sc, bfhi(w.y) * sc); o.z = pk2(bflo(w.z) * sc, bfhi(w.z) * sc); o.w = pk2(bflo(w.w) * sc, bfhi(w.w) * sc);
            *(LAS v4u*)(Kw + t * ML_LDW + cc * 16) = o; }
        if (wave >= 4) { const int sw = wave - 4;
#pragma unroll
            for (int i = 0; i < 11; ++i) { const int j = sw + 4 * i; if (j < 42) { const int di = j / 7, vi = j % 7;
                v2u w; w.x = pk2(acc[i][0], acc[i][1]); w.y = pk2(acc[i][2], acc[i][3]); *(LAS v2u*)(ST + (16 * vi + c16) * ML_LDS + (16 * di + 4 * rg) * 2) = w; } } }
        __syncthreads();
        if (wave < 4) {
            const int ti = wave, t = 16 * ti + c16;
            f32x4 aX[7];
#pragma unroll
            for (int vi = 0; vi < 7; ++vi) aX[vi] = (f32x4){0.f, 0.f, 0.f, 0.f};
#pragma unroll
            for (int ks = 0; ks < 3; ++ks) { const bf16x8 b8 = opr(Qs, ML_LDQ, 16 * ti, 32 * ks, c16, rg);
#pragma unroll
                for (int vi = 0; vi < 7; ++vi) aX[vi] = MFMA16(opr(ST, ML_LDS, 16 * vi, 32 * ks, c16, rg), b8, aX[vi]); }
            { const float wt = wA[t];
#pragma unroll
              for (int vi = 0; vi < 7; ++vi) aX[vi] = aX[vi] * wt; }
#pragma unroll
            for (int ks = 0; ks < 2; ++ks) { const bf16x8 b8 = opr(QKM, ML_LDM, 16 * ti, 32 * ks, c16, rg);
#pragma unroll
                for (int vi = 0; vi < 7; ++vi) aX[vi] = MFMA16(opt(Va, ML_LDW, 16 * vi, 32 * ks, lane), b8, aX[vi]); }
            const float den = lx_idx(aX[6][0], c16);
            const float inv = 1.0f / fmaxf(fabsf(den), emtA[t]);
            const int row = scan_row(b, dir, 64 * c + t);
            const unsigned oo = ((unsigned)row * (unsigned)dst_ld + (unsigned)(h * 96 + 4 * rg)) * 2u;
#pragma unroll
            for (int vi = 0; vi < 6; ++vi) { v2u w; w.x = pk2(aX[vi][0] * inv, aX[vi][1] * inv); w.y = pk2(aX[vi][2] * inv, aX[vi][3] * inv); gst8(dst, oo + 32u * vi, w); }
        } else {
            const int sw = wave - 4; const float decay = scal[0];
#pragma unroll
            for (int i = 0; i < 11; ++i) { const int j = sw + 4 * i; if (j < 42) { const int di = j / 7, vi = j % 7;
                acc[i] = acc[i] * decay;
#pragma unroll
                for (int ks = 0; ks < 2; ++ks) acc[i] = MFMA16(opt(Kw, ML_LDW, 16 * di, 32 * ks, lane), opt(Va, ML_LDW, 16 * vi, 32 * ks, lane), acc[i]); } }
        }
        __syncthreads();
    }
#undef ML_PREFETCH
}

constexpr int HG_QT = 0, HG_KR = 8704, HG_V = 17920, HG_ATT = 23040, HG_SPT = 25600, HG_ER = 43008, HG_TOT = 43520;
constexpr int HG_LDQ = 272, HG_LDK = 288, HG_LDV = 160, HG_LDA = 80, HG_LDS = 272;

__device__ __forceinline__ void hgrn2_stream(lptr lds, const bf16* P, bf16* dst, int dst_ld, const float* lbl  , int b, int h, int dir) {
    const int tid = tid_opaque(), lane = tid & 63, c16 = lane & 15, rg = lane >> 4, wave = __builtin_amdgcn_readfirstlane(tid >> 6);
    lptr QT = lds + HG_QT, KR = lds + HG_KR, Vs = lds + HG_V, ATT = lds + HG_ATT, SPT = lds + HG_SPT;
    LAS float* ER = (LAS float*)(lds + HG_ER); LAS float* TOT = (LAS float*)(lds + HG_TOT);
    const int tt = tid >> 4, kc = tid & 15;
    const int tv = tid >> 3, cv = tid & 7;
    float lb[8];
    { const f32x4 l0 = *(const f32x4*)(lbl + dir * 512 + h * 128 + 8 * kc), l1 = *(const f32x4*)(lbl + dir * 512 + h * 128 + 8 * kc + 4);
#pragma unroll
      for (int j = 0; j < 4; ++j) { lb[j] = l0[j]; lb[4 + j] = l1[j]; } }
    f32x4 acc[4];
#pragma unroll
    for (int i = 0; i < 4; ++i) acc[i] = (f32x4){0.f, 0.f, 0.f, 0.f};
    v4u zr, qr, vr;
#define HG_PREFETCH(c) do { { const unsigned ro_ = (unsigned)scan_row(b, dir, 32 * (c) + tt) * (unsigned)(DINP * 2) + 16u * kc; \
        zr = gld16(P, ro_ + (unsigned)(C_HGF + dir * 512 + h * 128) * 2u); qr = gld16(P, ro_ + (unsigned)(C_HGQ + h * 128) * 2u); } \
        if (tid < 256) { const unsigned ro_ = (unsigned)scan_row(b, dir, 32 * (c) + tv) * (unsigned)(DINP * 2) + 16u * cv; vr = gld16(P, ro_ + (unsigned)(C_HGI + h * 64) * 2u); } } while (0)
    HG_PREFETCH(0);
    for (int c = 0; c < NTOK / 32; ++c) {
        float kk[8], cs[8], qv[8];
        { const unsigned zw[4] = {zr.x, zr.y, zr.z, zr.w}, qw[4] = {qr.x, qr.y, qr.z, qr.w};
#pragma unroll
          for (int j = 0; j < 8; ++j) { const float z = (j & 1) ? bfhi(zw[j >> 1]) : bflo(zw[j >> 1]); qv[j] = (j & 1) ? bfhi(qw[j >> 1]) : bflo(qw[j >> 1]);
              const float e = __expf(-fabsf(z)); const float inv = __builtin_amdgcn_rcpf(1.0f + e);
              const float sig = z >= 0.f ? inv : e * inv, nsig = z >= 0.f ? e * inv : inv;
              const float oml = 1.0f - lb[j]; const float f = fmaxf(lb[j], 1e-30f) + oml * sig; kk[j] = oml * nsig;
              float x = __log2f(f);
              float y = lx_up(x, 16, lane); if (lane >= 16) x += y;
              y = lx_up(x, 32, lane); if (lane >= 32) x += y;
              cs[j] = x; } }
        if (tid < 256) *(LAS v4u*)(Vs + tv * HG_LDV + cv * 16) = vr;
        if (lane >= 48) { *(LAS f32x4*)(TOT + wave * 128 + 8 * kc) = (f32x4){cs[0], cs[1], cs[2], cs[3]}; *(LAS f32x4*)(TOT + wave * 128 + 8 * kc + 4) = (f32x4){cs[4], cs[5], cs[6], cs[7]}; }
        __syncthreads();
#pragma unroll
        for (int hf = 0; hf < 2; ++hf) {
            float off[4], tot[4];
#pragma unroll
            for (int j = 0; j < 4; ++j) { off[j] = 0.f; tot[j] = 0.f; }
#pragma unroll
            for (int w2 = 0; w2 < 8; ++w2) { const f32x4 t0 = *(const LAS f32x4*)(TOT + w2 * 128 + 8 * kc + 4 * hf); const float use = (w2 < wave) ? 1.0f : 0.0f;
#pragma unroll
                for (int j = 0; j < 4; ++j) { tot[j] += t0[j]; off[j] += use * t0[j]; } }
            float qt[4], kt[4], er[4];
#pragma unroll
            for (int j = 0; j < 4; ++j) { const float rr = 0.5f * tot[j]; float x = off[j] + cs[4 * hf + j] - rr; x = fminf(fmaxf(x, -100.f), 100.f);
                const float q = qv[4 * hf + j]; const float qs = q * __builtin_amdgcn_rcpf(1.0f + __expf(-q));
                qt[j] = qs * __builtin_amdgcn_exp2f(x); kt[j] = kk[4 * hf + j] * __builtin_amdgcn_exp2f(-x); er[j] = __builtin_amdgcn_exp2f(fmaxf(rr, -100.f)); }
            v2u wq, wk; wq.x = pk2(qt[0], qt[1]); wq.y = pk2(qt[2], qt[3]); wk.x = pk2(kt[0], kt[1]); wk.y = pk2(kt[2], kt[3]);
            *(LAS v2u*)(QT + tt * HG_LDQ + kc * 16 + 8 * hf) = wq; *(LAS v2u*)(KR + tt * HG_LDK + kc * 16 + 8 * hf) = wk;
            if (tid < 16) *(LAS f32x4*)(ER + 8 * kc + 4 * hf) = (f32x4){er[0], er[1], er[2], er[3]};
            asm volatile("" ::: "memory");
        }
        if (c + 1 < NTOK / 32) HG_PREFETCH(c + 1);
        __syncthreads();
        if (wave < 4) { const int si = wave & 1, ti = wave >> 1;
            f32x4 a4 = (f32x4){0.f, 0.f, 0.f, 0.f};
            if (si <= ti) {
#pragma unroll
                for (int ks = 0; ks < 4; ++ks) a4 = MFMA16(opr(KR, HG_LDK, 16 * si, 32 * ks, c16, rg), opr(QT, HG_LDQ, 16 * ti, 32 * ks, c16, rg), a4);
            }
            const int t = 16 * ti + c16, s0 = 16 * si + 4 * rg;
            v2u w; w.x = pk2(s0 <= t ? a4[0] : 0.f, s0 + 1 <= t ? a4[1] : 0.f); w.y = pk2(s0 + 2 <= t ? a4[2] : 0.f, s0 + 3 <= t ? a4[3] : 0.f);
            *(LAS v2u*)(ATT + t * HG_LDA + s0 * 2) = w; }
        { const f32x4 er = *(const LAS f32x4*)(ER + 16 * wave + 4 * rg);
#pragma unroll
          for (int ci = 0; ci < 4; ++ci) { acc[ci] = acc[ci] * er; v2u w; w.x = pk2(acc[ci][0], acc[ci][1]); w.y = pk2(acc[ci][2], acc[ci][3]);
              *(LAS v2u*)(SPT + (16 * ci + c16) * HG_LDS + (16 * wave + 4 * rg) * 2) = w; } }
        __syncthreads();
        { const int ci = wave & 3, ti = wave >> 2, t = 16 * ti + c16;
          f32x4 o4 = (f32x4){0.f, 0.f, 0.f, 0.f};
          o4 = MFMA16(opt(Vs, HG_LDV, 16 * ci, 0, lane), opr(ATT, HG_LDA, 16 * ti, 0, c16, rg), o4);
#pragma unroll
          for (int ks = 0; ks < 4; ++ks) o4 = MFMA16(opr(SPT, HG_LDS, 16 * ci, 32 * ks, c16, rg), opr(QT, HG_LDQ, 16 * ti, 32 * ks, c16, rg), o4);
          const int row = scan_row(b, dir, 32 * c + t);
          v2u w; w.x = pk2(o4[0], o4[1]); w.y = pk2(o4[2], o4[3]);
          gst8(dst, ((unsigned)row * (unsigned)dst_ld + (unsigned)(h * 64 + 16 * ci + 4 * rg)) * 2u, w); }
        { const bf16x8 a8 = opt(KR, HG_LDK, 16 * wave, 0, lane); const f32x4 er = *(const LAS f32x4*)(ER + 16 * wave + 4 * rg);
#pragma unroll
          for (int ci = 0; ci < 4; ++ci) { acc[ci] = MFMA16(a8, opt(Vs, HG_LDV, 16 * ci, 0, lane), acc[ci]); acc[ci] = acc[ci] * er; } }
        __syncthreads();
    }
#undef HG_PREFETCH
}

__device__ __forceinline__ void fin_phase(int row_lo, const bf16* P, bf16* YM, const bf16* RAWM, const bf16* RAWH, const float* mlgain  , const float* hggain  , int vcu, int G) {
    const int tid = tid_opaque(); const int lane = tid & 63, wave = __builtin_amdgcn_readfirstlane(tid >> 6);
    const int gw = vcu * NWAVES + wave, NGW = G * NWAVES;
    float gm[6], gh[4];
#pragma unroll
    for (int j = 0; j < 6; ++j) gm[j] = mlgain[6 * lane + j];
#pragma unroll
    for (int j = 0; j < 4; ++j) gh[j] = hggain[4 * lane + j];
    for (int r = row_lo + gw; r < MT; r += NGW) {
        bf16* ym = YM + (size_t)r * D;
        const unsigned* f3 = (const unsigned*)(ym + Y_ML + 6 * lane); const unsigned* b3 = (const unsigned*)(RAWM + (size_t)r * 384 + 6 * lane); const unsigned* o3 = (const unsigned*)(P + (size_t)r * DINP + C_MLO + 6 * lane);
        const unsigned fa = f3[0], fb_ = f3[1], fc = f3[2], ba = b3[0], bb = b3[1], bc = b3[2], oa = o3[0], ob = o3[1], oc = o3[2];
        const v2u f2 = *(const v2u*)(ym + Y_HG + 4 * lane), b2 = *(const v2u*)(RAWH + (size_t)r * 256 + 4 * lane), g2 = *(const v2u*)(P + (size_t)r * DINP + C_HGG + 4 * lane);
        float hm[6] = {bflo(fa) + bflo(ba), bfhi(fa) + bfhi(ba), bflo(fb_) + bflo(bb), bfhi(fb_) + bfhi(bb), bflo(fc) + bflo(bc), bfhi(fc) + bfhi(bc)};
        const float og[6] = {bflo(oa), bfhi(oa), bflo(ob), bfhi(ob), bflo(oc), bfhi(oc)};
        float hh[4] = {bflo(f2.x) + bflo(b2.x), bfhi(f2.x) + bfhi(b2.x), bflo(f2.y) + bflo(b2.y), bfhi(f2.y) + bfhi(b2.y)};
        const float gg[4] = {bflo(g2.x), bfhi(g2.x), bflo(g2.y), bfhi(g2.y)};
        float sm = 0.f, sh = 0.f;
#pragma unroll
        for (int j = 0; j < 6; ++j) sm += hm[j] * hm[j];
#pragma unroll
        for (int j = 0; j < 4; ++j) sh += hh[j] * hh[j];
#pragma unroll
        for (int o = 1; o < 16; o <<= 1) { sm += lx_xor(sm, o, lane); sh += lx_xor(sh, o, lane); }
        const float rm = 1.0f / sqrtf(sm * (1.0f / 96.0f) + EPS), rh = 1.0f / sqrtf(sh * (1.0f / 64.0f) + EPS);
#pragma unroll
        for (int j = 0; j < 6; ++j) hm[j] = hm[j] * rm * gm[j] * __builtin_amdgcn_rcpf(1.0f + __expf(-og[j]));
#pragma unroll
        for (int j = 0; j < 4; ++j) hh[j] = hh[j] * rh * gh[j] * gg[j] * __builtin_amdgcn_rcpf(1.0f + __expf(-gg[j]));
        unsigned* w3 = (unsigned*)(ym + Y_ML + 6 * lane); w3[0] = pk2(hm[0], hm[1]); w3[1] = pk2(hm[2], hm[3]); w3[2] = pk2(hm[4], hm[5]);
        v2u w2; w2.x = pk2(hh[0], hh[1]); w2.y = pk2(hh[2], hh[3]); *(v2u*)(ym + Y_HG + 4 * lane) = w2;
    }
}
#ifndef NO_HG
#define NO_HG 0
#endif
#ifndef NO_ML
#define NO_ML 0
#endif
#ifndef NO_AT
#define NO_AT 0
#endif
#ifndef NO_GEMM
#define NO_GEMM 0
#endif
#ifndef NO_G1
#define NO_G1 0
#endif
#ifndef NO_G2
#define NO_G2 0
#endif
#ifndef NO_G3
#define NO_G3 0
#endif
#ifndef NO_G4
#define NO_G4 0
#endif
#ifndef NO_P0
#define NO_P0 0
#endif
#ifndef REPMASK
#define REPMASK 7
#endif
#ifndef REP
#define REP 0
#endif
constexpr int NPHASE = 2 + 8 * DEPTH;

typedef __attribute__((address_space(4))) const Args* kargs_t;
__device__ __forceinline__ kargs_t kargs() { kargs_t p = (kargs_t)__builtin_amdgcn_kernarg_segment_ptr(); asm volatile("" : "+s"(p)); return p; }
#define WSP(T, off) ((T*)(ws + (off)))

__global__ void __launch_bounds__(NTHR, 2) fwd(Args a_unused) {
    extern __shared__ __attribute__((aligned(16))) unsigned char lds_raw[];
    lptr lds = (lptr)lds_raw;
    const int G = gridDim.x; const int bx = blockIdx.x; const int vcu = (G % 8 == 0) ? (bx % 8) * (G / 8) + bx / 8 : bx;
    volatile LAS unsigned* MISC = (volatile LAS unsigned*)(lds + LDSCTL_OFF);
    { const int tid = tid_opaque(); for (int u = tid; u < (LDS_BYTES - LDSCTL_OFF) / 4; u += NTHR) ((LAS unsigned*)(lds + LDSCTL_OFF))[u] = 0u; }
    __syncthreads();
    int lo, hi; XcdBarrier bar;
    { kargs_t A = kargs(); lo = A->ph_lo; hi = A->ph_hi; unsigned* bw = (unsigned*)(A->ws + WS_CTL) + CW_BAR;
      bar.bar = bw; bar.x = 0; bar.st = nullptr;
      if (hi - lo > 1) bar = xcd_barrier_post(bw, MISC + 8); }
    volatile LAS int* slot = (volatile LAS int*)(MISC + 16);
#define IN(k) (lo <= (k) && (k) < hi)
#define SEAM(k) do { if (IN(k) && IN((k) + 1)) xcd_barrier(bar); } while (0)
#define REPEAT(k) for (int rep_ = ((REP == (k) && l == 0) ? 2 : 1); rep_ > 0; --rep_)
#define REPBAR() do { if (rep_ > 1) xcd_barrier(bar); } while (0)

    if (IN(0)) { if (!NO_P0) p0_phase(lds, kargs()); } SEAM(0);

    for (int l = 0; l < DEPTH; ++l) {
        const int pb = 1 + 8 * l;
        const bool with_ctx = l < DEPTH - 1;
        const int r0 = with_ctx ? 0 : MC; const int Mg = MT - r0;
        if (IN(pb)) REPEAT(1) {
            kargs_t A = kargs(); unsigned char* ws = A->ws; const float* modl = WSP(float, WS_MOD) + (size_t)l * 17 * NMOD; float* ctxx = WSP(float, WS_CTXX);
            if (l == 0) thin_phase<false, true>(0, A->in[I_X], A->in[I_CTX], A->out, ctxx, false, nullptr, nullptr, 0, nullptr, modl, 0, D, A->in[I_GPREMIX] + l * D, WSP(bf16, WS_HB), vcu, G);
            else        thin_phase<true, true>(0, A->out, ctxx, A->out, ctxx, true, WSP(float, WS_YD), modl - 17 * NMOD, 5 * D, A->in[I_GPOSTFFN] + (l - 1) * D, modl, 0, D, A->in[I_GPREMIX] + l * D, WSP(bf16, WS_HB), vcu, G);
            convert_weights(lds, kargs(), l, vcu, G); REPBAR();
        }
        SEAM(pb);
        if (IN(pb + 1)) REPEAT(2) {
            kargs_t A = kargs(); unsigned char* ws = A->ws;
            pg8::Gemm g{WSP(bf16, WS_HB), WSP(bf16, WS_WIN), MT, DINP, D}; pg8::StaticOrder S; S.init(MT, DINP, G, bx);
            pg8::EpiIn E{WSP(bf16, WS_P), DINP, WSP(float, WS_MISC + 32768) + l * DINP, WSP(float, WS_GATE)};
            if (!NO_GEMM && !NO_G1) pg8::gemm_phase<pg8::EpiIn, pg8::StaticOrder, true, true>(lds, g, S, E); REPBAR();
        }
        SEAM(pb + 1);
        if (IN(pb + 2)) REPEAT(3) {
            { kargs_t A = kargs(); unsigned char* ws = A->ws; unsigned* qh = WSP(unsigned, WS_CTL) + CW_Q + 64 * (3 * l + 12 * (rep_ - 1));
              for (;;) { const int it = wg_pull(qh, slot); if (it >= 128) break;
                const int b = it >> 3, h = (it >> 1) & 3, dir = it & 1;
                if (!NO_HG && (rep_ == 1 || (REPMASK & 1))) hgrn2_stream(lds, WSP(bf16, WS_P), dir ? WSP(bf16, WS_RAWH) : WSP(bf16, WS_HB) + Y_HG, dir ? 256 : D, WSP(float, WS_MISC) + l * 1024, b, h, dir); } }
            { kargs_t A = kargs(); unsigned char* ws = A->ws; unsigned* qm = WSP(unsigned, WS_CTL) + CW_Q + 64 * (3 * l + 12 * (rep_ - 1)) + 64;
              for (;;) { const int it = wg_pull(qm, slot); if (it >= 128) break;
                const int b = it >> 3, h = (it >> 1) & 3, dir = it & 1;
                if (!NO_ML && (rep_ == 1 || (REPMASK & 2))) mlstm_stream(lds, WSP(bf16, WS_P), WSP(float, WS_GATE), dir ? WSP(bf16, WS_RAWM) : WSP(bf16, WS_HB) + Y_ML, dir ? 384 : D, A->in[I_MLFB] + l * 8, b, h, dir); } }
            { kargs_t A = kargs(); unsigned char* ws = A->ws; unsigned* qa = WSP(unsigned, WS_CTL) + CW_Q + 64 * (3 * l + 12 * (rep_ - 1)) + 128;
              const int na = with_ctx ? 576 : 512;
              const float lam_init = 0.8f - 0.6f * __expf(-0.3f * (float)l);
              for (;;) { const int it = wg_pull(qa, slot); if (it >= na) break;
                const int bh = it < 512 ? it >> 3 : it - 512, qb = it < 512 ? it & 7 : 8;
                if (!NO_AT && (rep_ == 1 || (REPMASK & 4))) attn_item(lds, WSP(bf16, WS_P), WSP(bf16, WS_HB), WSP(float, WS_MISC + 16384), A->in[I_DANORM] + l * 96, WSP(float, WS_MISC + 114688)[l], 1.0f - lam_init, bh >> 2, bh & 3, qb); } }
            __syncthreads(); REPBAR();
        }
        SEAM(pb + 2);
        if (IN(pb + 3)) {
            kargs_t A = kargs(); unsigned char* ws = A->ws;
            fin_phase(r0, WSP(bf16, WS_P), WSP(bf16, WS_HB), WSP(bf16, WS_RAWM), WSP(bf16, WS_RAWH), A->in[I_MLNORM] + l * 384, A->in[I_HGNORM] + l * 256, vcu, G);
        }
        SEAM(pb + 3);
        if (IN(pb + 4)) REPEAT(5) {
            kargs_t A = kargs(); unsigned char* ws = A->ws;
            pg8::Gemm g{WSP(bf16, WS_HB) + (size_t)r0 * D, WSP(bf16, WS_WOUT), Mg, D, D}; pg8::StaticOrder S; S.init(Mg, D, G, bx);
            pg8::EpiF32 E{WSP(float, WS_P) + (size_t)r0 * D, D};
            if (!NO_GEMM && !NO_G2) pg8::gemm_phase<pg8::EpiF32, pg8::StaticOrder, true, true>(lds, g, S, E); REPBAR();
        }
        SEAM(pb + 4);
        if (IN(pb + 5)) REPEAT(6) {
            kargs_t A = kargs(); unsigned char* ws = A->ws; const float* modl = WSP(float, WS_MOD) + (size_t)l * 17 * NMOD; float* ctxx = WSP(float, WS_CTXX);
            const float* xl = (l == 0) ? A->in[I_X] : A->out; const float* xc = (l == 0) ? A->in[I_CTX] : ctxx;
            thin_phase<true, true>(r0, xl, xc, A->out, ctxx, true, WSP(float, WS_P), modl, 2 * D, A->in[I_GPOSTMIX] + l * D, modl, 3 * D, 4 * D, A->in[I_GPREFFN] + l * D, WSP(bf16, WS_HB), vcu, G); REPBAR();
        }
        SEAM(pb + 5);
        if (IN(pb + 6)) REPEAT(7) {
            kargs_t A = kargs(); unsigned char* ws = A->ws;
            pg8::Gemm g{WSP(bf16, WS_HB) + (size_t)r0 * D, WSP(bf16, WS_WGU), Mg, NGU, D}; pg8::StaticOrder S; S.init(Mg, NGU, G, bx);
            pg8::EpiSwiglu E{WSP(bf16, WS_P) + (size_t)r0 * DFF, DFF};
            if (!NO_GEMM && !NO_G3) pg8::gemm_phase<pg8::EpiSwiglu, pg8::StaticOrder, true, true>(lds, g, S, E); REPBAR();
        }
        SEAM(pb + 6);
        if (IN(pb + 7)) REPEAT(8) {
            kargs_t A = kargs(); unsigned char* ws = A->ws;
            pg8::Gemm g{WSP(bf16, WS_P) + (size_t)r0 * DFF, WSP(bf16, WS_WD), Mg, D, DFF}; pg8::StaticOrder S; S.init(Mg, D, G, bx);
            pg8::EpiF32 E{WSP(float, WS_YD) + (size_t)r0 * D, D};
            if (!NO_GEMM && !NO_G4) pg8::gemm_phase<pg8::EpiF32, pg8::StaticOrder, true, true>(lds, g, S, E); REPBAR();
        }
        SEAM(pb + 7);
    }
    if (IN(NPHASE - 1)) {
        kargs_t A = kargs(); unsigned char* ws = A->ws; const float* modl = WSP(float, WS_MOD) + (size_t)(DEPTH - 1) * 17 * NMOD; float* ctxx = WSP(float, WS_CTXX);
        thin_phase<true, false>(MC, A->out, ctxx, A->out, ctxx, true, WSP(float, WS_YD), modl, 5 * D, A->in[I_GPOSTFFN] + (DEPTH - 1) * D, nullptr, 0, 0, nullptr, nullptr, vcu, G);
    }
#undef IN
#undef SEAM
}

extern "C" void kernel_launch(void* const* d_in, const int* in_sizes, int n_in, void* d_out, int out_size, void* d_ws, size_t ws_size, hipStream_t stream) {
    static int grid = 0;
    if (grid == 0) {
        if (n_in != 22 || in_sizes[0] != ML * D || out_size != ML * D || ws_size < WS_END) {
            fprintf(stderr, "kernel_launch: unexpected shapes: n_in %d in0 %d out %d ws %zu (need %zu); nothing launched\n", n_in, n_in > 0 ? in_sizes[0] : -1, out_size, ws_size, (size_t)WS_END); grid = -1; return; }
        int dev = 0, cus = 0, per_cu = 0;
        if (hipGetDevice(&dev) != hipSuccess || hipDeviceGetAttribute(&cus, hipDeviceAttributeMultiprocessorCount, dev) != hipSuccess) { fprintf(stderr, "kernel_launch: device query failed\n"); grid = -1; return; }
        if (hipFuncSetAttribute((const void*)fwd, hipFuncAttributeMaxDynamicSharedMemorySize, LDS_BYTES) != hipSuccess) { fprintf(stderr, "kernel_launch: hipFuncSetAttribute failed\n"); grid = -1; return; }
        if (hipOccupancyMaxActiveBlocksPerMultiprocessor(&per_cu, (const void*)fwd, NTHR, LDS_BYTES) != hipSuccess || per_cu < 1)
            fprintf(stderr, "kernel_launch: note: occupancy query reports %d workgroups per CU\n", per_cu);
        (void)hipGetLastError();
        grid = cus;
    }
    if (grid < 0) return;
    if (hipMemsetAsync((char*)d_ws + WS_CTL, 0, CTL_ZERO_BYTES, stream) != hipSuccess) { fprintf(stderr, "kernel_launch: memset failed\n"); return; }
    Args a{};
    for (int i = 0; i < 22; ++i) a.in[i] = (const float*)d_in[i];
    a.out = (float*)d_out; a.ws = (unsigned char*)d_ws;
#if MK_PER_PHASE
    for (int p = 0; p < NPHASE; ++p) { a.ph_lo = p; a.ph_hi = p + 1; hipLaunchKernelGGL(fwd, dim3(grid), dim3(NTHR), LDS_BYTES, stream, a); }
#else
    a.ph_lo = 0; a.ph_hi = NPHASE;
    hipLaunchKernelGGL(fwd, dim3(grid), dim3(NTHR), LDS_BYTES, stream, a);
#endif
    const hipError_t le = hipPeekAtLastError();
    if (le != hipSuccess) fprintf(stderr, "kernel_launch: launch failed: %s\n", hipGetErrorName(le));
}
```

```cpp
#include <hip/hip_runtime.h>
#include <cstdio>
#include <cstdint>
#ifndef MK_PER_PHASE
#define MK_PER_PHASE 0
#endif
namespace pg8 {
#define PG8_LAS __attribute__((address_space(3)))
typedef unsigned short bf16_t;
typedef short bf16x8 __attribute__((ext_vector_type(8)));
typedef float f32x4 __attribute__((ext_vector_type(4)));
typedef unsigned u32x4 __attribute__((ext_vector_type(4)));
constexpr int BM = 256, BK = 64, HALF = 128, HTB = HALF * BK * 2  , STAGE_BYTES = 8 * HTB, NXCD = 8, WGM = 8;

__host__ __device__ __forceinline__ int lds_byte(int r, int c) { const int st = (r >> 4) * 2 + (c >> 5), rr = r & 15, cc = c & 31, ob = rr * 64 + cc * 2; return st * 1024 + (ob ^ (((ob >> 9) & 1) << 5)); }
__host__ __device__ __forceinline__ void stage_rc(int b, int& R, int& C) { const int st = b / 1024, sb = b % 1024, swz = sb ^ (((sb >> 9) & 1) << 5); R = (st >> 1) * 16 + swz / 64; C = (st & 1) * 32 + (swz % 64) / 2; }
__host__ __device__ __forceinline__ int perm32(int rho) { const int n = rho >> 4, i = rho & 15; return 8 * (i >> 2) + 4 * n + (i & 3); }

struct Unit { int pm, pn; };
struct Gemm { const bf16_t* A; const bf16_t* Bt; int M, N, K; };

struct StaticOrder {
    int nM, nN, nwg, G, c;
    __host__ __device__ void init(int M, int N, int G_, int c_) { nM = M / BM; nN = N / BM; nwg = nM * nN; G = G_; c = c_; }
    __host__ __device__ bool next(int i, Unit& u) const {
        const long L = (long)i * G + c; if (L >= nwg) return false;
        int wgid = (int)L; { const int q = nwg / NXCD, r = nwg % NXCD, xcd = wgid % NXCD, off = wgid / NXCD; wgid = (xcd < r ? xcd * (q + 1) : r * (q + 1) + (xcd - r) * q) + off; }
        const int nig = WGM * nN, gid = wgid / nig, fm = gid * WGM, gsz = (nM - fm) < WGM ? (nM - fm) : WGM;
        u.pm = fm + ((wgid % nig) % gsz); u.pn = (wgid % nig) / gsz; return true;
    }
    __device__ __forceinline__ void a_ready(const Unit&) const {}
    __device__ __forceinline__ void done(const Unit&) const {}
};
__device__ __forceinline__ unsigned cvt_pk_bf16(float lo, float hi) { unsigned r; asm volatile("v_cvt_pk_bf16_f32 %0, %1, %2" : "=v"(r) : "v"(lo), "v"(hi)); return r; }
struct EpiF32 {
    static constexpr bool PERM = false, AFTER_DRAIN = false;
    float* C; int ldc;
    __device__ __forceinline__ void operator()(const f32x4 (&acc)[2][2][4][2], const Unit& u, int wr, int wc, int fr, int fq) const {
        const int row0 = u.pm * BM + wr * 64 + fr, col0 = u.pn * BM + wc * 32 + 4 * fq;
#pragma unroll
        for (int ai = 0; ai < 2; ++ai)
#pragma unroll
            for (int m = 0; m < 4; ++m) { float* rowp = C + (size_t)(row0 + ai * HALF + m * 16) * ldc + col0;
#pragma unroll
                for (int bj = 0; bj < 2; ++bj)
#pragma unroll
                    for (int n = 0; n < 2; ++n) *(f32x4*)(rowp + bj * HALF + n * 16) = acc[ai][bj][m][n]; }
    }
};
struct EpiBf {
    static constexpr bool PERM = true, AFTER_DRAIN = false;
    bf16_t* O; int ldc;
    __device__ __forceinline__ void operator()(const f32x4 (&acc)[2][2][4][2], const Unit& u, int wr, int wc, int fr, int fq) const {
        const int row0 = u.pm * BM + wr * 64 + fr; const int col0 = u.pn * BM + wc * 32 + 8 * fq;
#pragma unroll
        for (int ai = 0; ai < 2; ++ai)
#pragma unroll
            for (int m = 0; m < 4; ++m) { bf16_t* rowp = O + (size_t)(row0 + ai * HALF + m * 16) * ldc + col0;
#pragma unroll
                for (int bj = 0; bj < 2; ++bj) { const f32x4 v0 = acc[ai][bj][m][0], v1 = acc[ai][bj][m][1];
                    u32x4 w; w.x = cvt_pk_bf16(v0[0], v0[1]); w.y = cvt_pk_bf16(v0[2], v0[3]); w.z = cvt_pk_bf16(v1[0], v1[1]); w.w = cvt_pk_bf16(v1[2], v1[3]);
                    *(u32x4*)(rowp + bj * HALF) = w; } }
    }
};
struct EpiIn {
    static constexpr bool PERM = true, AFTER_DRAIN = false;
    bf16_t* O; int ldc; const float* bias; float* G;
    __device__ __forceinline__ void operator()(const f32x4 (&acc)[2][2][4][2], const Unit& u, int wr, int wc, int fr, int fq) const {
        const int row0 = u.pm * BM + wr * 64 + fr; const int col0 = u.pn * BM + wc * 32 + 8 * fq;
        const bool gate_lane = (u.pn == 6) && (wc == 0) && (fq < 2);
#pragma unroll
        for (int bj = 0; bj < 2; ++bj) {
            const f32x4 b0 = *(const f32x4*)(bias + col0 + bj * HALF), b1 = *(const f32x4*)(bias + col0 + bj * HALF + 4);
#pragma unroll
            for (int ai = 0; ai < 2; ++ai)
#pragma unroll
                for (int m = 0; m < 4; ++m) { const int row = row0 + ai * HALF + m * 16; bf16_t* rowp = O + (size_t)row * ldc + col0;
                    const f32x4 v0 = acc[ai][bj][m][0] + b0, v1 = acc[ai][bj][m][1] + b1;
                    u32x4 w; w.x = cvt_pk_bf16(v0[0], v0[1]); w.y = cvt_pk_bf16(v0[2], v0[3]); w.z = cvt_pk_bf16(v1[0], v1[1]); w.w = cvt_pk_bf16(v1[2], v1[3]);
                    *(u32x4*)(rowp + bj * HALF) = w;
                    if (bj == 0 && gate_lane) { float* g = G + (size_t)row * 16 + 8 * fq; *(f32x4*)g = v0; *(f32x4*)(g + 4) = v1; } }
        }
    }
};
struct EpiSwiglu {
    static constexpr bool PERM = true, AFTER_DRAIN = false;
    bf16_t* O; int ldc;
    __device__ __forceinline__ void operator()(const f32x4 (&acc)[2][2][4][2], const Unit& u, int wr, int wc, int fr, int fq) const {
        const int row0 = u.pm * BM + wr * 64 + fr; const int col0 = u.pn * HALF + wc * 32 + 8 * fq;
#pragma unroll
        for (int ai = 0; ai < 2; ++ai)
#pragma unroll
            for (int m = 0; m < 4; ++m) { bf16_t* rowp = O + (size_t)(row0 + ai * HALF + m * 16) * ldc + col0;
                f32x4 r0, r1;
#pragma unroll
                for (int i = 0; i < 4; ++i) { const float g0 = acc[ai][0][m][0][i], g1 = acc[ai][0][m][1][i];
                    r0[i] = g0 * __builtin_amdgcn_rcpf(1.0f + __expf(-g0)) * acc[ai][1][m][0][i];
                    r1[i] = g1 * __builtin_amdgcn_rcpf(1.0f + __expf(-g1)) * acc[ai][1][m][1][i]; }
                u32x4 w; w.x = cvt_pk_bf16(r0[0], r0[1]); w.y = cvt_pk_bf16(r0[2], r0[3]); w.z = cvt_pk_bf16(r1[0], r1[1]); w.w = cvt_pk_bf16(r1[2], r1[3]);
                *(u32x4*)rowp = w; }
    }
};
template <class Epi, class Sched, bool ALIGN_EPI = false, bool SP2 = false>
__device__ __forceinline__ void gemm_phase(PG8_LAS unsigned char* lds, const Gemm g, const Sched& S, const Epi& E) {
    int tid_ = threadIdx.x; asm volatile("" : "+v"(tid_));
    const int tid = tid_, wid = __builtin_amdgcn_readfirstlane(tid >> 6), lane = tid & 63, wr = wid >> 2, wc = wid & 3, fr = lane & 15, fq = lane >> 4;
    const int K = g.K, nt = K / BK;
    unsigned voffA[2], voffB[2];
#pragma unroll
    for (int i = 0; i < 2; ++i) { int R, C; stage_rc(tid * 16 + i * 8192, R, C); const int Rb = Epi::PERM ? ((R & ~31) + perm32(R & 31)) : R;
        voffA[i] = (unsigned)(R * K + C) * 2u; voffB[i] = (unsigned)(Rb * K + C) * 2u; }
    const size_t kstep = (size_t)(BK * 2);
    const size_t hstep = (size_t)HALF * K * 2;
    const size_t tstep = 2 * hstep;
    const unsigned ldsw = (unsigned)wid * 1024u;
    const int aoff = lds_byte(wr * 64 + fr, fq * 8), boff = lds_byte(wc * 32 + fr, fq * 8);
#define PG8_SA(b, h) (((b) * 2 + (h)) * HTB)
#define PG8_SB(b, h) ((4 + (b) * 2 + (h)) * HTB)
#define PG8_STAGE(bufoff, gbase, voff) do { _Pragma("unroll") for (int _i = 0; _i < 2; ++_i) \
        __builtin_amdgcn_global_load_lds((const unsigned*)((const char*)(gbase) + (voff)[_i]), (PG8_LAS unsigned*)(lds + (bufoff) + ldsw + _i * 8192), 16, 0, 0); } while (0)
#define PG8_LDA(dst, b, h) do { _Pragma("unroll") for (int m = 0; m < 4; ++m) _Pragma("unroll") for (int k = 0; k < 2; ++k) dst[m][k] = *(const PG8_LAS bf16x8*)(lds + PG8_SA(b, h) + aoff + m * 2048 + k * 1024); } while (0)
#define PG8_LDB(dst, b, h) do { _Pragma("unroll") for (int n = 0; n < 2; ++n) _Pragma("unroll") for (int k = 0; k < 2; ++k) dst[n][k] = *(const PG8_LAS bf16x8*)(lds + PG8_SB(b, h) + boff + n * 2048 + k * 1024); } while (0)
#define PG8_MMA(ai, bj, At, Bt) do { __builtin_amdgcn_s_setprio(1); _Pragma("unroll") for (int m = 0; m < 4; ++m) _Pragma("unroll") for (int n = 0; n < 2; ++n) _Pragma("unroll") for (int k = 0; k < 2; ++k) \
        acc[ai][bj][m][n] = __builtin_amdgcn_mfma_f32_16x16x32_bf16(Bt[n][k], At[m][k], acc[ai][bj][m][n], 0, 0, 0); __builtin_amdgcn_s_setprio(0); } while (0)
#define PG8_WAIT_V(n) asm volatile("s_waitcnt vmcnt(" #n ")" ::: "memory")
#define PG8_WAIT_L(n) asm volatile("s_waitcnt lgkmcnt(" #n ")" ::: "memory")
#define PG8_BAR __builtin_amdgcn_s_barrier()
#define PG8_SCHED __builtin_amdgcn_sched_barrier(0)
    Unit cur, nxt; int ui = 0;
    if (!S.next(0, cur)) return;
    f32x4 acc[2][2][4][2];
#pragma unroll
    for (int a = 0; a < 2; ++a)
#pragma unroll
        for (int b = 0; b < 2; ++b)
#pragma unroll
            for (int m = 0; m < 4; ++m)
#pragma unroll
                for (int n = 0; n < 2; ++n) acc[a][b][m][n] = (f32x4){0.f, 0.f, 0.f, 0.f};
    bf16x8 At[4][2], B0[2][2], B1[2][2];
    const char* cA = (const char*)g.A + (size_t)cur.pm * tstep; const char* cB = (const char*)g.Bt + (size_t)cur.pn * tstep;
    S.a_ready(cur);
    if constexpr (SP2) {
        PG8_STAGE(PG8_SB(0, 0), cB, voffB); PG8_STAGE(PG8_SB(0, 1), cB + hstep, voffB); PG8_STAGE(PG8_SA(0, 0), cA, voffA); PG8_STAGE(PG8_SA(0, 1), cA + hstep, voffA);
        if (wr == 1) PG8_BAR;
        PG8_WAIT_V(2); PG8_BAR;
        PG8_STAGE(PG8_SB(1, 0), cB + kstep, voffB); PG8_STAGE(PG8_SA(1, 0), cA + kstep, voffA); PG8_STAGE(PG8_SB(1, 1), cB + hstep + kstep, voffB);
        PG8_WAIT_V(6); PG8_BAR;
    } else {
        PG8_STAGE(PG8_SB(0, 0), cB, voffB); PG8_STAGE(PG8_SA(0, 0), cA, voffA); PG8_STAGE(PG8_SB(0, 1), cB + hstep, voffB); PG8_STAGE(PG8_SA(0, 1), cA + hstep, voffA);
        if (wr == 1) PG8_BAR;
        PG8_WAIT_V(4); PG8_BAR;
        PG8_STAGE(PG8_SB(1, 0), cB + kstep, voffB); PG8_STAGE(PG8_SA(1, 0), cA + kstep, voffA); PG8_STAGE(PG8_SB(1, 1), cB + hstep + kstep, voffB);
        PG8_WAIT_V(6); PG8_BAR;
    }
    for (;;) {
        const bool has_next = S.next(ui + 1, nxt);
        const char* nA = has_next ? (const char*)g.A + (size_t)nxt.pm * tstep : cA; const char* nB = has_next ? (const char*)g.Bt + (size_t)nxt.pn * tstep : cB;
        for (int t = 0; t < nt; t += 2) {
            const bool last = (t == nt - 2);
            const char* a1 = cA + (size_t)(t + 1) * kstep;
            const char* a2 = last ? nA : cA + (size_t)(t + 2) * kstep; const char* b2 = last ? nB : cB + (size_t)(t + 2) * kstep;
            const char* a3 = a2 + kstep; const char* b3 = b2 + kstep;
            if (last && has_next) S.a_ready(nxt);
            if constexpr (SP2) {
            PG8_LDB(B0, 0, 0); PG8_LDB(B1, 0, 1); PG8_SCHED; PG8_LDA(At, 0, 0); PG8_STAGE(PG8_SA(1, 1), a1 + hstep, voffA);
            PG8_WAIT_V(8); PG8_WAIT_L(0); PG8_BAR; PG8_MMA(0, 0, At, B0); PG8_MMA(0, 1, At, B1); PG8_BAR; PG8_SCHED;
            PG8_LDA(At, 0, 1); PG8_STAGE(PG8_SB(0, 0), b2, voffB); PG8_STAGE(PG8_SB(0, 1), b2 + hstep, voffB); PG8_STAGE(PG8_SA(0, 0), a2, voffA);
            PG8_WAIT_V(8); PG8_WAIT_L(0); PG8_BAR; PG8_MMA(1, 0, At, B0); PG8_MMA(1, 1, At, B1); PG8_BAR; PG8_SCHED;
            PG8_LDB(B0, 1, 0); PG8_LDB(B1, 1, 1); PG8_SCHED; PG8_LDA(At, 1, 0); PG8_STAGE(PG8_SA(0, 1), a2 + hstep, voffA);
            PG8_WAIT_V(8); PG8_WAIT_L(0); PG8_BAR; PG8_MMA(0, 0, At, B0); PG8_MMA(0, 1, At, B1); PG8_BAR; PG8_SCHED;
            PG8_LDA(At, 1, 1); PG8_STAGE(PG8_SB(1, 0), b3, voffB); PG8_STAGE(PG8_SB(1, 1), b3 + hstep, voffB); PG8_STAGE(PG8_SA(1, 0), a3, voffA);
            PG8_WAIT_V(8); PG8_WAIT_L(0); PG8_BAR; PG8_MMA(1, 0, At, B0); PG8_MMA(1, 1, At, B1); PG8_BAR; PG8_SCHED;
            } else {
            PG8_LDB(B0, 0, 0); PG8_SCHED; PG8_LDA(At, 0, 0); PG8_STAGE(PG8_SA(1, 1), a1 + hstep, voffA);
            PG8_WAIT_L(8); PG8_BAR; PG8_WAIT_L(0); PG8_MMA(0, 0, At, B0); PG8_BAR; PG8_SCHED;
            PG8_LDB(B1, 0, 1); PG8_STAGE(PG8_SB(0, 0), b2, voffB);
            PG8_BAR; PG8_WAIT_L(0); PG8_MMA(0, 1, At, B1); PG8_BAR;
            PG8_LDA(At, 0, 1); PG8_STAGE(PG8_SA(0, 0), a2, voffA);
            PG8_BAR; PG8_WAIT_L(0); PG8_MMA(1, 0, At, B0); PG8_BAR; PG8_SCHED;
            PG8_STAGE(PG8_SB(0, 1), b2 + hstep, voffB);
            PG8_WAIT_V(6); PG8_BAR; PG8_MMA(1, 1, At, B1); PG8_BAR;
            PG8_LDB(B0, 1, 0); PG8_SCHED; PG8_LDA(At, 1, 0); PG8_STAGE(PG8_SA(0, 1), a2 + hstep, voffA);
            PG8_WAIT_L(8); PG8_BAR; PG8_WAIT_L(0); PG8_MMA(0, 0, At, B0); PG8_BAR; PG8_SCHED;
            PG8_LDB(B1, 1, 1); PG8_STAGE(PG8_SB(1, 0), b3, voffB);
            PG8_BAR; PG8_WAIT_L(0); PG8_MMA(0, 1, At, B1); PG8_BAR;
            PG8_LDA(At, 1, 1); PG8_STAGE(PG8_SA(1, 0), a3, voffA);
            PG8_BAR; PG8_WAIT_L(0); PG8_MMA(1, 0, At, B0); PG8_BAR; PG8_SCHED;
            PG8_STAGE(PG8_SB(1, 1), b3 + hstep, voffB);
            PG8_WAIT_V(6); PG8_BAR; PG8_MMA(1, 1, At, B1); PG8_BAR;
            }
        }
        if constexpr (ALIGN_EPI) { if (wr == 0) PG8_BAR; }
        if constexpr (!Epi::AFTER_DRAIN) { E(acc, cur, wr, wc, fr, fq); S.done(cur); }
        if (!has_next) break;
#pragma unroll
        for (int a = 0; a < 2; ++a)
#pragma unroll
            for (int b = 0; b < 2; ++b)
#pragma unroll
                for (int m = 0; m < 4; ++m)
#pragma unroll
                    for (int n = 0; n < 2; ++n) acc[a][b][m][n] = (f32x4){0.f, 0.f, 0.f, 0.f};
        cur = nxt; cA = nA; cB = nB; ++ui;
        if constexpr (ALIGN_EPI) { if (wr == 1) PG8_BAR; }
    }
    PG8_WAIT_V(0);
    if constexpr (!ALIGN_EPI) { if (wr == 0) PG8_BAR; }
    PG8_BAR;
    if constexpr (Epi::AFTER_DRAIN) { E.fused(acc, cur, wr, wc, fr, fq, lds, wid, lane); S.done(cur); }
#undef PG8_SA
#undef PG8_SB
#undef PG8_STAGE
#undef PG8_LDA
#undef PG8_LDB
#undef PG8_MMA
#undef PG8_WAIT_V
#undef PG8_WAIT_L
#undef PG8_BAR
#undef PG8_SCHED
}
}
constexpr int D = 1024, NB = 16, SEQ = 2048, CTXL = 256, DEPTH = 4;
constexpr int MC = NB * CTXL, ML = NB * SEQ, MT = MC + ML;
constexpr int DIN = 4752, DINP = 4864, DFF = 2816, NGU = 2 * DFF, NMOD = 6 * D;
constexpr int C_MLQ = 0, C_MLK = 384, C_MLV = 768, C_MLO = 1152, C_MLI = 1536, C_MLF = 1544, C_HGQ = 1552, C_HGF = 2064, C_HGI = 3088, C_HGG = 3344, C_DAQ = 3600, C_DAK = 3984, C_DAV = 4368;
constexpr int Y_ML = 0, Y_HG = 384, Y_DA = 640;
constexpr float EPS = 1e-6f;
constexpr int NTOK = CTXL + SEQ;
static_assert(C_MLI == 6 * 256, "gate columns must open GEMM tile 6");

constexpr size_t MiB = 1u << 20;
constexpr size_t WS_CTL = 0, CTL_ZERO_BYTES = 1 * MiB;
constexpr size_t WS_MOD = 1 * MiB;
constexpr size_t WS_MISC = 3 * MiB;
constexpr size_t WS_GATE = 4 * MiB;
constexpr size_t WS_WIN = 8 * MiB, WS_WOUT = WS_WIN + (size_t)DINP * D * 2, WS_WGU = WS_WOUT + (size_t)D * D * 2, WS_WD = WS_WGU + (size_t)NGU * D * 2;
constexpr size_t WS_CTXX = 36 * MiB;
constexpr size_t WS_HB = 52 * MiB;
constexpr size_t WS_RAWM = 124 * MiB, WS_RAWH = 151 * MiB;
constexpr size_t WS_P = 169 * MiB;
constexpr size_t WS_YD = WS_P + 198 * MiB, WS_END = 511 * MiB;
static_assert(WS_WD + (size_t)D * DFF * 2 <= WS_CTXX, "weights fit");
static_assert(WS_RAWM + (size_t)64 * NTOK * 96 * 2 <= WS_RAWH && WS_RAWH + (size_t)64 * NTOK * 64 * 2 <= WS_P, "raw fits");
static_assert(WS_P + (size_t)MT * DINP * 2 <= WS_END && WS_YD + (size_t)MT * D * 4 <= WS_END && (size_t)MT * DFF * 2 <= 198 * MiB, "P region");
constexpr int CW_BAR = 4096;
constexpr int CW_Q = 16384;

constexpr int RING_BYTES = 131072, LDSCTL_OFF = RING_BYTES, LDS_BYTES = 147456;
constexpr int NWAVES = 8, NTHR = 512;

#define GAS __attribute__((address_space(1)))
#define LAS __attribute__((address_space(3)))
typedef unsigned short bf16;
typedef unsigned v4u __attribute__((ext_vector_type(4)));
typedef unsigned v2u __attribute__((ext_vector_type(2)));
typedef float f32x4 __attribute__((ext_vector_type(4)));
typedef float f32x16 __attribute__((ext_vector_type(16)));
typedef short bf16x8 __attribute__((ext_vector_type(8)));
typedef GAS unsigned gu32;
typedef LAS unsigned char* lptr;
#define RLX_AGENT __ATOMIC_RELAXED, __HIP_MEMORY_SCOPE_AGENT
#define LDS_WAIT() asm volatile("s_waitcnt lgkmcnt(0)" ::: "memory")
#define VM_WAIT() asm volatile("s_waitcnt vmcnt(0)" ::: "memory")
__device__ __forceinline__ unsigned f2bf(float f) { unsigned u = __builtin_bit_cast(unsigned, f); return (u + 0x7fffu + ((u >> 16) & 1u)) >> 16; }
typedef float f32x2_t __attribute__((ext_vector_type(2))); typedef __bf16 bf16x2_t __attribute__((ext_vector_type(2)));
__device__ __forceinline__ unsigned pk2(float lo, float hi) { f32x2_t v = {lo, hi}; bf16x2_t b = __builtin_convertvector(v, bf16x2_t); return __builtin_bit_cast(unsigned, b); }
__device__ __forceinline__ float bflo(unsigned w) { return __builtin_bit_cast(float, w << 16); }
__device__ __forceinline__ float bfhi(unsigned w) { return __builtin_bit_cast(float, w & 0xffff0000u); }
__device__ __forceinline__ float bf2f(bf16 v) { return __builtin_bit_cast(float, (unsigned)v << 16); }
__device__ __forceinline__ float lx_idx(float v, int src) { return __builtin_bit_cast(float, __builtin_amdgcn_ds_bpermute(src << 2, __builtin_bit_cast(int, v))); }
__device__ __forceinline__ float lx_xor(float v, int mask, int lane) { return lx_idx(v, lane ^ mask); }
__device__ __forceinline__ float lx_up(float v, int d, int lane) { return lx_idx(v, lane >= d ? lane - d : lane); }
__device__ __forceinline__ float wave_sum(float v, int lane) {
#pragma unroll
    for (int o = 1; o < 64; o <<= 1) v += lx_xor(v, o, lane);
    return v;
}
#define MFMA32(a, b, c) __builtin_amdgcn_mfma_f32_32x32x16_bf16((a), (b), (c), 0, 0, 0)
#define MFMA16(a, b, c) __builtin_amdgcn_mfma_f32_16x16x32_bf16((a), (b), (c), 0, 0, 0)
__device__ __forceinline__ int tid_opaque() { int t = threadIdx.x; asm volatile("" : "+v"(t)); return t; }
__device__ __forceinline__ bf16x8 lds8(lptr p) { return *(const LAS bf16x8*)p; }
__device__ __forceinline__ v4u gld16(const void* base, unsigned off) { return *(const v4u*)((const char*)base + off); }
__device__ __forceinline__ void gst8(void* base, unsigned off, v2u v) { *(v2u*)((char*)base + off) = v; }
typedef short v4i16 __attribute__((ext_vector_type(4)));
__device__ __forceinline__ bf16x8 opr(lptr img, int ldb, int r0, int k0, int c16, int rg) { return lds8(img + (r0 + c16) * ldb + (k0 + 8 * rg) * 2); }
__device__ __forceinline__ bf16x8 opt(lptr img, int ldb, int r0, int k0, int lane) {
    const int g = lane >> 4, q = (lane & 15) >> 2, p = lane & 3;
    lptr a = img + (k0 + 8 * g + q) * ldb + (r0 + 4 * p) * 2;
    const v4i16 lo = __builtin_amdgcn_ds_read_tr16_b64_v4i16((LAS v4i16*)a);
    const v4i16 hi = __builtin_amdgcn_ds_read_tr16_b64_v4i16((LAS v4i16*)(a + 4 * ldb));
    return __builtin_shufflevector(lo, hi, 0, 1, 2, 3, 4, 5, 6, 7);
}

#define XB_TMO      128
#define XB_XCNT(j)  (256  + 64 * (j))
#define XB_XSUB(j)  (1280 + 64 * (j))
#define XB_XGEN(j)  (2304 + 64 * (j))
#define XB_TOP      3328
#define XB_TOPGEN   3392
#define XCD_BAR_WORDS 3456
#define XB_SPIN_CAP (1u << 18)

__device__ __forceinline__ unsigned xb_ld(unsigned* p)              { return __hip_atomic_load(p, __ATOMIC_RELAXED, __HIP_MEMORY_SCOPE_AGENT); }
__device__ __forceinline__ unsigned xb_add(unsigned* p, unsigned v) { return __hip_atomic_fetch_add(p, v, __ATOMIC_RELAXED, __HIP_MEMORY_SCOPE_AGENT); }
__device__ __forceinline__ unsigned xb_xcc_id() { return (unsigned)__builtin_amdgcn_s_getreg((3 << 11) | 20) & 0xFu; }
#define XB_SPIN(cond, bar) do { unsigned _sp = 0; while (cond) { __builtin_amdgcn_s_sleep(1); \
    if ((++_sp & 255u) == 0u) { if (xb_ld(&(bar)[XB_TMO])) break; if (_sp > XB_SPIN_CAP) { atomicAdd(&(bar)[XB_TMO], 1u); break; } } } } while (0)

struct XcdBarrier {
    unsigned* bar; unsigned x;
    volatile LAS unsigned* st;
};

__device__ __forceinline__ XcdBarrier xcd_barrier_post(unsigned* bar, volatile LAS unsigned* st) {
    XcdBarrier b; b.bar = bar; b.x = xb_xcc_id(); b.st = st;
    if (threadIdx.x == 0) (void)xb_add(&bar[XB_XCNT(b.x)], 1u);
    return b;
}
__device__ __forceinline__ void xcd_barrier_complete(unsigned* bar, unsigned x, unsigned& nloc, unsigned& nx) {
    const unsigned G = gridDim.x * gridDim.y * gridDim.z;
    unsigned sum, cnt, mine, sp = 0u;
    for (;;) {
        sum = 0u; cnt = 0u; mine = 0u;
#pragma unroll
        for (unsigned j = 0; j < 16; ++j) { const unsigned c = xb_ld(&bar[XB_XCNT(j)]); sum += c; cnt += (c > 0u) ? 1u : 0u; mine = (j == x) ? c : mine; }
        if (sum == G) break;
        __builtin_amdgcn_s_sleep(1);
        if ((++sp & 255u) == 0u) { if (xb_ld(&bar[XB_TMO])) break; if (sp > XB_SPIN_CAP) { atomicAdd(&bar[XB_TMO], 1u); break; } }
    }
    nloc = mine > 0u ? mine : 1u; nx = cnt > 0u ? cnt : 1u;
}

__device__ __forceinline__ void xcd_barrier(const XcdBarrier& b) {
    asm volatile("s_waitcnt vmcnt(0)" ::: "memory");
    __syncthreads();
    if (threadIdx.x == 0) {
        unsigned* bar = b.bar;
        __builtin_amdgcn_s_waitcnt(0);
        unsigned nloc = b.st[0], nx = b.st[1];
        if (nloc == 0u) { xcd_barrier_complete(bar, b.x, nloc, nx); b.st[0] = nloc; b.st[1] = nx; }
        const unsigned old = xb_add(&bar[XB_XSUB(b.x)], 1u);
        const unsigned gen = old / nloc;
        if (old + 1u == (gen + 1u) * nloc) {
            __builtin_amdgcn_fence(__ATOMIC_RELEASE, "agent");
            asm volatile("s_waitcnt vmcnt(0)" ::: "memory");
            const unsigned og = xb_add(&bar[XB_TOP], 1u);
            const unsigned tg = og / nx;
            if (og + 1u == (tg + 1u) * nx) xb_add(&bar[XB_TOPGEN], 1u);
            else XB_SPIN(xb_ld(&bar[XB_TOPGEN]) == tg, bar);
            __builtin_amdgcn_fence(__ATOMIC_ACQUIRE, "agent");
            xb_add(&bar[XB_XGEN(b.x)], 1u);
            asm volatile("s_waitcnt vmcnt(0)" ::: "memory");
        } else {
            XB_SPIN(xb_ld(&bar[XB_XGEN(b.x)]) == gen, bar);
            __builtin_amdgcn_fence(__ATOMIC_ACQUIRE, "agent");
            asm volatile("s_waitcnt vmcnt(0)" ::: "memory");
        }
    }
    __syncthreads();
}


struct Args { const float* in[22]; float* out; unsigned char* ws; int ph_lo, ph_hi; };
enum { I_X = 0, I_C, I_CTX, I_CCTX, I_WADA, I_BADA, I_GPREMIX, I_GPOSTMIX, I_GPREFFN, I_GPOSTFFN, I_WIN, I_BIN, I_WOUT, I_MLFB, I_MLNORM, I_HGLB, I_HGNORM, I_DALAM, I_DANORM, I_WG, I_WU, I_WD };

__device__ __forceinline__ int wg_pull(unsigned* ctr, volatile LAS int* slot) {
    __syncthreads();
    if (threadIdx.x == 0) *slot = (int)__hip_atomic_fetch_add(ctr, 1u, RLX_AGENT);
    __syncthreads();
    return __builtin_amdgcn_readfirstlane(*slot);
}

typedef __attribute__((address_space(4))) const Args* kargs_p;
__device__ __forceinline__ void p0_phase(lptr lds, kargs_p ap) {
    struct { const float* in[22]; unsigned char* ws; } a; a.in[I_C] = ap->in[I_C]; a.in[I_CCTX] = ap->in[I_CCTX]; a.in[I_WADA] = ap->in[I_WADA]; a.in[I_BADA] = ap->in[I_BADA]; a.in[I_HGLB] = ap->in[I_HGLB]; a.in[I_BIN] = ap->in[I_BIN]; a.in[I_DALAM] = ap->in[I_DALAM]; a.ws = ap->ws;
    const int tid = tid_opaque();
    unsigned char* ws = a.ws;
    LAS float* sil = (LAS float*)lds;
    LAS float* part = (LAS float*)(lds + 69632);
    for (int i = tid; i < 17 * D; i += NTHR) { const int bb = i >> 10, k = i & 1023; const float v = bb < 16 ? a.in[I_C][bb * D + k] : a.in[I_CCTX][k]; sil[i] = v / (1.0f + __expf(-v)); }
    __syncthreads();
    float* mod = (float*)(ws + WS_MOD);
    for (int u = blockIdx.x; u < DEPTH * (NMOD / 32); u += gridDim.x) {
        const int l = u / (NMOD / 32), n0 = (u % (NMOD / 32)) * 32, col = tid & 31, ks = tid >> 5;
        const float* w = a.in[I_WADA] + (size_t)l * D * NMOD + (size_t)(ks * 64) * NMOD + n0 + col;
        float acc[17];
#pragma unroll
        for (int bb = 0; bb < 17; ++bb) acc[bb] = 0.f;
        for (int k = 0; k < 64; k += 4) {
            const float w0 = w[(size_t)k * NMOD], w1 = w[(size_t)(k + 1) * NMOD], w2 = w[(size_t)(k + 2) * NMOD], w3 = w[(size_t)(k + 3) * NMOD];
#pragma unroll
            for (int bb = 0; bb < 17; ++bb) { const f32x4 s = *(const LAS f32x4*)(sil + bb * D + ks * 64 + k); acc[bb] += s[0] * w0 + s[1] * w1 + s[2] * w2 + s[3] * w3; }
        }
#pragma unroll
        for (int bb = 0; bb < 17; ++bb) part[(ks * 17 + bb) * 32 + col] = acc[bb];
        __syncthreads();
        for (int i = tid; i < 17 * 32; i += NTHR) { const int bb = i >> 5, cc = i & 31; float s = 0.f;
#pragma unroll
            for (int k2 = 0; k2 < 16; ++k2) s += part[(k2 * 17 + bb) * 32 + cc];
            mod[((size_t)l * 17 + bb) * NMOD + n0 + cc] = s + a.in[I_BADA][l * NMOD + n0 + cc]; }
        __syncthreads();
    }
    const int gt = blockIdx.x * NTHR + tid, GT = gridDim.x * NTHR;
    float* lbs = (float*)(ws + WS_MISC); float* rope = (float*)(ws + WS_MISC + 16384); float* biasp = (float*)(ws + WS_MISC + 32768); float* lamv = (float*)(ws + WS_MISC + 114688);
    for (int j = gt; j < 1024; j += GT) { const float* hl = a.in[I_HGLB];
        const float v0 = hl[j], v1 = hl[1024 + j], v2 = hl[2048 + j], v3 = hl[3072 + j]; const float mx = fmaxf(fmaxf(v0, v1), fmaxf(v2, v3));
        const float e0 = expf(v0 - mx), e1 = expf(v1 - mx), e2 = expf(v2 - mx), e3 = expf(v3 - mx), inv = 1.0f / (e0 + e1 + e2 + e3);
        lbs[j] = 0.f; lbs[1024 + j] = e1 * inv; lbs[2048 + j] = (e1 + e2) * inv; lbs[3072 + j] = (e1 + e2 + e3) * inv; }
    for (int j = gt; j < 64 * 12; j += GT) { const int pos = j / 12, i = j % 12; const float inv = powf(10000.0f, -(float)(2 * i) / 24.0f); const float ang = (float)pos * inv; rope[2 * j] = cosf(ang); rope[2 * j + 1] = sinf(ang); }
    for (int j = gt; j < DEPTH * DINP; j += GT) { const int l = j / DINP, n = j % DINP; biasp[j] = n < DIN ? a.in[I_BIN][l * DIN + n] : 0.f; }
    if (gt < DEPTH) { const float* lv = a.in[I_DALAM] + gt * 4 * 48; float s01 = 0.f, s23 = 0.f;
        for (int d = 0; d < 48; ++d) { s01 += lv[d] * lv[48 + d]; s23 += lv[96 + d] * lv[144 + d]; }
        const float lam_init = 0.8f - 0.6f * expf(-0.3f * (float)gt);
        lamv[gt] = expf(s01) - expf(s23) + lam_init; }
}

template <bool RES, bool NORM>
__device__ __forceinline__ void thin_phase(int row_lo, const float* xs_lat, const float* xs_ctx, float* xd_lat, float* xd_ctx, bool write_x,
                                           const bf16* y, const float* mod_r, int goff, const float* gpost,
                                           const float* mod_n, int soff, int aoff, const float* gpre, bf16* hout, int vcu, int G, int probe = 0) {
    const int tid = tid_opaque(); const int lane = tid & 63, wave = __builtin_amdgcn_readfirstlane(tid >> 6);
    const int nrows = MT - row_lo; int rwg = (nrows + G - 1) / G; rwg += rwg & 1;
    const int wbeg = row_lo + vcu * rwg, rend = (wbeg + rwg < MT) ? wbeg + rwg : MT;
    const int rbeg = wbeg + 2 * wave;
    constexpr int RSTEP = 2 * NWAVES;
    int cur_bb = -1;
    f32x4 gp[4], ga[4], sh[4];
#pragma unroll
    for (int j = 0; j < 4; ++j) { gp[j] = (f32x4){0.f, 0.f, 0.f, 0.f}; ga[j] = gp[j]; sh[j] = gp[j]; }
    f32x4 xa[2][4], ya[2][4];
#define TH_LOAD(X, Y, r_) do { _Pragma("unroll") for (int q_ = 0; q_ < 2; ++q_) { const int rr_ = (r_) + q_; const bool ic_ = rr_ < MC; \
        const float* xs_ = ic_ ? xs_ctx + (size_t)rr_ * D : xs_lat + (size_t)(rr_ - MC) * D; \
        _Pragma("unroll") for (int j_ = 0; j_ < 4; ++j_) { X[q_][j_] = *(const f32x4*)(xs_ + 4 * lane + 256 * j_); if (RES) { const v2u yw_ = *(const v2u*)(y + (size_t)rr_ * D + 4 * lane + 256 * j_); Y[q_][j_] = (f32x4){bflo(yw_.x), bfhi(yw_.x), bflo(yw_.y), bfhi(yw_.y)}; } } } } while (0)
    if (rbeg < rend) TH_LOAD(xa, ya, rbeg);
    for (int r = rbeg; r < rend; r += RSTEP) {
        f32x4 xb[2][4], yb[2][4];
        if (r + RSTEP < rend) TH_LOAD(xb, yb, r + RSTEP);
        const bool isctx = r < MC; const int bb = isctx ? 16 : (r - MC) / SEQ;
        if (bb != cur_bb) { cur_bb = bb;
#pragma unroll
            for (int j = 0; j < 4; ++j) { const int e = 4 * lane + 256 * j;
                if (RES) gp[j] = *(const f32x4*)(mod_r + (size_t)bb * NMOD + goff + e) * *(const f32x4*)(gpost + e);
                if (NORM) { ga[j] = *(const f32x4*)(gpre + e) * (*(const f32x4*)(mod_n + (size_t)bb * NMOD + aoff + e) + 1.0f); sh[j] = *(const f32x4*)(mod_n + (size_t)bb * NMOD + soff + e); } } }
        if (RES) { float s0 = 0.f, s1 = 0.f;
#pragma unroll
            for (int j = 0; j < 4; ++j) { s0 += (ya[0][j][0] * ya[0][j][0] + ya[0][j][1] * ya[0][j][1]) + (ya[0][j][2] * ya[0][j][2] + ya[0][j][3] * ya[0][j][3]);
                                          s1 += (ya[1][j][0] * ya[1][j][0] + ya[1][j][1] * ya[1][j][1]) + (ya[1][j][2] * ya[1][j][2] + ya[1][j][3] * ya[1][j][3]); }
#pragma unroll
            for (int o = 1; o < 64; o <<= 1) { s0 += lx_xor(s0, o, lane); s1 += lx_xor(s1, o, lane); }
            const float r0s = 1.0f / sqrtf(s0 * (1.0f / D) + EPS), r1s = 1.0f / sqrtf(s1 * (1.0f / D) + EPS);
#pragma unroll
            for (int j = 0; j < 4; ++j) { xa[0][j] += gp[j] * ya[0][j] * r0s; xa[1][j] += gp[j] * ya[1][j] * r1s; } }
        float* xd0 = isctx ? xd_ctx + (size_t)r * D : xd_lat + (size_t)(r - MC) * D;
        if (write_x && !(probe & 1)) {
#pragma unroll
            for (int j = 0; j < 4; ++j) { *(f32x4*)(xd0 + 4 * lane + 256 * j) = xa[0][j]; *(f32x4*)(xd0 + D + 4 * lane + 256 * j) = xa[1][j]; } }
        if (NORM) { float s0 = 0.f, s1 = 0.f;
#pragma unroll
            for (int j = 0; j < 4; ++j) { s0 += (xa[0][j][0] * xa[0][j][0] + xa[0][j][1] * xa[0][j][1]) + (xa[0][j][2] * xa[0][j][2] + xa[0][j][3] * xa[0][j][3]);
                                          s1 += (xa[1][j][0] * xa[1][j][0] + xa[1][j][1] * xa[1][j][1]) + (xa[1][j][2] * xa[1][j][2] + xa[1][j][3] * xa[1][j][3]); }
#pragma unroll
            for (int o = 1; o < 64; o <<= 1) { s0 += lx_xor(s0, o, lane); s1 += lx_xor(s1, o, lane); }
            const float r0s = 1.0f / sqrtf(s0 * (1.0f / D) + EPS), r1s = 1.0f / sqrtf(s1 * (1.0f / D) + EPS);
#pragma unroll
            for (int j = 0; j < 4; ++j) { const f32x4 h0 = xa[0][j] * r0s * ga[j] + sh[j], h1 = xa[1][j] * r1s * ga[j] + sh[j];
                v2u w0, w1; w0.x = pk2(h0[0], h0[1]); w0.y = pk2(h0[2], h0[3]); w1.x = pk2(h1[0], h1[1]); w1.y = pk2(h1[2], h1[3]);
                if (!(probe & 2)) { *(v2u*)(hout + (size_t)r * D + 4 * lane + 256 * j) = w0; *(v2u*)(hout + (size_t)(r + 1) * D + 4 * lane + 256 * j) = w1; } } }
#pragma unroll
        for (int q = 0; q < 2; ++q)
#pragma unroll
            for (int j = 0; j < 4; ++j) { xa[q][j] = xb[q][j]; if (RES) ya[q][j] = yb[q][j]; }
    }
#undef TH_LOAD
}

template <int MODE>
__device__ __forceinline__ void tr_item(const float* W, int K, int N, int nblk, bf16* WT, LAS float* scr, int item, int lane) {
    const int kb = item / nblk, nb = item % nblk, k0 = 64 * kb, n0 = 32 * nb;
    const int nn = n0 + (lane & 31); const bool ok = nn < N;
#pragma unroll 8
    for (int i = 0; i < 32; ++i) { const int kk = 2 * i + (lane >> 5); scr[kk * 33 + (lane & 31)] = ok ? W[(size_t)(k0 + kk) * N + nn] : 0.f; }
    LDS_WAIT(); asm volatile("" ::: "memory");
    const int c = lane & 7;
#pragma unroll
    for (int j = 0; j < 4; ++j) { const int n = (lane >> 3) + 8 * j; const LAS float* s = scr + (8 * c) * 33 + n;
        v4u o; o.x = pk2(s[0 * 33], s[1 * 33]); o.y = pk2(s[2 * 33], s[3 * 33]); o.z = pk2(s[4 * 33], s[5 * 33]); o.w = pk2(s[6 * 33], s[7 * 33]);
        const int ng = n0 + n; const int drow = MODE == 0 ? ng : ((ng >> 7) * 256 + (ng & 127) + (MODE == 2 ? 128 : 0));
        *(v4u*)(WT + (size_t)drow * K + k0 + 8 * c) = o; }
    LDS_WAIT(); asm volatile("" ::: "memory");
}
__device__ __forceinline__ void convert_weights(lptr lds, kargs_p ap, int l, int vcu, int G) {
    const unsigned char* const wsb = ap->ws; const float* const p_win = ap->in[I_WIN]; const float* const p_wout = ap->in[I_WOUT]; const float* const p_wg = ap->in[I_WG]; const float* const p_wu = ap->in[I_WU]; const float* const p_wd = ap->in[I_WD];
    const int tid = tid_opaque(); const int lane = tid & 63, wave = __builtin_amdgcn_readfirstlane(tid >> 6);
    LAS float* scr = (LAS float*)(lds + wave * 8448);
    const int gw = vcu * NWAVES + wave, NGW = G * NWAVES;
    unsigned char* ws = (unsigned char*)wsb;
    constexpr int I_IN = 16 * (DINP / 32), I_OUT = 16 * 32, I_GU = 16 * (DFF / 32), I_DN = (DFF / 64) * 32;
    constexpr int NITEMS = I_IN + I_OUT + 2 * I_GU + I_DN;
    for (int it = gw; it < NITEMS; it += NGW) {
        int r = it;
        if (r < I_IN) { tr_item<0>(p_win + (size_t)l * D * DIN, D, DIN, DINP / 32, (bf16*)(ws + WS_WIN), scr, r, lane); continue; } r -= I_IN;
        if (r < I_OUT) { tr_item<0>(p_wout + (size_t)l * D * D, D, D, 32, (bf16*)(ws + WS_WOUT), scr, r, lane); continue; } r -= I_OUT;
        if (r < I_GU) { tr_item<1>(p_wg + (size_t)l * D * DFF, D, DFF, DFF / 32, (bf16*)(ws + WS_WGU), scr, r, lane); continue; } r -= I_GU;
        if (r < I_GU) { tr_item<2>(p_wu + (size_t)l * D * DFF, D, DFF, DFF / 32, (bf16*)(ws + WS_WGU), scr, r, lane); continue; } r -= I_GU;
        tr_item<0>(p_wd + (size_t)l * DFF * D, DFF, D, 32, (bf16*)(ws + WS_WD), scr, r, lane);
    }
}
constexpr int AT_Q = 0, AT_K0 = 53248, AT_KB = 13312, AT_V0 = 79872, AT_VB = 12288, AT_ROPE = 107520;
constexpr float AT_THR = 8.0f;
constexpr float QSCALE = 0.14433756729740643f * 1.4426950408889634f;

__device__ __forceinline__ void rope24(const v4u (&in)[3], v4u (&out)[3], bool rot, const LAS float* tab, float scale) {
    float v[24];
#pragma unroll
    for (int i = 0; i < 3; ++i) { v[8 * i + 0] = bflo(in[i].x); v[8 * i + 1] = bfhi(in[i].x); v[8 * i + 2] = bflo(in[i].y); v[8 * i + 3] = bfhi(in[i].y);
                                  v[8 * i + 4] = bflo(in[i].z); v[8 * i + 5] = bfhi(in[i].z); v[8 * i + 6] = bflo(in[i].w); v[8 * i + 7] = bfhi(in[i].w); }
    if (rot) {
#pragma unroll
        for (int i = 0; i < 12; ++i) { const float c = tab[2 * i], s = tab[2 * i + 1]; const float x1 = v[i], x2 = v[12 + i]; v[i] = x1 * c - x2 * s; v[12 + i] = x1 * s + x2 * c; } }
#pragma unroll
    for (int i = 0; i < 3; ++i) { out[i].x = pk2(v[8 * i + 0] * scale, v[8 * i + 1] * scale); out[i].y = pk2(v[8 * i + 2] * scale, v[8 * i + 3] * scale);
                                  out[i].z = pk2(v[8 * i + 4] * scale, v[8 * i + 5] * scale); out[i].w = pk2(v[8 * i + 6] * scale, v[8 * i + 7] * scale); }
}
__device__ __forceinline__ float sm_max(const f32x16& S, int lane) {
    float mx = S[0];
#pragma unroll
    for (int r = 1; r < 16; ++r) mx = fmaxf(mx, S[r]);
    return fmaxf(mx, lx_xor(mx, 32, lane));
}
__device__ __forceinline__ void sm_exp(const f32x16& S, float m, float& l, bf16x8& p0, bf16x8& p1) {
    float p[16]; float ps = 0.f;
#pragma unroll
    for (int r = 0; r < 16; ++r) { p[r] = __builtin_amdgcn_exp2f(S[r] - m); ps += p[r]; }
    l += ps;
    v4u a, b;
    a.x = pk2(p[0], p[1]); a.y = pk2(p[2], p[3]); a.z = pk2(p[4], p[5]); a.w = pk2(p[6], p[7]);
    b.x = pk2(p[8], p[9]); b.y = pk2(p[10], p[11]); b.z = pk2(p[12], p[13]); b.w = pk2(p[14], p[15]);
    p0 = __builtin_bit_cast(bf16x8, a); p1 = __builtin_bit_cast(bf16x8, b);
}
__device__ __forceinline__ bf16x8 vt_frag(lptr vt, int ct, int sub, int sp, int lane) {
    const int h = lane >> 5, blk = (lane >> 4) & 1, q = (lane & 15) >> 2, p = lane & 3;
    lptr a = vt + (32 * sub + 16 * sp + 4 * h + q) * 192 + (32 * ct + 16 * blk + 4 * p) * 2;
    const v4i16 lo = __builtin_amdgcn_ds_read_tr16_b64_v4i16((LAS v4i16*)a);
    const v4i16 hi = __builtin_amdgcn_ds_read_tr16_b64_v4i16((LAS v4i16*)(a + 8 * 192));
    return __builtin_shufflevector(lo, hi, 0, 1, 2, 3, 4, 5, 6, 7);
}

__device__ __forceinline__ void attn_item(lptr lds, const bf16* P, bf16* YM, const float* rope_g, const float* danorm, float lam, float out_scale, int b, int h, int qb, int probe) {
    const int tid = tid_opaque(), lane = tid & 63, r32 = lane & 31, hi = lane >> 5, wave = __builtin_amdgcn_readfirstlane(tid >> 6);
    const bool lat = qb < 8;
    const int qrow0 = lat ? MC + b * SEQ + qb * 256 : b * CTXL;
    const int nt = lat ? 36 : 4;
    LAS float* ropeL = (LAS float*)(lds + AT_ROPE);
    for (int i = tid; i < 64 * 24; i += NTHR) ropeL[i] = rope_g[i];
    __syncthreads();
    for (int it = tid; it < 1024; it += NTHR) {
        const int row = it >> 2, map = (it >> 1) & 1, half = it & 1;
        const unsigned so = (unsigned)(qrow0 + row) * (unsigned)(DINP * 2) + (unsigned)(C_DAQ + h * 96 + map * 48 + half * 24) * 2u;
        v4u in[3], out[3];
#pragma unroll
        for (int i = 0; i < 3; ++i) in[i] = gld16(P, so + 16u * i);
        const int t = qb * 256 + row; const int pos = half ? (t & 63) : (t >> 6);
        rope24(in, out, lat, ropeL + (lat ? pos : 0) * 24, QSCALE);
        lptr dst = lds + AT_Q + (row * 104 + map * 48 + half * 24) * 2;
#pragma unroll
        for (int i = 0; i < 3; ++i) *(LAS v4u*)(dst + 16 * i) = out[i];
    }
    v4u kin[3], vin[2];
    const int kkey = tid >> 2, kmap = (tid >> 1) & 1, khalf = tid & 1;
    const int vkey0 = tid / 12, vcc0 = tid % 12, vkey1 = (tid + 512) / 12, vcc1 = (tid + 512) % 12;
#define AT_TILE_ROW0(tile) (((tile) < 4) ? (b * CTXL + 64 * (tile)) : (MC + b * SEQ + 64 * ((tile) - 4)))
#define AT_LOAD(tile) do { const int row0_ = AT_TILE_ROW0(tile); \
        if (tid < 256) { const unsigned s_ = (unsigned)(row0_ + kkey) * (unsigned)(DINP * 2) + (unsigned)(C_DAK + h * 96 + kmap * 48 + khalf * 24) * 2u; kin[0] = gld16(P, s_); kin[1] = gld16(P, s_ + 16u); kin[2] = gld16(P, s_ + 32u); \
                         vin[1] = gld16(P, (unsigned)(row0_ + vkey1) * (unsigned)(DINP * 2) + (unsigned)(C_DAV + h * 96 + vcc1 * 8) * 2u); } \
        vin[0] = gld16(P, (unsigned)(row0_ + vkey0) * (unsigned)(DINP * 2) + (unsigned)(C_DAV + h * 96 + vcc0 * 8) * 2u); } while (0)
#define AT_VPUT(vt, key, cc, VV) do { *(LAS v4u*)((vt) + (key) * 192 + (cc) * 16) = (VV); } while (0)
#define AT_STORE(tile, buf) do { const bool krot_ = (tile) >= 4; \
        if (tid < 256) { const int t_ = 64 * ((tile) - 4) + kkey; const int pos_k = khalf ? (t_ & 63) : (t_ >> 6); v4u o_[3]; rope24(kin, o_, krot_, ropeL + (krot_ ? pos_k : 0) * 24, 1.0f); \
                         lptr d_k = lds + AT_K0 + (buf) * AT_KB + (kkey * 104 + kmap * 48 + khalf * 24) * 2; *(LAS v4u*)d_k = o_[0]; *(LAS v4u*)(d_k + 16) = o_[1]; *(LAS v4u*)(d_k + 32) = o_[2]; \
                         AT_VPUT(lds + AT_V0 + (buf) * AT_VB, vkey1, vcc1, vin[1]); } \
        AT_VPUT(lds + AT_V0 + (buf) * AT_VB, vkey0, vcc0, vin[0]); } while (0)
    AT_LOAD(0); AT_STORE(0, 0);
    __syncthreads();
    bf16x8 qf[2][3];
#pragma unroll
    for (int map = 0; map < 2; ++map)
#pragma unroll
        for (int ks = 0; ks < 3; ++ks) qf[map][ks] = lds8(lds + AT_Q + ((wave * 32 + r32) * 104 + map * 48 + ks * 16 + hi * 8) * 2);
    f32x16 O0[3], O1[3];
#pragma unroll
    for (int ct = 0; ct < 3; ++ct)
#pragma unroll
        for (int r = 0; r < 16; ++r) { O0[ct][r] = 0.f; O1[ct][r] = 0.f; }
    float m0 = -1e30f, m1 = -1e30f, l0 = 0.f, l1 = 0.f;
    for (int i = 0; i < nt; ++i) {
        const int cur = i & 1;
        if (i + 1 < nt && !(probe & 1)) AT_LOAD(i + 1);
        lptr ks_ = lds + AT_K0 + cur * AT_KB, vt_ = lds + AT_V0 + cur * AT_VB;
#pragma unroll 1
        for (int sub = 0; sub < 2; ++sub) {
            f32x16 S0, S1;
#pragma unroll
            for (int r = 0; r < 16; ++r) { S0[r] = 0.f; S1[r] = 0.f; }
#pragma unroll
            for (int ks = 0; ks < 3; ++ks) {
                const bf16x8 k0 = lds8(ks_ + ((sub * 32 + r32) * 104 + ks * 16 + hi * 8) * 2);
                const bf16x8 k1 = lds8(ks_ + ((sub * 32 + r32) * 104 + 48 + ks * 16 + hi * 8) * 2);
                S0 = MFMA32(k0, qf[0][ks], S0); S1 = MFMA32(k1, qf[1][ks], S1);
            }
            const float mx0 = sm_max(S0, lane), mx1 = sm_max(S1, lane);
            if (__any((mx0 > m0 + AT_THR) || (mx1 > m1 + AT_THR))) {
                const float n0 = fmaxf(m0, mx0), n1 = fmaxf(m1, mx1);
                const float a0 = __builtin_amdgcn_exp2f(m0 - n0), a1 = __builtin_amdgcn_exp2f(m1 - n1);
                m0 = n0; m1 = n1; l0 *= a0; l1 *= a1;
#pragma unroll
                for (int ct = 0; ct < 3; ++ct)
#pragma unroll
                    for (int r = 0; r < 16; ++r) { O0[ct][r] *= a0; O1[ct][r] *= a1; }
            }
            bf16x8 p00, p01, p10, p11;
            sm_exp(S0, m0, l0, p00, p01);
            sm_exp(S1, m1, l1, p10, p11);
#pragma unroll
            for (int ct = 0; ct < 3; ++ct) {
                const bf16x8 v0 = vt_frag(vt_, ct, sub, 0, lane);
                const bf16x8 v1 = vt_frag(vt_, ct, sub, 1, lane);
                O0[ct] = MFMA32(v0, p00, O0[ct]); O1[ct] = MFMA32(v0, p10, O1[ct]);
                O0[ct] = MFMA32(v1, p01, O0[ct]); O1[ct] = MFMA32(v1, p11, O1[ct]);
            }
        }
        if (i + 1 < nt && !(probe & 2)) AT_STORE(i + 1, cur ^ 1);
        __syncthreads();
    }
#undef AT_TILE_ROW0
#undef AT_LOAD
#undef AT_VPUT
#undef AT_STORE
    const float i0 = 1.0f / (l0 + lx_xor(l0, 32, lane)), i1 = lam / (l1 + lx_xor(l1, 32, lane));
    float ss = 0.f;
#pragma unroll
    for (int ct = 0; ct < 3; ++ct)
#pragma unroll
        for (int r = 0; r < 16; ++r) { const float o = O0[ct][r] * i0 - O1[ct][r] * i1; O0[ct][r] = o; ss += o * o; }
    ss += lx_xor(ss, 32, lane);
    const float rs = out_scale / sqrtf(ss * (1.0f / 96.0f) + EPS);
    const unsigned oro = ((unsigned)(qrow0 + wave * 32 + r32) * (unsigned)D + (unsigned)(Y_DA + h * 96)) * 2u;
#pragma unroll
    for (int ct = 0; ct < 3; ++ct)
#pragma unroll
        for (int g = 0; g < 4; ++g) { const int c0 = 32 * ct + 8 * g + 4 * hi; const f32x4 gn = *(const f32x4*)(danorm + c0);
            v2u w; w.x = pk2(O0[ct][4 * g] * rs * gn[0], O0[ct][4 * g + 1] * rs * gn[1]); w.y = pk2(O0[ct][4 * g + 2] * rs * gn[2], O0[ct][4 * g + 3] * rs * gn[3]);
            gst8(YM, oro + 2u * c0, w); }
}
__device__ __forceinline__ int scan_row(int b, int dir, int p) {
    if (p < CTXL) { const int t = dir ? CTXL - 1 - p : p; return b * CTXL + t; }
    const int pl = p - CTXL; const int t = dir ? SEQ - 1 - pl : pl; return MC + b * SEQ + t;
}

constexpr int ML_Q = 0, ML_K = 13312, ML_KW = 26624, ML_VA = 40960, ML_QKM = 55296, ML_ST = 64512, ML_GF = 87808;
constexpr int ML_LDQ = 208, ML_LDW = 224, ML_LDM = 144, ML_LDS = 208;
constexpr float KSCALE = 0.10206207261596577f;

__device__ __forceinline__ void mlstm_stream(lptr lds, const bf16* P, const float* G, bf16* dst, int dst_ld, const float* fbias  , int b, int h, int dir) {
    const int tid = tid_opaque(), lane = tid & 63, c16 = lane & 15, rg = lane >> 4, wave = __builtin_amdgcn_readfirstlane(tid >> 6);
    lptr Qs = lds + ML_Q, Ks = lds + ML_K, Kw = lds + ML_KW, Va = lds + ML_VA, QKM = lds + ML_QKM, ST = lds + ML_ST;
    LAS float* gA = (LAS float*)(lds + ML_GF); LAS float* MxA = gA + 64; LAS float* wA = gA + 128; LAS float* emtA = gA + 192; LAS float* wkA = gA + 256; LAS float* scal = gA + 320;
    if (tid < 128) { const int t = tid >> 1, hh = tid & 1; v4u w; w.x = hh ? 0u : 0x3F80u; w.y = 0u; w.z = 0u; w.w = 0u; *(LAS v4u*)(Va + t * ML_LDW + (96 + 8 * hh) * 2) = w; }
    const float fb = fbias[dir * 4 + h];
    f32x4 acc[11];
#pragma unroll
    for (int i = 0; i < 11; ++i) acc[i] = (f32x4){0.f, 0.f, 0.f, 0.f};
    float m_prev = -1e30f;
    v4u pre[5]; float gi = 0.f, gf = 0.f;
#define ML_PREFETCH(c) do { \
    _Pragma("unroll") for (int i_ = 0; i_ < 5; ++i_) { const int id_ = tid + NTHR * i_; if (id_ < 2304) { const int t_ = id_ / 36, r_ = id_ % 36, wh_ = r_ / 12, cc_ = r_ % 12; \
        const unsigned ro_ = (unsigned)scan_row(b, dir, 64 * (c) + t_) * (unsigned)(DINP * 2); pre[i_] = gld16(P, ro_ + (unsigned)(wh_ * 384 + h * 96 + cc_ * 8) * 2u); } } \
    if (wave == 0) { const unsigned go_ = (unsigned)scan_row(b, dir, 64 * (c) + lane) * 64u + (unsigned)(dir * 4 + h) * 4u; gi = *(const float*)((const char*)G + go_); gf = *(const float*)((const char*)G + go_ + 32u); } } while (0)
    ML_PREFETCH(0);
    for (int c = 0; c < NTOK / 64; ++c) {
#pragma unroll
        for (int i = 0; i < 5; ++i) { const int id = tid + NTHR * i; if (id < 2304) { const int t = id / 36, r = id % 36, wh = r / 12, cc = r % 12;
            lptr d = (wh == 0) ? Qs + t * ML_LDQ : (wh == 1) ? Ks + t * ML_LDQ : Va + t * ML_LDW;
            *(LAS v4u*)(d + cc * 16) = pre[i]; } }
        if (wave == 0) {
            const float fp = gf + fb;
            const float lf = fminf(fp, 0.f) - log1pf(__expf(-fabsf(fp)));
            float bs = lf;
#pragma unroll
            for (int o = 1; o < 64; o <<= 1) { const float v = lx_up(bs, o, lane); if (lane >= o) bs += v; }
            const float g = gi - bs;
            float cm = g;
#pragma unroll
            for (int o = 1; o < 64; o <<= 1) { const float v = lx_up(cm, o, lane); if (lane >= o) cm = fmaxf(cm, v); }
            const float Mx = fmaxf(m_prev, cm);
            const float mt = bs + Mx;
            const float blast = lx_idx(bs, 63), m_new = lx_idx(mt, 63);
            gA[lane] = g; MxA[lane] = Mx; wA[lane] = __expf(m_prev - Mx); emtA[lane] = __expf(-mt); wkA[lane] = __expf(g + blast - m_new) * KSCALE;
            if (lane == 0) scal[0] = __expf(blast + m_prev - m_new);
            m_prev = m_new;
        }
        if (c + 1 < NTOK / 64) ML_PREFETCH(c + 1);
        __syncthreads();
#pragma unroll
        for (int j = 0; j < 2; ++j) { const int idx = 2 * wave + j, si = idx & 3, ti = idx >> 2;
            f32x4 a4 = (f32x4){0.f, 0.f, 0.f, 0.f};
            if (si <= ti) {
#pragma unroll
                for (int ks = 0; ks < 3; ++ks) a4 = MFMA16(opr(Ks, ML_LDQ, 16 * si, 32 * ks, c16, rg), opr(Qs, ML_LDQ, 16 * ti, 32 * ks, c16, rg), a4);
            }
            const int t = 16 * ti + c16, s0 = 16 * si + 4 * rg; const float mxt = MxA[t]; const f32x4 g4 = *(const LAS f32x4*)(gA + s0);
            float v[4];
#pragma unroll
            for (int r = 0; r < 4; ++r) v[r] = (s0 + r <= t) ? a4[r] * KSCALE * __expf(g4[r] - mxt) : 0.f;
            v2u w; w.x = pk2(v[0], v[1]); w.y = pk2(v[2], v[3]); *(LAS v2u*)(QKM + t * ML_LDM + s0 * 2) = w; }
        for (int id = tid; id < 64 * 12; id += NTHR) { const int t = id / 12, cc = id % 12; const v4u w = *(const LAS v4u*)(Ks + t * ML_LDQ + cc * 16); const float sc = wkA[t];
            v4u o; o.x = pk2(bflo(w.x) * sc, bfhi(w.x) * sc); o.y = pk2(bflo(w.y) * sc, bfhi(w.y) * sc); o.z = pk2(bflo(w.z) * sc, bfhi(w.z) * sc); o.w = pk2(bflo(w.w) * sc, bfhi(w.w) * sc);
            *(LAS v4u*)(Kw + t * ML_LDW + cc * 16) = o; }
        if (wave >= 4) { const int sw = wave - 4;
#pragma unroll
            for (int i = 0; i < 11; ++i) { const int j = sw + 4 * i; if (j < 42) { const int di = j / 7, vi = j % 7;
                v2u w; w.x = pk2(acc[i][0], acc[i][1]); w.y = pk2(acc[i][2], acc[i][3]); *(LAS v2u*)(ST + (16 * vi + c16) * ML_LDS + (16 * di + 4 * rg) * 2) = w; } } }
        __syncthreads();
        if (wave < 4) {
            const int ti = wave, t = 16 * ti + c16;
            f32x4 aX[7];
#pragma unroll
            for (int vi = 0; vi < 7; ++vi) aX[vi] = (f32x4){0.f, 0.f, 0.f, 0.f};
#pragma unroll
            for (int ks = 0; ks < 3; ++ks) { const bf16x8 b8 = opr(Qs, ML_LDQ, 16 * ti, 32 * ks, c16, rg);
#pragma unroll
                for (int vi = 0; vi < 7; ++vi) aX[vi] = MFMA16(opr(ST, ML_LDS, 16 * vi, 32 * ks, c16, rg), b8, aX[vi]); }
            { const float wt = wA[t];
#pragma unroll
              for (int vi = 0; vi < 7; ++vi) aX[vi] = aX[vi] * wt; }
#pragma unroll
            for (int ks = 0; ks < 2; ++ks) { const bf16x8 b8 = opr(QKM, ML_LDM, 16 * ti, 32 * ks, c16, rg);
#pragma unroll
                for (int vi = 0; vi < 7; ++vi) aX[vi] = MFMA16(opt(Va, ML_LDW, 16 * vi, 32 * ks, lane), b8, aX[vi]); }
            const float den = lx_idx(aX[6][0], c16);
            const float inv = 1.0f / fmaxf(fabsf(den), emtA[t]);
            const int row = scan_row(b, dir, 64 * c + t);
            const unsigned oo = ((unsigned)row * (unsigned)dst_ld + (unsigned)(h * 96 + 4 * rg)) * 2u;
#pragma unroll
            for (int vi = 0; vi < 6; ++vi) { v2u w; w.x = pk2(aX[vi][0] * inv, aX[vi][1] * inv); w.y = pk2(aX[vi][2] * inv, aX[vi][3] * inv); gst8(dst, oo + 32u * vi, w); }
        } else {
            const int sw = wave - 4; const float decay = scal[0];
#pragma unroll
            for (int i = 0; i < 11; ++i) { const int j = sw + 4 * i; if (j < 42) { const int di = j / 7, vi = j % 7;
                acc[i] = acc[i] * decay;
#pragma unroll
                for (int ks = 0; ks < 2; ++ks) acc[i] = MFMA16(opt(Kw, ML_LDW, 16 * di, 32 * ks, lane), opt(Va, ML_LDW, 16 * vi, 32 * ks, lane), acc[i]); } }
        }
        __syncthreads();
    }
#undef ML_PREFETCH
}

constexpr int HG_QT = 0, HG_KR = 8704, HG_V = 17920, HG_ATT = 23040, HG_SPT = 25600, HG_ER = 43008, HG_TOT = 43520;
constexpr int HG_LDQ = 272, HG_LDK = 288, HG_LDV = 160, HG_LDA = 80, HG_LDS = 272;

__device__ __forceinline__ void hgrn2_stream(lptr lds, const bf16* P, bf16* dst, int dst_ld, const float* lbl  , int b, int h, int dir) {
    const int tid = tid_opaque(), lane = tid & 63, c16 = lane & 15, rg = lane >> 4, wave = __builtin_amdgcn_readfirstlane(tid >> 6);
    lptr QT = lds + HG_QT, KR = lds + HG_KR, Vs = lds + HG_V, ATT = lds + HG_ATT, SPT = lds + HG_SPT;
    LAS float* ER = (LAS float*)(lds + HG_ER); LAS float* TOT = (LAS float*)(lds + HG_TOT);
    const int tt = tid >> 4, kc = tid & 15;
    const int tv = tid >> 3, cv = tid & 7;
    float lb[8];
    { const f32x4 l0 = *(const f32x4*)(lbl + dir * 512 + h * 128 + 8 * kc), l1 = *(const f32x4*)(lbl + dir * 512 + h * 128 + 8 * kc + 4);
#pragma unroll
      for (int j = 0; j < 4; ++j) { lb[j] = l0[j]; lb[4 + j] = l1[j]; } }
    f32x4 acc[4];
#pragma unroll
    for (int i = 0; i < 4; ++i) acc[i] = (f32x4){0.f, 0.f, 0.f, 0.f};
    v4u zr, qr, vr;
#define HG_PREFETCH(c) do { { const unsigned ro_ = (unsigned)scan_row(b, dir, 32 * (c) + tt) * (unsigned)(DINP * 2) + 16u * kc; \
        zr = gld16(P, ro_ + (unsigned)(C_HGF + dir * 512 + h * 128) * 2u); qr = gld16(P, ro_ + (unsigned)(C_HGQ + h * 128) * 2u); } \
        if (tid < 256) { const unsigned ro_ = (unsigned)scan_row(b, dir, 32 * (c) + tv) * (unsigned)(DINP * 2) + 16u * cv; vr = gld16(P, ro_ + (unsigned)(C_HGI + h * 64) * 2u); } } while (0)
    HG_PREFETCH(0);
    for (int c = 0; c < NTOK / 32; ++c) {
        float kk[8], cs[8], qv[8];
        { const unsigned zw[4] = {zr.x, zr.y, zr.z, zr.w}, qw[4] = {qr.x, qr.y, qr.z, qr.w};
#pragma unroll
          for (int j = 0; j < 8; ++j) { const float z = (j & 1) ? bfhi(zw[j >> 1]) : bflo(zw[j >> 1]); qv[j] = (j & 1) ? bfhi(qw[j >> 1]) : bflo(qw[j >> 1]);
              const float e = __expf(-fabsf(z)); const float inv = __builtin_amdgcn_rcpf(1.0f + e);
              const float sig = z >= 0.f ? inv : e * inv, nsig = z >= 0.f ? e * inv : inv;
              const float oml = 1.0f - lb[j]; const float f = fmaxf(lb[j], 1e-30f) + oml * sig; kk[j] = oml * nsig;
              float x = __log2f(f);
              float y = lx_up(x, 16, lane); if (lane >= 16) x += y;
              y = lx_up(x, 32, lane); if (lane >= 32) x += y;
              cs[j] = x; } }
        if (tid < 256) *(LAS v4u*)(Vs + tv * HG_LDV + cv * 16) = vr;
        if (lane >= 48) { *(LAS f32x4*)(TOT + wave * 128 + 8 * kc) = (f32x4){cs[0], cs[1], cs[2], cs[3]}; *(LAS f32x4*)(TOT + wave * 128 + 8 * kc + 4) = (f32x4){cs[4], cs[5], cs[6], cs[7]}; }
        __syncthreads();
#pragma unroll
        for (int hf = 0; hf < 2; ++hf) {
            float off[4], tot[4];
#pragma unroll
            for (int j = 0; j < 4; ++j) { off[j] = 0.f; tot[j] = 0.f; }
#pragma unroll
            for (int w2 = 0; w2 < 8; ++w2) { const f32x4 t0 = *(const LAS f32x4*)(TOT + w2 * 128 + 8 * kc + 4 * hf); const float use = (w2 < wave) ? 1.0f : 0.0f;
#pragma unroll
                for (int j = 0; j < 4; ++j) { tot[j] += t0[j]; off[j] += use * t0[j]; } }
            float qt[4], kt[4], er[4];
#pragma unroll
            for (int j = 0; j < 4; ++j) { const float rr = 0.5f * tot[j]; float x = off[j] + cs[4 * hf + j] - rr; x = fminf(fmaxf(x, -100.f), 100.f);
                const float q = qv[4 * hf + j]; const float qs = q * __builtin_amdgcn_rcpf(1.0f + __expf(-q));
                qt[j] = qs * __builtin_amdgcn_exp2f(x); kt[j] = kk[4 * hf + j] * __builtin_amdgcn_exp2f(-x); er[j] = __builtin_amdgcn_exp2f(fmaxf(rr, -100.f)); }
            v2u wq, wk; wq.x = pk2(qt[0], qt[1]); wq.y = pk2(qt[2], qt[3]); wk.x = pk2(kt[0], kt[1]); wk.y = pk2(kt[2], kt[3]);
            *(LAS v2u*)(QT + tt * HG_LDQ + kc * 16 + 8 * hf) = wq; *(LAS v2u*)(KR + tt * HG_LDK + kc * 16 + 8 * hf) = wk;
            if (tid < 16) *(LAS f32x4*)(ER + 8 * kc + 4 * hf) = (f32x4){er[0], er[1], er[2], er[3]};
            asm volatile("" ::: "memory");
        }
        if (c + 1 < NTOK / 32) HG_PREFETCH(c + 1);
        __syncthreads();
        if (wave < 4) { const int si = wave & 1, ti = wave >> 1;
            f32x4 a4 = (f32x4){0.f, 0.f, 0.f, 0.f};
            if (si <= ti) {
#pragma unroll
                for (int ks = 0; ks < 4; ++ks) a4 = MFMA16(opr(KR, HG_LDK, 16 * si, 32 * ks, c16, rg), opr(QT, HG_LDQ, 16 * ti, 32 * ks, c16, rg), a4);
            }
            const int t = 16 * ti + c16, s0 = 16 * si + 4 * rg;
            v2u w; w.x = pk2(s0 <= t ? a4[0] : 0.f, s0 + 1 <= t ? a4[1] : 0.f); w.y = pk2(s0 + 2 <= t ? a4[2] : 0.f, s0 + 3 <= t ? a4[3] : 0.f);
            *(LAS v2u*)(ATT + t * HG_LDA + s0 * 2) = w; }
        { const f32x4 er = *(const LAS f32x4*)(ER + 16 * wave + 4 * rg);
#pragma unroll
          for (int ci = 0; ci < 4; ++ci) { acc[ci] = acc[ci] * er; v2u w; w.x = pk2(acc[ci][0], acc[ci][1]); w.y = pk2(acc[ci][2], acc[ci][3]);
              *(LAS v2u*)(SPT + (16 * ci + c16) * HG_LDS + (16 * wave + 4 * rg) * 2) = w; } }
        __syncthreads();
        { const int ci = wave & 3, ti = wave >> 2, t = 16 * ti + c16;
          f32x4 o4 = (f32x4){0.f, 0.f, 0.f, 0.f};
          o4 = MFMA16(opt(Vs, HG_LDV, 16 * ci, 0, lane), opr(ATT, HG_LDA, 16 * ti, 0, c16, rg), o4);
#pragma unroll
          for (int ks = 0; ks < 4; ++ks) o4 = MFMA16(opr(SPT, HG_LDS, 16 * ci, 32 * ks, c16, rg), opr(QT, HG_LDQ, 16 * ti, 32 * ks, c16, rg), o4);
          const int row = scan_row(b, dir, 32 * c + t);
          v2u w; w.x = pk2(o4[0], o4[1]); w.y = pk2(o4[2], o4[3]);
          gst8(dst, ((unsigned)row * (unsigned)dst_ld + (unsigned)(h * 64 + 16 * ci + 4 * rg)) * 2u, w); }
        { const bf16x8 a8 = opt(KR, HG_LDK, 16 * wave, 0, lane); const f32x4 er = *(const LAS f32x4*)(ER + 16 * wave + 4 * rg);
#pragma unroll
          for (int ci = 0; ci < 4; ++ci) { acc[ci] = MFMA16(a8, opt(Vs, HG_LDV, 16 * ci, 0, lane), acc[ci]); acc[ci] = acc[ci] * er; } }
        __syncthreads();
    }
#undef HG_PREFETCH
}

__device__ __forceinline__ void fin_phase(int row_lo, const bf16* P, bf16* YM, const bf16* RAWM, const bf16* RAWH, const float* mlgain  , const float* hggain  , int vcu, int G) {
    const int tid = tid_opaque(); const int lane = tid & 63, wave = __builtin_amdgcn_readfirstlane(tid >> 6);
    const int gw = vcu * NWAVES + wave, NGW = G * NWAVES;
    float gm[6], gh[4];
#pragma unroll
    for (int j = 0; j < 6; ++j) gm[j] = mlgain[6 * lane + j];
#pragma unroll
    for (int j = 0; j < 4; ++j) gh[j] = hggain[4 * lane + j];
    for (int r = row_lo + gw; r < MT; r += NGW) {
        bf16* ym = YM + (size_t)r * D;
        const unsigned* f3 = (const unsigned*)(ym + Y_ML + 6 * lane); const unsigned* b3 = (const unsigned*)(RAWM + (size_t)r * 384 + 6 * lane); const unsigned* o3 = (const unsigned*)(P + (size_t)r * DINP + C_MLO + 6 * lane);
        const unsigned fa = f3[0], fb_ = f3[1], fc = f3[2], ba = b3[0], bb = b3[1], bc = b3[2], oa = o3[0], ob = o3[1], oc = o3[2];
        const v2u f2 = *(const v2u*)(ym + Y_HG + 4 * lane), b2 = *(const v2u*)(RAWH + (size_t)r * 256 + 4 * lane), g2 = *(const v2u*)(P + (size_t)r * DINP + C_HGG + 4 * lane);
        float hm[6] = {bflo(fa) + bflo(ba), bfhi(fa) + bfhi(ba), bflo(fb_) + bflo(bb), bfhi(fb_) + bfhi(bb), bflo(fc) + bflo(bc), bfhi(fc) + bfhi(bc)};
        const float og[6] = {bflo(oa), bfhi(oa), bflo(ob), bfhi(ob), bflo(oc), bfhi(oc)};
        float hh[4] = {bflo(f2.x) + bflo(b2.x), bfhi(f2.x) + bfhi(b2.x), bflo(f2.y) + bflo(b2.y), bfhi(f2.y) + bfhi(b2.y)};
        const float gg[4] = {bflo(g2.x), bfhi(g2.x), bflo(g2.y), bfhi(g2.y)};
        float sm = 0.f, sh = 0.f;
#pragma unroll
        for (int j = 0; j < 6; ++j) sm += hm[j] * hm[j];
#pragma unroll
        for (int j = 0; j < 4; ++j) sh += hh[j] * hh[j];
#pragma unroll
        for (int o = 1; o < 16; o <<= 1) { sm += lx_xor(sm, o, lane); sh += lx_xor(sh, o, lane); }
        const float rm = 1.0f / sqrtf(sm * (1.0f / 96.0f) + EPS), rh = 1.0f / sqrtf(sh * (1.0f / 64.0f) + EPS);
#pragma unroll
        for (int j = 0; j < 6; ++j) hm[j] = hm[j] * rm * gm[j] * __builtin_amdgcn_rcpf(1.0f + __expf(-og[j]));
#pragma unroll
        for (int j = 0; j < 4; ++j) hh[j] = hh[j] * rh * gh[j] * gg[j] * __builtin_amdgcn_rcpf(1.0f + __expf(-gg[j]));
        unsigned* w3 = (unsigned*)(ym + Y_ML + 6 * lane); w3[0] = pk2(hm[0], hm[1]); w3[1] = pk2(hm[2], hm[3]); w3[2] = pk2(hm[4], hm[5]);
        v2u w2; w2.x = pk2(hh[0], hh[1]); w2.y = pk2(hh[2], hh[3]); *(v2u*)(ym + Y_HG + 4 * lane) = w2;
    }
}
#ifndef NO_HG
#define NO_HG 0
#endif
#ifndef NO_ML
#define NO_ML 0
#endif
#ifndef NO_AT
#define NO_AT 0
#endif
#ifndef NO_GEMM
#define NO_GEMM 0
#endif
#ifndef NO_G1
#define NO_G1 0
#endif
#ifndef NO_G2
#define NO_G2 0
#endif
#ifndef NO_G3
#define NO_G3 0
#endif
#ifndef NO_G4
#define NO_G4 0
#endif
#ifndef NO_P0
#define NO_P0 0
#endif
#ifndef STAMP_ON
#define STAMP_ON 0
#endif
#ifndef SA
#define SA 0
#define SB 1
#define SC 0
#define SD 1
#endif
#ifndef THIN_PROBE
#define THIN_PROBE 0
#endif
#ifndef ATT_PROBE
#define ATT_PROBE 0
#endif
#ifndef REPMASK
#define REPMASK 7
#endif
#ifndef REP
#define REP 0
#endif
constexpr int NPHASE = 2 + 8 * DEPTH;

typedef __attribute__((address_space(4))) const Args* kargs_t;
__device__ __forceinline__ kargs_t kargs() { kargs_t p = (kargs_t)__builtin_amdgcn_kernarg_segment_ptr(); asm volatile("" : "+s"(p)); return p; }
#define WSP(T, off) ((T*)(ws + (off)))

__global__ void __launch_bounds__(NTHR, 2) fwd(Args a_unused) {
    extern __shared__ __attribute__((aligned(16))) unsigned char lds_raw[];
    lptr lds = (lptr)lds_raw;
    const int G = gridDim.x; const int bx = blockIdx.x; const int vcu = (G % 8 == 0) ? (bx % 8) * (G / 8) + bx / 8 : bx;
    volatile LAS unsigned* MISC = (volatile LAS unsigned*)(lds + LDSCTL_OFF);
    { const int tid = tid_opaque(); for (int u = tid; u < (LDS_BYTES - LDSCTL_OFF) / 4; u += NTHR) ((LAS unsigned*)(lds + LDSCTL_OFF))[u] = 0u; }
    __syncthreads();
    int lo, hi; XcdBarrier bar;
    { kargs_t A = kargs(); lo = A->ph_lo; hi = A->ph_hi; unsigned* bw = (unsigned*)(A->ws + WS_CTL) + CW_BAR;
      bar.bar = bw; bar.x = 0; bar.st = nullptr;
      if (hi - lo > 1) bar = xcd_barrier_post(bw, MISC + 8); }
    volatile LAS int* slot = (volatile LAS int*)(MISC + 16);
#if STAMP_ON
#define STAMP(k) do { if (bx == 0 && tid_opaque() == 0) { kargs_t A_ = kargs(); __hip_atomic_store((unsigned long long*)(A_->ws + WS_MISC + 131072) + (k), (unsigned long long)__builtin_amdgcn_s_memrealtime(), RLX_AGENT); } } while (0)
#else
#define STAMP(k) do { } while (0)
#endif
#define IN(k) (lo <= (k) && (k) < hi)
#define SEAM(k) do { if (IN(k) && IN((k) + 1)) xcd_barrier(bar); STAMP((k) + 1); } while (0)
#define REPEAT(k) for (int rep_ = ((REP == (k) && l == 0) ? 2 : 1); rep_ > 0; --rep_)
#define REPBAR() do { if (rep_ > 1) xcd_barrier(bar); } while (0)

    STAMP(0);
    if (IN(0)) { if (!NO_P0) p0_phase(lds, kargs()); } SEAM(0);

    for (int l = 0; l < DEPTH; ++l) {
        const int pb = 1 + 8 * l;
        const bool with_ctx = l < DEPTH - 1;
        const int r0 = with_ctx ? 0 : MC; const int Mg = MT - r0;
        if (IN(pb)) REPEAT(1) {
            kargs_t A = kargs(); unsigned char* ws = A->ws; const float* modl = WSP(float, WS_MOD) + (size_t)l * 17 * NMOD; float* ctxx = WSP(float, WS_CTXX);
            if (l == 0) thin_phase<false, true>(0, A->in[I_X], A->in[I_CTX], A->out, ctxx, false, (const bf16*)nullptr, nullptr, 0, nullptr, modl, 0, D, A->in[I_GPREMIX] + l * D, WSP(bf16, WS_HB), vcu, G);
            else        thin_phase<true, true>(0, A->out, ctxx, A->out, ctxx, true, WSP(bf16, WS_YD), modl - 17 * NMOD, 5 * D, A->in[I_GPOSTFFN] + (l - 1) * D, modl, 0, D, A->in[I_GPREMIX] + l * D, WSP(bf16, WS_HB), vcu, G);
            convert_weights(lds, kargs(), l, vcu, G); REPBAR();
        }
        SEAM(pb);
        if (IN(pb + 1)) REPEAT(2) {
            kargs_t A = kargs(); unsigned char* ws = A->ws;
            pg8::Gemm g{WSP(bf16, WS_HB), WSP(bf16, WS_WIN), MT, DINP, D}; pg8::StaticOrder S; S.init(MT, DINP, G, bx);
            pg8::EpiIn E{WSP(bf16, WS_P), DINP, WSP(float, WS_MISC + 32768) + l * DINP, WSP(float, WS_GATE)};
            if (!NO_GEMM && !NO_G1) pg8::gemm_phase<pg8::EpiIn, pg8::StaticOrder, true, true>(lds, g, S, E); REPBAR();
        }
        SEAM(pb + 1);
        if (IN(pb + 2)) REPEAT(3) {
            { kargs_t A = kargs(); unsigned char* ws = A->ws; unsigned* qh = WSP(unsigned, WS_CTL) + CW_Q + 64 * (16 * l + 64 * (rep_ - 1));
              for (;;) { const int it = wg_pull(qh, slot); if (it >= 128) break;
                const int b = it >> 3, h = (it >> 1) & 3, dir = it & 1;
                if (!NO_HG && (rep_ == 1 || (REPMASK & 1))) hgrn2_stream(lds, WSP(bf16, WS_P), dir ? WSP(bf16, WS_RAWH) : WSP(bf16, WS_HB) + Y_HG, dir ? 256 : D, WSP(float, WS_MISC) + l * 1024, b, h, dir); } }
            { kargs_t A = kargs(); unsigned char* ws = A->ws; unsigned* qm = WSP(unsigned, WS_CTL) + CW_Q + 64 * (16 * l + 64 * (rep_ - 1) + 1);
              for (;;) { const int it = wg_pull(qm, slot); if (it >= 128) break;
                const int b = it >> 3, h = (it >> 1) & 3, dir = it & 1;
                if (!NO_ML && (rep_ == 1 || (REPMASK & 2))) mlstm_stream(lds, WSP(bf16, WS_P), WSP(float, WS_GATE), dir ? WSP(bf16, WS_RAWM) : WSP(bf16, WS_HB) + Y_ML, dir ? 384 : D, A->in[I_MLFB] + l * 8, b, h, dir); } }
            { kargs_t A = kargs(); unsigned char* ws = A->ws; unsigned* qa = WSP(unsigned, WS_CTL) + CW_Q + 64 * (16 * l + 64 * (rep_ - 1) + 2);
              const int nq = with_ctx ? 72 : 64;
              const float lam_init = 0.8f - 0.6f * __expf(-0.3f * (float)l);
              const int myx = (int)(xb_xcc_id() & 7u);
              for (int k = 0; k < 8; ++k) { const int qx = (myx + k) & 7;
                for (;;) { const int it = wg_pull(qa + 64 * qx, slot); if (it >= nq) break;
                  const int bh = it < 64 ? (it >> 3) * 8 + qx : (it - 64) * 8 + qx, qb = it < 64 ? it & 7 : 8;
                  if (!NO_AT && (rep_ == 1 || (REPMASK & 4))) attn_item(lds, WSP(bf16, WS_P), WSP(bf16, WS_HB), WSP(float, WS_MISC + 16384), A->in[I_DANORM] + l * 96, WSP(float, WS_MISC + 114688)[l], 1.0f - lam_init, bh >> 2, bh & 3, qb, rep_ == 2 ? ATT_PROBE : 0); } } }
            __syncthreads(); REPBAR();
        }
        SEAM(pb + 2);
        if (IN(pb + 3)) {
            kargs_t A = kargs(); unsigned char* ws = A->ws;
            fin_phase(r0, WSP(bf16, WS_P), WSP(bf16, WS_HB), WSP(bf16, WS_RAWM), WSP(bf16, WS_RAWH), A->in[I_MLNORM] + l * 384, A->in[I_HGNORM] + l * 256, vcu, G);
        }
        SEAM(pb + 3);
        if (IN(pb + 4)) REPEAT(5) {
            kargs_t A = kargs(); unsigned char* ws = A->ws;
            pg8::Gemm g{WSP(bf16, WS_HB) + (size_t)r0 * D, WSP(bf16, WS_WOUT), Mg, D, D}; pg8::StaticOrder S; S.init(Mg, D, G, bx);
            pg8::EpiBf E{WSP(bf16, WS_P) + (size_t)r0 * D, D};
            if (!NO_GEMM && !NO_G2) pg8::gemm_phase<pg8::EpiBf, pg8::StaticOrder, true, true>(lds, g, S, E); REPBAR();
        }
        SEAM(pb + 4);
        if (IN(pb + 5)) REPEAT(6) {
            kargs_t A = kargs(); unsigned char* ws = A->ws; const float* modl = WSP(float, WS_MOD) + (size_t)l * 17 * NMOD; float* ctxx = WSP(float, WS_CTXX);
            const float* xl = (l == 0) ? A->in[I_X] : A->out; const float* xc = (l == 0) ? A->in[I_CTX] : ctxx;
            thin_phase<true, true>(r0, xl, xc, A->out, ctxx, true, WSP(bf16, WS_P), modl, 2 * D, A->in[I_GPOSTMIX] + l * D, modl, 3 * D, 4 * D, A->in[I_GPREFFN] + l * D, WSP(bf16, WS_HB), vcu, G, rep_ == 2 ? THIN_PROBE : 0); REPBAR();
        }
        SEAM(pb + 5);
        if (IN(pb + 6)) REPEAT(7) {
            kargs_t A = kargs(); unsigned char* ws = A->ws;
            pg8::Gemm g{WSP(bf16, WS_HB) + (size_t)r0 * D, WSP(bf16, WS_WGU), Mg, NGU, D}; pg8::StaticOrder S; S.init(Mg, NGU, G, bx);
            pg8::EpiSwiglu E{WSP(bf16, WS_P) + (size_t)r0 * DFF, DFF};
            if (!NO_GEMM && !NO_G3) pg8::gemm_phase<pg8::EpiSwiglu, pg8::StaticOrder, true, true>(lds, g, S, E); REPBAR();
        }
        SEAM(pb + 6);
        if (IN(pb + 7)) REPEAT(8) {
            kargs_t A = kargs(); unsigned char* ws = A->ws;
            pg8::Gemm g{WSP(bf16, WS_P) + (size_t)r0 * DFF, WSP(bf16, WS_WD), Mg, D, DFF}; pg8::StaticOrder S; S.init(Mg, D, G, bx);
            pg8::EpiBf E{WSP(bf16, WS_YD) + (size_t)r0 * D, D};
            if (!NO_GEMM && !NO_G4) pg8::gemm_phase<pg8::EpiBf, pg8::StaticOrder, true, true>(lds, g, S, E); REPBAR();
        }
        SEAM(pb + 7);
    }
    if (IN(NPHASE - 1)) {
        kargs_t A = kargs(); unsigned char* ws = A->ws; const float* modl = WSP(float, WS_MOD) + (size_t)(DEPTH - 1) * 17 * NMOD; float* ctxx = WSP(float, WS_CTXX);
        thin_phase<true, false>(MC, A->out, ctxx, A->out, ctxx, true, WSP(bf16, WS_YD), modl, 5 * D, A->in[I_GPOSTFFN] + (DEPTH - 1) * D, nullptr, 0, 0, nullptr, nullptr, vcu, G);
#if STAMP_ON
        {
            __syncthreads();
            const unsigned long long* st = (const unsigned long long*)(ws + WS_MISC + 131072);
            const float d1 = (float)(long long)(__hip_atomic_load(st + SB, RLX_AGENT) - __hip_atomic_load(st + SA, RLX_AGENT)) * 1e-5f;
            const float d2 = (float)(long long)(__hip_atomic_load(st + SD, RLX_AGENT) - __hip_atomic_load(st + SC, RLX_AGENT)) * 1e-2f;
            const int tid = tid_opaque(); const int rwg = ML / G; float* o = A->out + (size_t)vcu * rwg * D;
            for (int i = tid; i < rwg * D; i += NTHR) o[i] *= (1.0f + d1);
            __syncthreads();
            if (bx == 0 && tid == 0) A->out[(size_t)vcu * rwg * D] = d2;
        }
#endif
    }
#undef IN
#undef SEAM
}

extern "C" void kernel_launch(void* const* d_in, const int* in_sizes, int n_in, void* d_out, int out_size, void* d_ws, size_t ws_size, hipStream_t stream) {
    static int grid = 0;
    if (grid == 0) {
        if (n_in != 22 || in_sizes[0] != ML * D || out_size != ML * D || ws_size < WS_END) {
            fprintf(stderr, "kernel_launch: unexpected shapes: n_in %d in0 %d out %d ws %zu (need %zu); nothing launched\n", n_in, n_in > 0 ? in_sizes[0] : -1, out_size, ws_size, (size_t)WS_END); grid = -1; return; }
        int dev = 0, cus = 0, per_cu = 0;
        if (hipGetDevice(&dev) != hipSuccess || hipDeviceGetAttribute(&cus, hipDeviceAttributeMultiprocessorCount, dev) != hipSuccess) { fprintf(stderr, "kernel_launch: device query failed\n"); grid = -1; return; }
        if (hipFuncSetAttribute((const void*)fwd, hipFuncAttributeMaxDynamicSharedMemorySize, LDS_BYTES) != hipSuccess) { fprintf(stderr, "kernel_launch: hipFuncSetAttribute failed\n"); grid = -1; return; }
        if (hipOccupancyMaxActiveBlocksPerMultiprocessor(&per_cu, (const void*)fwd, NTHR, LDS_BYTES) != hipSuccess || per_cu < 1)
            fprintf(stderr, "kernel_launch: note: occupancy query reports %d workgroups per CU\n", per_cu);
        (void)hipGetLastError();
        grid = cus;
    }
    if (grid < 0) return;
    if (hipMemsetAsync((char*)d_ws + WS_CTL, 0, CTL_ZERO_BYTES, stream) != hipSuccess) { fprintf(stderr, "kernel_launch: memset failed\n"); return; }
    Args a{};
    for (int i = 0; i < 22; ++i) a.in[i] = (const float*)d_in[i];
    a.out = (float*)d_out; a.ws = (unsigned char*)d_ws;
#if MK_PER_PHASE
    for (int p = 0; p < NPHASE; ++p) { a.ph_lo = p; a.ph_hi = p + 1; hipLaunchKernelGGL(fwd, dim3(grid), dim3(NTHR), LDS_BYTES, stream, a); }
#else
    a.ph_lo = 0; a.ph_hi = NPHASE;
    hipLaunchKernelGGL(fwd, dim3(grid), dim3(NTHR), LDS_BYTES, stream, a);
#endif
    const hipError_t le = hipPeekAtLastError();
    if (le != hipSuccess) fprintf(stderr, "kernel_launch: launch failed: %s\n", hipGetErrorName(le));
}
```

```cpp
#include <hip/hip_runtime.h>
#include <cstdio>
#include <cstdint>
#ifndef MK_PER_PHASE
#define MK_PER_PHASE 0
#endif
namespace pg8 {
#define PG8_LAS __attribute__((address_space(3)))
typedef unsigned short bf16_t;
typedef short bf16x8 __attribute__((ext_vector_type(8)));
typedef float f32x4 __attribute__((ext_vector_type(4)));
typedef unsigned u32x4 __attribute__((ext_vector_type(4)));
constexpr int BM = 256, BK = 64, HALF = 128, HTB = HALF * BK * 2  , STAGE_BYTES = 8 * HTB, NXCD = 8, WGM = 8;

__host__ __device__ __forceinline__ int lds_byte(int r, int c) { const int st = (r >> 4) * 2 + (c >> 5), rr = r & 15, cc = c & 31, ob = rr * 64 + cc * 2; return st * 1024 + (ob ^ (((ob >> 9) & 1) << 5)); }
__host__ __device__ __forceinline__ void stage_rc(int b, int& R, int& C) { const int st = b / 1024, sb = b % 1024, swz = sb ^ (((sb >> 9) & 1) << 5); R = (st >> 1) * 16 + swz / 64; C = (st & 1) * 32 + (swz % 64) / 2; }
__host__ __device__ __forceinline__ int perm32(int rho) { const int n = rho >> 4, i = rho & 15; return 8 * (i >> 2) + 4 * n + (i & 3); }

struct Unit { int pm, pn; };
struct Gemm { const bf16_t* A; const bf16_t* Bt; int M, N, K; };

struct StaticOrder {
    int nM, nN, nwg, G, c;
    __host__ __device__ void init(int M, int N, int G_, int c_) { nM = M / BM; nN = N / BM; nwg = nM * nN; G = G_; c = c_; }
    __host__ __device__ bool next(int i, Unit& u) const {
        const long L = (long)i * G + c; if (L >= nwg) return false;
        int wgid = (int)L; { const int q = nwg / NXCD, r = nwg % NXCD, xcd = wgid % NXCD, off = wgid / NXCD; wgid = (xcd < r ? xcd * (q + 1) : r * (q + 1) + (xcd - r) * q) + off; }
        const int nig = WGM * nN, gid = wgid / nig, fm = gid * WGM, gsz = (nM - fm) < WGM ? (nM - fm) : WGM;
        u.pm = fm + ((wgid % nig) % gsz); u.pn = (wgid % nig) / gsz; return true;
    }
    __device__ __forceinline__ void a_ready(const Unit&) const {}
    __device__ __forceinline__ void done(const Unit&) const {}
};
__device__ __forceinline__ unsigned cvt_pk_bf16(float lo, float hi) { unsigned r; asm volatile("v_cvt_pk_bf16_f32 %0, %1, %2" : "=v"(r) : "v"(lo), "v"(hi)); return r; }
struct EpiF32 {
    static constexpr bool PERM = false, AFTER_DRAIN = false;
    float* C; int ldc;
    __device__ __forceinline__ void operator()(const f32x4 (&acc)[2][2][4][2], const Unit& u, int wr, int wc, int fr, int fq) const {
        const int row0 = u.pm * BM + wr * 64 + fr, col0 = u.pn * BM + wc * 32 + 4 * fq;
#pragma unroll
        for (int ai = 0; ai < 2; ++ai)
#pragma unroll
            for (int m = 0; m < 4; ++m) { float* rowp = C + (size_t)(row0 + ai * HALF + m * 16) * ldc + col0;
#pragma unroll
                for (int bj = 0; bj < 2; ++bj)
#pragma unroll
                    for (int n = 0; n < 2; ++n) *(f32x4*)(rowp + bj * HALF + n * 16) = acc[ai][bj][m][n]; }
    }
};
struct EpiBf {
    static constexpr bool PERM = true, AFTER_DRAIN = false;
    bf16_t* O; int ldc;
    __device__ __forceinline__ void operator()(const f32x4 (&acc)[2][2][4][2], const Unit& u, int wr, int wc, int fr, int fq) const {
        const int row0 = u.pm * BM + wr * 64 + fr; const int col0 = u.pn * BM + wc * 32 + 8 * fq;
#pragma unroll
        for (int ai = 0; ai < 2; ++ai)
#pragma unroll
            for (int m = 0; m < 4; ++m) { bf16_t* rowp = O + (size_t)(row0 + ai * HALF + m * 16) * ldc + col0;
#pragma unroll
                for (int bj = 0; bj < 2; ++bj) { const f32x4 v0 = acc[ai][bj][m][0], v1 = acc[ai][bj][m][1];
                    u32x4 w; w.x = cvt_pk_bf16(v0[0], v0[1]); w.y = cvt_pk_bf16(v0[2], v0[3]); w.z = cvt_pk_bf16(v1[0], v1[1]); w.w = cvt_pk_bf16(v1[2], v1[3]);
                    *(u32x4*)(rowp + bj * HALF) = w; } }
    }
};
struct EpiIn {
    static constexpr bool PERM = true, AFTER_DRAIN = false;
    bf16_t* O; int ldc; const float* bias; float* G; const float* rope; int mc; float qscale;
    __device__ __forceinline__ void operator()(const f32x4 (&acc)[2][2][4][2], const Unit& u, int wr, int wc, int fr, int fq) const {
        const int row0 = u.pm * BM + wr * 64 + fr; const int col0 = u.pn * BM + wc * 32 + 8 * fq;
        const bool gate_lane = (u.pn == 6) && (wc == 0) && (fq < 2);
        const bool da_tile = (u.pn >= 14) && (u.pn <= 17);
#pragma unroll
        for (int bj = 0; bj < 2; ++bj) {
            const int c = col0 + bj * HALF;
            const f32x4 b0 = *(const f32x4*)(bias + c), b1 = *(const f32x4*)(bias + c + 4);
            const bool is_da = da_tile && c >= 3600 && c < 4368;
            const bool is_q = is_da && c < 3984;
            const int d48 = is_da ? (c - 3600) % 48 : 0; const int hf = d48 >= 24 ? 1 : 0, i0 = (d48 - 24 * hf) >> 1;
#pragma unroll
            for (int ai = 0; ai < 2; ++ai)
#pragma unroll
                for (int m = 0; m < 4; ++m) { const int row = row0 + ai * HALF + m * 16; bf16_t* rowp = O + (size_t)row * ldc + col0;
                    f32x4 v0 = acc[ai][bj][m][0] + b0, v1 = acc[ai][bj][m][1] + b1;
                    if (is_da) {
                        if (row >= mc) { const int t = (row - mc) & 2047; const int pos = hf ? (t & 63) : (t >> 6);
                            const f32x4 cs0 = *(const f32x4*)(rope + pos * 24 + 2 * i0), cs1 = *(const f32x4*)(rope + pos * 24 + 2 * i0 + 4);
                            const f32x4 r0 = {v0[0] * cs0[0] - v0[1] * cs0[1], v0[0] * cs0[1] + v0[1] * cs0[0], v0[2] * cs0[2] - v0[3] * cs0[3], v0[2] * cs0[3] + v0[3] * cs0[2]};
                            const f32x4 r1 = {v1[0] * cs1[0] - v1[1] * cs1[1], v1[0] * cs1[1] + v1[1] * cs1[0], v1[2] * cs1[2] - v1[3] * cs1[3], v1[2] * cs1[3] + v1[3] * cs1[2]};
                            v0 = r0; v1 = r1; }
                        if (is_q) { v0 = v0 * qscale; v1 = v1 * qscale; } }
                    u32x4 w; w.x = cvt_pk_bf16(v0[0], v0[1]); w.y = cvt_pk_bf16(v0[2], v0[3]); w.z = cvt_pk_bf16(v1[0], v1[1]); w.w = cvt_pk_bf16(v1[2], v1[3]);
                    *(u32x4*)(rowp + bj * HALF) = w;
                    if (bj == 0 && gate_lane) { float* g = G + (size_t)row * 16 + 8 * fq; *(f32x4*)g = v0; *(f32x4*)(g + 4) = v1; } }
        }
    }
};
struct EpiSwiglu {
    static constexpr bool PERM = true, AFTER_DRAIN = false;
    bf16_t* O; int ldc;
    __device__ __forceinline__ void operator()(const f32x4 (&acc)[2][2][4][2], const Unit& u, int wr, int wc, int fr, int fq) const {
        const int row0 = u.pm * BM + wr * 64 + fr; const int col0 = u.pn * HALF + wc * 32 + 8 * fq;
#pragma unroll
        for (int ai = 0; ai < 2; ++ai)
#pragma unroll
            for (int m = 0; m < 4; ++m) { bf16_t* rowp = O + (size_t)(row0 + ai * HALF + m * 16) * ldc + col0;
                f32x4 r0, r1;
#pragma unroll
                for (int i = 0; i < 4; ++i) { const float g0 = acc[ai][0][m][0][i], g1 = acc[ai][0][m][1][i];
                    r0[i] = g0 * __builtin_amdgcn_rcpf(1.0f + __expf(-g0)) * acc[ai][1][m][0][i];
                    r1[i] = g1 * __builtin_amdgcn_rcpf(1.0f + __expf(-g1)) * acc[ai][1][m][1][i]; }
                u32x4 w; w.x = cvt_pk_bf16(r0[0], r0[1]); w.y = cvt_pk_bf16(r0[2], r0[3]); w.z = cvt_pk_bf16(r1[0], r1[1]); w.w = cvt_pk_bf16(r1[2], r1[3]);
                *(u32x4*)rowp = w; }
    }
};
template <class Epi, class Sched, bool ALIGN_EPI = false, bool SP2 = false>
__device__ __forceinline__ void gemm_phase(PG8_LAS unsigned char* lds, const Gemm g, const Sched& S, const Epi& E) {
    int tid_ = threadIdx.x; asm volatile("" : "+v"(tid_));
    const int tid = tid_, wid = __builtin_amdgcn_readfirstlane(tid >> 6), lane = tid & 63, wr = wid >> 2, wc = wid & 3, fr = lane & 15, fq = lane >> 4;
    const int K = g.K, nt = K / BK;
    unsigned voffA[2], voffB[2];
#pragma unroll
    for (int i = 0; i < 2; ++i) { int R, C; stage_rc(tid * 16 + i * 8192, R, C); const int Rb = Epi::PERM ? ((R & ~31) + perm32(R & 31)) : R;
        voffA[i] = (unsigned)(R * K + C) * 2u; voffB[i] = (unsigned)(Rb * K + C) * 2u; }
    const size_t kstep = (size_t)(BK * 2);
    const size_t hstep = (size_t)HALF * K * 2;
    const size_t tstep = 2 * hstep;
    const unsigned ldsw = (unsigned)wid * 1024u;
    const int aoff = lds_byte(wr * 64 + fr, fq * 8), boff = lds_byte(wc * 32 + fr, fq * 8);
#define PG8_SA(b, h) (((b) * 2 + (h)) * HTB)
#define PG8_SB(b, h) ((4 + (b) * 2 + (h)) * HTB)
#define PG8_STAGE(bufoff, gbase, voff) do { _Pragma("unroll") for (int _i = 0; _i < 2; ++_i) \
        __builtin_amdgcn_global_load_lds((const unsigned*)((const char*)(gbase) + (voff)[_i]), (PG8_LAS unsigned*)(lds + (bufoff) + ldsw + _i * 8192), 16, 0, 0); } while (0)
#define PG8_LDA(dst, b, h) do { _Pragma("unroll") for (int m = 0; m < 4; ++m) _Pragma("unroll") for (int k = 0; k < 2; ++k) dst[m][k] = *(const PG8_LAS bf16x8*)(lds + PG8_SA(b, h) + aoff + m * 2048 + k * 1024); } while (0)
#define PG8_LDB(dst, b, h) do { _Pragma("unroll") for (int n = 0; n < 2; ++n) _Pragma("unroll") for (int k = 0; k < 2; ++k) dst[n][k] = *(const PG8_LAS bf16x8*)(lds + PG8_SB(b, h) + boff + n * 2048 + k * 1024); } while (0)
#define PG8_MMA(ai, bj, At, Bt) do { __builtin_amdgcn_s_setprio(1); _Pragma("unroll") for (int m = 0; m < 4; ++m) _Pragma("unroll") for (int n = 0; n < 2; ++n) _Pragma("unroll") for (int k = 0; k < 2; ++k) \
        acc[ai][bj][m][n] = __builtin_amdgcn_mfma_f32_16x16x32_bf16(Bt[n][k], At[m][k], acc[ai][bj][m][n], 0, 0, 0); __builtin_amdgcn_s_setprio(0); } while (0)
#define PG8_WAIT_V(n) asm volatile("s_waitcnt vmcnt(" #n ")" ::: "memory")
#define PG8_WAIT_L(n) asm volatile("s_waitcnt lgkmcnt(" #n ")" ::: "memory")
#define PG8_BAR __builtin_amdgcn_s_barrier()
#define PG8_SCHED __builtin_amdgcn_sched_barrier(0)
    Unit cur, nxt; int ui = 0;
    if (!S.next(0, cur)) return;
    f32x4 acc[2][2][4][2];
#pragma unroll
    for (int a = 0; a < 2; ++a)
#pragma unroll
        for (int b = 0; b < 2; ++b)
#pragma unroll
            for (int m = 0; m < 4; ++m)
#pragma unroll
                for (int n = 0; n < 2; ++n) acc[a][b][m][n] = (f32x4){0.f, 0.f, 0.f, 0.f};
    bf16x8 At[4][2], B0[2][2], B1[2][2];
    const char* cA = (const char*)g.A + (size_t)cur.pm * tstep; const char* cB = (const char*)g.Bt + (size_t)cur.pn * tstep;
    S.a_ready(cur);
    if constexpr (SP2) {
        PG8_STAGE(PG8_SB(0, 0), cB, voffB); PG8_STAGE(PG8_SB(0, 1), cB + hstep, voffB); PG8_STAGE(PG8_SA(0, 0), cA, voffA); PG8_STAGE(PG8_SA(0, 1), cA + hstep, voffA);
        if (wr == 1) PG8_BAR;
        PG8_WAIT_V(2); PG8_BAR;
        PG8_STAGE(PG8_SB(1, 0), cB + kstep, voffB); PG8_STAGE(PG8_SA(1, 0), cA + kstep, voffA); PG8_STAGE(PG8_SB(1, 1), cB + hstep + kstep, voffB);
        PG8_WAIT_V(6); PG8_BAR;
    } else {
        PG8_STAGE(PG8_SB(0, 0), cB, voffB); PG8_STAGE(PG8_SA(0, 0), cA, voffA); PG8_STAGE(PG8_SB(0, 1), cB + hstep, voffB); PG8_STAGE(PG8_SA(0, 1), cA + hstep, voffA);
        if (wr == 1) PG8_BAR;
        PG8_WAIT_V(4); PG8_BAR;
        PG8_STAGE(PG8_SB(1, 0), cB + kstep, voffB); PG8_STAGE(PG8_SA(1, 0), cA + kstep, voffA); PG8_STAGE(PG8_SB(1, 1), cB + hstep + kstep, voffB);
        PG8_WAIT_V(6); PG8_BAR;
    }
    for (;;) {
        const bool has_next = S.next(ui + 1, nxt);
        const char* nA = has_next ? (const char*)g.A + (size_t)nxt.pm * tstep : cA; const char* nB = has_next ? (const char*)g.Bt + (size_t)nxt.pn * tstep : cB;
        for (int t = 0; t < nt; t += 2) {
            const bool last = (t == nt - 2);
            const char* a1 = cA + (size_t)(t + 1) * kstep;
            const char* a2 = last ? nA : cA + (size_t)(t + 2) * kstep; const char* b2 = last ? nB : cB + (size_t)(t + 2) * kstep;
            const char* a3 = a2 + kstep; const char* b3 = b2 + kstep;
            if (last && has_next) S.a_ready(nxt);
            if constexpr (SP2) {
            PG8_LDB(B0, 0, 0); PG8_LDB(B1, 0, 1); PG8_SCHED; PG8_LDA(At, 0, 0); PG8_STAGE(PG8_SA(1, 1), a1 + hstep, voffA);
            PG8_WAIT_V(8); PG8_WAIT_L(0); PG8_BAR; PG8_MMA(0, 0, At, B0); PG8_MMA(0, 1, At, B1); PG8_BAR; PG8_SCHED;
            PG8_LDA(At, 0, 1); PG8_STAGE(PG8_SB(0, 0), b2, voffB); PG8_STAGE(PG8_SB(0, 1), b2 + hstep, voffB); PG8_STAGE(PG8_SA(0, 0), a2, voffA);
            PG8_WAIT_V(8); PG8_WAIT_L(0); PG8_BAR; PG8_MMA(1, 0, At, B0); PG8_MMA(1, 1, At, B1); PG8_BAR; PG8_SCHED;
            PG8_LDB(B0, 1, 0); PG8_LDB(B1, 1, 1); PG8_SCHED; PG8_LDA(At, 1, 0); PG8_STAGE(PG8_SA(0, 1), a2 + hstep, voffA);
            PG8_WAIT_V(8); PG8_WAIT_L(0); PG8_BAR; PG8_MMA(0, 0, At, B0); PG8_MMA(0, 1, At, B1); PG8_BAR; PG8_SCHED;
            PG8_LDA(At, 1, 1); PG8_STAGE(PG8_SB(1, 0), b3, voffB); PG8_STAGE(PG8_SB(1, 1), b3 + hstep, voffB); PG8_STAGE(PG8_SA(1, 0), a3, voffA);
            PG8_WAIT_V(8); PG8_WAIT_L(0); PG8_BAR; PG8_MMA(1, 0, At, B0); PG8_MMA(1, 1, At, B1); PG8_BAR; PG8_SCHED;
            } else {
            PG8_LDB(B0, 0, 0); PG8_SCHED; PG8_LDA(At, 0, 0); PG8_STAGE(PG8_SA(1, 1), a1 + hstep, voffA);
            PG8_WAIT_L(8); PG8_BAR; PG8_WAIT_L(0); PG8_MMA(0, 0, At, B0); PG8_BAR; PG8_SCHED;
            PG8_LDB(B1, 0, 1); PG8_STAGE(PG8_SB(0, 0), b2, voffB);
            PG8_BAR; PG8_WAIT_L(0); PG8_MMA(0, 1, At, B1); PG8_BAR;
            PG8_LDA(At, 0, 1); PG8_STAGE(PG8_SA(0, 0), a2, voffA);
            PG8_BAR; PG8_WAIT_L(0); PG8_MMA(1, 0, At, B0); PG8_BAR; PG8_SCHED;
            PG8_STAGE(PG8_SB(0, 1), b2 + hstep, voffB);
            PG8_WAIT_V(6); PG8_BAR; PG8_MMA(1, 1, At, B1); PG8_BAR;
            PG8_LDB(B0, 1, 0); PG8_SCHED; PG8_LDA(At, 1, 0); PG8_STAGE(PG8_SA(0, 1), a2 + hstep, voffA);
            PG8_WAIT_L(8); PG8_BAR; PG8_WAIT_L(0); PG8_MMA(0, 0, At, B0); PG8_BAR; PG8_SCHED;
            PG8_LDB(B1, 1, 1); PG8_STAGE(PG8_SB(1, 0), b3, voffB);
            PG8_BAR; PG8_WAIT_L(0); PG8_MMA(0, 1, At, B1); PG8_BAR;
            PG8_LDA(At, 1, 1); PG8_STAGE(PG8_SA(1, 0), a3, voffA);
            PG8_BAR; PG8_WAIT_L(0); PG8_MMA(1, 0, At, B0); PG8_BAR; PG8_SCHED;
            PG8_STAGE(PG8_SB(1, 1), b3 + hstep, voffB);
            PG8_WAIT_V(6); PG8_BAR; PG8_MMA(1, 1, At, B1); PG8_BAR;
            }
        }
        if constexpr (ALIGN_EPI) { if (wr == 0) PG8_BAR; }
        if constexpr (!Epi::AFTER_DRAIN) { E(acc, cur, wr, wc, fr, fq); S.done(cur); }
        if (!has_next) break;
#pragma unroll
        for (int a = 0; a < 2; ++a)
#pragma unroll
            for (int b = 0; b < 2; ++b)
#pragma unroll
                for (int m = 0; m < 4; ++m)
#pragma unroll
                    for (int n = 0; n < 2; ++n) acc[a][b][m][n] = (f32x4){0.f, 0.f, 0.f, 0.f};
        cur = nxt; cA = nA; cB = nB; ++ui;
        if constexpr (ALIGN_EPI) { if (wr == 1) PG8_BAR; }
    }
    PG8_WAIT_V(0);
    if constexpr (!ALIGN_EPI) { if (wr == 0) PG8_BAR; }
    PG8_BAR;
    if constexpr (Epi::AFTER_DRAIN) { E.fused(acc, cur, wr, wc, fr, fq, lds, wid, lane); S.done(cur); }
#undef PG8_SA
#undef PG8_SB
#undef PG8_STAGE
#undef PG8_LDA
#undef PG8_LDB
#undef PG8_MMA
#undef PG8_WAIT_V
#undef PG8_WAIT_L
#undef PG8_BAR
#undef PG8_SCHED
}
}
constexpr int D = 1024, NB = 16, SEQ = 2048, CTXL = 256, DEPTH = 4;
constexpr int MC = NB * CTXL, ML = NB * SEQ, MT = MC + ML;
constexpr int DIN = 4752, DINP = 4864, DFF = 2816, NGU = 2 * DFF, NMOD = 6 * D;
constexpr int C_MLQ = 0, C_MLK = 384, C_MLV = 768, C_MLO = 1152, C_MLI = 1536, C_MLF = 1544, C_HGQ = 1552, C_HGF = 2064, C_HGI = 3088, C_HGG = 3344, C_DAQ = 3600, C_DAK = 3984, C_DAV = 4368;
constexpr int Y_ML = 0, Y_HG = 384, Y_DA = 640;
constexpr float EPS = 1e-6f;
constexpr int NTOK = CTXL + SEQ;
static_assert(C_MLI == 6 * 256, "gate columns must open GEMM tile 6");

constexpr size_t MiB = 1u << 20;
constexpr size_t WS_CTL = 0, CTL_ZERO_BYTES = 1 * MiB;
constexpr size_t WS_MOD = 1 * MiB;
constexpr size_t WS_MISC = 3 * MiB;
constexpr size_t WS_GATE = 4 * MiB;
constexpr size_t WS_WIN = 8 * MiB, WS_WOUT = WS_WIN + (size_t)DINP * D * 2, WS_WGU = WS_WOUT + (size_t)D * D * 2, WS_WD = WS_WGU + (size_t)NGU * D * 2;
constexpr size_t WS_CTXX = 36 * MiB;
constexpr size_t WS_HB = 52 * MiB;
constexpr size_t WS_RAWM = 124 * MiB, WS_RAWH = 151 * MiB;
constexpr size_t WS_P = 169 * MiB;
constexpr size_t WS_YD = WS_P + 198 * MiB, WS_END = 511 * MiB;
static_assert(WS_WD + (size_t)D * DFF * 2 <= WS_CTXX, "weights fit");
static_assert(WS_RAWM + (size_t)64 * NTOK * 96 * 2 <= WS_RAWH && WS_RAWH + (size_t)64 * NTOK * 64 * 2 <= WS_P, "raw fits");
static_assert(WS_P + (size_t)MT * DINP * 2 <= WS_END && WS_YD + (size_t)MT * D * 4 <= WS_END && (size_t)MT * DFF * 2 <= 198 * MiB, "P region");
constexpr int CW_BAR = 4096;
constexpr int CW_Q = 16384;

constexpr int RING_BYTES = 131072, LDSCTL_OFF = RING_BYTES, LDS_BYTES = 147456;
constexpr int NWAVES = 8, NTHR = 512;

#define GAS __attribute__((address_space(1)))
#define LAS __attribute__((address_space(3)))
typedef unsigned short bf16;
typedef unsigned v4u __attribute__((ext_vector_type(4)));
typedef unsigned v2u __attribute__((ext_vector_type(2)));
typedef float f32x4 __attribute__((ext_vector_type(4)));
typedef float f32x16 __attribute__((ext_vector_type(16)));
typedef short bf16x8 __attribute__((ext_vector_type(8)));
typedef GAS unsigned gu32;
typedef LAS unsigned char* lptr;
#define RLX_AGENT __ATOMIC_RELAXED, __HIP_MEMORY_SCOPE_AGENT
#define LDS_WAIT() asm volatile("s_waitcnt lgkmcnt(0)" ::: "memory")
#define VM_WAIT() asm volatile("s_waitcnt vmcnt(0)" ::: "memory")
__device__ __forceinline__ unsigned f2bf(float f) { unsigned u = __builtin_bit_cast(unsigned, f); return (u + 0x7fffu + ((u >> 16) & 1u)) >> 16; }
typedef float f32x2_t __attribute__((ext_vector_type(2))); typedef __bf16 bf16x2_t __attribute__((ext_vector_type(2)));
__device__ __forceinline__ unsigned pk2(float lo, float hi) { f32x2_t v = {lo, hi}; bf16x2_t b = __builtin_convertvector(v, bf16x2_t); return __builtin_bit_cast(unsigned, b); }
__device__ __forceinline__ float bflo(unsigned w) { return __builtin_bit_cast(float, w << 16); }
__device__ __forceinline__ float bfhi(unsigned w) { return __builtin_bit_cast(float, w & 0xffff0000u); }
__device__ __forceinline__ float bf2f(bf16 v) { return __builtin_bit_cast(float, (unsigned)v << 16); }
__device__ __forceinline__ float lx_idx(float v, int src) { return __builtin_bit_cast(float, __builtin_amdgcn_ds_bpermute(src << 2, __builtin_bit_cast(int, v))); }
__device__ __forceinline__ float lx_xor(float v, int mask, int lane) { return lx_idx(v, lane ^ mask); }
__device__ __forceinline__ float lx_up(float v, int d, int lane) { return lx_idx(v, lane >= d ? lane - d : lane); }
__device__ __forceinline__ float wave_sum(float v, int lane) {
#pragma unroll
    for (int o = 1; o < 64; o <<= 1) v += lx_xor(v, o, lane);
    return v;
}
#define MFMA32(a, b, c) __builtin_amdgcn_mfma_f32_32x32x16_bf16((a), (b), (c), 0, 0, 0)
#define MFMA16(a, b, c) __builtin_amdgcn_mfma_f32_16x16x32_bf16((a), (b), (c), 0, 0, 0)
__device__ __forceinline__ int tid_opaque() { int t = threadIdx.x; asm volatile("" : "+v"(t)); return t; }
__device__ __forceinline__ bf16x8 lds8(lptr p) { return *(const LAS bf16x8*)p; }
__device__ __forceinline__ v4u gld16(const void* base, unsigned off) { return *(const v4u*)((const char*)base + off); }
__device__ __forceinline__ void gst8(void* base, unsigned off, v2u v) { *(v2u*)((char*)base + off) = v; }
typedef short v4i16 __attribute__((ext_vector_type(4)));
__device__ __forceinline__ bf16x8 opr(lptr img, int ldb, int r0, int k0, int c16, int rg) { return lds8(img + (r0 + c16) * ldb + (k0 + 8 * rg) * 2); }
__device__ __forceinline__ bf16x8 opt(lptr img, int ldb, int r0, int k0, int lane) {
    const int g = lane >> 4, q = (lane & 15) >> 2, p = lane & 3;
    lptr a = img + (k0 + 8 * g + q) * ldb + (r0 + 4 * p) * 2;
    const v4i16 lo = __builtin_amdgcn_ds_read_tr16_b64_v4i16((LAS v4i16*)a);
    const v4i16 hi = __builtin_amdgcn_ds_read_tr16_b64_v4i16((LAS v4i16*)(a + 4 * ldb));
    return __builtin_shufflevector(lo, hi, 0, 1, 2, 3, 4, 5, 6, 7);
}

#define XB_TMO      128
#define XB_XCNT(j)  (256  + 64 * (j))
#define XB_XSUB(j)  (1280 + 64 * (j))
#define XB_XGEN(j)  (2304 + 64 * (j))
#define XB_TOP      3328
#define XB_TOPGEN   3392
#define XCD_BAR_WORDS 3456
#define XB_SPIN_CAP (1u << 18)

__device__ __forceinline__ unsigned xb_ld(unsigned* p)              { return __hip_atomic_load(p, __ATOMIC_RELAXED, __HIP_MEMORY_SCOPE_AGENT); }
__device__ __forceinline__ unsigned xb_add(unsigned* p, unsigned v) { return __hip_atomic_fetch_add(p, v, __ATOMIC_RELAXED, __HIP_MEMORY_SCOPE_AGENT); }
__device__ __forceinline__ unsigned xb_xcc_id() { return (unsigned)__builtin_amdgcn_s_getreg((3 << 11) | 20) & 0xFu; }
#define XB_SPIN(cond, bar) do { unsigned _sp = 0; while (cond) { __builtin_amdgcn_s_sleep(1); \
    if ((++_sp & 255u) == 0u) { if (xb_ld(&(bar)[XB_TMO])) break; if (_sp > XB_SPIN_CAP) { atomicAdd(&(bar)[XB_TMO], 1u); break; } } } } while (0)

struct XcdBarrier {
    unsigned* bar; unsigned x;
    volatile LAS unsigned* st;
};

__device__ __forceinline__ XcdBarrier xcd_barrier_post(unsigned* bar, volatile LAS unsigned* st) {
    XcdBarrier b; b.bar = bar; b.x = xb_xcc_id(); b.st = st;
    if (threadIdx.x == 0) (void)xb_add(&bar[XB_XCNT(b.x)], 1u);
    return b;
}
__device__ __forceinline__ void xcd_barrier_complete(unsigned* bar, unsigned x, unsigned& nloc, unsigned& nx) {
    const unsigned G = gridDim.x * gridDim.y * gridDim.z;
    unsigned sum, cnt, mine, sp = 0u;
    for (;;) {
        sum = 0u; cnt = 0u; mine = 0u;
#pragma unroll
        for (unsigned j = 0; j < 16; ++j) { const unsigned c = xb_ld(&bar[XB_XCNT(j)]); sum += c; cnt += (c > 0u) ? 1u : 0u; mine = (j == x) ? c : mine; }
        if (sum == G) break;
        __builtin_amdgcn_s_sleep(1);
        if ((++sp & 255u) == 0u) { if (xb_ld(&bar[XB_TMO])) break; if (sp > XB_SPIN_CAP) { atomicAdd(&bar[XB_TMO], 1u); break; } }
    }
    nloc = mine > 0u ? mine : 1u; nx = cnt > 0u ? cnt : 1u;
}

__device__ __forceinline__ void xcd_barrier(const XcdBarrier& b) {
    asm volatile("s_waitcnt vmcnt(0)" ::: "memory");
    __syncthreads();
    if (threadIdx.x == 0) {
        unsigned* bar = b.bar;
        __builtin_amdgcn_s_waitcnt(0);
        unsigned nloc = b.st[0], nx = b.st[1];
        if (nloc == 0u) { xcd_barrier_complete(bar, b.x, nloc, nx); b.st[0] = nloc; b.st[1] = nx; }
        const unsigned old = xb_add(&bar[XB_XSUB(b.x)], 1u);
        const unsigned gen = old / nloc;
        if (old + 1u == (gen + 1u) * nloc) {
            __builtin_amdgcn_fence(__ATOMIC_RELEASE, "agent");
            asm volatile("s_waitcnt vmcnt(0)" ::: "memory");
            const unsigned og = xb_add(&bar[XB_TOP], 1u);
            const unsigned tg = og / nx;
            if (og + 1u == (tg + 1u) * nx) xb_add(&bar[XB_TOPGEN], 1u);
            else XB_SPIN(xb_ld(&bar[XB_TOPGEN]) == tg, bar);
            __builtin_amdgcn_fence(__ATOMIC_ACQUIRE, "agent");
            xb_add(&bar[XB_XGEN(b.x)], 1u);
            asm volatile("s_waitcnt vmcnt(0)" ::: "memory");
        } else {
            XB_SPIN(xb_ld(&bar[XB_XGEN(b.x)]) == gen, bar);
            __builtin_amdgcn_fence(__ATOMIC_ACQUIRE, "agent");
            asm volatile("s_waitcnt vmcnt(0)" ::: "memory");
        }
    }
    __syncthreads();
}


struct Args { const float* in[22]; float* out; unsigned char* ws; int ph_lo, ph_hi; };
enum { I_X = 0, I_C, I_CTX, I_CCTX, I_WADA, I_BADA, I_GPREMIX, I_GPOSTMIX, I_GPREFFN, I_GPOSTFFN, I_WIN, I_BIN, I_WOUT, I_MLFB, I_MLNORM, I_HGLB, I_HGNORM, I_DALAM, I_DANORM, I_WG, I_WU, I_WD };

__host__ __device__ __forceinline__ int perm_in_col(int n) { if (n < C_DAQ || n >= C_DAV) return n; const int d = (n - C_DAQ) % 48, base = n - d, half = d / 24, e = d % 24; return base + 24 * half + 2 * (e % 12) + (e >= 12 ? 1 : 0); }
__device__ __forceinline__ int wg_pull(unsigned* ctr, volatile LAS int* slot) {
    __syncthreads();
    if (threadIdx.x == 0) *slot = (int)__hip_atomic_fetch_add(ctr, 1u, RLX_AGENT);
    __syncthreads();
    return __builtin_amdgcn_readfirstlane(*slot);
}

typedef __attribute__((address_space(4))) const Args* kargs_p;
__device__ __forceinline__ void p0_phase(lptr lds, kargs_p ap) {
    struct { const float* in[22]; unsigned char* ws; } a; a.in[I_C] = ap->in[I_C]; a.in[I_CCTX] = ap->in[I_CCTX]; a.in[I_WADA] = ap->in[I_WADA]; a.in[I_BADA] = ap->in[I_BADA]; a.in[I_HGLB] = ap->in[I_HGLB]; a.in[I_BIN] = ap->in[I_BIN]; a.in[I_DALAM] = ap->in[I_DALAM]; a.ws = ap->ws;
    const int tid = tid_opaque();
    unsigned char* ws = a.ws;
    LAS float* sil = (LAS float*)lds;
    LAS float* part = (LAS float*)(lds + 69632);
    for (int i = tid; i < 17 * D; i += NTHR) { const int bb = i >> 10, k = i & 1023; const float v = bb < 16 ? a.in[I_C][bb * D + k] : a.in[I_CCTX][k]; sil[i] = v / (1.0f + __expf(-v)); }
    __syncthreads();
    float* mod = (float*)(ws + WS_MOD);
    for (int u = blockIdx.x; u < DEPTH * (NMOD / 32); u += gridDim.x) {
        const int l = u / (NMOD / 32), n0 = (u % (NMOD / 32)) * 32, col = tid & 31, ks = tid >> 5;
        const float* w = a.in[I_WADA] + (size_t)l * D * NMOD + (size_t)(ks * 64) * NMOD + n0 + col;
        float acc[17];
#pragma unroll
        for (int bb = 0; bb < 17; ++bb) acc[bb] = 0.f;
        for (int k = 0; k < 64; k += 4) {
            const float w0 = w[(size_t)k * NMOD], w1 = w[(size_t)(k + 1) * NMOD], w2 = w[(size_t)(k + 2) * NMOD], w3 = w[(size_t)(k + 3) * NMOD];
#pragma unroll
            for (int bb = 0; bb < 17; ++bb) { const f32x4 s = *(const LAS f32x4*)(sil + bb * D + ks * 64 + k); acc[bb] += s[0] * w0 + s[1] * w1 + s[2] * w2 + s[3] * w3; }
        }
#pragma unroll
        for (int bb = 0; bb < 17; ++bb) part[(ks * 17 + bb) * 32 + col] = acc[bb];
        __syncthreads();
        for (int i = tid; i < 17 * 32; i += NTHR) { const int bb = i >> 5, cc = i & 31; float s = 0.f;
#pragma unroll
            for (int k2 = 0; k2 < 16; ++k2) s += part[(k2 * 17 + bb) * 32 + cc];
            mod[((size_t)l * 17 + bb) * NMOD + n0 + cc] = s + a.in[I_BADA][l * NMOD + n0 + cc]; }
        __syncthreads();
    }
    const int gt = blockIdx.x * NTHR + tid, GT = gridDim.x * NTHR;
    float* lbs = (float*)(ws + WS_MISC); float* rope = (float*)(ws + WS_MISC + 16384); float* biasp = (float*)(ws + WS_MISC + 32768); float* lamv = (float*)(ws + WS_MISC + 114688);
    for (int j = gt; j < 1024; j += GT) { const float* hl = a.in[I_HGLB];
        const float v0 = hl[j], v1 = hl[1024 + j], v2 = hl[2048 + j], v3 = hl[3072 + j]; const float mx = fmaxf(fmaxf(v0, v1), fmaxf(v2, v3));
        const float e0 = expf(v0 - mx), e1 = expf(v1 - mx), e2 = expf(v2 - mx), e3 = expf(v3 - mx), inv = 1.0f / (e0 + e1 + e2 + e3);
        lbs[j] = 0.f; lbs[1024 + j] = e1 * inv; lbs[2048 + j] = (e1 + e2) * inv; lbs[3072 + j] = (e1 + e2 + e3) * inv; }
    for (int j = gt; j < 64 * 12; j += GT) { const int pos = j / 12, i = j % 12; const float inv = powf(10000.0f, -(float)(2 * i) / 24.0f); const float ang = (float)pos * inv; rope[2 * j] = cosf(ang); rope[2 * j + 1] = sinf(ang); }
    for (int j = gt; j < DEPTH * DINP; j += GT) { const int l = j / DINP, n = j % DINP; biasp[l * DINP + perm_in_col(n)] = n < DIN ? a.in[I_BIN][l * DIN + n] : 0.f; }
    if (gt < DEPTH) { const float* lv = a.in[I_DALAM] + gt * 4 * 48; float s01 = 0.f, s23 = 0.f;
        for (int d = 0; d < 48; ++d) { s01 += lv[d] * lv[48 + d]; s23 += lv[96 + d] * lv[144 + d]; }
        const float lam_init = 0.8f - 0.6f * expf(-0.3f * (float)gt);
        lamv[gt] = expf(s01) - expf(s23) + lam_init; }
}

template <bool RES, bool NORM>
__device__ __forceinline__ void thin_phase(int row_lo, const float* xs_lat, const float* xs_ctx, float* xd_lat, float* xd_ctx, bool write_x,
                                           const bf16* y, const float* mod_r, int goff, const float* gpost,
                                           const float* mod_n, int soff, int aoff, const float* gpre, bf16* hout, int vcu, int G, int probe = 0) {
    const int tid = tid_opaque(); const int lane = tid & 63, wave = __builtin_amdgcn_readfirstlane(tid >> 6);
    const int nrows = MT - row_lo; int rwg = (nrows + G - 1) / G; rwg += rwg & 1;
    const int wbeg = row_lo + vcu * rwg, rend = (wbeg + rwg < MT) ? wbeg + rwg : MT;
    const int rbeg = wbeg + 2 * wave;
    constexpr int RSTEP = 2 * NWAVES;
    int cur_bb = -1;
    f32x4 gp[4], ga[4], sh[4];
#pragma unroll
    for (int j = 0; j < 4; ++j) { gp[j] = (f32x4){0.f, 0.f, 0.f, 0.f}; ga[j] = gp[j]; sh[j] = gp[j]; }
    f32x4 xa[2][4], ya[2][4];
#define TH_LOAD(X, Y, r_) do { _Pragma("unroll") for (int q_ = 0; q_ < 2; ++q_) { const int rr_ = (r_) + q_; const bool ic_ = rr_ < MC; \
        const float* xs_ = ic_ ? xs_ctx + (size_t)rr_ * D : xs_lat + (size_t)(rr_ - MC) * D; \
        _Pragma("unroll") for (int j_ = 0; j_ < 4; ++j_) { X[q_][j_] = *(const f32x4*)(xs_ + 4 * lane + 256 * j_); if (RES) { const v2u yw_ = *(const v2u*)(y + (size_t)rr_ * D + 4 * lane + 256 * j_); Y[q_][j_] = (f32x4){bflo(yw_.x), bfhi(yw_.x), bflo(yw_.y), bfhi(yw_.y)}; } } } } while (0)
    if (rbeg < rend) TH_LOAD(xa, ya, rbeg);
    for (int r = rbeg; r < rend; r += RSTEP) {
        f32x4 xb[2][4], yb[2][4];
        if (r + RSTEP < rend) TH_LOAD(xb, yb, r + RSTEP);
        const bool isctx = r < MC; const int bb = isctx ? 16 : (r - MC) / SEQ;
        if (bb != cur_bb) { cur_bb = bb;
#pragma unroll
            for (int j = 0; j < 4; ++j) { const int e = 4 * lane + 256 * j;
                if (RES) gp[j] = *(const f32x4*)(mod_r + (size_t)bb * NMOD + goff + e) * *(const f32x4*)(gpost + e);
                if (NORM) { ga[j] = *(const f32x4*)(gpre + e) * (*(const f32x4*)(mod_n + (size_t)bb * NMOD + aoff + e) + 1.0f); sh[j] = *(const f32x4*)(mod_n + (size_t)bb * NMOD + soff + e); } } }
        if (RES) { float s0 = 0.f, s1 = 0.f;
#pragma unroll
            for (int j = 0; j < 4; ++j) { s0 += (ya[0][j][0] * ya[0][j][0] + ya[0][j][1] * ya[0][j][1]) + (ya[0][j][2] * ya[0][j][2] + ya[0][j][3] * ya[0][j][3]);
                                          s1 += (ya[1][j][0] * ya[1][j][0] + ya[1][j][1] * ya[1][j][1]) + (ya[1][j][2] * ya[1][j][2] + ya[1][j][3] * ya[1][j][3]); }
#pragma unroll
            for (int o = 1; o < 64; o <<= 1) { s0 += lx_xor(s0, o, lane); s1 += lx_xor(s1, o, lane); }
            const float r0s = 1.0f / sqrtf(s0 * (1.0f / D) + EPS), r1s = 1.0f / sqrtf(s1 * (1.0f / D) + EPS);
#pragma unroll
            for (int j = 0; j < 4; ++j) { xa[0][j] += gp[j] * ya[0][j] * r0s; xa[1][j] += gp[j] * ya[1][j] * r1s; } }
        float* xd0 = isctx ? xd_ctx + (size_t)r * D : xd_lat + (size_t)(r - MC) * D;
        if (write_x && !(probe & 1)) {
#pragma unroll
            for (int j = 0; j < 4; ++j) { *(f32x4*)(xd0 + 4 * lane + 256 * j) = xa[0][j]; *(f32x4*)(xd0 + D + 4 * lane + 256 * j) = xa[1][j]; } }
        if (NORM) { float s0 = 0.f, s1 = 0.f;
#pragma unroll
            for (int j = 0; j < 4; ++j) { s0 += (xa[0][j][0] * xa[0][j][0] + xa[0][j][1] * xa[0][j][1]) + (xa[0][j][2] * xa[0][j][2] + xa[0][j][3] * xa[0][j][3]);
                                          s1 += (xa[1][j][0] * xa[1][j][0] + xa[1][j][1] * xa[1][j][1]) + (xa[1][j][2] * xa[1][j][2] + xa[1][j][3] * xa[1][j][3]); }
#pragma unroll
            for (int o = 1; o < 64; o <<= 1) { s0 += lx_xor(s0, o, lane); s1 += lx_xor(s1, o, lane); }
            const float r0s = 1.0f / sqrtf(s0 * (1.0f / D) + EPS), r1s = 1.0f / sqrtf(s1 * (1.0f / D) + EPS);
#pragma unroll
            for (int j = 0; j < 4; ++j) { const f32x4 h0 = xa[0][j] * r0s * ga[j] + sh[j], h1 = xa[1][j] * r1s * ga[j] + sh[j];
                v2u w0, w1; w0.x = pk2(h0[0], h0[1]); w0.y = pk2(h0[2], h0[3]); w1.x = pk2(h1[0], h1[1]); w1.y = pk2(h1[2], h1[3]);
                if (!(probe & 2)) { *(v2u*)(hout + (size_t)r * D + 4 * lane + 256 * j) = w0; *(v2u*)(hout + (size_t)(r + 1) * D + 4 * lane + 256 * j) = w1; } } }
#pragma unroll
        for (int q = 0; q < 2; ++q)
#pragma unroll
            for (int j = 0; j < 4; ++j) { xa[q][j] = xb[q][j]; if (RES) ya[q][j] = yb[q][j]; }
    }
#undef TH_LOAD
}

template <int MODE>
__device__ __forceinline__ void tr_item(const float* W, int K, int N, int nblk, bf16* WT, LAS float* scr, int item, int lane) {
    const int kb = item / nblk, nb = item % nblk, k0 = 64 * kb, n0 = 32 * nb;
    const int nn = n0 + (lane & 31); const bool ok = nn < N;
#pragma unroll 8
    for (int i = 0; i < 32; ++i) { const int kk = 2 * i + (lane >> 5); scr[kk * 33 + (lane & 31)] = ok ? W[(size_t)(k0 + kk) * N + nn] : 0.f; }
    LDS_WAIT(); asm volatile("" ::: "memory");
    const int c = lane & 7;
#pragma unroll
    for (int j = 0; j < 4; ++j) { const int n = (lane >> 3) + 8 * j; const LAS float* s = scr + (8 * c) * 33 + n;
        v4u o; o.x = pk2(s[0 * 33], s[1 * 33]); o.y = pk2(s[2 * 33], s[3 * 33]); o.z = pk2(s[4 * 33], s[5 * 33]); o.w = pk2(s[6 * 33], s[7 * 33]);
        const int ng = n0 + n; const int drow = MODE == 0 ? ng : MODE == 3 ? perm_in_col(ng) : ((ng >> 7) * 256 + (ng & 127) + (MODE == 2 ? 128 : 0));
        *(v4u*)(WT + (size_t)drow * K + k0 + 8 * c) = o; }
    LDS_WAIT(); asm volatile("" ::: "memory");
}
__device__ __forceinline__ void convert_weights(lptr lds, kargs_p ap, int l, int vcu, int G) {
    const unsigned char* const wsb = ap->ws; const float* const p_win = ap->in[I_WIN]; const float* const p_wout = ap->in[I_WOUT]; const float* const p_wg = ap->in[I_WG]; const float* const p_wu = ap->in[I_WU]; const float* const p_wd = ap->in[I_WD];
    const int tid = tid_opaque(); const int lane = tid & 63, wave = __builtin_amdgcn_readfirstlane(tid >> 6);
    LAS float* scr = (LAS float*)(lds + wave * 8448);
    const int gw = vcu * NWAVES + wave, NGW = G * NWAVES;
    unsigned char* ws = (unsigned char*)wsb;
    constexpr int I_IN = 16 * (DINP / 32), I_OUT = 16 * 32, I_GU = 16 * (DFF / 32), I_DN = (DFF / 64) * 32;
    constexpr int NITEMS = I_IN + I_OUT + 2 * I_GU + I_DN;
    for (int it = gw; it < NITEMS; it += NGW) {
        int r = it;
        if (r < I_IN) { tr_item<3>(p_win + (size_t)l * D * DIN, D, DIN, DINP / 32, (bf16*)(ws + WS_WIN), scr, r, lane); continue; } r -= I_IN;
        if (r < I_OUT) { tr_item<0>(p_wout + (size_t)l * D * D, D, D, 32, (bf16*)(ws + WS_WOUT), scr, r, lane); continue; } r -= I_OUT;
        if (r < I_GU) { tr_item<1>(p_wg + (size_t)l * D * DFF, D, DFF, DFF / 32, (bf16*)(ws + WS_WGU), scr, r, lane); continue; } r -= I_GU;
        if (r < I_GU) { tr_item<2>(p_wu + (size_t)l * D * DFF, D, DFF, DFF / 32, (bf16*)(ws + WS_WGU), scr, r, lane); continue; } r -= I_GU;
        tr_item<0>(p_wd + (size_t)l * DFF * D, DFF, D, 32, (bf16*)(ws + WS_WD), scr, r, lane);
    }
}
constexpr int AT_BUF = 25600, AT_KOFF = 0, AT_VOFF = 13312, AT_QF = 76800;
constexpr float AT_THR = 8.0f;
constexpr float QSCALE = 0.14433756729740643f * 1.4426950408889634f;

__device__ __forceinline__ f32x16 zero16() { f32x16 z; _Pragma("unroll") for (int r = 0; r < 16; ++r) z[r] = 0.f; return z; }
__device__ __forceinline__ float sm_max(const f32x16& S, int lane) {
    float mx = S[0];
#pragma unroll
    for (int r = 1; r < 16; ++r) mx = fmaxf(mx, S[r]);
    return fmaxf(mx, lx_xor(mx, 32, lane));
}
__device__ __forceinline__ void sm_exp(const f32x16& S, float m, float& l, bf16x8& p0, bf16x8& p1) {
    float p[16]; float ps = 0.f;
#pragma unroll
    for (int r = 0; r < 16; ++r) { p[r] = __builtin_amdgcn_exp2f(S[r] - m); ps += p[r]; }
    l += ps;
    v4u a, b;
    a.x = pk2(p[0], p[1]); a.y = pk2(p[2], p[3]); a.z = pk2(p[4], p[5]); a.w = pk2(p[6], p[7]);
    b.x = pk2(p[8], p[9]); b.y = pk2(p[10], p[11]); b.z = pk2(p[12], p[13]); b.w = pk2(p[14], p[15]);
    p0 = __builtin_bit_cast(bf16x8, a); p1 = __builtin_bit_cast(bf16x8, b);
}
__device__ __forceinline__ bf16x8 vt_frag(lptr vt, int ct, int sub, int sp, int lane) {
    const int h = lane >> 5, blk = (lane >> 4) & 1, q = (lane & 15) >> 2, p = lane & 3;
    lptr a = vt + (32 * sub + 16 * sp + 4 * h + q) * 192 + (32 * ct + 16 * blk + 4 * p) * 2;
    const v4i16 lo = __builtin_amdgcn_ds_read_tr16_b64_v4i16((LAS v4i16*)a);
    const v4i16 hi = __builtin_amdgcn_ds_read_tr16_b64_v4i16((LAS v4i16*)(a + 8 * 192));
    return __builtin_shufflevector(lo, hi, 0, 1, 2, 3, 4, 5, 6, 7);
}

__device__ __forceinline__ void attn_item(lptr lds, const bf16* P, bf16* YM, const float* danorm, float lam, float out_scale, int b, int h, int qb, int probe) {
    const int tid = tid_opaque(), lane = tid & 63, r32 = lane & 31, hi = lane >> 5, wave = __builtin_amdgcn_readfirstlane(tid >> 6);
    const bool lat = qb < 8;
    const int qrow0 = lat ? MC + b * SEQ + qb * 256 : b * CTXL;
    const int nt = lat ? 36 : 4;
    v4u kin[2], vin[2];
    const int key0 = tid / 12, cc0 = tid % 12, key1 = (tid + 512) / 12, cc1 = (tid + 512) % 12;
#define AT_TILE_ROW0(tile) (((tile) < 4) ? (b * CTXL + 64 * (tile)) : (MC + b * SEQ + 64 * ((tile) - 4)))
#define AT_LOAD(tile) do { const int row0_ = AT_TILE_ROW0(tile); \
        { const unsigned s_ = (unsigned)(row0_ + key0) * (unsigned)(DINP * 2) + (unsigned)(h * 96 + cc0 * 8) * 2u; kin[0] = gld16(P, s_ + C_DAK * 2u); vin[0] = gld16(P, s_ + C_DAV * 2u); } \
        if (tid < 256) { const unsigned s_ = (unsigned)(row0_ + key1) * (unsigned)(DINP * 2) + (unsigned)(h * 96 + cc1 * 8) * 2u; kin[1] = gld16(P, s_ + C_DAK * 2u); vin[1] = gld16(P, s_ + C_DAV * 2u); } } while (0)
#define AT_STORE(tile, buf) do { lptr kd_ = lds + (buf) * AT_BUF + AT_KOFF, vd_ = lds + (buf) * AT_BUF + AT_VOFF; \
        *(LAS v4u*)(kd_ + key0 * 208 + cc0 * 16) = kin[0]; *(LAS v4u*)(vd_ + key0 * 192 + cc0 * 16) = vin[0]; \
        if (tid < 256) { *(LAS v4u*)(kd_ + key1 * 208 + cc1 * 16) = kin[1]; *(LAS v4u*)(vd_ + key1 * 192 + cc1 * 16) = vin[1]; } } while (0)
    AT_LOAD(0);
    lptr qfp = lds + AT_QF + (wave * 6 * 64 + lane) * 16;
    { const unsigned qo = (unsigned)(qrow0 + wave * 32 + r32) * (unsigned)(DINP * 2) + (unsigned)(C_DAQ + h * 96 + hi * 8) * 2u;
#pragma unroll
      for (int f = 0; f < 6; ++f) *(LAS v4u*)(qfp + f * 1024) = gld16(P, qo + (unsigned)((f / 3) * 48 + (f % 3) * 16) * 2u); }
    AT_STORE(0, 0);
    if (nt > 1) AT_LOAD(1);
    __syncthreads();
    f32x16 O0[3], O1[3];
#pragma unroll
    for (int ct = 0; ct < 3; ++ct)
#pragma unroll
        for (int r = 0; r < 16; ++r) { O0[ct][r] = 0.f; O1[ct][r] = 0.f; }
    float m0 = -1e30f, m1 = -1e30f, l0 = 0.f, l1 = 0.f;
#define AT_QK(SX0, SX1, kb, sub) do { \
        _Pragma("unroll") for (int ks = 0; ks < 3; ++ks) { \
            const bf16x8 k0_ = lds8((kb) + (((sub) * 32 + r32) * 104 + ks * 16 + hi * 8) * 2); \
            const bf16x8 k1_ = lds8((kb) + (((sub) * 32 + r32) * 104 + 48 + ks * 16 + hi * 8) * 2); \
            const bf16x8 q0_ = lds8(qfp + ks * 1024), q1_ = lds8(qfp + (3 + ks) * 1024); \
            if (ks == 0) { SX0 = MFMA32(k0_, q0_, zero16()); SX1 = MFMA32(k1_, q1_, zero16()); } \
            else { SX0 = MFMA32(k0_, q0_, SX0); SX1 = MFMA32(k1_, q1_, SX1); } } } while (0)
#define AT_SMPV(SX0, SX1, vb, sub) do { \
        const float mx0_ = sm_max(SX0, lane), mx1_ = sm_max(SX1, lane); \
        if (__any((mx0_ > m0 + AT_THR) || (mx1_ > m1 + AT_THR))) { \
            const float n0_ = fmaxf(m0, mx0_), n1_ = fmaxf(m1, mx1_); \
            const float a0_ = __builtin_amdgcn_exp2f(m0 - n0_), a1_ = __builtin_amdgcn_exp2f(m1 - n1_); \
            m0 = n0_; m1 = n1_; l0 *= a0_; l1 *= a1_; \
            _Pragma("unroll") for (int ct = 0; ct < 3; ++ct) _Pragma("unroll") for (int r = 0; r < 16; ++r) { O0[ct][r] *= a0_; O1[ct][r] *= a1_; } } \
        bf16x8 p00_, p01_, p10_, p11_; \
        sm_exp(SX0, m0, l0, p00_, p01_); sm_exp(SX1, m1, l1, p10_, p11_); \
        _Pragma("unroll") for (int ct = 0; ct < 3; ++ct) { \
            const bf16x8 v0_ = vt_frag((vb), ct, (sub), 0, lane); const bf16x8 v1_ = vt_frag((vb), ct, (sub), 1, lane); \
            O0[ct] = MFMA32(v0_, p00_, O0[ct]); O1[ct] = MFMA32(v0_, p10_, O1[ct]); \
            O0[ct] = MFMA32(v1_, p01_, O0[ct]); O1[ct] = MFMA32(v1_, p11_, O1[ct]); } } while (0)
    f32x16 SA0, SA1, SB0, SB1;
    AT_QK(SA0, SA1, lds + AT_KOFF, 0);
    int cb = 0;
    for (int i = 0; i < nt; ++i) {
        const int nb = (cb == 2) ? 0 : cb + 1;
        if (i + 1 < nt && !(probe & 2)) AT_STORE(i + 1, nb);
        if (i + 2 < nt && !(probe & 1)) AT_LOAD(i + 2);
        lptr kc_ = lds + cb * AT_BUF + AT_KOFF, vc_ = lds + cb * AT_BUF + AT_VOFF;
        AT_QK(SB0, SB1, kc_, 1);
        AT_SMPV(SA0, SA1, vc_, 0);
        __syncthreads();
        if (i + 1 < nt) AT_QK(SA0, SA1, lds + nb * AT_BUF + AT_KOFF, 0);
        AT_SMPV(SB0, SB1, vc_, 1);
        cb = nb;
    }
#undef AT_TILE_ROW0
#undef AT_LOAD
#undef AT_STORE
#undef AT_QK
#undef AT_SMPV
    const float i0 = 1.0f / (l0 + lx_xor(l0, 32, lane)), i1 = lam / (l1 + lx_xor(l1, 32, lane));
    float ss = 0.f;
#pragma unroll
    for (int ct = 0; ct < 3; ++ct)
#pragma unroll
        for (int r = 0; r < 16; ++r) { const float o = O0[ct][r] * i0 - O1[ct][r] * i1; O0[ct][r] = o; ss += o * o; }
    ss += lx_xor(ss, 32, lane);
    const float rs = out_scale / sqrtf(ss * (1.0f / 96.0f) + EPS);
    const unsigned oro = ((unsigned)(qrow0 + wave * 32 + r32) * (unsigned)D + (unsigned)(Y_DA + h * 96)) * 2u;
#pragma unroll
    for (int ct = 0; ct < 3; ++ct)
#pragma unroll
        for (int g = 0; g < 4; ++g) { const int c0 = 32 * ct + 8 * g + 4 * hi; const f32x4 gn = *(const f32x4*)(danorm + c0);
            v2u w; w.x = pk2(O0[ct][4 * g] * rs * gn[0], O0[ct][4 * g + 1] * rs * gn[1]); w.y = pk2(O0[ct][4 * g + 2] * rs * gn[2], O0[ct][4 * g + 3] * rs * gn[3]);
            gst8(YM, oro + 2u * c0, w); }
}
__device__ __forceinline__ int scan_row(int b, int dir, int p) {
    if (p < CTXL) { const int t = dir ? CTXL - 1 - p : p; return b * CTXL + t; }
    const int pl = p - CTXL; const int t = dir ? SEQ - 1 - pl : pl; return MC + b * SEQ + t;
}

constexpr int ML_Q = 0, ML_K = 13312, ML_KW = 26624, ML_VA = 40960, ML_QKM = 55296, ML_ST = 64512, ML_GF = 87808;
constexpr int ML_LDQ = 208, ML_LDW = 224, ML_LDM = 144, ML_LDS = 208;
constexpr float KSCALE = 0.10206207261596577f;

__device__ __forceinline__ void mlstm_stream(lptr lds, const bf16* P, const float* G, bf16* dst, int dst_ld, const float* fbias  , int b, int h, int dir) {
    const int tid = tid_opaque(), lane = tid & 63, c16 = lane & 15, rg = lane >> 4, wave = __builtin_amdgcn_readfirstlane(tid >> 6);
    lptr Qs = lds + ML_Q, Ks = lds + ML_K, Kw = lds + ML_KW, Va = lds + ML_VA, QKM = lds + ML_QKM, ST = lds + ML_ST;
    LAS float* gA = (LAS float*)(lds + ML_GF); LAS float* MxA = gA + 64; LAS float* wA = gA + 128; LAS float* emtA = gA + 192; LAS float* wkA = gA + 256; LAS float* scal = gA + 320;
    if (tid < 128) { const int t = tid >> 1, hh = tid & 1; v4u w; w.x = hh ? 0u : 0x3F80u; w.y = 0u; w.z = 0u; w.w = 0u; *(LAS v4u*)(Va + t * ML_LDW + (96 + 8 * hh) * 2) = w; }
    const float fb = fbias[dir * 4 + h];
    f32x4 acc[11];
#pragma unroll
    for (int i = 0; i < 11; ++i) acc[i] = (f32x4){0.f, 0.f, 0.f, 0.f};
    float m_prev = -1e30f;
    v4u pre[5]; float gi = 0.f, gf = 0.f;
#define ML_PREFETCH(c) do { \
    _Pragma("unroll") for (int i_ = 0; i_ < 5; ++i_) { const int id_ = tid + NTHR * i_; if (id_ < 2304) { const int t_ = id_ / 36, r_ = id_ % 36, wh_ = r_ / 12, cc_ = r_ % 12; \
        const unsigned ro_ = (unsigned)scan_row(b, dir, 64 * (c) + t_) * (unsigned)(DINP * 2); pre[i_] = gld16(P, ro_ + (unsigned)(wh_ * 384 + h * 96 + cc_ * 8) * 2u); } } \
    if (wave == 0) { const unsigned go_ = (unsigned)scan_row(b, dir, 64 * (c) + lane) * 64u + (unsigned)(dir * 4 + h) * 4u; gi = *(const float*)((const char*)G + go_); gf = *(const float*)((const char*)G + go_ + 32u); } } while (0)
    ML_PREFETCH(0);
    for (int c = 0; c < NTOK / 64; ++c) {
#pragma unroll
        for (int i = 0; i < 5; ++i) { const int id = tid + NTHR * i; if (id < 2304) { const int t = id / 36, r = id % 36, wh = r / 12, cc = r % 12;
            lptr d = (wh == 0) ? Qs + t * ML_LDQ : (wh == 1) ? Ks + t * ML_LDQ : Va + t * ML_LDW;
            *(LAS v4u*)(d + cc * 16) = pre[i]; } }
        if (wave == 0) {
            const float fp = gf + fb;
            const float lf = fminf(fp, 0.f) - log1pf(__expf(-fabsf(fp)));
            float bs = lf;
#pragma unroll
            for (int o = 1; o < 64; o <<= 1) { const float v = lx_up(bs, o, lane); if (lane >= o) bs += v; }
            const float g = gi - bs;
            float cm = g;
#pragma unroll
            for (int o = 1; o < 64; o <<= 1) { const float v = lx_up(cm, o, lane); if (lane >= o) cm = fmaxf(cm, v); }
            const float Mx = fmaxf(m_prev, cm);
            const float mt = bs + Mx;
            const float blast = lx_idx(bs, 63), m_new = lx_idx(mt, 63);
            gA[lane] = g; MxA[lane] = Mx; wA[lane] = __expf(m_prev - Mx); emtA[lane] = __expf(-mt); wkA[lane] = __expf(g + blast - m_new) * KSCALE;
            if (lane == 0) scal[0] = __expf(blast + m_prev - m_new);
            m_prev = m_new;
        }
        if (c + 1 < NTOK / 64) ML_PREFETCH(c + 1);
        __syncthreads();
#pragma unroll
        for (int j = 0; j < 2; ++j) { const int idx = 2 * wave + j, si = idx & 3, ti = idx >> 2;
            f32x4 a4 = (f32x4){0.f, 0.f, 0.f, 0.f};
            if (si <= ti) {
#pragma unroll
                for (int ks = 0; ks < 3; ++ks) a4 = MFMA16(opr(Ks, ML_LDQ, 16 * si, 32 * ks, c16, rg), opr(Qs, ML_LDQ, 16 * ti, 32 * ks, c16, rg), a4);
            }
            const int t = 16 * ti + c16, s0 = 16 * si + 4 * rg; const float mxt = MxA[t]; const f32x4 g4 = *(const LAS f32x4*)(gA + s0);
            float v[4];
#pragma unroll
            for (int r = 0; r < 4; ++r) v[r] = (s0 + r <= t) ? a4[r] * KSCALE * __expf(g4[r] - mxt) : 0.f;
            v2u w; w.x = pk2(v[0], v[1]); w.y = pk2(v[2], v[3]); *(LAS v2u*)(QKM + t * ML_LDM + s0 * 2) = w; }
        for (int id = tid; id < 64 * 12; id += NTHR) { const int t = id / 12, cc = id % 12; const v4u w = *(const LAS v4u*)(Ks + t * ML_LDQ + cc * 16); const float sc = wkA[t];
            v4u o; o.x = pk2(bflo(w.x) * sc, bfhi(w.x) * sc); o.y = pk2(bflo(w.y) * sc, bfhi(w.y) * sc); o.z = pk2(bflo(w.z) * sc, bfhi(w.z) * sc); o.w = pk2(bflo(w.w) * sc, bfhi(w.w) * sc);
            *(LAS v4u*)(Kw + t * ML_LDW + cc * 16) = o; }
        if (wave >= 4) { const int sw = wave - 4;
#pragma unroll
            for (int i = 0; i < 11; ++i) { const int j = sw + 4 * i; if (j < 42) { const int di = j / 7, vi = j % 7;
                v2u w; w.x = pk2(acc[i][0], acc[i][1]); w.y = pk2(acc[i][2], acc[i][3]); *(LAS v2u*)(ST + (16 * vi + c16) * ML_LDS + (16 * di + 4 * rg) * 2) = w; } } }
        __syncthreads();
        if (wave < 4) {
            const int ti = wave, t = 16 * ti + c16;
            f32x4 aX[7];
#pragma unroll
            for (int vi = 0; vi < 7; ++vi) aX[vi] = (f32x4){0.f, 0.f, 0.f, 0.f};
#pragma unroll
            for (int ks = 0; ks < 3; ++ks) { const bf16x8 b8 = opr(Qs, ML_LDQ, 16 * ti, 32 * ks, c16, rg);
#pragma unroll
                for (int vi = 0; vi < 7; ++vi) aX[vi] = MFMA16(opr(ST, ML_LDS, 16 * vi, 32 * ks, c16, rg), b8, aX[vi]); }
            { const float wt = wA[t];
#pragma unroll
              for (int vi = 0; vi < 7; ++vi) aX[vi] = aX[vi] * wt; }
#pragma unroll
            for (int ks = 0; ks < 2; ++ks) { const bf16x8 b8 = opr(QKM, ML_LDM, 16 * ti, 32 * ks, c16, rg);
#pragma unroll
                for (int vi = 0; vi < 7; ++vi) aX[vi] = MFMA16(opt(Va, ML_LDW, 16 * vi, 32 * ks, lane), b8, aX[vi]); }
            const float den = lx_idx(aX[6][0], c16);
            const float inv = 1.0f / fmaxf(fabsf(den), emtA[t]);
            const int row = scan_row(b, dir, 64 * c + t);
            const unsigned oo = ((unsigned)row * (unsigned)dst_ld + (unsigned)(h * 96 + 4 * rg)) * 2u;
#pragma unroll
            for (int vi = 0; vi < 6; ++vi) { v2u w; w.x = pk2(aX[vi][0] * inv, aX[vi][1] * inv); w.y = pk2(aX[vi][2] * inv, aX[vi][3] * inv); gst8(dst, oo + 32u * vi, w); }
        } else {
            const int sw = wave - 4; const float decay = scal[0];
#pragma unroll
            for (int i = 0; i < 11; ++i) { const int j = sw + 4 * i; if (j < 42) { const int di = j / 7, vi = j % 7;
                acc[i] = acc[i] * decay;
#pragma unroll
                for (int ks = 0; ks < 2; ++ks) acc[i] = MFMA16(opt(Kw, ML_LDW, 16 * di, 32 * ks, lane), opt(Va, ML_LDW, 16 * vi, 32 * ks, lane), acc[i]); } }
        }
        __syncthreads();
    }
#undef ML_PREFETCH
}

constexpr int HG_QT = 0, HG_KR = 8704, HG_V = 17920, HG_ATT = 23040, HG_SPT = 25600, HG_ER = 43008, HG_TOT = 43520;
constexpr int HG_LDQ = 272, HG_LDK = 288, HG_LDV = 160, HG_LDA = 80, HG_LDS = 272;

__device__ __forceinline__ void hgrn2_stream(lptr lds, const bf16* P, bf16* dst, int dst_ld, const float* lbl  , int b, int h, int dir) {
    const int tid = tid_opaque(), lane = tid & 63, c16 = lane & 15, rg = lane >> 4, wave = __builtin_amdgcn_readfirstlane(tid >> 6);
    lptr QT = lds + HG_QT, KR = lds + HG_KR, Vs = lds + HG_V, ATT = lds + HG_ATT, SPT = lds + HG_SPT;
    LAS float* ER = (LAS float*)(lds + HG_ER); LAS float* TOT = (LAS float*)(lds + HG_TOT);
    const int tt = tid >> 4, kc = tid & 15;
    const int tv = tid >> 3, cv = tid & 7;
    float lb[8];
    { const f32x4 l0 = *(const f32x4*)(lbl + dir * 512 + h * 128 + 8 * kc), l1 = *(const f32x4*)(lbl + dir * 512 + h * 128 + 8 * kc + 4);
#pragma unroll
      for (int j = 0; j < 4; ++j) { lb[j] = l0[j]; lb[4 + j] = l1[j]; } }
    f32x4 acc[4];
#pragma unroll
    for (int i = 0; i < 4; ++i) acc[i] = (f32x4){0.f, 0.f, 0.f, 0.f};
    v4u zr, qr, vr;
#define HG_PREFETCH(c) do { { const unsigned ro_ = (unsigned)scan_row(b, dir, 32 * (c) + tt) * (unsigned)(DINP * 2) + 16u * kc; \
        zr = gld16(P, ro_ + (unsigned)(C_HGF + dir * 512 + h * 128) * 2u); qr = gld16(P, ro_ + (unsigned)(C_HGQ + h * 128) * 2u); } \
        if (tid < 256) { const unsigned ro_ = (unsigned)scan_row(b, dir, 32 * (c) + tv) * (unsigned)(DINP * 2) + 16u * cv; vr = gld16(P, ro_ + (unsigned)(C_HGI + h * 64) * 2u); } } while (0)
    HG_PREFETCH(0);
    for (int c = 0; c < NTOK / 32; ++c) {
        float kk[8], cs[8], qv[8];
        { const unsigned zw[4] = {zr.x, zr.y, zr.z, zr.w}, qw[4] = {qr.x, qr.y, qr.z, qr.w};
#pragma unroll
          for (int j = 0; j < 8; ++j) { const float z = (j & 1) ? bfhi(zw[j >> 1]) : bflo(zw[j >> 1]); qv[j] = (j & 1) ? bfhi(qw[j >> 1]) : bflo(qw[j >> 1]);
              const float e = __expf(-fabsf(z)); const float inv = __builtin_amdgcn_rcpf(1.0f + e);
              const float sig = z >= 0.f ? inv : e * inv, nsig = z >= 0.f ? e * inv : inv;
              const float oml = 1.0f - lb[j]; const float f = fmaxf(lb[j], 1e-30f) + oml * sig; kk[j] = oml * nsig;
              float x = __log2f(f);
              float y = lx_up(x, 16, lane); if (lane >= 16) x += y;
              y = lx_up(x, 32, lane); if (lane >= 32) x += y;
              cs[j] = x; } }
        if (tid < 256) *(LAS v4u*)(Vs + tv * HG_LDV + cv * 16) = vr;
        if (lane >= 48) { *(LAS f32x4*)(TOT + wave * 128 + 8 * kc) = (f32x4){cs[0], cs[1], cs[2], cs[3]}; *(LAS f32x4*)(TOT + wave * 128 + 8 * kc + 4) = (f32x4){cs[4], cs[5], cs[6], cs[7]}; }
        __syncthreads();
#pragma unroll
        for (int hf = 0; hf < 2; ++hf) {
            float off[4], tot[4];
#pragma unroll
            for (int j = 0; j < 4; ++j) { off[j] = 0.f; tot[j] = 0.f; }
#pragma unroll
            for (int w2 = 0; w2 < 8; ++w2) { const f32x4 t0 = *(const LAS f32x4*)(TOT + w2 * 128 + 8 * kc + 4 * hf); const float use = (w2 < wave) ? 1.0f : 0.0f;
#pragma unroll
                for (int j = 0; j < 4; ++j) { tot[j] += t0[j]; off[j] += use * t0[j]; } }
            float qt[4], kt[4], er[4];
#pragma unroll
            for (int j = 0; j < 4; ++j) { const float rr = 0.5f * tot[j]; float x = off[j] + cs[4 * hf + j] - rr; x = fminf(fmaxf(x, -100.f), 100.f);
                const float q = qv[4 * hf + j]; const float qs = q * __builtin_amdgcn_rcpf(1.0f + __expf(-q));
                qt[j] = qs * __builtin_amdgcn_exp2f(x); kt[j] = kk[4 * hf + j] * __builtin_amdgcn_exp2f(-x); er[j] = __builtin_amdgcn_exp2f(fmaxf(rr, -100.f)); }
            v2u wq, wk; wq.x = pk2(qt[0], qt[1]); wq.y = pk2(qt[2], qt[3]); wk.x = pk2(kt[0], kt[1]); wk.y = pk2(kt[2], kt[3]);
            *(LAS v2u*)(QT + tt * HG_LDQ + kc * 16 + 8 * hf) = wq; *(LAS v2u*)(KR + tt * HG_LDK + kc * 16 + 8 * hf) = wk;
            if (tid < 16) *(LAS f32x4*)(ER + 8 * kc + 4 * hf) = (f32x4){er[0], er[1], er[2], er[3]};
            asm volatile("" ::: "memory");
        }
        if (c + 1 < NTOK / 32) HG_PREFETCH(c + 1);
        __syncthreads();
        if (wave < 4) { const int si = wave & 1, ti = wave >> 1;
            f32x4 a4 = (f32x4){0.f, 0.f, 0.f, 0.f};
            if (si <= ti) {
#pragma unroll
                for (int ks = 0; ks < 4; ++ks) a4 = MFMA16(opr(KR, HG_LDK, 16 * si, 32 * ks, c16, rg), opr(QT, HG_LDQ, 16 * ti, 32 * ks, c16, rg), a4);
            }
            const int t = 16 * ti + c16, s0 = 16 * si + 4 * rg;
            v2u w; w.x = pk2(s0 <= t ? a4[0] : 0.f, s0 + 1 <= t ? a4[1] : 0.f); w.y = pk2(s0 + 2 <= t ? a4[2] : 0.f, s0 + 3 <= t ? a4[3] : 0.f);
            *(LAS v2u*)(ATT + t * HG_LDA + s0 * 2) = w; }
        { const f32x4 er = *(const LAS f32x4*)(ER + 16 * wave + 4 * rg);
#pragma unroll
          for (int ci = 0; ci < 4; ++ci) { acc[ci] = acc[ci] * er; v2u w; w.x = pk2(acc[ci][0], acc[ci][1]); w.y = pk2(acc[ci][2], acc[ci][3]);
              *(LAS v2u*)(SPT + (16 * ci + c16) * HG_LDS + (16 * wave + 4 * rg) * 2) = w; } }
        __syncthreads();
        { const int ci = wave & 3, ti = wave >> 2, t = 16 * ti + c16;
          f32x4 o4 = (f32x4){0.f, 0.f, 0.f, 0.f};
          o4 = MFMA16(opt(Vs, HG_LDV, 16 * ci, 0, lane), opr(ATT, HG_LDA, 16 * ti, 0, c16, rg), o4);
#pragma unroll
          for (int ks = 0; ks < 4; ++ks) o4 = MFMA16(opr(SPT, HG_LDS, 16 * ci, 32 * ks, c16, rg), opr(QT, HG_LDQ, 16 * ti, 32 * ks, c16, rg), o4);
          const int row = scan_row(b, dir, 32 * c + t);
          v2u w; w.x = pk2(o4[0], o4[1]); w.y = pk2(o4[2], o4[3]);
          gst8(dst, ((unsigned)row * (unsigned)dst_ld + (unsigned)(h * 64 + 16 * ci + 4 * rg)) * 2u, w); }
        { const bf16x8 a8 = opt(KR, HG_LDK, 16 * wave, 0, lane); const f32x4 er = *(const LAS f32x4*)(ER + 16 * wave + 4 * rg);
#pragma unroll
          for (int ci = 0; ci < 4; ++ci) { acc[ci] = MFMA16(a8, opt(Vs, HG_LDV, 16 * ci, 0, lane), acc[ci]); acc[ci] = acc[ci] * er; } }
        __syncthreads();
    }
#undef HG_PREFETCH
}

__device__ __forceinline__ void fin_phase(int row_lo, const bf16* P, bf16* YM, const bf16* RAWM, const bf16* RAWH, const float* mlgain  , const float* hggain  , int vcu, int G) {
    const int tid = tid_opaque(); const int lane = tid & 63, wave = __builtin_amdgcn_readfirstlane(tid >> 6);
    const int gw = vcu * NWAVES + wave, NGW = G * NWAVES;
    float gm[6], gh[4];
#pragma unroll
    for (int j = 0; j < 6; ++j) gm[j] = mlgain[6 * lane + j];
#pragma unroll
    for (int j = 0; j < 4; ++j) gh[j] = hggain[4 * lane + j];
    for (int r = row_lo + gw; r < MT; r += NGW) {
        bf16* ym = YM + (size_t)r * D;
        const unsigned* f3 = (const unsigned*)(ym + Y_ML + 6 * lane); const unsigned* b3 = (const unsigned*)(RAWM + (size_t)r * 384 + 6 * lane); const unsigned* o3 = (const unsigned*)(P + (size_t)r * DINP + C_MLO + 6 * lane);
        const unsigned fa = f3[0], fb_ = f3[1], fc = f3[2], ba = b3[0], bb = b3[1], bc = b3[2], oa = o3[0], ob = o3[1], oc = o3[2];
        const v2u f2 = *(const v2u*)(ym + Y_HG + 4 * lane), b2 = *(const v2u*)(RAWH + (size_t)r * 256 + 4 * lane), g2 = *(const v2u*)(P + (size_t)r * DINP + C_HGG + 4 * lane);
        float hm[6] = {bflo(fa) + bflo(ba), bfhi(fa) + bfhi(ba), bflo(fb_) + bflo(bb), bfhi(fb_) + bfhi(bb), bflo(fc) + bflo(bc), bfhi(fc) + bfhi(bc)};
        const float og[6] = {bflo(oa), bfhi(oa), bflo(ob), bfhi(ob), bflo(oc), bfhi(oc)};
        float hh[4] = {bflo(f2.x) + bflo(b2.x), bfhi(f2.x) + bfhi(b2.x), bflo(f2.y) + bflo(b2.y), bfhi(f2.y) + bfhi(b2.y)};
        const float gg[4] = {bflo(g2.x), bfhi(g2.x), bflo(g2.y), bfhi(g2.y)};
        float sm = 0.f, sh = 0.f;
#pragma unroll
        for (int j = 0; j < 6; ++j) sm += hm[j] * hm[j];
#pragma unroll
        for (int j = 0; j < 4; ++j) sh += hh[j] * hh[j];
#pragma unroll
        for (int o = 1; o < 16; o <<= 1) { sm += lx_xor(sm, o, lane); sh += lx_xor(sh, o, lane); }
        const float rm = 1.0f / sqrtf(sm * (1.0f / 96.0f) + EPS), rh = 1.0f / sqrtf(sh * (1.0f / 64.0f) + EPS);
#pragma unroll
        for (int j = 0; j < 6; ++j) hm[j] = hm[j] * rm * gm[j] * __builtin_amdgcn_rcpf(1.0f + __expf(-og[j]));
#pragma unroll
        for (int j = 0; j < 4; ++j) hh[j] = hh[j] * rh * gh[j] * gg[j] * __builtin_amdgcn_rcpf(1.0f + __expf(-gg[j]));
        unsigned* w3 = (unsigned*)(ym + Y_ML + 6 * lane); w3[0] = pk2(hm[0], hm[1]); w3[1] = pk2(hm[2], hm[3]); w3[2] = pk2(hm[4], hm[5]);
        v2u w2; w2.x = pk2(hh[0], hh[1]); w2.y = pk2(hh[2], hh[3]); *(v2u*)(ym + Y_HG + 4 * lane) = w2;
    }
}
#ifndef NO_HG
#define NO_HG 0
#endif
#ifndef NO_ML
#define NO_ML 0
#endif
#ifndef NO_AT
#define NO_AT 0
#endif
#ifndef NO_GEMM
#define NO_GEMM 0
#endif
#ifndef NO_G1
#define NO_G1 0
#endif
#ifndef NO_G2
#define NO_G2 0
#endif
#ifndef NO_G3
#define NO_G3 0
#endif
#ifndef NO_G4
#define NO_G4 0
#endif
#ifndef NO_P0
#define NO_P0 0
#endif
#ifndef STAMP_ON
#define STAMP_ON 0
#endif
#ifndef SA
#define SA 0
#define SB 1
#define SC 0
#define SD 1
#endif
#ifndef THIN_PROBE
#define THIN_PROBE 0
#endif
#ifndef ATT_PROBE
#define ATT_PROBE 0
#endif
#ifndef REPMASK
#define REPMASK 7
#endif
#ifndef REP
#define REP 0
#endif
constexpr int NPHASE = 2 + 8 * DEPTH;

typedef __attribute__((address_space(4))) const Args* kargs_t;
__device__ __forceinline__ kargs_t kargs() { kargs_t p = (kargs_t)__builtin_amdgcn_kernarg_segment_ptr(); asm volatile("" : "+s"(p)); return p; }
#define WSP(T, off) ((T*)(ws + (off)))

__global__ void __launch_bounds__(NTHR, 2) fwd(Args a_unused) {
    extern __shared__ __attribute__((aligned(16))) unsigned char lds_raw[];
    lptr lds = (lptr)lds_raw;
    const int G = gridDim.x; const int bx = blockIdx.x; const int vcu = (G % 8 == 0) ? (bx % 8) * (G / 8) + bx / 8 : bx;
    volatile LAS unsigned* MISC = (volatile LAS unsigned*)(lds + LDSCTL_OFF);
    { const int tid = tid_opaque(); for (int u = tid; u < (LDS_BYTES - LDSCTL_OFF) / 4; u += NTHR) ((LAS unsigned*)(lds + LDSCTL_OFF))[u] = 0u; }
    __syncthreads();
    int lo, hi; XcdBarrier bar;
    { kargs_t A = kargs(); lo = A->ph_lo; hi = A->ph_hi; unsigned* bw = (unsigned*)(A->ws + WS_CTL) + CW_BAR;
      bar.bar = bw; bar.x = 0; bar.st = nullptr;
      if (hi - lo > 1) bar = xcd_barrier_post(bw, MISC + 8); }
    volatile LAS int* slot = (volatile LAS int*)(MISC + 16);
#if STAMP_ON
#define STAMP(k) do { if (bx == 0 && tid_opaque() == 0) { kargs_t A_ = kargs(); __hip_atomic_store((unsigned long long*)(A_->ws + WS_MISC + 131072) + (k), (unsigned long long)__builtin_amdgcn_s_memrealtime(), RLX_AGENT); } } while (0)
#else
#define STAMP(k) do { } while (0)
#endif
#define IN(k) (lo <= (k) && (k) < hi)
#define SEAM(k) do { if (IN(k) && IN((k) + 1)) xcd_barrier(bar); STAMP((k) + 1); } while (0)
#define REPEAT(k) for (int rep_ = ((REP == (k) && l == 0) ? 2 : 1); rep_ > 0; --rep_)
#define REPBAR() do { if (rep_ > 1) xcd_barrier(bar); } while (0)

    STAMP(0);
    if (IN(0)) { if (!NO_P0) p0_phase(lds, kargs()); } SEAM(0);

    for (int l = 0; l < DEPTH; ++l) {
        const int pb = 1 + 8 * l;
        const bool with_ctx = l < DEPTH - 1;
        const int r0 = with_ctx ? 0 : MC; const int Mg = MT - r0;
        if (IN(pb)) REPEAT(1) {
            kargs_t A = kargs(); unsigned char* ws = A->ws; const float* modl = WSP(float, WS_MOD) + (size_t)l * 17 * NMOD; float* ctxx = WSP(float, WS_CTXX);
            if (l == 0) thin_phase<false, true>(0, A->in[I_X], A->in[I_CTX], A->out, ctxx, false, (const bf16*)nullptr, nullptr, 0, nullptr, modl, 0, D, A->in[I_GPREMIX] + l * D, WSP(bf16, WS_HB), vcu, G);
            else        thin_phase<true, true>(0, A->out, ctxx, A->out, ctxx, true, WSP(bf16, WS_YD), modl - 17 * NMOD, 5 * D, A->in[I_GPOSTFFN] + (l - 1) * D, modl, 0, D, A->in[I_GPREMIX] + l * D, WSP(bf16, WS_HB), vcu, G);
            convert_weights(lds, kargs(), l, vcu, G); REPBAR();
        }
        SEAM(pb);
        if (IN(pb + 1)) REPEAT(2) {
            kargs_t A = kargs(); unsigned char* ws = A->ws;
            pg8::Gemm g{WSP(bf16, WS_HB), WSP(bf16, WS_WIN), MT, DINP, D}; pg8::StaticOrder S; S.init(MT, DINP, G, bx);
            pg8::EpiIn E{WSP(bf16, WS_P), DINP, WSP(float, WS_MISC + 32768) + l * DINP, WSP(float, WS_GATE), WSP(float, WS_MISC + 16384), MC, QSCALE};
            if (!NO_GEMM && !NO_G1) pg8::gemm_phase<pg8::EpiIn, pg8::StaticOrder, true, true>(lds, g, S, E); REPBAR();
        }
        SEAM(pb + 1);
        if (IN(pb + 2)) REPEAT(3) {
            { kargs_t A = kargs(); unsigned char* ws = A->ws; unsigned* qh = WSP(unsigned, WS_CTL) + CW_Q + 64 * (16 * l + 64 * (rep_ - 1));
              for (;;) { const int it = wg_pull(qh, slot); if (it >= 128) break;
                const int b = it >> 3, h = (it >> 1) & 3, dir = it & 1;
                if (!NO_HG && (rep_ == 1 || (REPMASK & 1))) hgrn2_stream(lds, WSP(bf16, WS_P), dir ? WSP(bf16, WS_RAWH) : WSP(bf16, WS_HB) + Y_HG, dir ? 256 : D, WSP(float, WS_MISC) + l * 1024, b, h, dir); } }
            { kargs_t A = kargs(); unsigned char* ws = A->ws; unsigned* qm = WSP(unsigned, WS_CTL) + CW_Q + 64 * (16 * l + 64 * (rep_ - 1) + 1);
              for (;;) { const int it = wg_pull(qm, slot); if (it >= 128) break;
                const int b = it >> 3, h = (it >> 1) & 3, dir = it & 1;
                if (!NO_ML && (rep_ == 1 || (REPMASK & 2))) mlstm_stream(lds, WSP(bf16, WS_P), WSP(float, WS_GATE), dir ? WSP(bf16, WS_RAWM) : WSP(bf16, WS_HB) + Y_ML, dir ? 384 : D, A->in[I_MLFB] + l * 8, b, h, dir); } }
            { kargs_t A = kargs(); unsigned char* ws = A->ws; unsigned* qa = WSP(unsigned, WS_CTL) + CW_Q + 64 * (16 * l + 64 * (rep_ - 1) + 2);
              const int nq = with_ctx ? 72 : 64;
              const float lam_init = 0.8f - 0.6f * __expf(-0.3f * (float)l);
              const int myx = (int)(xb_xcc_id() & 7u);
              for (int k = 0; k < 8; ++k) { const int qx = (myx + k) & 7;
                for (;;) { const int it = wg_pull(qa + 64 * qx, slot); if (it >= nq) break;
                  const int bh = it < 64 ? (it >> 3) * 8 + qx : (it - 64) * 8 + qx, qb = it < 64 ? it & 7 : 8;
                  if (!NO_AT && (rep_ == 1 || (REPMASK & 4))) attn_item(lds, WSP(bf16, WS_P), WSP(bf16, WS_HB), A->in[I_DANORM] + l * 96, WSP(float, WS_MISC + 114688)[l], 1.0f - lam_init, bh >> 2, bh & 3, qb, rep_ == 2 ? ATT_PROBE : 0); } } }
            __syncthreads(); REPBAR();
        }
        SEAM(pb + 2);
        if (IN(pb + 3)) {
            kargs_t A = kargs(); unsigned char* ws = A->ws;
            fin_phase(r0, WSP(bf16, WS_P), WSP(bf16, WS_HB), WSP(bf16, WS_RAWM), WSP(bf16, WS_RAWH), A->in[I_MLNORM] + l * 384, A->in[I_HGNORM] + l * 256, vcu, G);
        }
        SEAM(pb + 3);
        if (IN(pb + 4)) REPEAT(5) {
            kargs_t A = kargs(); unsigned char* ws = A->ws;
            pg8::Gemm g{WSP(bf16, WS_HB) + (size_t)r0 * D, WSP(bf16, WS_WOUT), Mg, D, D}; pg8::StaticOrder S; S.init(Mg, D, G, bx);
            pg8::EpiBf E{WSP(bf16, WS_P) + (size_t)r0 * D, D};
            if (!NO_GEMM && !NO_G2) pg8::gemm_phase<pg8::EpiBf, pg8::StaticOrder, true, true>(lds, g, S, E); REPBAR();
        }
        SEAM(pb + 4);
        if (IN(pb + 5)) REPEAT(6) {
            kargs_t A = kargs(); unsigned char* ws = A->ws; const float* modl = WSP(float, WS_MOD) + (size_t)l * 17 * NMOD; float* ctxx = WSP(float, WS_CTXX);
            const float* xl = (l == 0) ? A->in[I_X] : A->out; const float* xc = (l == 0) ? A->in[I_CTX] : ctxx;
            thin_phase<true, true>(r0, xl, xc, A->out, ctxx, true, WSP(bf16, WS_P), modl, 2 * D, A->in[I_GPOSTMIX] + l * D, modl, 3 * D, 4 * D, A->in[I_GPREFFN] + l * D, WSP(bf16, WS_HB), vcu, G, rep_ == 2 ? THIN_PROBE : 0); REPBAR();
        }
        SEAM(pb + 5);
        if (IN(pb + 6)) REPEAT(7) {
            kargs_t A = kargs(); unsigned char* ws = A->ws;
            pg8::Gemm g{WSP(bf16, WS_HB) + (size_t)r0 * D, WSP(bf16, WS_WGU), Mg, NGU, D}; pg8::StaticOrder S; S.init(Mg, NGU, G, bx);
            pg8::EpiSwiglu E{WSP(bf16, WS_P) + (size_t)r0 * DFF, DFF};
            if (!NO_GEMM && !NO_G3) pg8::gemm_phase<pg8::EpiSwiglu, pg8::StaticOrder, true, true>(lds, g, S, E); REPBAR();
        }
        SEAM(pb + 6);
        if (IN(pb + 7)) REPEAT(8) {
            kargs_t A = kargs(); unsigned char* ws = A->ws;
            pg8::Gemm g{WSP(bf16, WS_P) + (size_t)r0 * DFF, WSP(bf16, WS_WD), Mg, D, DFF}; pg8::StaticOrder S; S.init(Mg, D, G, bx);
            pg8::EpiBf E{WSP(bf16, WS_YD) + (size_t)r0 * D, D};
            if (!NO_GEMM && !NO_G4) pg8::gemm_phase<pg8::EpiBf, pg8::StaticOrder, true, true>(lds, g, S, E); REPBAR();
        }
        SEAM(pb + 7);
    }
    if (IN(NPHASE - 1)) {
        kargs_t A = kargs(); unsigned char* ws = A->ws; const float* modl = WSP(float, WS_MOD) + (size_t)(DEPTH - 1) * 17 * NMOD; float* ctxx = WSP(float, WS_CTXX);
        thin_phase<true, false>(MC, A->out, ctxx, A->out, ctxx, true, WSP(bf16, WS_YD), modl, 5 * D, A->in[I_GPOSTFFN] + (DEPTH - 1) * D, nullptr, 0, 0, nullptr, nullptr, vcu, G);
#if STAMP_ON
        {
            __syncthreads();
            const unsigned long long* st = (const unsigned long long*)(ws + WS_MISC + 131072);
            const float d1 = (float)(long long)(__hip_atomic_load(st + SB, RLX_AGENT) - __hip_atomic_load(st + SA, RLX_AGENT)) * 1e-5f;
            const float d2 = (float)(long long)(__hip_atomic_load(st + SD, RLX_AGENT) - __hip_atomic_load(st + SC, RLX_AGENT)) * 1e-2f;
            const int tid = tid_opaque(); const int rwg = ML / G; float* o = A->out + (size_t)vcu * rwg * D;
            for (int i = tid; i < rwg * D; i += NTHR) o[i] *= (1.0f + d1);
            __syncthreads();
            if (bx == 0 && tid == 0) A->out[(size_t)vcu * rwg * D] = d2;
        }
#endif
    }
#undef IN
#undef SEAM
}

extern "C" void kernel_launch(void* const* d_in, const int* in_sizes, int n_in, void* d_out, int out_size, void* d_ws, size_t ws_size, hipStream_t stream) {
    static int grid = 0;
    if (grid == 0) {
        if (n_in != 22 || in_sizes[0] != ML * D || out_size != ML * D || ws_size < WS_END) {
            fprintf(stderr, "kernel_launch: unexpected shapes: n_in %d in0 %d out %d ws %zu (need %zu); nothing launched\n", n_in, n_in > 0 ? in_sizes[0] : -1, out_size, ws_size, (size_t)WS_END); grid = -1; return; }
        int dev = 0, cus = 0, per_cu = 0;
        if (hipGetDevice(&dev) != hipSuccess || hipDeviceGetAttribute(&cus, hipDeviceAttributeMultiprocessorCount, dev) != hipSuccess) { fprintf(stderr, "kernel_launch: device query failed\n"); grid = -1; return; }
        if (hipFuncSetAttribute((const void*)fwd, hipFuncAttributeMaxDynamicSharedMemorySize, LDS_BYTES) != hipSuccess) { fprintf(stderr, "kernel_launch: hipFuncSetAttribute failed\n"); grid = -1; return; }
        if (hipOccupancyMaxActiveBlocksPerMultiprocessor(&per_cu, (const void*)fwd, NTHR, LDS_BYTES) != hipSuccess || per_cu < 1)
            fprintf(stderr, "kernel_launch: note: occupancy query reports %d workgroups per CU\n", per_cu);
        (void)hipGetLastError();
        grid = cus;
    }
    if (grid < 0) return;
    if (hipMemsetAsync((char*)d_ws + WS_CTL, 0, CTL_ZERO_BYTES, stream) != hipSuccess) { fprintf(stderr, "kernel_launch: memset failed\n"); return; }
    Args a{};
    for (int i = 0; i < 22; ++i) a.in[i] = (const float*)d_in[i];
    a.out = (float*)d_out; a.ws = (unsigned char*)d_ws;
#if MK_PER_PHASE
    for (int p = 0; p < NPHASE; ++p) { a.ph_lo = p; a.ph_hi = p + 1; hipLaunchKernelGGL(fwd, dim3(grid), dim3(NTHR), LDS_BYTES, stream, a); }
#else
    a.ph_lo = 0; a.ph_hi = NPHASE;
    hipLaunchKernelGGL(fwd, dim3(grid), dim3(NTHR), LDS_BYTES, stream, a);
#endif
    const hipError_t le = hipPeekAtLastError();
    if (le != hipSuccess) fprintf(stderr, "kernel_launch: launch failed: %s\n", hipGetErrorName(le));
}
```

```cpp
#include <hip/hip_runtime.h>
#include <cstdio>
#include <cstdint>
#ifndef MK_PER_PHASE
#define MK_PER_PHASE 0
#endif
namespace pg8 {
#define PG8_LAS __attribute__((address_space(3)))
typedef unsigned short bf16_t;
typedef short bf16x8 __attribute__((ext_vector_type(8)));
typedef float f32x4 __attribute__((ext_vector_type(4)));
typedef unsigned u32x4 __attribute__((ext_vector_type(4)));
constexpr int BM = 256, BK = 64, HALF = 128, HTB = HALF * BK * 2  , STAGE_BYTES = 8 * HTB, NXCD = 8, WGM = 8;

__host__ __device__ __forceinline__ int lds_byte(int r, int c) { const int st = (r >> 4) * 2 + (c >> 5), rr = r & 15, cc = c & 31, ob = rr * 64 + cc * 2; return st * 1024 + (ob ^ (((ob >> 9) & 1) << 5)); }
__host__ __device__ __forceinline__ void stage_rc(int b, int& R, int& C) { const int st = b / 1024, sb = b % 1024, swz = sb ^ (((sb >> 9) & 1) << 5); R = (st >> 1) * 16 + swz / 64; C = (st & 1) * 32 + (swz % 64) / 2; }
__host__ __device__ __forceinline__ int perm32(int rho) { const int n = rho >> 4, i = rho & 15; return 8 * (i >> 2) + 4 * n + (i & 3); }

struct Unit { int pm, pn; };
struct Gemm { const bf16_t* A; const bf16_t* Bt; int M, N, K; };

struct StaticOrder {
    int nM, nN, nwg, G, c;
    __host__ __device__ void init(int M, int N, int G_, int c_) { nM = M / BM; nN = N / BM; nwg = nM * nN; G = G_; c = c_; }
    __host__ __device__ bool next(int i, Unit& u) const {
        const long L = (long)i * G + c; if (L >= nwg) return false;
        int wgid = (int)L; { const int q = nwg / NXCD, r = nwg % NXCD, xcd = wgid % NXCD, off = wgid / NXCD; wgid = (xcd < r ? xcd * (q + 1) : r * (q + 1) + (xcd - r) * q) + off; }
        const int nig = WGM * nN, gid = wgid / nig, fm = gid * WGM, gsz = (nM - fm) < WGM ? (nM - fm) : WGM;
        u.pm = fm + ((wgid % nig) % gsz); u.pn = (wgid % nig) / gsz; return true;
    }
    __device__ __forceinline__ void a_ready(const Unit&) const {}
    __device__ __forceinline__ void done(const Unit&) const {}
};
__device__ __forceinline__ unsigned cvt_pk_bf16(float lo, float hi) { unsigned r; asm volatile("v_cvt_pk_bf16_f32 %0, %1, %2" : "=v"(r) : "v"(lo), "v"(hi)); return r; }
struct EpiF32 {
    static constexpr bool PERM = false, AFTER_DRAIN = false;
    float* C; int ldc;
    __device__ __forceinline__ void operator()(const f32x4 (&acc)[2][2][4][2], const Unit& u, int wr, int wc, int fr, int fq) const {
        const int row0 = u.pm * BM + wr * 64 + fr, col0 = u.pn * BM + wc * 32 + 4 * fq;
#pragma unroll
        for (int ai = 0; ai < 2; ++ai)
#pragma unroll
            for (int m = 0; m < 4; ++m) { float* rowp = C + (size_t)(row0 + ai * HALF + m * 16) * ldc + col0;
#pragma unroll
                for (int bj = 0; bj < 2; ++bj)
#pragma unroll
                    for (int n = 0; n < 2; ++n) *(f32x4*)(rowp + bj * HALF + n * 16) = acc[ai][bj][m][n]; }
    }
};
struct EpiBf {
    static constexpr bool PERM = true, AFTER_DRAIN = false;
    bf16_t* O; int ldc;
    __device__ __forceinline__ void operator()(const f32x4 (&acc)[2][2][4][2], const Unit& u, int wr, int wc, int fr, int fq) const {
        const int row0 = u.pm * BM + wr * 64 + fr; const int col0 = u.pn * BM + wc * 32 + 8 * fq;
#pragma unroll
        for (int ai = 0; ai < 2; ++ai)
#pragma unroll
            for (int m = 0; m < 4; ++m) { bf16_t* rowp = O + (size_t)(row0 + ai * HALF + m * 16) * ldc + col0;
#pragma unroll
                for (int bj = 0; bj < 2; ++bj) { const f32x4 v0 = acc[ai][bj][m][0], v1 = acc[ai][bj][m][1];
                    u32x4 w; w.x = cvt_pk_bf16(v0[0], v0[1]); w.y = cvt_pk_bf16(v0[2], v0[3]); w.z = cvt_pk_bf16(v1[0], v1[1]); w.w = cvt_pk_bf16(v1[2], v1[3]);
                    *(u32x4*)(rowp + bj * HALF) = w; } }
    }
};
struct EpiIn {
    static constexpr bool PERM = true, AFTER_DRAIN = false;
    bf16_t* O; int ldc; const float* bias; float* G; const float* rope; int mc; float qscale;
    __device__ __forceinline__ void operator()(const f32x4 (&acc)[2][2][4][2], const Unit& u, int wr, int wc, int fr, int fq) const {
        const int row0 = u.pm * BM + wr * 64 + fr; const int col0 = u.pn * BM + wc * 32 + 8 * fq;
        const bool gate_lane = (u.pn == 6) && (wc == 0) && (fq < 2);
        const bool da_tile = (u.pn >= 14) && (u.pn <= 17);
#pragma unroll
        for (int bj = 0; bj < 2; ++bj) {
            const int c = col0 + bj * HALF;
            const f32x4 b0 = *(const f32x4*)(bias + c), b1 = *(const f32x4*)(bias + c + 4);
            const bool is_da = da_tile && c >= 3600 && c < 4368;
            const bool is_q = is_da && c < 3984;
            const int d48 = is_da ? (c - 3600) % 48 : 0; const int hf = d48 >= 24 ? 1 : 0, i0 = (d48 - 24 * hf) >> 1;
#pragma unroll
            for (int ai = 0; ai < 2; ++ai)
#pragma unroll
                for (int m = 0; m < 4; ++m) { const int row = row0 + ai * HALF + m * 16; bf16_t* rowp = O + (size_t)row * ldc + col0;
                    f32x4 v0 = acc[ai][bj][m][0] + b0, v1 = acc[ai][bj][m][1] + b1;
                    if (is_da) {
                        if (row >= mc) { const int t = (row - mc) & 2047; const int pos = hf ? (t & 63) : (t >> 6);
                            const f32x4 cs0 = *(const f32x4*)(rope + pos * 24 + 2 * i0), cs1 = *(const f32x4*)(rope + pos * 24 + 2 * i0 + 4);
                            const f32x4 r0 = {v0[0] * cs0[0] - v0[1] * cs0[1], v0[0] * cs0[1] + v0[1] * cs0[0], v0[2] * cs0[2] - v0[3] * cs0[3], v0[2] * cs0[3] + v0[3] * cs0[2]};
                            const f32x4 r1 = {v1[0] * cs1[0] - v1[1] * cs1[1], v1[0] * cs1[1] + v1[1] * cs1[0], v1[2] * cs1[2] - v1[3] * cs1[3], v1[2] * cs1[3] + v1[3] * cs1[2]};
                            v0 = r0; v1 = r1; }
                        if (is_q) { v0 = v0 * qscale; v1 = v1 * qscale; } }
                    u32x4 w; w.x = cvt_pk_bf16(v0[0], v0[1]); w.y = cvt_pk_bf16(v0[2], v0[3]); w.z = cvt_pk_bf16(v1[0], v1[1]); w.w = cvt_pk_bf16(v1[2], v1[3]);
                    *(u32x4*)(rowp + bj * HALF) = w;
                    if (bj == 0 && gate_lane) { float* g = G + (size_t)row * 16 + 8 * fq; *(f32x4*)g = v0; *(f32x4*)(g + 4) = v1; } }
        }
    }
};
struct EpiSwiglu {
    static constexpr bool PERM = true, AFTER_DRAIN = false;
    bf16_t* O; int ldc;
    __device__ __forceinline__ void operator()(const f32x4 (&acc)[2][2][4][2], const Unit& u, int wr, int wc, int fr, int fq) const {
        const int row0 = u.pm * BM + wr * 64 + fr; const int col0 = u.pn * HALF + wc * 32 + 8 * fq;
#pragma unroll
        for (int ai = 0; ai < 2; ++ai)
#pragma unroll
            for (int m = 0; m < 4; ++m) { bf16_t* rowp = O + (size_t)(row0 + ai * HALF + m * 16) * ldc + col0;
                f32x4 r0, r1;
#pragma unroll
                for (int i = 0; i < 4; ++i) { const float g0 = acc[ai][0][m][0][i], g1 = acc[ai][0][m][1][i];
                    r0[i] = g0 * __builtin_amdgcn_rcpf(1.0f + __expf(-g0)) * acc[ai][1][m][0][i];
                    r1[i] = g1 * __builtin_amdgcn_rcpf(1.0f + __expf(-g1)) * acc[ai][1][m][1][i]; }
                u32x4 w; w.x = cvt_pk_bf16(r0[0], r0[1]); w.y = cvt_pk_bf16(r0[2], r0[3]); w.z = cvt_pk_bf16(r1[0], r1[1]); w.w = cvt_pk_bf16(r1[2], r1[3]);
                *(u32x4*)rowp = w; }
    }
};
template <class Epi, class Sched, bool ALIGN_EPI = false, bool SP2 = false>
__device__ __forceinline__ void gemm_phase(PG8_LAS unsigned char* lds, const Gemm g, const Sched& S, const Epi& E) {
    int tid_ = threadIdx.x; asm volatile("" : "+v"(tid_));
    const int tid = tid_, wid = __builtin_amdgcn_readfirstlane(tid >> 6), lane = tid & 63, wr = wid >> 2, wc = wid & 3, fr = lane & 15, fq = lane >> 4;
    const int K = g.K, nt = K / BK;
    unsigned voffA[2], voffB[2];
#pragma unroll
    for (int i = 0; i < 2; ++i) { int R, C; stage_rc(tid * 16 + i * 8192, R, C); const int Rb = Epi::PERM ? ((R & ~31) + perm32(R & 31)) : R;
        voffA[i] = (unsigned)(R * K + C) * 2u; voffB[i] = (unsigned)(Rb * K + C) * 2u; }
    const size_t kstep = (size_t)(BK * 2);
    const size_t hstep = (size_t)HALF * K * 2;
    const size_t tstep = 2 * hstep;
    const unsigned ldsw = (unsigned)wid * 1024u;
    const int aoff = lds_byte(wr * 64 + fr, fq * 8), boff = lds_byte(wc * 32 + fr, fq * 8);
#define PG8_SA(b, h) (((b) * 2 + (h)) * HTB)
#define PG8_SB(b, h) ((4 + (b) * 2 + (h)) * HTB)
#define PG8_STAGE(bufoff, gbase, voff) do { _Pragma("unroll") for (int _i = 0; _i < 2; ++_i) \
        __builtin_amdgcn_global_load_lds((const unsigned*)((const char*)(gbase) + (voff)[_i]), (PG8_LAS unsigned*)(lds + (bufoff) + ldsw + _i * 8192), 16, 0, 0); } while (0)
#define PG8_LDA(dst, b, h) do { _Pragma("unroll") for (int m = 0; m < 4; ++m) _Pragma("unroll") for (int k = 0; k < 2; ++k) dst[m][k] = *(const PG8_LAS bf16x8*)(lds + PG8_SA(b, h) + aoff + m * 2048 + k * 1024); } while (0)
#define PG8_LDB(dst, b, h) do { _Pragma("unroll") for (int n = 0; n < 2; ++n) _Pragma("unroll") for (int k = 0; k < 2; ++k) dst[n][k] = *(const PG8_LAS bf16x8*)(lds + PG8_SB(b, h) + boff + n * 2048 + k * 1024); } while (0)
#define PG8_MMA(ai, bj, At, Bt) do { __builtin_amdgcn_s_setprio(1); _Pragma("unroll") for (int m = 0; m < 4; ++m) _Pragma("unroll") for (int n = 0; n < 2; ++n) _Pragma("unroll") for (int k = 0; k < 2; ++k) \
        acc[ai][bj][m][n] = __builtin_amdgcn_mfma_f32_16x16x32_bf16(Bt[n][k], At[m][k], acc[ai][bj][m][n], 0, 0, 0); __builtin_amdgcn_s_setprio(0); } while (0)
#define PG8_WAIT_V(n) asm volatile("s_waitcnt vmcnt(" #n ")" ::: "memory")
#define PG8_WAIT_L(n) asm volatile("s_waitcnt lgkmcnt(" #n ")" ::: "memory")
#define PG8_BAR __builtin_amdgcn_s_barrier()
#define PG8_SCHED __builtin_amdgcn_sched_barrier(0)
    Unit cur, nxt; int ui = 0;
    if (!S.next(0, cur)) return;
    f32x4 acc[2][2][4][2];
#pragma unroll
    for (int a = 0; a < 2; ++a)
#pragma unroll
        for (int b = 0; b < 2; ++b)
#pragma unroll
            for (int m = 0; m < 4; ++m)
#pragma unroll
                for (int n = 0; n < 2; ++n) acc[a][b][m][n] = (f32x4){0.f, 0.f, 0.f, 0.f};
    bf16x8 At[4][2], B0[2][2], B1[2][2];
    const char* cA = (const char*)g.A + (size_t)cur.pm * tstep; const char* cB = (const char*)g.Bt + (size_t)cur.pn * tstep;
    S.a_ready(cur);
    if constexpr (SP2) {
        PG8_STAGE(PG8_SB(0, 0), cB, voffB); PG8_STAGE(PG8_SB(0, 1), cB + hstep, voffB); PG8_STAGE(PG8_SA(0, 0), cA, voffA); PG8_STAGE(PG8_SA(0, 1), cA + hstep, voffA);
        if (wr == 1) PG8_BAR;
        PG8_WAIT_V(2); PG8_BAR;
        PG8_STAGE(PG8_SB(1, 0), cB + kstep, voffB); PG8_STAGE(PG8_SA(1, 0), cA + kstep, voffA); PG8_STAGE(PG8_SB(1, 1), cB + hstep + kstep, voffB);
        PG8_WAIT_V(6); PG8_BAR;
    } else {
        PG8_STAGE(PG8_SB(0, 0), cB, voffB); PG8_STAGE(PG8_SA(0, 0), cA, voffA); PG8_STAGE(PG8_SB(0, 1), cB + hstep, voffB); PG8_STAGE(PG8_SA(0, 1), cA + hstep, voffA);
        if (wr == 1) PG8_BAR;
        PG8_WAIT_V(4); PG8_BAR;
        PG8_STAGE(PG8_SB(1, 0), cB + kstep, voffB); PG8_STAGE(PG8_SA(1, 0), cA + kstep, voffA); PG8_STAGE(PG8_SB(1, 1), cB + hstep + kstep, voffB);
        PG8_WAIT_V(6); PG8_BAR;
    }
    for (;;) {
        const bool has_next = S.next(ui + 1, nxt);
        const char* nA = has_next ? (const char*)g.A + (size_t)nxt.pm * tstep : cA; const char* nB = has_next ? (const char*)g.Bt + (size_t)nxt.pn * tstep : cB;
        for (int t = 0; t < nt; t += 2) {
            const bool last = (t == nt - 2);
            const char* a1 = cA + (size_t)(t + 1) * kstep;
            const char* a2 = last ? nA : cA + (size_t)(t + 2) * kstep; const char* b2 = last ? nB : cB + (size_t)(t + 2) * kstep;
            const char* a3 = a2 + kstep; const char* b3 = b2 + kstep;
            if (last && has_next) S.a_ready(nxt);
            if constexpr (SP2) {
            PG8_LDB(B0, 0, 0); PG8_LDB(B1, 0, 1); PG8_SCHED; PG8_LDA(At, 0, 0); PG8_STAGE(PG8_SA(1, 1), a1 + hstep, voffA);
            PG8_WAIT_V(8); PG8_WAIT_L(0); PG8_BAR; PG8_MMA(0, 0, At, B0); PG8_MMA(0, 1, At, B1); PG8_BAR; PG8_SCHED;
            PG8_LDA(At, 0, 1); PG8_STAGE(PG8_SB(0, 0), b2, voffB); PG8_STAGE(PG8_SB(0, 1), b2 + hstep, voffB); PG8_STAGE(PG8_SA(0, 0), a2, voffA);
            PG8_WAIT_V(8); PG8_WAIT_L(0); PG8_BAR; PG8_MMA(1, 0, At, B0); PG8_MMA(1, 1, At, B1); PG8_BAR; PG8_SCHED;
            PG8_LDB(B0, 1, 0); PG8_LDB(B1, 1, 1); PG8_SCHED; PG8_LDA(At, 1, 0); PG8_STAGE(PG8_SA(0, 1), a2 + hstep, voffA);
            PG8_WAIT_V(8); PG8_WAIT_L(0); PG8_BAR; PG8_MMA(0, 0, At, B0); PG8_MMA(0, 1, At, B1); PG8_BAR; PG8_SCHED;
            PG8_LDA(At, 1, 1); PG8_STAGE(PG8_SB(1, 0), b3, voffB); PG8_STAGE(PG8_SB(1, 1), b3 + hstep, voffB); PG8_STAGE(PG8_SA(1, 0), a3, voffA);
            PG8_WAIT_V(8); PG8_WAIT_L(0); PG8_BAR; PG8_MMA(1, 0, At, B0); PG8_MMA(1, 1, At, B1); PG8_BAR; PG8_SCHED;
            } else {
            PG8_LDB(B0, 0, 0); PG8_SCHED; PG8_LDA(At, 0, 0); PG8_STAGE(PG8_SA(1, 1), a1 + hstep, voffA);
            PG8_WAIT_L(8); PG8_BAR; PG8_WAIT_L(0); PG8_MMA(0, 0, At, B0); PG8_BAR; PG8_SCHED;
            PG8_LDB(B1, 0, 1); PG8_STAGE(PG8_SB(0, 0), b2, voffB);
            PG8_BAR; PG8_WAIT_L(0); PG8_MMA(0, 1, At, B1); PG8_BAR;
            PG8_LDA(At, 0, 1); PG8_STAGE(PG8_SA(0, 0), a2, voffA);
            PG8_BAR; PG8_WAIT_L(0); PG8_MMA(1, 0, At, B0); PG8_BAR; PG8_SCHED;
            PG8_STAGE(PG8_SB(0, 1), b2 + hstep, voffB);
            PG8_WAIT_V(6); PG8_BAR; PG8_MMA(1, 1, At, B1); PG8_BAR;
            PG8_LDB(B0, 1, 0); PG8_SCHED; PG8_LDA(At, 1, 0); PG8_STAGE(PG8_SA(0, 1), a2 + hstep, voffA);
            PG8_WAIT_L(8); PG8_BAR; PG8_WAIT_L(0); PG8_MMA(0, 0, At, B0); PG8_BAR; PG8_SCHED;
            PG8_LDB(B1, 1, 1); PG8_STAGE(PG8_SB(1, 0), b3, voffB);
            PG8_BAR; PG8_WAIT_L(0); PG8_MMA(0, 1, At, B1); PG8_BAR;
            PG8_LDA(At, 1, 1); PG8_STAGE(PG8_SA(1, 0), a3, voffA);
            PG8_BAR; PG8_WAIT_L(0); PG8_MMA(1, 0, At, B0); PG8_BAR; PG8_SCHED;
            PG8_STAGE(PG8_SB(1, 1), b3 + hstep, voffB);
            PG8_WAIT_V(6); PG8_BAR; PG8_MMA(1, 1, At, B1); PG8_BAR;
            }
        }
        if constexpr (ALIGN_EPI) { if (wr == 0) PG8_BAR; }
        if constexpr (!Epi::AFTER_DRAIN) { E(acc, cur, wr, wc, fr, fq); S.done(cur); }
        if (!has_next) break;
#pragma unroll
        for (int a = 0; a < 2; ++a)
#pragma unroll
            for (int b = 0; b < 2; ++b)
#pragma unroll
                for (int m = 0; m < 4; ++m)
#pragma unroll
                    for (int n = 0; n < 2; ++n) acc[a][b][m][n] = (f32x4){0.f, 0.f, 0.f, 0.f};
        cur = nxt; cA = nA; cB = nB; ++ui;
        if constexpr (ALIGN_EPI) { if (wr == 1) PG8_BAR; }
    }
    PG8_WAIT_V(0);
    if constexpr (!ALIGN_EPI) { if (wr == 0) PG8_BAR; }
    PG8_BAR;
    if constexpr (Epi::AFTER_DRAIN) { E.fused(acc, cur, wr, wc, fr, fq, lds, wid, lane); S.done(cur); }
#undef PG8_SA
#undef PG8_SB
#undef PG8_STAGE
#undef PG8_LDA
#undef PG8_LDB
#undef PG8_MMA
#undef PG8_WAIT_V
#undef PG8_WAIT_L
#undef PG8_BAR
#undef PG8_SCHED
}
}
constexpr int D = 1024, NB = 16, SEQ = 2048, CTXL = 256, DEPTH = 4;
constexpr int MC = NB * CTXL, ML = NB * SEQ, MT = MC + ML;
constexpr int DIN = 4752, DINP = 4864, DFF = 2816, NGU = 2 * DFF, NMOD = 6 * D;
constexpr int C_MLQ = 0, C_MLK = 384, C_MLV = 768, C_MLO = 1152, C_MLI = 1536, C_MLF = 1544, C_HGQ = 1552, C_HGF = 2064, C_HGI = 3088, C_HGG = 3344, C_DAQ = 3600, C_DAK = 3984, C_DAV = 4368;
constexpr int Y_ML = 0, Y_HG = 384, Y_DA = 640;
constexpr float EPS = 1e-6f;
constexpr int NTOK = CTXL + SEQ;
static_assert(C_MLI == 6 * 256, "gate columns must open GEMM tile 6");

constexpr size_t MiB = 1u << 20;
constexpr size_t WS_CTL = 0, CTL_ZERO_BYTES = 1 * MiB;
constexpr size_t WS_MOD = 1 * MiB;
constexpr size_t WS_MISC = 3 * MiB;
constexpr size_t WS_GATE = 4 * MiB;
constexpr size_t WS_WIN = 8 * MiB, WS_WOUT = WS_WIN + (size_t)DINP * D * 2, WS_WGU = WS_WOUT + (size_t)D * D * 2, WS_WD = WS_WGU + (size_t)NGU * D * 2;
constexpr size_t WS_CTXX = 36 * MiB;
constexpr size_t WS_HB = 52 * MiB;
constexpr size_t WS_RAWM = 124 * MiB, WS_RAWH = 151 * MiB;
constexpr size_t WS_P = 169 * MiB;
constexpr size_t WS_YD = WS_P + 198 * MiB, WS_END = 511 * MiB;
static_assert(WS_WD + (size_t)D * DFF * 2 <= WS_CTXX, "weights fit");
static_assert(WS_RAWM + (size_t)64 * NTOK * 96 * 2 <= WS_RAWH && WS_RAWH + (size_t)64 * NTOK * 64 * 2 <= WS_P, "raw fits");
static_assert(WS_P + (size_t)MT * DINP * 2 <= WS_END && WS_YD + (size_t)MT * D * 4 <= WS_END && (size_t)MT * DFF * 2 <= 198 * MiB, "P region");
constexpr int CW_BAR = 4096;
constexpr int CW_Q = 16384;

constexpr int RING_BYTES = 131072, LDSCTL_OFF = RING_BYTES, LDS_BYTES = 147456;
constexpr int NWAVES = 8, NTHR = 512;

#define GAS __attribute__((address_space(1)))
#define LAS __attribute__((address_space(3)))
typedef unsigned short bf16;
typedef unsigned v4u __attribute__((ext_vector_type(4)));
typedef unsigned v2u __attribute__((ext_vector_type(2)));
typedef float f32x4 __attribute__((ext_vector_type(4)));
typedef float f32x16 __attribute__((ext_vector_type(16)));
typedef short bf16x8 __attribute__((ext_vector_type(8)));
typedef GAS unsigned gu32;
typedef LAS unsigned char* lptr;
#define RLX_AGENT __ATOMIC_RELAXED, __HIP_MEMORY_SCOPE_AGENT
#define LDS_WAIT() asm volatile("s_waitcnt lgkmcnt(0)" ::: "memory")
#define VM_WAIT() asm volatile("s_waitcnt vmcnt(0)" ::: "memory")
__device__ __forceinline__ unsigned f2bf(float f) { unsigned u = __builtin_bit_cast(unsigned, f); return (u + 0x7fffu + ((u >> 16) & 1u)) >> 16; }
typedef float f32x2_t __attribute__((ext_vector_type(2))); typedef __bf16 bf16x2_t __attribute__((ext_vector_type(2)));
__device__ __forceinline__ unsigned pk2(float lo, float hi) { f32x2_t v = {lo, hi}; bf16x2_t b = __builtin_convertvector(v, bf16x2_t); return __builtin_bit_cast(unsigned, b); }
__device__ __forceinline__ float bflo(unsigned w) { return __builtin_bit_cast(float, w << 16); }
__device__ __forceinline__ float bfhi(unsigned w) { return __builtin_bit_cast(float, w & 0xffff0000u); }
__device__ __forceinline__ float bf2f(bf16 v) { return __builtin_bit_cast(float, (unsigned)v << 16); }
__device__ __forceinline__ float lx_idx(float v, int src) { return __builtin_bit_cast(float, __builtin_amdgcn_ds_bpermute(src << 2, __builtin_bit_cast(int, v))); }
__device__ __forceinline__ float lx_xor(float v, int mask, int lane) { return lx_idx(v, lane ^ mask); }
__device__ __forceinline__ float lx_up(float v, int d, int lane) { return lx_idx(v, lane >= d ? lane - d : lane); }
__device__ __forceinline__ float wave_sum(float v, int lane) {
#pragma unroll
    for (int o = 1; o < 64; o <<= 1) v += lx_xor(v, o, lane);
    return v;
}
#define MFMA32(a, b, c) __builtin_amdgcn_mfma_f32_32x32x16_bf16((a), (b), (c), 0, 0, 0)
#define MFMA16(a, b, c) __builtin_amdgcn_mfma_f32_16x16x32_bf16((a), (b), (c), 0, 0, 0)
__device__ __forceinline__ int tid_opaque() { int t = threadIdx.x; asm volatile("" : "+v"(t)); return t; }
__device__ __forceinline__ bf16x8 lds8(lptr p) { return *(const LAS bf16x8*)p; }
__device__ __forceinline__ v4u gld16(const void* base, unsigned off) { return *(const v4u*)((const char*)base + off); }
__device__ __forceinline__ void gst8(void* base, unsigned off, v2u v) { *(v2u*)((char*)base + off) = v; }
typedef short v4i16 __attribute__((ext_vector_type(4)));
__device__ __forceinline__ bf16x8 opr(lptr img, int ldb, int r0, int k0, int c16, int rg) { return lds8(img + (r0 + c16) * ldb + (k0 + 8 * rg) * 2); }
__device__ __forceinline__ bf16x8 opt(lptr img, int ldb, int r0, int k0, int lane) {
    const int g = lane >> 4, q = (lane & 15) >> 2, p = lane & 3;
    lptr a = img + (k0 + 8 * g + q) * ldb + (r0 + 4 * p) * 2;
    const v4i16 lo = __builtin_amdgcn_ds_read_tr16_b64_v4i16((LAS v4i16*)a);
    const v4i16 hi = __builtin_amdgcn_ds_read_tr16_b64_v4i16((LAS v4i16*)(a + 4 * ldb));
    return __builtin_shufflevector(lo, hi, 0, 1, 2, 3, 4, 5, 6, 7);
}

#define XB_TMO      128
#define XB_XCNT(j)  (256  + 64 * (j))
#define XB_XSUB(j)  (1280 + 64 * (j))
#define XB_XGEN(j)  (2304 + 64 * (j))
#define XB_TOP      3328
#define XB_TOPGEN   3392
#define XCD_BAR_WORDS 3456
#define XB_SPIN_CAP (1u << 18)

__device__ __forceinline__ unsigned xb_ld(unsigned* p)              { return __hip_atomic_load(p, __ATOMIC_RELAXED, __HIP_MEMORY_SCOPE_AGENT); }
__device__ __forceinline__ unsigned xb_add(unsigned* p, unsigned v) { return __hip_atomic_fetch_add(p, v, __ATOMIC_RELAXED, __HIP_MEMORY_SCOPE_AGENT); }
__device__ __forceinline__ unsigned xb_xcc_id() { return (unsigned)__builtin_amdgcn_s_getreg((3 << 11) | 20) & 0xFu; }
#define XB_SPIN(cond, bar) do { unsigned _sp = 0; while (cond) { __builtin_amdgcn_s_sleep(1); \
    if ((++_sp & 255u) == 0u) { if (xb_ld(&(bar)[XB_TMO])) break; if (_sp > XB_SPIN_CAP) { atomicAdd(&(bar)[XB_TMO], 1u); break; } } } } while (0)

struct XcdBarrier {
    unsigned* bar; unsigned x;
    volatile LAS unsigned* st;
};

__device__ __forceinline__ XcdBarrier xcd_barrier_post(unsigned* bar, volatile LAS unsigned* st) {
    XcdBarrier b; b.bar = bar; b.x = xb_xcc_id(); b.st = st;
    if (threadIdx.x == 0) (void)xb_add(&bar[XB_XCNT(b.x)], 1u);
    return b;
}
__device__ __forceinline__ void xcd_barrier_complete(unsigned* bar, unsigned x, unsigned& nloc, unsigned& nx) {
    const unsigned G = gridDim.x * gridDim.y * gridDim.z;
    unsigned sum, cnt, mine, sp = 0u;
    for (;;) {
        sum = 0u; cnt = 0u; mine = 0u;
#pragma unroll
        for (unsigned j = 0; j < 16; ++j) { const unsigned c = xb_ld(&bar[XB_XCNT(j)]); sum += c; cnt += (c > 0u) ? 1u : 0u; mine = (j == x) ? c : mine; }
        if (sum == G) break;
        __builtin_amdgcn_s_sleep(1);
        if ((++sp & 255u) == 0u) { if (xb_ld(&bar[XB_TMO])) break; if (sp > XB_SPIN_CAP) { atomicAdd(&bar[XB_TMO], 1u); break; } }
    }
    nloc = mine > 0u ? mine : 1u; nx = cnt > 0u ? cnt : 1u;
}

__device__ __forceinline__ void xcd_barrier(const XcdBarrier& b) {
    asm volatile("s_waitcnt vmcnt(0)" ::: "memory");
    __syncthreads();
    if (threadIdx.x == 0) {
        unsigned* bar = b.bar;
        __builtin_amdgcn_s_waitcnt(0);
        unsigned nloc = b.st[0], nx = b.st[1];
        if (nloc == 0u) { xcd_barrier_complete(bar, b.x, nloc, nx); b.st[0] = nloc; b.st[1] = nx; }
        const unsigned old = xb_add(&bar[XB_XSUB(b.x)], 1u);
        const unsigned gen = old / nloc;
        if (old + 1u == (gen + 1u) * nloc) {
            __builtin_amdgcn_fence(__ATOMIC_RELEASE, "agent");
            asm volatile("s_waitcnt vmcnt(0)" ::: "memory");
            const unsigned og = xb_add(&bar[XB_TOP], 1u);
            const unsigned tg = og / nx;
            if (og + 1u == (tg + 1u) * nx) xb_add(&bar[XB_TOPGEN], 1u);
            else XB_SPIN(xb_ld(&bar[XB_TOPGEN]) == tg, bar);
            __builtin_amdgcn_fence(__ATOMIC_ACQUIRE, "agent");
            xb_add(&bar[XB_XGEN(b.x)], 1u);
            asm volatile("s_waitcnt vmcnt(0)" ::: "memory");
        } else {
            XB_SPIN(xb_ld(&bar[XB_XGEN(b.x)]) == gen, bar);
            __builtin_amdgcn_fence(__ATOMIC_ACQUIRE, "agent");
            asm volatile("s_waitcnt vmcnt(0)" ::: "memory");
        }
    }
    __syncthreads();
}


struct Args { const float* in[22]; float* out; unsigned char* ws; int ph_lo, ph_hi; };
enum { I_X = 0, I_C, I_CTX, I_CCTX, I_WADA, I_BADA, I_GPREMIX, I_GPOSTMIX, I_GPREFFN, I_GPOSTFFN, I_WIN, I_BIN, I_WOUT, I_MLFB, I_MLNORM, I_HGLB, I_HGNORM, I_DALAM, I_DANORM, I_WG, I_WU, I_WD };

__host__ __device__ __forceinline__ int perm_in_col(int n) { if (n < C_DAQ || n >= C_DAV) return n; const int d = (n - C_DAQ) % 48, base = n - d, half = d / 24, e = d % 24; return base + 24 * half + 2 * (e % 12) + (e >= 12 ? 1 : 0); }
__device__ __forceinline__ int wg_pull(unsigned* ctr, volatile LAS int* slot) {
    __syncthreads();
    if (threadIdx.x == 0) *slot = (int)__hip_atomic_fetch_add(ctr, 1u, RLX_AGENT);
    __syncthreads();
    return __builtin_amdgcn_readfirstlane(*slot);
}

typedef __attribute__((address_space(4))) const Args* kargs_p;
__device__ __forceinline__ void p0_phase(lptr lds, kargs_p ap) {
    struct { const float* in[22]; unsigned char* ws; } a; a.in[I_C] = ap->in[I_C]; a.in[I_CCTX] = ap->in[I_CCTX]; a.in[I_WADA] = ap->in[I_WADA]; a.in[I_BADA] = ap->in[I_BADA]; a.in[I_HGLB] = ap->in[I_HGLB]; a.in[I_BIN] = ap->in[I_BIN]; a.in[I_DALAM] = ap->in[I_DALAM]; a.ws = ap->ws;
    const int tid = tid_opaque();
    unsigned char* ws = a.ws;
    LAS float* sil = (LAS float*)lds;
    LAS float* part = (LAS float*)(lds + 69632);
    for (int i = tid; i < 17 * D; i += NTHR) { const int bb = i >> 10, k = i & 1023; const float v = bb < 16 ? a.in[I_C][bb * D + k] : a.in[I_CCTX][k]; sil[i] = v / (1.0f + __expf(-v)); }
    __syncthreads();
    float* mod = (float*)(ws + WS_MOD);
    for (int u = blockIdx.x; u < DEPTH * (NMOD / 32); u += gridDim.x) {
        const int l = u / (NMOD / 32), n0 = (u % (NMOD / 32)) * 32, col = tid & 31, ks = tid >> 5;
        const float* w = a.in[I_WADA] + (size_t)l * D * NMOD + (size_t)(ks * 64) * NMOD + n0 + col;
        float acc[17];
#pragma unroll
        for (int bb = 0; bb < 17; ++bb) acc[bb] = 0.f;
        float wr[64];
#pragma unroll
        for (int k = 0; k < 64; ++k) wr[k] = w[(size_t)k * NMOD];
#pragma unroll
        for (int k = 0; k < 64; k += 4) {
#pragma unroll
            for (int bb = 0; bb < 17; ++bb) { const f32x4 s = *(const LAS f32x4*)(sil + bb * D + ks * 64 + k); acc[bb] += s[0] * wr[k] + s[1] * wr[k + 1] + s[2] * wr[k + 2] + s[3] * wr[k + 3]; }
        }
#pragma unroll
        for (int bb = 0; bb < 17; ++bb) part[(ks * 17 + bb) * 32 + col] = acc[bb];
        __syncthreads();
        for (int i = tid; i < 17 * 32; i += NTHR) { const int bb = i >> 5, cc = i & 31; float s = 0.f;
#pragma unroll
            for (int k2 = 0; k2 < 16; ++k2) s += part[(k2 * 17 + bb) * 32 + cc];
            mod[((size_t)l * 17 + bb) * NMOD + n0 + cc] = s + a.in[I_BADA][l * NMOD + n0 + cc]; }
        __syncthreads();
    }
    const int gt = blockIdx.x * NTHR + tid, GT = gridDim.x * NTHR;
    float* lbs = (float*)(ws + WS_MISC); float* rope = (float*)(ws + WS_MISC + 16384); float* biasp = (float*)(ws + WS_MISC + 32768); float* lamv = (float*)(ws + WS_MISC + 114688);
    for (int j = gt; j < 1024; j += GT) { const float* hl = a.in[I_HGLB];
        const float v0 = hl[j], v1 = hl[1024 + j], v2 = hl[2048 + j], v3 = hl[3072 + j]; const float mx = fmaxf(fmaxf(v0, v1), fmaxf(v2, v3));
        const float e0 = expf(v0 - mx), e1 = expf(v1 - mx), e2 = expf(v2 - mx), e3 = expf(v3 - mx), inv = 1.0f / (e0 + e1 + e2 + e3);
        lbs[j] = 0.f; lbs[1024 + j] = e1 * inv; lbs[2048 + j] = (e1 + e2) * inv; lbs[3072 + j] = (e1 + e2 + e3) * inv; }
    for (int j = gt; j < 64 * 12; j += GT) { const int pos = j / 12, i = j % 12; const float inv = powf(10000.0f, -(float)(2 * i) / 24.0f); const float ang = (float)pos * inv; rope[2 * j] = cosf(ang); rope[2 * j + 1] = sinf(ang); }
    for (int j = gt; j < DEPTH * DINP; j += GT) { const int l = j / DINP, n = j % DINP; biasp[l * DINP + perm_in_col(n)] = n < DIN ? a.in[I_BIN][l * DIN + n] : 0.f; }
    if (gt < DEPTH) { const float* lv = a.in[I_DALAM] + gt * 4 * 48; float s01 = 0.f, s23 = 0.f;
        for (int d = 0; d < 48; ++d) { s01 += lv[d] * lv[48 + d]; s23 += lv[96 + d] * lv[144 + d]; }
        const float lam_init = 0.8f - 0.6f * expf(-0.3f * (float)gt);
        lamv[gt] = expf(s01) - expf(s23) + lam_init; }
}

template <bool RES, bool NORM>
__device__ __forceinline__ void thin_phase(int row_lo, const float* xs_lat, const float* xs_ctx, float* xd_lat, float* xd_ctx, bool write_x,
                                           const bf16* y, const float* mod_r, int goff, const float* gpost,
                                           const float* mod_n, int soff, int aoff, const float* gpre, bf16* hout, int vcu, int G, int probe = 0) {
    const int tid = tid_opaque(); const int lane = tid & 63, wave = __builtin_amdgcn_readfirstlane(tid >> 6);
    const int nrows = MT - row_lo; int rwg = (nrows + G - 1) / G; rwg += rwg & 1;
    const int wbeg = row_lo + vcu * rwg, rend = (wbeg + rwg < MT) ? wbeg + rwg : MT;
    const int rbeg = wbeg + 2 * wave;
    constexpr int RSTEP = 2 * NWAVES;
    int cur_bb = -1;
    f32x4 gp[4], ga[4], sh[4];
#pragma unroll
    for (int j = 0; j < 4; ++j) { gp[j] = (f32x4){0.f, 0.f, 0.f, 0.f}; ga[j] = gp[j]; sh[j] = gp[j]; }
    f32x4 xa[2][4], ya[2][4];
#define TH_LOAD(X, Y, r_) do { _Pragma("unroll") for (int q_ = 0; q_ < 2; ++q_) { const int rr_ = (r_) + q_; const bool ic_ = rr_ < MC; \
        const float* xs_ = ic_ ? xs_ctx + (size_t)rr_ * D : xs_lat + (size_t)(rr_ - MC) * D; \
        _Pragma("unroll") for (int j_ = 0; j_ < 4; ++j_) { X[q_][j_] = *(const f32x4*)(xs_ + 4 * lane + 256 * j_); if (RES) { const v2u yw_ = *(const v2u*)(y + (size_t)rr_ * D + 4 * lane + 256 * j_); Y[q_][j_] = (f32x4){bflo(yw_.x), bfhi(yw_.x), bflo(yw_.y), bfhi(yw_.y)}; } } } } while (0)
    if (rbeg < rend) TH_LOAD(xa, ya, rbeg);
    for (int r = rbeg; r < rend; r += RSTEP) {
        f32x4 xb[2][4], yb[2][4];
        if (r + RSTEP < rend) TH_LOAD(xb, yb, r + RSTEP);
        const bool isctx = r < MC; const int bb = isctx ? 16 : (r - MC) / SEQ;
        if (bb != cur_bb) { cur_bb = bb;
#pragma unroll
            for (int j = 0; j < 4; ++j) { const int e = 4 * lane + 256 * j;
                if (RES) gp[j] = *(const f32x4*)(mod_r + (size_t)bb * NMOD + goff + e) * *(const f32x4*)(gpost + e);
                if (NORM) { ga[j] = *(const f32x4*)(gpre + e) * (*(const f32x4*)(mod_n + (size_t)bb * NMOD + aoff + e) + 1.0f); sh[j] = *(const f32x4*)(mod_n + (size_t)bb * NMOD + soff + e); } } }
        if (RES) { float s0 = 0.f, s1 = 0.f;
#pragma unroll
            for (int j = 0; j < 4; ++j) { s0 += (ya[0][j][0] * ya[0][j][0] + ya[0][j][1] * ya[0][j][1]) + (ya[0][j][2] * ya[0][j][2] + ya[0][j][3] * ya[0][j][3]);
                                          s1 += (ya[1][j][0] * ya[1][j][0] + ya[1][j][1] * ya[1][j][1]) + (ya[1][j][2] * ya[1][j][2] + ya[1][j][3] * ya[1][j][3]); }
#pragma unroll
            for (int o = 1; o < 64; o <<= 1) { s0 += lx_xor(s0, o, lane); s1 += lx_xor(s1, o, lane); }
            const float r0s = 1.0f / sqrtf(s0 * (1.0f / D) + EPS), r1s = 1.0f / sqrtf(s1 * (1.0f / D) + EPS);
#pragma unroll
            for (int j = 0; j < 4; ++j) { xa[0][j] += gp[j] * ya[0][j] * r0s; xa[1][j] += gp[j] * ya[1][j] * r1s; } }
        float* xd0 = isctx ? xd_ctx + (size_t)r * D : xd_lat + (size_t)(r - MC) * D;
        if (write_x && !(probe & 1)) {
#pragma unroll
            for (int j = 0; j < 4; ++j) { *(f32x4*)(xd0 + 4 * lane + 256 * j) = xa[0][j]; *(f32x4*)(xd0 + D + 4 * lane + 256 * j) = xa[1][j]; } }
        if (NORM) { float s0 = 0.f, s1 = 0.f;
#pragma unroll
            for (int j = 0; j < 4; ++j) { s0 += (xa[0][j][0] * xa[0][j][0] + xa[0][j][1] * xa[0][j][1]) + (xa[0][j][2] * xa[0][j][2] + xa[0][j][3] * xa[0][j][3]);
                                          s1 += (xa[1][j][0] * xa[1][j][0] + xa[1][j][1] * xa[1][j][1]) + (xa[1][j][2] * xa[1][j][2] + xa[1][j][3] * xa[1][j][3]); }
#pragma unroll
            for (int o = 1; o < 64; o <<= 1) { s0 += lx_xor(s0, o, lane); s1 += lx_xor(s1, o, lane); }
            const float r0s = 1.0f / sqrtf(s0 * (1.0f / D) + EPS), r1s = 1.0f / sqrtf(s1 * (1.0f / D) + EPS);
#pragma unroll
            for (int j = 0; j < 4; ++j) { const f32x4 h0 = xa[0][j] * r0s * ga[j] + sh[j], h1 = xa[1][j] * r1s * ga[j] + sh[j];
                v2u w0, w1; w0.x = pk2(h0[0], h0[1]); w0.y = pk2(h0[2], h0[3]); w1.x = pk2(h1[0], h1[1]); w1.y = pk2(h1[2], h1[3]);
                if (!(probe & 2)) { *(v2u*)(hout + (size_t)r * D + 4 * lane + 256 * j) = w0; *(v2u*)(hout + (size_t)(r + 1) * D + 4 * lane + 256 * j) = w1; } } }
#pragma unroll
        for (int q = 0; q < 2; ++q)
#pragma unroll
            for (int j = 0; j < 4; ++j) { xa[q][j] = xb[q][j]; if (RES) ya[q][j] = yb[q][j]; }
    }
#undef TH_LOAD
}

template <int MODE>
__device__ __forceinline__ void tr_item(const float* W, int K, int N, int nblk, bf16* WT, LAS float* scr, int item, int lane) {
    const int kb = item / nblk, nb = item % nblk, k0 = 64 * kb, n0 = 32 * nb;
    const int nn = n0 + (lane & 31); const bool ok = nn < N;
#pragma unroll 8
    for (int i = 0; i < 32; ++i) { const int kk = 2 * i + (lane >> 5); scr[kk * 33 + (lane & 31)] = ok ? W[(size_t)(k0 + kk) * N + nn] : 0.f; }
    LDS_WAIT(); asm volatile("" ::: "memory");
    const int c = lane & 7;
#pragma unroll
    for (int j = 0; j < 4; ++j) { const int n = (lane >> 3) + 8 * j; const LAS float* s = scr + (8 * c) * 33 + n;
        v4u o; o.x = pk2(s[0 * 33], s[1 * 33]); o.y = pk2(s[2 * 33], s[3 * 33]); o.z = pk2(s[4 * 33], s[5 * 33]); o.w = pk2(s[6 * 33], s[7 * 33]);
        const int ng = n0 + n; const int drow = MODE == 0 ? ng : MODE == 3 ? perm_in_col(ng) : ((ng >> 7) * 256 + (ng & 127) + (MODE == 2 ? 128 : 0));
        *(v4u*)(WT + (size_t)drow * K + k0 + 8 * c) = o; }
    LDS_WAIT(); asm volatile("" ::: "memory");
}
__device__ __forceinline__ void convert_weights(lptr lds, kargs_p ap, int l, int vcu, int G) {
    const unsigned char* const wsb = ap->ws; const float* const p_win = ap->in[I_WIN]; const float* const p_wout = ap->in[I_WOUT]; const float* const p_wg = ap->in[I_WG]; const float* const p_wu = ap->in[I_WU]; const float* const p_wd = ap->in[I_WD];
    const int tid = tid_opaque(); const int lane = tid & 63, wave = __builtin_amdgcn_readfirstlane(tid >> 6);
    LAS float* scr = (LAS float*)(lds + wave * 8448);
    const int gw = vcu * NWAVES + wave, NGW = G * NWAVES;
    unsigned char* ws = (unsigned char*)wsb;
    constexpr int I_IN = 16 * (DINP / 32), I_OUT = 16 * 32, I_GU = 16 * (DFF / 32), I_DN = (DFF / 64) * 32;
    constexpr int NITEMS = I_IN + I_OUT + 2 * I_GU + I_DN;
    for (int it = gw; it < NITEMS; it += NGW) {
        int r = it;
        if (r < I_IN) { tr_item<3>(p_win + (size_t)l * D * DIN, D, DIN, DINP / 32, (bf16*)(ws + WS_WIN), scr, r, lane); continue; } r -= I_IN;
        if (r < I_OUT) { tr_item<0>(p_wout + (size_t)l * D * D, D, D, 32, (bf16*)(ws + WS_WOUT), scr, r, lane); continue; } r -= I_OUT;
        if (r < I_GU) { tr_item<1>(p_wg + (size_t)l * D * DFF, D, DFF, DFF / 32, (bf16*)(ws + WS_WGU), scr, r, lane); continue; } r -= I_GU;
        if (r < I_GU) { tr_item<2>(p_wu + (size_t)l * D * DFF, D, DFF, DFF / 32, (bf16*)(ws + WS_WGU), scr, r, lane); continue; } r -= I_GU;
        tr_item<0>(p_wd + (size_t)l * DFF * D, DFF, D, 32, (bf16*)(ws + WS_WD), scr, r, lane);
    }
}
constexpr int AT_BUF = 25600, AT_KOFF = 0, AT_VOFF = 13312, AT_QF = 76800;
constexpr float AT_THR = 8.0f;
constexpr float QSCALE = 0.14433756729740643f * 1.4426950408889634f;

__device__ __forceinline__ f32x16 zero16() { f32x16 z; _Pragma("unroll") for (int r = 0; r < 16; ++r) z[r] = 0.f; return z; }
__device__ __forceinline__ float sm_max(const f32x16& S, int lane) {
    float mx = S[0];
#pragma unroll
    for (int r = 1; r < 16; ++r) mx = fmaxf(mx, S[r]);
    return fmaxf(mx, lx_xor(mx, 32, lane));
}
__device__ __forceinline__ void sm_exp(const f32x16& S, float m, float& l, bf16x8& p0, bf16x8& p1) {
    float p[16]; float ps = 0.f;
#pragma unroll
    for (int r = 0; r < 16; ++r) { p[r] = __builtin_amdgcn_exp2f(S[r] - m); ps += p[r]; }
    l += ps;
    v4u a, b;
    a.x = pk2(p[0], p[1]); a.y = pk2(p[2], p[3]); a.z = pk2(p[4], p[5]); a.w = pk2(p[6], p[7]);
    b.x = pk2(p[8], p[9]); b.y = pk2(p[10], p[11]); b.z = pk2(p[12], p[13]); b.w = pk2(p[14], p[15]);
    p0 = __builtin_bit_cast(bf16x8, a); p1 = __builtin_bit_cast(bf16x8, b);
}
__device__ __forceinline__ bf16x8 vt_frag(lptr vt, int ct, int sub, int sp, int lane) {
    const int h = lane >> 5, blk = (lane >> 4) & 1, q = (lane & 15) >> 2, p = lane & 3;
    lptr a = vt + (32 * sub + 16 * sp + 4 * h + q) * 192 + (32 * ct + 16 * blk + 4 * p) * 2;
    const v4i16 lo = __builtin_amdgcn_ds_read_tr16_b64_v4i16((LAS v4i16*)a);
    const v4i16 hi = __builtin_amdgcn_ds_read_tr16_b64_v4i16((LAS v4i16*)(a + 8 * 192));
    return __builtin_shufflevector(lo, hi, 0, 1, 2, 3, 4, 5, 6, 7);
}

__device__ __forceinline__ void attn_item(lptr lds, const bf16* P, bf16* YM, const float* danorm, float lam, float out_scale, int b, int h, int qb, int probe) {
    const int tid = tid_opaque(), lane = tid & 63, r32 = lane & 31, hi = lane >> 5, wave = __builtin_amdgcn_readfirstlane(tid >> 6);
    const bool lat = qb < 8;
    const int qrow0 = lat ? MC + b * SEQ + qb * 256 : b * CTXL;
    const int nt = lat ? 36 : 4;
    v4u kin[2], vin[2];
    const int key0 = tid / 12, cc0 = tid % 12, key1 = (tid + 512) / 12, cc1 = (tid + 512) % 12;
#define AT_TILE_ROW0(tile) (((tile) < 4) ? (b * CTXL + 64 * (tile)) : (MC + b * SEQ + 64 * ((tile) - 4)))
#define AT_LOAD(tile) do { const int row0_ = AT_TILE_ROW0(tile); \
        { const unsigned s_ = (unsigned)(row0_ + key0) * (unsigned)(DINP * 2) + (unsigned)(h * 96 + cc0 * 8) * 2u; kin[0] = gld16(P, s_ + C_DAK * 2u); vin[0] = gld16(P, s_ + C_DAV * 2u); } \
        if (tid < 256) { const unsigned s_ = (unsigned)(row0_ + key1) * (unsigned)(DINP * 2) + (unsigned)(h * 96 + cc1 * 8) * 2u; kin[1] = gld16(P, s_ + C_DAK * 2u); vin[1] = gld16(P, s_ + C_DAV * 2u); } } while (0)
#define AT_STORE(tile, buf) do { lptr kd_ = lds + (buf) * AT_BUF + AT_KOFF, vd_ = lds + (buf) * AT_BUF + AT_VOFF; \
        *(LAS v4u*)(kd_ + key0 * 208 + cc0 * 16) = kin[0]; *(LAS v4u*)(vd_ + key0 * 192 + cc0 * 16) = vin[0]; \
        if (tid < 256) { *(LAS v4u*)(kd_ + key1 * 208 + cc1 * 16) = kin[1]; *(LAS v4u*)(vd_ + key1 * 192 + cc1 * 16) = vin[1]; } } while (0)
    AT_LOAD(0);
    lptr qfp = lds + AT_QF + (wave * 6 * 64 + lane) * 16;
    { const unsigned qo = (unsigned)(qrow0 + wave * 32 + r32) * (unsigned)(DINP * 2) + (unsigned)(C_DAQ + h * 96 + hi * 8) * 2u;
#pragma unroll
      for (int f = 0; f < 6; ++f) *(LAS v4u*)(qfp + f * 1024) = gld16(P, qo + (unsigned)((f / 3) * 48 + (f % 3) * 16) * 2u); }
    AT_STORE(0, 0);
    if (nt > 1) AT_LOAD(1);
    __syncthreads();
    f32x16 O0[3], O1[3];
#pragma unroll
    for (int ct = 0; ct < 3; ++ct)
#pragma unroll
        for (int r = 0; r < 16; ++r) { O0[ct][r] = 0.f; O1[ct][r] = 0.f; }
    float m0 = -1e30f, m1 = -1e30f, l0 = 0.f, l1 = 0.f;
#define AT_QK(SX0, SX1, kb, sub) do { \
        _Pragma("unroll") for (int ks = 0; ks < 3; ++ks) { \
            const bf16x8 k0_ = lds8((kb) + (((sub) * 32 + r32) * 104 + ks * 16 + hi * 8) * 2); \
            const bf16x8 k1_ = lds8((kb) + (((sub) * 32 + r32) * 104 + 48 + ks * 16 + hi * 8) * 2); \
            const bf16x8 q0_ = lds8(qfp + ks * 1024), q1_ = lds8(qfp + (3 + ks) * 1024); \
            if (ks == 0) { SX0 = MFMA32(k0_, q0_, zero16()); SX1 = MFMA32(k1_, q1_, zero16()); } \
            else { SX0 = MFMA32(k0_, q0_, SX0); SX1 = MFMA32(k1_, q1_, SX1); } } } while (0)
#define AT_SMPV(SX0, SX1, vb, sub) do { \
        const float mx0_ = sm_max(SX0, lane), mx1_ = sm_max(SX1, lane); \
        if (__any((mx0_ > m0 + AT_THR) || (mx1_ > m1 + AT_THR))) { \
            const float n0_ = fmaxf(m0, mx0_), n1_ = fmaxf(m1, mx1_); \
            const float a0_ = __builtin_amdgcn_exp2f(m0 - n0_), a1_ = __builtin_amdgcn_exp2f(m1 - n1_); \
            m0 = n0_; m1 = n1_; l0 *= a0_; l1 *= a1_; \
            _Pragma("unroll") for (int ct = 0; ct < 3; ++ct) _Pragma("unroll") for (int r = 0; r < 16; ++r) { O0[ct][r] *= a0_; O1[ct][r] *= a1_; } } \
        bf16x8 p00_, p01_, p10_, p11_; \
        sm_exp(SX0, m0, l0, p00_, p01_); sm_exp(SX1, m1, l1, p10_, p11_); \
        _Pragma("unroll") for (int ct = 0; ct < 3; ++ct) { \
            const bf16x8 v0_ = vt_frag((vb), ct, (sub), 0, lane); const bf16x8 v1_ = vt_frag((vb), ct, (sub), 1, lane); \
            O0[ct] = MFMA32(v0_, p00_, O0[ct]); O1[ct] = MFMA32(v0_, p10_, O1[ct]); \
            O0[ct] = MFMA32(v1_, p01_, O0[ct]); O1[ct] = MFMA32(v1_, p11_, O1[ct]); } } while (0)
    f32x16 SA0, SA1, SB0, SB1;
    AT_QK(SA0, SA1, lds + AT_KOFF, 0);
    int cb = 0;
    for (int i = 0; i < nt; ++i) {
        const int nb = (cb == 2) ? 0 : cb + 1;
        if (i + 1 < nt && !(probe & 2)) AT_STORE(i + 1, nb);
        if (i + 2 < nt && !(probe & 1)) AT_LOAD(i + 2);
        lptr kc_ = lds + cb * AT_BUF + AT_KOFF, vc_ = lds + cb * AT_BUF + AT_VOFF;
        AT_QK(SB0, SB1, kc_, 1);
        AT_SMPV(SA0, SA1, vc_, 0);
        __syncthreads();
        if (i + 1 < nt) AT_QK(SA0, SA1, lds + nb * AT_BUF + AT_KOFF, 0);
        AT_SMPV(SB0, SB1, vc_, 1);
        cb = nb;
    }
#undef AT_TILE_ROW0
#undef AT_LOAD
#undef AT_STORE
#undef AT_QK
#undef AT_SMPV
    const float i0 = 1.0f / (l0 + lx_xor(l0, 32, lane)), i1 = lam / (l1 + lx_xor(l1, 32, lane));
    float ss = 0.f;
#pragma unroll
    for (int ct = 0; ct < 3; ++ct)
#pragma unroll
        for (int r = 0; r < 16; ++r) { const float o = O0[ct][r] * i0 - O1[ct][r] * i1; O0[ct][r] = o; ss += o * o; }
    ss += lx_xor(ss, 32, lane);
    const float rs = out_scale / sqrtf(ss * (1.0f / 96.0f) + EPS);
    const unsigned oro = ((unsigned)(qrow0 + wave * 32 + r32) * (unsigned)D + (unsigned)(Y_DA + h * 96)) * 2u;
#pragma unroll
    for (int ct = 0; ct < 3; ++ct)
#pragma unroll
        for (int g = 0; g < 4; ++g) { const int c0 = 32 * ct + 8 * g + 4 * hi; const f32x4 gn = *(const f32x4*)(danorm + c0);
            v2u w; w.x = pk2(O0[ct][4 * g] * rs * gn[0], O0[ct][4 * g + 1] * rs * gn[1]); w.y = pk2(O0[ct][4 * g + 2] * rs * gn[2], O0[ct][4 * g + 3] * rs * gn[3]);
            gst8(YM, oro + 2u * c0, w); }
}
__device__ __forceinline__ int scan_row(int b, int dir, int p) {
    if (p < CTXL) { const int t = dir ? CTXL - 1 - p : p; return b * CTXL + t; }
    const int pl = p - CTXL; const int t = dir ? SEQ - 1 - pl : pl; return MC + b * SEQ + t;
}

constexpr int ML_Q = 0, ML_K = 13312, ML_KW = 26624, ML_VA = 40960, ML_QKM = 55296, ML_ST = 64512, ML_GF = 87808;
constexpr int ML_LDQ = 208, ML_LDW = 224, ML_LDM = 144, ML_LDS = 208;
constexpr float KSCALE = 0.10206207261596577f;

__device__ __forceinline__ void mlstm_stream(lptr lds, const bf16* P, const float* G, bf16* dst, int dst_ld, const float* fbias  , int b, int h, int dir) {
    const int tid = tid_opaque(), lane = tid & 63, c16 = lane & 15, rg = lane >> 4, wave = __builtin_amdgcn_readfirstlane(tid >> 6);
    lptr Qs = lds + ML_Q, Ks = lds + ML_K, Kw = lds + ML_KW, Va = lds + ML_VA, QKM = lds + ML_QKM, ST = lds + ML_ST;
    LAS float* gA = (LAS float*)(lds + ML_GF); LAS float* MxA = gA + 64; LAS float* wA = gA + 128; LAS float* emtA = gA + 192; LAS float* wkA = gA + 256; LAS float* scal = gA + 320;
    if (tid < 128) { const int t = tid >> 1, hh = tid & 1; v4u w; w.x = hh ? 0u : 0x3F80u; w.y = 0u; w.z = 0u; w.w = 0u; *(LAS v4u*)(Va + t * ML_LDW + (96 + 8 * hh) * 2) = w; }
    const float fb = fbias[dir * 4 + h];
    f32x4 acc[11];
#pragma unroll
    for (int i = 0; i < 11; ++i) acc[i] = (f32x4){0.f, 0.f, 0.f, 0.f};
    float m_prev = -1e30f;
    v4u pre[5]; float gi = 0.f, gf = 0.f;
#define ML_PREFETCH(c) do { \
    _Pragma("unroll") for (int i_ = 0; i_ < 5; ++i_) { const int id_ = tid + NTHR * i_; if (id_ < 2304) { const int t_ = id_ / 36, r_ = id_ % 36, wh_ = r_ / 12, cc_ = r_ % 12; \
        const unsigned ro_ = (unsigned)scan_row(b, dir, 64 * (c) + t_) * (unsigned)(DINP * 2); pre[i_] = gld16(P, ro_ + (unsigned)(wh_ * 384 + h * 96 + cc_ * 8) * 2u); } } \
    if (wave == 0) { const unsigned go_ = (unsigned)scan_row(b, dir, 64 * (c) + lane) * 64u + (unsigned)(dir * 4 + h) * 4u; gi = *(const float*)((const char*)G + go_); gf = *(const float*)((const char*)G + go_ + 32u); } } while (0)
    ML_PREFETCH(0);
    for (int c = 0; c < NTOK / 64; ++c) {
#pragma unroll
        for (int i = 0; i < 5; ++i) { const int id = tid + NTHR * i; if (id < 2304) { const int t = id / 36, r = id % 36, wh = r / 12, cc = r % 12;
            lptr d = (wh == 0) ? Qs + t * ML_LDQ : (wh == 1) ? Ks + t * ML_LDQ : Va + t * ML_LDW;
            *(LAS v4u*)(d + cc * 16) = pre[i]; } }
        if (wave == 0) {
            const float fp = gf + fb;
            const float lf = fminf(fp, 0.f) - log1pf(__expf(-fabsf(fp)));
            float bs = lf;
#pragma unroll
            for (int o = 1; o < 64; o <<= 1) { const float v = lx_up(bs, o, lane); if (lane >= o) bs += v; }
            const float g = gi - bs;
            float cm = g;
#pragma unroll
            for (int o = 1; o < 64; o <<= 1) { const float v = lx_up(cm, o, lane); if (lane >= o) cm = fmaxf(cm, v); }
            const float Mx = fmaxf(m_prev, cm);
            const float mt = bs + Mx;
            const float blast = lx_idx(bs, 63), m_new = lx_idx(mt, 63);
            gA[lane] = g; MxA[lane] = Mx; wA[lane] = __expf(m_prev - Mx); emtA[lane] = __expf(-mt); wkA[lane] = __expf(g + blast - m_new) * KSCALE;
            if (lane == 0) scal[0] = __expf(blast + m_prev - m_new);
            m_prev = m_new;
        }
        if (c + 1 < NTOK / 64) ML_PREFETCH(c + 1);
        __syncthreads();
#pragma unroll
        for (int j = 0; j < 2; ++j) { const int idx = 2 * wave + j, si = idx & 3, ti = idx >> 2;
            f32x4 a4 = (f32x4){0.f, 0.f, 0.f, 0.f};
            if (si <= ti) {
#pragma unroll
                for (int ks = 0; ks < 3; ++ks) a4 = MFMA16(opr(Ks, ML_LDQ, 16 * si, 32 * ks, c16, rg), opr(Qs, ML_LDQ, 16 * ti, 32 * ks, c16, rg), a4);
            }
            const int t = 16 * ti + c16, s0 = 16 * si + 4 * rg; const float mxt = MxA[t]; const f32x4 g4 = *(const LAS f32x4*)(gA + s0);
            float v[4];
#pragma unroll
            for (int r = 0; r < 4; ++r) v[r] = (s0 + r <= t) ? a4[r] * KSCALE * __expf(g4[r] - mxt) : 0.f;
            v2u w; w.x = pk2(v[0], v[1]); w.y = pk2(v[2], v[3]); *(LAS v2u*)(QKM + t * ML_LDM + s0 * 2) = w; }
        for (int id = tid; id < 64 * 12; id += NTHR) { const int t = id / 12, cc = id % 12; const v4u w = *(const LAS v4u*)(Ks + t * ML_LDQ + cc * 16); const float sc = wkA[t];
            v4u o; o.x = pk2(bflo(w.x) * sc, bfhi(w.x) * sc); o.y = pk2(bflo(w.y) * sc, bfhi(w.y) * sc); o.z = pk2(bflo(w.z) * sc, bfhi(w.z) * sc); o.w = pk2(bflo(w.w) * sc, bfhi(w.w) * sc);
            *(LAS v4u*)(Kw + t * ML_LDW + cc * 16) = o; }
        if (wave >= 4) { const int sw = wave - 4;
#pragma unroll
            for (int i = 0; i < 11; ++i) { const int j = sw + 4 * i; if (j < 42) { const int di = j / 7, vi = j % 7;
                v2u w; w.x = pk2(acc[i][0], acc[i][1]); w.y = pk2(acc[i][2], acc[i][3]); *(LAS v2u*)(ST + (16 * vi + c16) * ML_LDS + (16 * di + 4 * rg) * 2) = w; } } }
        __syncthreads();
        if (wave < 4) {
            const int ti = wave, t = 16 * ti + c16;
            f32x4 aX[7];
#pragma unroll
            for (int vi = 0; vi < 7; ++vi) aX[vi] = (f32x4){0.f, 0.f, 0.f, 0.f};
#pragma unroll
            for (int ks = 0; ks < 3; ++ks) { const bf16x8 b8 = opr(Qs, ML_LDQ, 16 * ti, 32 * ks, c16, rg);
#pragma unroll
                for (int vi = 0; vi < 7; ++vi) aX[vi] = MFMA16(opr(ST, ML_LDS, 16 * vi, 32 * ks, c16, rg), b8, aX[vi]); }
            { const float wt = wA[t];
#pragma unroll
              for (int vi = 0; vi < 7; ++vi) aX[vi] = aX[vi] * wt; }
#pragma unroll
            for (int ks = 0; ks < 2; ++ks) { const bf16x8 b8 = opr(QKM, ML_LDM, 16 * ti, 32 * ks, c16, rg);
#pragma unroll
                for (int vi = 0; vi < 7; ++vi) aX[vi] = MFMA16(opt(Va, ML_LDW, 16 * vi, 32 * ks, lane), b8, aX[vi]); }
            const float den = lx_idx(aX[6][0], c16);
            const float inv = 1.0f / fmaxf(fabsf(den), emtA[t]);
            const int row = scan_row(b, dir, 64 * c + t);
            const unsigned oo = ((unsigned)row * (unsigned)dst_ld + (unsigned)(h * 96 + 4 * rg)) * 2u;
#pragma unroll
            for (int vi = 0; vi < 6; ++vi) { v2u w; w.x = pk2(aX[vi][0] * inv, aX[vi][1] * inv); w.y = pk2(aX[vi][2] * inv, aX[vi][3] * inv); gst8(dst, oo + 32u * vi, w); }
        } else {
            const int sw = wave - 4; const float decay = scal[0];
#pragma unroll
            for (int i = 0; i < 11; ++i) { const int j = sw + 4 * i; if (j < 42) { const int di = j / 7, vi = j % 7;
                acc[i] = acc[i] * decay;
#pragma unroll
                for (int ks = 0; ks < 2; ++ks) acc[i] = MFMA16(opt(Kw, ML_LDW, 16 * di, 32 * ks, lane), opt(Va, ML_LDW, 16 * vi, 32 * ks, lane), acc[i]); } }
        }
        __syncthreads();
    }
#undef ML_PREFETCH
}

constexpr int HG_QT = 0, HG_KR = 8704, HG_V = 17920, HG_ATT = 23040, HG_SPT = 25600, HG_ER = 43008, HG_TOT = 43520, HG_OFF = 47616;
constexpr int HG_LDQ = 272, HG_LDK = 288, HG_LDV = 160, HG_LDA = 80, HG_LDS = 272;

__device__ __forceinline__ void hgrn2_stream(lptr lds, const bf16* P, bf16* dst, int dst_ld, const float* lbl  , int b, int h, int dir) {
    const int tid = tid_opaque(), lane = tid & 63, c16 = lane & 15, rg = lane >> 4, wave = __builtin_amdgcn_readfirstlane(tid >> 6);
    lptr QT = lds + HG_QT, KR = lds + HG_KR, Vs = lds + HG_V, ATT = lds + HG_ATT, SPT = lds + HG_SPT;
    LAS float* ER = (LAS float*)(lds + HG_ER); LAS float* TOT = (LAS float*)(lds + HG_TOT); LAS float* OFF = (LAS float*)(lds + HG_OFF);
    const int tt = tid >> 4, kc = tid & 15;
    const int tv = tid >> 3, cv = tid & 7;
    float lb[8];
    { const f32x4 l0 = *(const f32x4*)(lbl + dir * 512 + h * 128 + 8 * kc), l1 = *(const f32x4*)(lbl + dir * 512 + h * 128 + 8 * kc + 4);
#pragma unroll
      for (int j = 0; j < 4; ++j) { lb[j] = l0[j]; lb[4 + j] = l1[j]; } }
    f32x4 acc[4];
#pragma unroll
    for (int i = 0; i < 4; ++i) acc[i] = (f32x4){0.f, 0.f, 0.f, 0.f};
    v4u zr, qr, vr;
#define HG_PREFETCH(c) do { { const unsigned ro_ = (unsigned)scan_row(b, dir, 32 * (c) + tt) * (unsigned)(DINP * 2) + 16u * kc; \
        zr = gld16(P, ro_ + (unsigned)(C_HGF + dir * 512 + h * 128) * 2u); qr = gld16(P, ro_ + (unsigned)(C_HGQ + h * 128) * 2u); } \
        if (tid < 256) { const unsigned ro_ = (unsigned)scan_row(b, dir, 32 * (c) + tv) * (unsigned)(DINP * 2) + 16u * cv; vr = gld16(P, ro_ + (unsigned)(C_HGI + h * 64) * 2u); } } while (0)
    HG_PREFETCH(0);
    for (int c = 0; c < NTOK / 32; ++c) {
        float kk[8], cs[8], qv[8];
        { const unsigned zw[4] = {zr.x, zr.y, zr.z, zr.w}, qw[4] = {qr.x, qr.y, qr.z, qr.w};
#pragma unroll
          for (int j = 0; j < 8; ++j) { const float z = (j & 1) ? bfhi(zw[j >> 1]) : bflo(zw[j >> 1]); qv[j] = (j & 1) ? bfhi(qw[j >> 1]) : bflo(qw[j >> 1]);
              const float e = __expf(-fabsf(z)); const float inv = __builtin_amdgcn_rcpf(1.0f + e);
              const float sig = z >= 0.f ? inv : e * inv, nsig = z >= 0.f ? e * inv : inv;
              const float oml = 1.0f - lb[j]; const float f = fmaxf(lb[j], 1e-30f) + oml * sig; kk[j] = oml * nsig;
              float x = __log2f(f);
              float y = lx_up(x, 16, lane); if (lane >= 16) x += y;
              y = lx_up(x, 32, lane); if (lane >= 32) x += y;
              cs[j] = x; } }
        if (tid < 256) *(LAS v4u*)(Vs + tv * HG_LDV + cv * 16) = vr;
        if (lane >= 48) { *(LAS f32x4*)(TOT + wave * 128 + 8 * kc) = (f32x4){cs[0], cs[1], cs[2], cs[3]}; *(LAS f32x4*)(TOT + wave * 128 + 8 * kc + 4) = (f32x4){cs[4], cs[5], cs[6], cs[7]}; }
        __syncthreads();
        if (tid < 128) { f32x4 o0 = (f32x4){0.f, 0.f, 0.f, 0.f}, o1 = o0, s0 = o0, s1 = o0;
#pragma unroll
            for (int w2 = 0; w2 < 8; ++w2) { const f32x4 t0 = *(const LAS f32x4*)(TOT + w2 * 128 + 8 * kc), t1 = *(const LAS f32x4*)(TOT + w2 * 128 + 8 * kc + 4);
                if (w2 == tt) { o0 = s0; o1 = s1; } s0 += t0; s1 += t1; }
            *(LAS f32x4*)(OFF + tt * 128 + 8 * kc) = o0; *(LAS f32x4*)(OFF + tt * 128 + 8 * kc + 4) = o1;
            if (tt == 0) { *(LAS f32x4*)(OFF + 1024 + 8 * kc) = s0; *(LAS f32x4*)(OFF + 1024 + 8 * kc + 4) = s1;
                const f32x4 e0 = {__builtin_amdgcn_exp2f(fmaxf(0.5f * s0[0], -100.f)), __builtin_amdgcn_exp2f(fmaxf(0.5f * s0[1], -100.f)), __builtin_amdgcn_exp2f(fmaxf(0.5f * s0[2], -100.f)), __builtin_amdgcn_exp2f(fmaxf(0.5f * s0[3], -100.f))};
                const f32x4 e1 = {__builtin_amdgcn_exp2f(fmaxf(0.5f * s1[0], -100.f)), __builtin_amdgcn_exp2f(fmaxf(0.5f * s1[1], -100.f)), __builtin_amdgcn_exp2f(fmaxf(0.5f * s1[2], -100.f)), __builtin_amdgcn_exp2f(fmaxf(0.5f * s1[3], -100.f))};
                *(LAS f32x4*)(ER + 8 * kc) = e0; *(LAS f32x4*)(ER + 8 * kc + 4) = e1; } }
        __syncthreads();
        { const f32x4 o0 = *(const LAS f32x4*)(OFF + wave * 128 + 8 * kc), o1 = *(const LAS f32x4*)(OFF + wave * 128 + 8 * kc + 4);
          const f32x4 t0 = *(const LAS f32x4*)(OFF + 1024 + 8 * kc), t1 = *(const LAS f32x4*)(OFF + 1024 + 8 * kc + 4);
          float qt[8], kt[8];
#pragma unroll
          for (int j = 0; j < 8; ++j) { const float rr = 0.5f * (j < 4 ? t0[j & 3] : t1[j & 3]); float x = (j < 4 ? o0[j & 3] : o1[j & 3]) + cs[j] - rr; x = fminf(fmaxf(x, -100.f), 100.f);
              const float q = qv[j]; const float qs = q * __builtin_amdgcn_rcpf(1.0f + __expf(-q));
              qt[j] = qs * __builtin_amdgcn_exp2f(x); kt[j] = kk[j] * __builtin_amdgcn_exp2f(-x); }
          v4u wq, wk; wq.x = pk2(qt[0], qt[1]); wq.y = pk2(qt[2], qt[3]); wq.z = pk2(qt[4], qt[5]); wq.w = pk2(qt[6], qt[7]);
          wk.x = pk2(kt[0], kt[1]); wk.y = pk2(kt[2], kt[3]); wk.z = pk2(kt[4], kt[5]); wk.w = pk2(kt[6], kt[7]);
          *(LAS v4u*)(QT + tt * HG_LDQ + kc * 16) = wq; *(LAS v4u*)(KR + tt * HG_LDK + kc * 16) = wk; }
        if (c + 1 < NTOK / 32) HG_PREFETCH(c + 1);
        __syncthreads();
        if (wave < 4) { const int si = wave & 1, ti = wave >> 1;
            f32x4 a4 = (f32x4){0.f, 0.f, 0.f, 0.f};
            if (si <= ti) {
#pragma unroll
                for (int ks = 0; ks < 4; ++ks) a4 = MFMA16(opr(KR, HG_LDK, 16 * si, 32 * ks, c16, rg), opr(QT, HG_LDQ, 16 * ti, 32 * ks, c16, rg), a4);
            }
            const int t = 16 * ti + c16, s0 = 16 * si + 4 * rg;
            v2u w; w.x = pk2(s0 <= t ? a4[0] : 0.f, s0 + 1 <= t ? a4[1] : 0.f); w.y = pk2(s0 + 2 <= t ? a4[2] : 0.f, s0 + 3 <= t ? a4[3] : 0.f);
            *(LAS v2u*)(ATT + t * HG_LDA + s0 * 2) = w; }
        { const f32x4 er = *(const LAS f32x4*)(ER + 16 * wave + 4 * rg);
#pragma unroll
          for (int ci = 0; ci < 4; ++ci) { acc[ci] = acc[ci] * er; v2u w; w.x = pk2(acc[ci][0], acc[ci][1]); w.y = pk2(acc[ci][2], acc[ci][3]);
              *(LAS v2u*)(SPT + (16 * ci + c16) * HG_LDS + (16 * wave + 4 * rg) * 2) = w; } }
        __syncthreads();
        { const int ci = wave & 3, ti = wave >> 2, t = 16 * ti + c16;
          f32x4 o4 = (f32x4){0.f, 0.f, 0.f, 0.f};
          o4 = MFMA16(opt(Vs, HG_LDV, 16 * ci, 0, lane), opr(ATT, HG_LDA, 16 * ti, 0, c16, rg), o4);
#pragma unroll
          for (int ks = 0; ks < 4; ++ks) o4 = MFMA16(opr(SPT, HG_LDS, 16 * ci, 32 * ks, c16, rg), opr(QT, HG_LDQ, 16 * ti, 32 * ks, c16, rg), o4);
          const int row = scan_row(b, dir, 32 * c + t);
          v2u w; w.x = pk2(o4[0], o4[1]); w.y = pk2(o4[2], o4[3]);
          gst8(dst, ((unsigned)row * (unsigned)dst_ld + (unsigned)(h * 64 + 16 * ci + 4 * rg)) * 2u, w); }
        { const bf16x8 a8 = opt(KR, HG_LDK, 16 * wave, 0, lane); const f32x4 er = *(const LAS f32x4*)(ER + 16 * wave + 4 * rg);
#pragma unroll
          for (int ci = 0; ci < 4; ++ci) { acc[ci] = MFMA16(a8, opt(Vs, HG_LDV, 16 * ci, 0, lane), acc[ci]); acc[ci] = acc[ci] * er; } }
        __syncthreads();
    }
#undef HG_PREFETCH
}

__device__ __forceinline__ void fin_phase(int row_lo, const bf16* P, bf16* YM, const bf16* RAWM, const bf16* RAWH, const float* mlgain  , const float* hggain  , int vcu, int G) {
    const int tid = tid_opaque(); const int lane = tid & 63, wave = __builtin_amdgcn_readfirstlane(tid >> 6);
    const int gw = vcu * NWAVES + wave, NGW = G * NWAVES;
    float gm[6], gh[4];
#pragma unroll
    for (int j = 0; j < 6; ++j) gm[j] = mlgain[6 * lane + j];
#pragma unroll
    for (int j = 0; j < 4; ++j) gh[j] = hggain[4 * lane + j];
    for (int r = row_lo + gw; r < MT; r += NGW) {
        bf16* ym = YM + (size_t)r * D;
        const unsigned* f3 = (const unsigned*)(ym + Y_ML + 6 * lane); const unsigned* b3 = (const unsigned*)(RAWM + (size_t)r * 384 + 6 * lane); const unsigned* o3 = (const unsigned*)(P + (size_t)r * DINP + C_MLO + 6 * lane);
        const unsigned fa = f3[0], fb_ = f3[1], fc = f3[2], ba = b3[0], bb = b3[1], bc = b3[2], oa = o3[0], ob = o3[1], oc = o3[2];
        const v2u f2 = *(const v2u*)(ym + Y_HG + 4 * lane), b2 = *(const v2u*)(RAWH + (size_t)r * 256 + 4 * lane), g2 = *(const v2u*)(P + (size_t)r * DINP + C_HGG + 4 * lane);
        float hm[6] = {bflo(fa) + bflo(ba), bfhi(fa) + bfhi(ba), bflo(fb_) + bflo(bb), bfhi(fb_) + bfhi(bb), bflo(fc) + bflo(bc), bfhi(fc) + bfhi(bc)};
        const float og[6] = {bflo(oa), bfhi(oa), bflo(ob), bfhi(ob), bflo(oc), bfhi(oc)};
        float hh[4] = {bflo(f2.x) + bflo(b2.x), bfhi(f2.x) + bfhi(b2.x), bflo(f2.y) + bflo(b2.y), bfhi(f2.y) + bfhi(b2.y)};
        const float gg[4] = {bflo(g2.x), bfhi(g2.x), bflo(g2.y), bfhi(g2.y)};
        float sm = 0.f, sh = 0.f;
#pragma unroll
        for (int j = 0; j < 6; ++j) sm += hm[j] * hm[j];
#pragma unroll
        for (int j = 0; j < 4; ++j) sh += hh[j] * hh[j];
#pragma unroll
        for (int o = 1; o < 16; o <<= 1) { sm += lx_xor(sm, o, lane); sh += lx_xor(sh, o, lane); }
        const float rm = 1.0f / sqrtf(sm * (1.0f / 96.0f) + EPS), rh = 1.0f / sqrtf(sh * (1.0f / 64.0f) + EPS);
#pragma unroll
        for (int j = 0; j < 6; ++j) hm[j] = hm[j] * rm * gm[j] * __builtin_amdgcn_rcpf(1.0f + __expf(-og[j]));
#pragma unroll
        for (int j = 0; j < 4; ++j) hh[j] = hh[j] * rh * gh[j] * gg[j] * __builtin_amdgcn_rcpf(1.0f + __expf(-gg[j]));
        unsigned* w3 = (unsigned*)(ym + Y_ML + 6 * lane); w3[0] = pk2(hm[0], hm[1]); w3[1] = pk2(hm[2], hm[3]); w3[2] = pk2(hm[4], hm[5]);
        v2u w2; w2.x = pk2(hh[0], hh[1]); w2.y = pk2(hh[2], hh[3]); *(v2u*)(ym + Y_HG + 4 * lane) = w2;
    }
}
#ifndef NO_HG
#define NO_HG 0
#endif
#ifndef NO_ML
#define NO_ML 0
#endif
#ifndef NO_AT
#define NO_AT 0
#endif
#ifndef NO_GEMM
#define NO_GEMM 0
#endif
#ifndef NO_G1
#define NO_G1 0
#endif
#ifndef NO_G2
#define NO_G2 0
#endif
#ifndef NO_G3
#define NO_G3 0
#endif
#ifndef NO_G4
#define NO_G4 0
#endif
#ifndef NO_P0
#define NO_P0 0
#endif
#ifndef STAMP_ON
#define STAMP_ON 0
#endif
#ifndef SA
#define SA 0
#define SB 1
#define SC 0
#define SD 1
#endif
#ifndef THIN_PROBE
#define THIN_PROBE 0
#endif
#ifndef ATT_PROBE
#define ATT_PROBE 0
#endif
#ifndef REPMASK
#define REPMASK 7
#endif
#ifndef REP
#define REP 0
#endif
constexpr int NPHASE = 2 + 8 * DEPTH;

typedef __attribute__((address_space(4))) const Args* kargs_t;
__device__ __forceinline__ kargs_t kargs() { kargs_t p = (kargs_t)__builtin_amdgcn_kernarg_segment_ptr(); asm volatile("" : "+s"(p)); return p; }
#define WSP(T, off) ((T*)(ws + (off)))

__global__ void __launch_bounds__(NTHR, 2) fwd(Args a_unused) {
    extern __shared__ __attribute__((aligned(16))) unsigned char lds_raw[];
    lptr lds = (lptr)lds_raw;
    const int G = gridDim.x; const int bx = blockIdx.x; const int vcu = (G % 8 == 0) ? (bx % 8) * (G / 8) + bx / 8 : bx;
    volatile LAS unsigned* MISC = (volatile LAS unsigned*)(lds + LDSCTL_OFF);
    { const int tid = tid_opaque(); for (int u = tid; u < (LDS_BYTES - LDSCTL_OFF) / 4; u += NTHR) ((LAS unsigned*)(lds + LDSCTL_OFF))[u] = 0u; }
    __syncthreads();
    int lo, hi; XcdBarrier bar;
    { kargs_t A = kargs(); lo = A->ph_lo; hi = A->ph_hi; unsigned* bw = (unsigned*)(A->ws + WS_CTL) + CW_BAR;
      bar.bar = bw; bar.x = 0; bar.st = nullptr;
      if (hi - lo > 1) bar = xcd_barrier_post(bw, MISC + 8); }
    volatile LAS int* slot = (volatile LAS int*)(MISC + 16);
#if STAMP_ON
#define STAMP(k) do { if (bx == 0 && tid_opaque() == 0) { kargs_t A_ = kargs(); __hip_atomic_store((unsigned long long*)(A_->ws + WS_MISC + 131072) + (k), (unsigned long long)__builtin_amdgcn_s_memrealtime(), RLX_AGENT); } } while (0)
#else
#define STAMP(k) do { } while (0)
#endif
#define IN(k) (lo <= (k) && (k) < hi)
#define SEAM(k) do { if (IN(k) && IN((k) + 1)) xcd_barrier(bar); STAMP((k) + 1); } while (0)
#define REPEAT(k) for (int rep_ = ((REP == (k) && l == 0) ? 2 : 1); rep_ > 0; --rep_)
#define REPBAR() do { if (rep_ > 1) xcd_barrier(bar); } while (0)

    STAMP(0);
    if (IN(0)) { if (!NO_P0) p0_phase(lds, kargs()); } SEAM(0);

    for (int l = 0; l < DEPTH; ++l) {
        const int pb = 1 + 8 * l;
        const bool with_ctx = l < DEPTH - 1;
        const int r0 = with_ctx ? 0 : MC; const int Mg = MT - r0;
        if (IN(pb)) REPEAT(1) {
            kargs_t A = kargs(); unsigned char* ws = A->ws; const float* modl = WSP(float, WS_MOD) + (size_t)l * 17 * NMOD; float* ctxx = WSP(float, WS_CTXX);
            if (l == 0) thin_phase<false, true>(0, A->in[I_X], A->in[I_CTX], A->out, ctxx, false, (const bf16*)nullptr, nullptr, 0, nullptr, modl, 0, D, A->in[I_GPREMIX] + l * D, WSP(bf16, WS_HB), vcu, G);
            else        thin_phase<true, true>(0, A->out, ctxx, A->out, ctxx, true, WSP(bf16, WS_YD), modl - 17 * NMOD, 5 * D, A->in[I_GPOSTFFN] + (l - 1) * D, modl, 0, D, A->in[I_GPREMIX] + l * D, WSP(bf16, WS_HB), vcu, G);
            convert_weights(lds, kargs(), l, vcu, G); REPBAR();
        }
        SEAM(pb);
        if (IN(pb + 1)) REPEAT(2) {
            kargs_t A = kargs(); unsigned char* ws = A->ws;
            pg8::Gemm g{WSP(bf16, WS_HB), WSP(bf16, WS_WIN), MT, DINP, D}; pg8::StaticOrder S; S.init(MT, DINP, G, bx);
            pg8::EpiIn E{WSP(bf16, WS_P), DINP, WSP(float, WS_MISC + 32768) + l * DINP, WSP(float, WS_GATE), WSP(float, WS_MISC + 16384), MC, QSCALE};
            if (!NO_GEMM && !NO_G1) pg8::gemm_phase<pg8::EpiIn, pg8::StaticOrder, true, true>(lds, g, S, E); REPBAR();
        }
        SEAM(pb + 1);
        if (IN(pb + 2)) REPEAT(3) {
            { kargs_t A = kargs(); unsigned char* ws = A->ws; unsigned* qh = WSP(unsigned, WS_CTL) + CW_Q + 64 * (16 * l + 64 * (rep_ - 1));
              for (;;) { const int it = wg_pull(qh, slot); if (it >= 128) break;
                const int b = it >> 3, h = (it >> 1) & 3, dir = it & 1;
                if (!NO_HG && (rep_ == 1 || (REPMASK & 1))) hgrn2_stream(lds, WSP(bf16, WS_P), dir ? WSP(bf16, WS_RAWH) : WSP(bf16, WS_HB) + Y_HG, dir ? 256 : D, WSP(float, WS_MISC) + l * 1024, b, h, dir); } }
            { kargs_t A = kargs(); unsigned char* ws = A->ws; unsigned* qm = WSP(unsigned, WS_CTL) + CW_Q + 64 * (16 * l + 64 * (rep_ - 1) + 1);
              for (;;) { const int it = wg_pull(qm, slot); if (it >= 128) break;
                const int b = it >> 3, h = (it >> 1) & 3, dir = it & 1;
                if (!NO_ML && (rep_ == 1 || (REPMASK & 2))) mlstm_stream(lds, WSP(bf16, WS_P), WSP(float, WS_GATE), dir ? WSP(bf16, WS_RAWM) : WSP(bf16, WS_HB) + Y_ML, dir ? 384 : D, A->in[I_MLFB] + l * 8, b, h, dir); } }
            { kargs_t A = kargs(); unsigned char* ws = A->ws; unsigned* qa = WSP(unsigned, WS_CTL) + CW_Q + 64 * (16 * l + 64 * (rep_ - 1) + 2);
              const int nq = with_ctx ? 72 : 64;
              const float lam_init = 0.8f - 0.6f * __expf(-0.3f * (float)l);
              const int myx = (int)(xb_xcc_id() & 7u);
              for (int k = 0; k < 8; ++k) { const int qx = (myx + k) & 7;
                for (;;) { const int it = wg_pull(qa + 64 * qx, slot); if (it >= nq) break;
                  const int bh = it < 64 ? (it >> 3) * 8 + qx : (it - 64) * 8 + qx, qb = it < 64 ? it & 7 : 8;
                  if (!NO_AT && (rep_ == 1 || (REPMASK & 4))) attn_item(lds, WSP(bf16, WS_P), WSP(bf16, WS_HB), A->in[I_DANORM] + l * 96, WSP(float, WS_MISC + 114688)[l], 1.0f - lam_init, bh >> 2, bh & 3, qb, rep_ == 2 ? ATT_PROBE : 0); } } }
            __syncthreads(); REPBAR();
        }
        SEAM(pb + 2);
        if (IN(pb + 3)) {
            kargs_t A = kargs(); unsigned char* ws = A->ws;
            fin_phase(r0, WSP(bf16, WS_P), WSP(bf16, WS_HB), WSP(bf16, WS_RAWM), WSP(bf16, WS_RAWH), A->in[I_MLNORM] + l * 384, A->in[I_HGNORM] + l * 256, vcu, G);
        }
        SEAM(pb + 3);
        if (IN(pb + 4)) REPEAT(5) {
            kargs_t A = kargs(); unsigned char* ws = A->ws;
            pg8::Gemm g{WSP(bf16, WS_HB) + (size_t)r0 * D, WSP(bf16, WS_WOUT), Mg, D, D}; pg8::StaticOrder S; S.init(Mg, D, G, bx);
            pg8::EpiBf E{WSP(bf16, WS_P) + (size_t)r0 * D, D};
            if (!NO_GEMM && !NO_G2) pg8::gemm_phase<pg8::EpiBf, pg8::StaticOrder, true, true>(lds, g, S, E); REPBAR();
        }
        SEAM(pb + 4);
        if (IN(pb + 5)) REPEAT(6) {
            kargs_t A = kargs(); unsigned char* ws = A->ws; const float* modl = WSP(float, WS_MOD) + (size_t)l * 17 * NMOD; float* ctxx = WSP(float, WS_CTXX);
            const float* xl = (l == 0) ? A->in[I_X] : A->out; const float* xc = (l == 0) ? A->in[I_CTX] : ctxx;
            thin_phase<true, true>(r0, xl, xc, A->out, ctxx, true, WSP(bf16, WS_P), modl, 2 * D, A->in[I_GPOSTMIX] + l * D, modl, 3 * D, 4 * D, A->in[I_GPREFFN] + l * D, WSP(bf16, WS_HB), vcu, G, rep_ == 2 ? THIN_PROBE : 0); REPBAR();
        }
        SEAM(pb + 5);
        if (IN(pb + 6)) REPEAT(7) {
            kargs_t A = kargs(); unsigned char* ws = A->ws;
            pg8::Gemm g{WSP(bf16, WS_HB) + (size_t)r0 * D, WSP(bf16, WS_WGU), Mg, NGU, D}; pg8::StaticOrder S; S.init(Mg, NGU, G, bx);
            pg8::EpiSwiglu E{WSP(bf16, WS_P) + (size_t)r0 * DFF, DFF};
            if (!NO_GEMM && !NO_G3) pg8::gemm_phase<pg8::EpiSwiglu, pg8::StaticOrder, true, true>(lds, g, S, E); REPBAR();
        }
        SEAM(pb + 6);
        if (IN(pb + 7)) REPEAT(8) {
            kargs_t A = kargs(); unsigned char* ws = A->ws;
            pg8::Gemm g{WSP(bf16, WS_P) + (size_t)r0 * DFF, WSP(bf16, WS_WD), Mg, D, DFF}; pg8::StaticOrder S; S.init(Mg, D, G, bx);
            pg8::EpiBf E{WSP(bf16, WS_YD) + (size_t)r0 * D, D};
            if (!NO_GEMM && !NO_G4) pg8::gemm_phase<pg8::EpiBf, pg8::StaticOrder, true, true>(lds, g, S, E); REPBAR();
        }
        SEAM(pb + 7);
    }
    if (IN(NPHASE - 1)) {
        kargs_t A = kargs(); unsigned char* ws = A->ws; const float* modl = WSP(float, WS_MOD) + (size_t)(DEPTH - 1) * 17 * NMOD; float* ctxx = WSP(float, WS_CTXX);
        thin_phase<true, false>(MC, A->out, ctxx, A->out, ctxx, true, WSP(bf16, WS_YD), modl, 5 * D, A->in[I_GPOSTFFN] + (DEPTH - 1) * D, nullptr, 0, 0, nullptr, nullptr, vcu, G);
#if STAMP_ON
        {
            __syncthreads();
            const unsigned long long* st = (const unsigned long long*)(ws + WS_MISC + 131072);
            const float d1 = (float)(long long)(__hip_atomic_load(st + SB, RLX_AGENT) - __hip_atomic_load(st + SA, RLX_AGENT)) * 1e-5f;
            const float d2 = (float)(long long)(__hip_atomic_load(st + SD, RLX_AGENT) - __hip_atomic_load(st + SC, RLX_AGENT)) * 1e-2f;
            const int tid = tid_opaque(); const int rwg = ML / G; float* o = A->out + (size_t)vcu * rwg * D;
            for (int i = tid; i < rwg * D; i += NTHR) o[i] *= (1.0f + d1);
            __syncthreads();
            if (bx == 0 && tid == 0) A->out[(size_t)vcu * rwg * D] = d2;
        }
#endif
    }
#undef IN
#undef SEAM
}

extern "C" void kernel_launch(void* const* d_in, const int* in_sizes, int n_in, void* d_out, int out_size, void* d_ws, size_t ws_size, hipStream_t stream) {
    static int grid = 0;
    if (grid == 0) {
        if (n_in != 22 || in_sizes[0] != ML * D || out_size != ML * D || ws_size < WS_END) {
            fprintf(stderr, "kernel_launch: unexpected shapes: n_in %d in0 %d out %d ws %zu (need %zu); nothing launched\n", n_in, n_in > 0 ? in_sizes[0] : -1, out_size, ws_size, (size_t)WS_END); grid = -1; return; }
        int dev = 0, cus = 0, per_cu = 0;
        if (hipGetDevice(&dev) != hipSuccess || hipDeviceGetAttribute(&cus, hipDeviceAttributeMultiprocessorCount, dev) != hipSuccess) { fprintf(stderr, "kernel_launch: device query failed\n"); grid = -1; return; }
        if (hipFuncSetAttribute((const void*)fwd, hipFuncAttributeMaxDynamicSharedMemorySize, LDS_BYTES) != hipSuccess) { fprintf(stderr, "kernel_launch: hipFuncSetAttribute failed\n"); grid = -1; return; }
        if (hipOccupancyMaxActiveBlocksPerMultiprocessor(&per_cu, (const void*)fwd, NTHR, LDS_BYTES) != hipSuccess || per_cu < 1)
            fprintf(stderr, "kernel_launch: note: occupancy query reports %d workgroups per CU\n", per_cu);
        (void)hipGetLastError();
        grid = cus;
    }
    if (grid < 0) return;
    if (hipMemsetAsync((char*)d_ws + WS_CTL, 0, CTL_ZERO_BYTES, stream) != hipSuccess) { fprintf(stderr, "kernel_launch: memset failed\n"); return; }
    Args a{};
    for (int i = 0; i < 22; ++i) a.in[i] = (const float*)d_in[i];
    a.out = (float*)d_out; a.ws = (unsigned char*)d_ws;
#if MK_PER_PHASE
    for (int p = 0; p < NPHASE; ++p) { a.ph_lo = p; a.ph_hi = p + 1; hipLaunchKernelGGL(fwd, dim3(grid), dim3(NTHR), LDS_BYTES, stream, a); }
#else
    a.ph_lo = 0; a.ph_hi = NPHASE;
    hipLaunchKernelGGL(fwd, dim3(grid), dim3(NTHR), LDS_BYTES, stream, a);
#endif
    const hipError_t le = hipPeekAtLastError();
    if (le != hipSuccess) fprintf(stderr, "kernel_launch: launch failed: %s\n", hipGetErrorName(le));
}
```

```cpp
#include <hip/hip_runtime.h>
#include <cstdio>
#include <cstdint>
#ifndef MK_PER_PHASE
#define MK_PER_PHASE 0
#endif
namespace pg8 {
#define PG8_LAS __attribute__((address_space(3)))
typedef unsigned short bf16_t;
typedef short bf16x8 __attribute__((ext_vector_type(8)));
typedef float f32x4 __attribute__((ext_vector_type(4)));
typedef unsigned u32x4 __attribute__((ext_vector_type(4)));
constexpr int BM = 256, BK = 64, HALF = 128, HTB = HALF * BK * 2  , STAGE_BYTES = 8 * HTB, NXCD = 8, WGM = 8;

__host__ __device__ __forceinline__ int lds_byte(int r, int c) { const int st = (r >> 4) * 2 + (c >> 5), rr = r & 15, cc = c & 31, ob = rr * 64 + cc * 2; return st * 1024 + (ob ^ (((ob >> 9) & 1) << 5)); }
__host__ __device__ __forceinline__ void stage_rc(int b, int& R, int& C) { const int st = b / 1024, sb = b % 1024, swz = sb ^ (((sb >> 9) & 1) << 5); R = (st >> 1) * 16 + swz / 64; C = (st & 1) * 32 + (swz % 64) / 2; }
__host__ __device__ __forceinline__ int perm32(int rho) { const int n = rho >> 4, i = rho & 15; return 8 * (i >> 2) + 4 * n + (i & 3); }

struct Unit { int pm, pn; };
struct Gemm { const bf16_t* A; const bf16_t* Bt; int M, N, K; };

struct StaticOrder {
    int nM, nN, nwg, G, c;
    __host__ __device__ void init(int M, int N, int G_, int c_) { nM = M / BM; nN = N / BM; nwg = nM * nN; G = G_; c = c_; }
    __host__ __device__ bool next(int i, Unit& u) const {
        const long L = (long)i * G + c; if (L >= nwg) return false;
        int wgid = (int)L; { const int q = nwg / NXCD, r = nwg % NXCD, xcd = wgid % NXCD, off = wgid / NXCD; wgid = (xcd < r ? xcd * (q + 1) : r * (q + 1) + (xcd - r) * q) + off; }
        const int nig = WGM * nN, gid = wgid / nig, fm = gid * WGM, gsz = (nM - fm) < WGM ? (nM - fm) : WGM;
        u.pm = fm + ((wgid % nig) % gsz); u.pn = (wgid % nig) / gsz; return true;
    }
    __device__ __forceinline__ void a_ready(const Unit&) const {}
    __device__ __forceinline__ void done(const Unit&) const {}
};
__device__ __forceinline__ unsigned cvt_pk_bf16(float lo, float hi) { unsigned r; asm volatile("v_cvt_pk_bf16_f32 %0, %1, %2" : "=v"(r) : "v"(lo), "v"(hi)); return r; }
struct EpiF32 {
    static constexpr bool PERM = false, AFTER_DRAIN = false;
    float* C; int ldc;
    __device__ __forceinline__ void operator()(const f32x4 (&acc)[2][2][4][2], const Unit& u, int wr, int wc, int fr, int fq) const {
        const int row0 = u.pm * BM + wr * 64 + fr, col0 = u.pn * BM + wc * 32 + 4 * fq;
#pragma unroll
        for (int ai = 0; ai < 2; ++ai)
#pragma unroll
            for (int m = 0; m < 4; ++m) { float* rowp = C + (size_t)(row0 + ai * HALF + m * 16) * ldc + col0;
#pragma unroll
                for (int bj = 0; bj < 2; ++bj)
#pragma unroll
                    for (int n = 0; n < 2; ++n) *(f32x4*)(rowp + bj * HALF + n * 16) = acc[ai][bj][m][n]; }
    }
};
struct EpiBf {
    static constexpr bool PERM = true, AFTER_DRAIN = false;
    bf16_t* O; int ldc;
    __device__ __forceinline__ void operator()(const f32x4 (&acc)[2][2][4][2], const Unit& u, int wr, int wc, int fr, int fq) const {
        const int row0 = u.pm * BM + wr * 64 + fr; const int col0 = u.pn * BM + wc * 32 + 8 * fq;
#pragma unroll
        for (int ai = 0; ai < 2; ++ai)
#pragma unroll
            for (int m = 0; m < 4; ++m) { bf16_t* rowp = O + (size_t)(row0 + ai * HALF + m * 16) * ldc + col0;
#pragma unroll
                for (int bj = 0; bj < 2; ++bj) { const f32x4 v0 = acc[ai][bj][m][0], v1 = acc[ai][bj][m][1];
                    u32x4 w; w.x = cvt_pk_bf16(v0[0], v0[1]); w.y = cvt_pk_bf16(v0[2], v0[3]); w.z = cvt_pk_bf16(v1[0], v1[1]); w.w = cvt_pk_bf16(v1[2], v1[3]);
                    *(u32x4*)(rowp + bj * HALF) = w; } }
    }
};
constexpr unsigned EI_KIND = 1u << 16, EI_SKIP = 1u << 17, EI_DA = 1u << 18, EI_Q = 1u << 19, EI_HF = 1u << 20;
__host__ __device__ __forceinline__ void epi_in_entry(int g, unsigned& x, unsigned& y) {
    const int c = 8 * g; x = 0u; y = EI_SKIP;
    if (c < 1152)      { const int f = c / 384, hh = (c % 384) / 96, o = c % 96;            x = 0u         + (unsigned)hh * 2304u * 576u + (unsigned)(f * 96 + o) * 2u; y = 576u; }
    else if (c < 1536) { x = 301989888u + (unsigned)(c - 1152) * 2u; y = 768u | EI_KIND; }
    else if (c < 1552) { }
    else if (c < 2064) { const int hh = (c - 1552) / 128, o = (c - 1552) % 128;             x = 84934656u  + (unsigned)hh * 2304u * 896u + (unsigned)(256 + o) * 2u; y = 896u; }
    else if (c < 3088) { const int d = (c - 2064) / 512, hh = ((c - 2064) % 512) / 128, o = (c - 2064) % 128; x = 84934656u + (unsigned)hh * 2304u * 896u + (unsigned)(d * 128 + o) * 2u; y = 896u; }
    else if (c < 3344) { const int hh = (c - 3088) / 64, o = (c - 3088) % 64;               x = 84934656u  + (unsigned)hh * 2304u * 896u + (unsigned)(384 + o) * 2u; y = 896u; }
    else if (c < 3600) { x = 330301440u + (unsigned)(c - 3344) * 2u; y = 512u | EI_KIND; }
    else if (c < 4752) { const int f = (c - 3600) / 384, hh = ((c - 3600) % 384) / 96, o = (c - 3600) % 96; x = 217055232u + (unsigned)hh * 2304u * 576u + (unsigned)(f * 96 + o) * 2u; y = 576u;
                         if (c < 4368) { const int d48 = (c - 3600) % 48, hf = d48 >= 24 ? 1 : 0, i0 = (d48 - 24 * hf) >> 1; y |= EI_DA | (c < 3984 ? EI_Q : 0u) | (hf ? EI_HF : 0u) | ((unsigned)i0 << 24); } }
}
struct EpiIn {
    static constexpr bool PERM = true, AFTER_DRAIN = false;
    unsigned char* PX; const PG8_LAS float* bias; float* G; const PG8_LAS float* rope; const PG8_LAS unsigned* tab; int mc; float qscale;
    __device__ __forceinline__ void operator()(const f32x4 (&acc)[2][2][4][2], const Unit& u, int wr, int wc, int fr, int fq) const {
        const int trow0 = u.pm * BM;
        const int bat = trow0 < mc ? trow0 >> 8 : (trow0 - mc) >> 11; const int slot0 = trow0 < mc ? (trow0 & 255) : 256 + ((trow0 - mc) & 2047);
        const unsigned rc_blk = (unsigned)(bat * 4 * 2304 + slot0), rc_row = (unsigned)trow0;
        const int rin = wr * 64 + fr;
        const int col0 = u.pn * BM + wc * 32 + 8 * fq;
        const bool gate_lane = (u.pn == 6) && (wc == 0) && (fq < 2);
#pragma unroll
        for (int bj = 0; bj < 2; ++bj) {
            const int c = col0 + bj * HALF;
            const f32x4 b0 = *(const PG8_LAS f32x4*)(bias + c), b1 = *(const PG8_LAS f32x4*)(bias + c + 4);
            const unsigned ex = tab[2 * (c >> 3)], ey = tab[2 * (c >> 3) + 1];
            const unsigned ld = ey & 0xffffu;
            const unsigned off = ex + ((ey & EI_KIND) ? rc_row : rc_blk) * ld + (unsigned)rin * ld;
            const bool skip = (ey & EI_SKIP) != 0u, is_da = (ey & EI_DA) != 0u, is_q = (ey & EI_Q) != 0u; const int hf = (ey & EI_HF) ? 1 : 0, i0 = (int)(ey >> 24);
#pragma unroll
            for (int ai = 0; ai < 2; ++ai)
#pragma unroll
                for (int m = 0; m < 4; ++m) { const int row = trow0 + rin + ai * HALF + m * 16;
                    f32x4 v0 = acc[ai][bj][m][0] + b0, v1 = acc[ai][bj][m][1] + b1;
                    if (is_da) {
                        if (row >= mc) { const int t = (row - mc) & 2047; const int pos = hf ? (t & 63) : (t >> 6);
                            const f32x4 cs0 = *(const PG8_LAS f32x4*)(rope + pos * 24 + 2 * i0), cs1 = *(const PG8_LAS f32x4*)(rope + pos * 24 + 2 * i0 + 4);
                            const f32x4 r0 = {v0[0] * cs0[0] - v0[1] * cs0[1], v0[0] * cs0[1] + v0[1] * cs0[0], v0[2] * cs0[2] - v0[3] * cs0[3], v0[2] * cs0[3] + v0[3] * cs0[2]};
                            const f32x4 r1 = {v1[0] * cs1[0] - v1[1] * cs1[1], v1[0] * cs1[1] + v1[1] * cs1[0], v1[2] * cs1[2] - v1[3] * cs1[3], v1[2] * cs1[3] + v1[3] * cs1[2]};
                            v0 = r0; v1 = r1; }
                        if (is_q) { v0 = v0 * qscale; v1 = v1 * qscale; } }
                    if (!skip) { u32x4 w; w.x = cvt_pk_bf16(v0[0], v0[1]); w.y = cvt_pk_bf16(v0[2], v0[3]); w.z = cvt_pk_bf16(v1[0], v1[1]); w.w = cvt_pk_bf16(v1[2], v1[3]);
                        *(u32x4*)(PX + (off + (unsigned)(ai * HALF + m * 16) * ld)) = w; }
                    if (bj == 0 && gate_lane) { float* g = G + (size_t)row * 16 + 8 * fq; *(f32x4*)g = v0; *(f32x4*)(g + 4) = v1; } }
        }
    }
};
struct EpiSwiglu {
    static constexpr bool PERM = true, AFTER_DRAIN = false;
    bf16_t* O; int ldc;
    __device__ __forceinline__ void operator()(const f32x4 (&acc)[2][2][4][2], const Unit& u, int wr, int wc, int fr, int fq) const {
        const int row0 = u.pm * BM + wr * 64 + fr; const int col0 = u.pn * HALF + wc * 32 + 8 * fq;
#pragma unroll
        for (int ai = 0; ai < 2; ++ai)
#pragma unroll
            for (int m = 0; m < 4; ++m) { bf16_t* rowp = O + (size_t)(row0 + ai * HALF + m * 16) * ldc + col0;
                f32x4 r0, r1;
#pragma unroll
                for (int i = 0; i < 4; ++i) { const float g0 = acc[ai][0][m][0][i], g1 = acc[ai][0][m][1][i];
                    r0[i] = g0 * __builtin_amdgcn_rcpf(1.0f + __expf(-g0)) * acc[ai][1][m][0][i];
                    r1[i] = g1 * __builtin_amdgcn_rcpf(1.0f + __expf(-g1)) * acc[ai][1][m][1][i]; }
                u32x4 w; w.x = cvt_pk_bf16(r0[0], r0[1]); w.y = cvt_pk_bf16(r0[2], r0[3]); w.z = cvt_pk_bf16(r1[0], r1[1]); w.w = cvt_pk_bf16(r1[2], r1[3]);
                *(u32x4*)rowp = w; }
    }
};
template <class Epi, class Sched, bool ALIGN_EPI = false, bool SP2 = false>
__device__ __forceinline__ void gemm_phase(PG8_LAS unsigned char* lds, const Gemm g, const Sched& S, const Epi& E) {
    int tid_ = threadIdx.x; asm volatile("" : "+v"(tid_));
    const int tid = tid_, wid = __builtin_amdgcn_readfirstlane(tid >> 6), lane = tid & 63, wr = wid >> 2, wc = wid & 3, fr = lane & 15, fq = lane >> 4;
    const int K = g.K, nt = K / BK;
    unsigned voffA[2], voffB[2];
#pragma unroll
    for (int i = 0; i < 2; ++i) { int R, C; stage_rc(tid * 16 + i * 8192, R, C); const int Rb = Epi::PERM ? ((R & ~31) + perm32(R & 31)) : R;
        voffA[i] = (unsigned)(R * K + C) * 2u; voffB[i] = (unsigned)(Rb * K + C) * 2u; }
    const size_t kstep = (size_t)(BK * 2);
    const size_t hstep = (size_t)HALF * K * 2;
    const size_t tstep = 2 * hstep;
    const unsigned ldsw = (unsigned)wid * 1024u;
    const int aoff = lds_byte(wr * 64 + fr, fq * 8), boff = lds_byte(wc * 32 + fr, fq * 8);
#define PG8_SA(b, h) (((b) * 2 + (h)) * HTB)
#define PG8_SB(b, h) ((4 + (b) * 2 + (h)) * HTB)
#define PG8_STAGE(bufoff, gbase, voff) do { _Pragma("unroll") for (int _i = 0; _i < 2; ++_i) \
        __builtin_amdgcn_global_load_lds((const unsigned*)((const char*)(gbase) + (voff)[_i]), (PG8_LAS unsigned*)(lds + (bufoff) + ldsw + _i * 8192), 16, 0, 0); } while (0)
#define PG8_LDA(dst, b, h) do { _Pragma("unroll") for (int m = 0; m < 4; ++m) _Pragma("unroll") for (int k = 0; k < 2; ++k) dst[m][k] = *(const PG8_LAS bf16x8*)(lds + PG8_SA(b, h) + aoff + m * 2048 + k * 1024); } while (0)
#define PG8_LDB(dst, b, h) do { _Pragma("unroll") for (int n = 0; n < 2; ++n) _Pragma("unroll") for (int k = 0; k < 2; ++k) dst[n][k] = *(const PG8_LAS bf16x8*)(lds + PG8_SB(b, h) + boff + n * 2048 + k * 1024); } while (0)
#define PG8_MMA(ai, bj, At, Bt) do { __builtin_amdgcn_s_setprio(1); _Pragma("unroll") for (int m = 0; m < 4; ++m) _Pragma("unroll") for (int n = 0; n < 2; ++n) _Pragma("unroll") for (int k = 0; k < 2; ++k) \
        acc[ai][bj][m][n] = __builtin_amdgcn_mfma_f32_16x16x32_bf16(Bt[n][k], At[m][k], acc[ai][bj][m][n], 0, 0, 0); __builtin_amdgcn_s_setprio(0); } while (0)
#define PG8_WAIT_V(n) asm volatile("s_waitcnt vmcnt(" #n ")" ::: "memory")
#define PG8_WAIT_L(n) asm volatile("s_waitcnt lgkmcnt(" #n ")" ::: "memory")
#define PG8_BAR __builtin_amdgcn_s_barrier()
#define PG8_SCHED __builtin_amdgcn_sched_barrier(0)
    Unit cur, nxt; int ui = 0;
    if (!S.next(0, cur)) return;
    f32x4 acc[2][2][4][2];
#pragma unroll
    for (int a = 0; a < 2; ++a)
#pragma unroll
        for (int b = 0; b < 2; ++b)
#pragma unroll
            for (int m = 0; m < 4; ++m)
#pragma unroll
                for (int n = 0; n < 2; ++n) acc[a][b][m][n] = (f32x4){0.f, 0.f, 0.f, 0.f};
    bf16x8 At[4][2], B0[2][2], B1[2][2];
    const char* cA = (const char*)g.A + (size_t)cur.pm * tstep; const char* cB = (const char*)g.Bt + (size_t)cur.pn * tstep;
    S.a_ready(cur);
    if constexpr (SP2) {
        PG8_STAGE(PG8_SB(0, 0), cB, voffB); PG8_STAGE(PG8_SB(0, 1), cB + hstep, voffB); PG8_STAGE(PG8_SA(0, 0), cA, voffA); PG8_STAGE(PG8_SA(0, 1), cA + hstep, voffA);
        if (wr == 1) PG8_BAR;
        PG8_WAIT_V(2); PG8_BAR;
        PG8_STAGE(PG8_SB(1, 0), cB + kstep, voffB); PG8_STAGE(PG8_SA(1, 0), cA + kstep, voffA); PG8_STAGE(PG8_SB(1, 1), cB + hstep + kstep, voffB);
        PG8_WAIT_V(6); PG8_BAR;
    } else {
        PG8_STAGE(PG8_SB(0, 0), cB, voffB); PG8_STAGE(PG8_SA(0, 0), cA, voffA); PG8_STAGE(PG8_SB(0, 1), cB + hstep, voffB); PG8_STAGE(PG8_SA(0, 1), cA + hstep, voffA);
        if (wr == 1) PG8_BAR;
        PG8_WAIT_V(4); PG8_BAR;
        PG8_STAGE(PG8_SB(1, 0), cB + kstep, voffB); PG8_STAGE(PG8_SA(1, 0), cA + kstep, voffA); PG8_STAGE(PG8_SB(1, 1), cB + hstep + kstep, voffB);
        PG8_WAIT_V(6); PG8_BAR;
    }
    for (;;) {
        const bool has_next = S.next(ui + 1, nxt);
        const char* nA = has_next ? (const char*)g.A + (size_t)nxt.pm * tstep : cA; const char* nB = has_next ? (const char*)g.Bt + (size_t)nxt.pn * tstep : cB;
        for (int t = 0; t < nt; t += 2) {
            const bool last = (t == nt - 2);
            const char* a1 = cA + (size_t)(t + 1) * kstep;
            const char* a2 = last ? nA : cA + (size_t)(t + 2) * kstep; const char* b2 = last ? nB : cB + (size_t)(t + 2) * kstep;
            const char* a3 = a2 + kstep; const char* b3 = b2 + kstep;
            if (last && has_next) S.a_ready(nxt);
            if constexpr (SP2) {
            PG8_LDB(B0, 0, 0); PG8_LDB(B1, 0, 1); PG8_SCHED; PG8_LDA(At, 0, 0); PG8_STAGE(PG8_SA(1, 1), a1 + hstep, voffA);
            PG8_WAIT_V(8); PG8_WAIT_L(0); PG8_BAR; PG8_MMA(0, 0, At, B0); PG8_MMA(0, 1, At, B1); PG8_BAR; PG8_SCHED;
            PG8_LDA(At, 0, 1); PG8_STAGE(PG8_SB(0, 0), b2, voffB); PG8_STAGE(PG8_SB(0, 1), b2 + hstep, voffB); PG8_STAGE(PG8_SA(0, 0), a2, voffA);
            PG8_WAIT_V(8); PG8_WAIT_L(0); PG8_BAR; PG8_MMA(1, 0, At, B0); PG8_MMA(1, 1, At, B1); PG8_BAR; PG8_SCHED;
            PG8_LDB(B0, 1, 0); PG8_LDB(B1, 1, 1); PG8_SCHED; PG8_LDA(At, 1, 0); PG8_STAGE(PG8_SA(0, 1), a2 + hstep, voffA);
            PG8_WAIT_V(8); PG8_WAIT_L(0); PG8_BAR; PG8_MMA(0, 0, At, B0); PG8_MMA(0, 1, At, B1); PG8_BAR; PG8_SCHED;
            PG8_LDA(At, 1, 1); PG8_STAGE(PG8_SB(1, 0), b3, voffB); PG8_STAGE(PG8_SB(1, 1), b3 + hstep, voffB); PG8_STAGE(PG8_SA(1, 0), a3, voffA);
            PG8_WAIT_V(8); PG8_WAIT_L(0); PG8_BAR; PG8_MMA(1, 0, At, B0); PG8_MMA(1, 1, At, B1); PG8_BAR; PG8_SCHED;
            } else {
            PG8_LDB(B0, 0, 0); PG8_SCHED; PG8_LDA(At, 0, 0); PG8_STAGE(PG8_SA(1, 1), a1 + hstep, voffA);
            PG8_WAIT_L(8); PG8_BAR; PG8_WAIT_L(0); PG8_MMA(0, 0, At, B0); PG8_BAR; PG8_SCHED;
            PG8_LDB(B1, 0, 1); PG8_STAGE(PG8_SB(0, 0), b2, voffB);
            PG8_BAR; PG8_WAIT_L(0); PG8_MMA(0, 1, At, B1); PG8_BAR;
            PG8_LDA(At, 0, 1); PG8_STAGE(PG8_SA(0, 0), a2, voffA);
            PG8_BAR; PG8_WAIT_L(0); PG8_MMA(1, 0, At, B0); PG8_BAR; PG8_SCHED;
            PG8_STAGE(PG8_SB(0, 1), b2 + hstep, voffB);
            PG8_WAIT_V(6); PG8_BAR; PG8_MMA(1, 1, At, B1); PG8_BAR;
            PG8_LDB(B0, 1, 0); PG8_SCHED; PG8_LDA(At, 1, 0); PG8_STAGE(PG8_SA(0, 1), a2 + hstep, voffA);
            PG8_WAIT_L(8); PG8_BAR; PG8_WAIT_L(0); PG8_MMA(0, 0, At, B0); PG8_BAR; PG8_SCHED;
            PG8_LDB(B1, 1, 1); PG8_STAGE(PG8_SB(1, 0), b3, voffB);
            PG8_BAR; PG8_WAIT_L(0); PG8_MMA(0, 1, At, B1); PG8_BAR;
            PG8_LDA(At, 1, 1); PG8_STAGE(PG8_SA(1, 0), a3, voffA);
            PG8_BAR; PG8_WAIT_L(0); PG8_MMA(1, 0, At, B0); PG8_BAR; PG8_SCHED;
            PG8_STAGE(PG8_SB(1, 1), b3 + hstep, voffB);
            PG8_WAIT_V(6); PG8_BAR; PG8_MMA(1, 1, At, B1); PG8_BAR;
            }
        }
        if constexpr (ALIGN_EPI) { if (wr == 0) PG8_BAR; }
        if constexpr (!Epi::AFTER_DRAIN) { E(acc, cur, wr, wc, fr, fq); S.done(cur); }
        if (!has_next) break;
#pragma unroll
        for (int a = 0; a < 2; ++a)
#pragma unroll
            for (int b = 0; b < 2; ++b)
#pragma unroll
                for (int m = 0; m < 4; ++m)
#pragma unroll
                    for (int n = 0; n < 2; ++n) acc[a][b][m][n] = (f32x4){0.f, 0.f, 0.f, 0.f};
        cur = nxt; cA = nA; cB = nB; ++ui;
        if constexpr (ALIGN_EPI) { if (wr == 1) PG8_BAR; }
    }
    PG8_WAIT_V(0);
    if constexpr (!ALIGN_EPI) { if (wr == 0) PG8_BAR; }
    PG8_BAR;
    if constexpr (Epi::AFTER_DRAIN) { E.fused(acc, cur, wr, wc, fr, fq, lds, wid, lane); S.done(cur); }
#undef PG8_SA
#undef PG8_SB
#undef PG8_STAGE
#undef PG8_LDA
#undef PG8_LDB
#undef PG8_MMA
#undef PG8_WAIT_V
#undef PG8_WAIT_L
#undef PG8_BAR
#undef PG8_SCHED
}
}
constexpr int D = 1024, NB = 16, SEQ = 2048, CTXL = 256, DEPTH = 4;
constexpr int MC = NB * CTXL, ML = NB * SEQ, MT = MC + ML;
constexpr int DIN = 4752, DINP = 4864, DFF = 2816, NGU = 2 * DFF, NMOD = 6 * D;
constexpr int C_MLQ = 0, C_MLK = 384, C_MLV = 768, C_MLO = 1152, C_MLI = 1536, C_MLF = 1544, C_HGQ = 1552, C_HGF = 2064, C_HGI = 3088, C_HGG = 3344, C_DAQ = 3600, C_DAK = 3984, C_DAV = 4368;
constexpr int Y_ML = 0, Y_HG = 384, Y_DA = 640;
constexpr float EPS = 1e-6f;
constexpr int NTOK = CTXL + SEQ;
static_assert(C_MLI == 6 * 256, "gate columns must open GEMM tile 6");
constexpr int NSLOT = CTXL + SEQ;
constexpr unsigned MLX_LD = 576, HGX_LD = 896, DAX_LD = 576, MLO_LD = 768, HGG_LD = 512;
constexpr size_t MLX_OFF = 0, HGX_OFF = MLX_OFF + (size_t)64 * NSLOT * MLX_LD, DAX_OFF = HGX_OFF + (size_t)64 * NSLOT * HGX_LD, MLO_OFF = DAX_OFF + (size_t)64 * NSLOT * DAX_LD, HGG_OFF = MLO_OFF + (size_t)MT * MLO_LD, PX_END = HGG_OFF + (size_t)MT * HGG_LD;
static_assert(PX_END <= (size_t)MT * DINP * 2, "mixer operand blocks fit the P region");
static_assert(HGX_OFF == 84934656ull && DAX_OFF == 217055232ull && MLO_OFF == 301989888ull && HGG_OFF == 330301440ull, "EpiIn hard-codes these offsets");

constexpr size_t MiB = 1u << 20;
constexpr size_t WS_CTL = 0, CTL_ZERO_BYTES = 1 * MiB;
constexpr size_t WS_MOD = 1 * MiB;
constexpr size_t WS_MISC = 3 * MiB;
constexpr size_t WS_GATE = 4 * MiB;
constexpr size_t WS_WIN = 8 * MiB, WS_WOUT = WS_WIN + (size_t)DINP * D * 2, WS_WGU = WS_WOUT + (size_t)D * D * 2, WS_WD = WS_WGU + (size_t)NGU * D * 2;
constexpr size_t WS_CTXX = 36 * MiB;
constexpr size_t WS_HB = 52 * MiB;
constexpr size_t WS_RAWM = 124 * MiB, WS_RAWH = 151 * MiB;
constexpr size_t WS_P = 169 * MiB;
constexpr size_t WS_YD = WS_P + 198 * MiB, WS_END = 511 * MiB;
static_assert(WS_WD + (size_t)D * DFF * 2 <= WS_CTXX, "weights fit");
static_assert(WS_RAWM + (size_t)64 * NTOK * 96 * 2 <= WS_RAWH && WS_RAWH + (size_t)64 * NTOK * 64 * 2 <= WS_P, "raw fits");
static_assert(WS_P + (size_t)MT * DINP * 2 <= WS_END && WS_YD + (size_t)MT * D * 4 <= WS_END && (size_t)MT * DFF * 2 <= 198 * MiB, "P region");
constexpr int CW_BAR = 4096;
constexpr int CW_Q = 16384;

constexpr int RING_BYTES = 131072, LDSCTL_OFF = RING_BYTES, LDS_BYTES = 163840;
constexpr int LDS_BIAS = LDSCTL_OFF + 1024, LDS_ROPE = LDS_BIAS + DINP * 4, LDS_ETAB = LDS_ROPE + 64 * 24 * 4;
static_assert(LDS_ETAB + (DINP / 8) * 8 <= LDS_BYTES, "LDS map");
constexpr int NWAVES = 8, NTHR = 512;

#define GAS __attribute__((address_space(1)))
#define LAS __attribute__((address_space(3)))
typedef unsigned short bf16;
typedef unsigned v4u __attribute__((ext_vector_type(4)));
typedef unsigned v2u __attribute__((ext_vector_type(2)));
typedef float f32x4 __attribute__((ext_vector_type(4)));
typedef float f32x16 __attribute__((ext_vector_type(16)));
typedef short bf16x8 __attribute__((ext_vector_type(8)));
typedef GAS unsigned gu32;
typedef LAS unsigned char* lptr;
#define RLX_AGENT __ATOMIC_RELAXED, __HIP_MEMORY_SCOPE_AGENT
#define LDS_WAIT() asm volatile("s_waitcnt lgkmcnt(0)" ::: "memory")
#define VM_WAIT() asm volatile("s_waitcnt vmcnt(0)" ::: "memory")
__device__ __forceinline__ unsigned f2bf(float f) { unsigned u = __builtin_bit_cast(unsigned, f); return (u + 0x7fffu + ((u >> 16) & 1u)) >> 16; }
typedef float f32x2_t __attribute__((ext_vector_type(2))); typedef __bf16 bf16x2_t __attribute__((ext_vector_type(2)));
__device__ __forceinline__ unsigned pk2(float lo, float hi) { f32x2_t v = {lo, hi}; bf16x2_t b = __builtin_convertvector(v, bf16x2_t); return __builtin_bit_cast(unsigned, b); }
__device__ __forceinline__ float bflo(unsigned w) { return __builtin_bit_cast(float, w << 16); }
__device__ __forceinline__ float bfhi(unsigned w) { return __builtin_bit_cast(float, w & 0xffff0000u); }
__device__ __forceinline__ float bf2f(bf16 v) { return __builtin_bit_cast(float, (unsigned)v << 16); }
__device__ __forceinline__ float lx_idx(float v, int src) { return __builtin_bit_cast(float, __builtin_amdgcn_ds_bpermute(src << 2, __builtin_bit_cast(int, v))); }
__device__ __forceinline__ float lx_xor(float v, int mask, int lane) { return lx_idx(v, lane ^ mask); }
__device__ __forceinline__ float lx_up(float v, int d, int lane) { return lx_idx(v, lane >= d ? lane - d : lane); }
template <int CTRL, int RMASK> __device__ __forceinline__ float dpp_f(float oldv, float v) { return __builtin_bit_cast(float, __builtin_amdgcn_update_dpp(__builtin_bit_cast(int, oldv), __builtin_bit_cast(int, v), CTRL, RMASK, 0xf, false)); }
__device__ __forceinline__ float scan_sum64(float v) {
    v += dpp_f<0x111, 0xf>(0.f, v); v += dpp_f<0x112, 0xf>(0.f, v); v += dpp_f<0x114, 0xf>(0.f, v); v += dpp_f<0x118, 0xf>(0.f, v);
    v += dpp_f<0x142, 0xa>(0.f, v); v += dpp_f<0x143, 0xc>(0.f, v); return v; }
__device__ __forceinline__ float scan_max64(float v) { const float ninf = -3.0e38f;
    v = fmaxf(v, dpp_f<0x111, 0xf>(ninf, v)); v = fmaxf(v, dpp_f<0x112, 0xf>(ninf, v)); v = fmaxf(v, dpp_f<0x114, 0xf>(ninf, v)); v = fmaxf(v, dpp_f<0x118, 0xf>(ninf, v));
    v = fmaxf(v, dpp_f<0x142, 0xa>(ninf, v)); v = fmaxf(v, dpp_f<0x143, 0xc>(ninf, v)); return v; }
__device__ __forceinline__ float wave_sum(float v, int lane) {
#pragma unroll
    for (int o = 1; o < 64; o <<= 1) v += lx_xor(v, o, lane);
    return v;
}
#define MFMA32(a, b, c) __builtin_amdgcn_mfma_f32_32x32x16_bf16((a), (b), (c), 0, 0, 0)
#define MFMA16(a, b, c) __builtin_amdgcn_mfma_f32_16x16x32_bf16((a), (b), (c), 0, 0, 0)
__device__ __forceinline__ int tid_opaque() { int t = threadIdx.x; asm volatile("" : "+v"(t)); return t; }
__device__ __forceinline__ bf16x8 lds8(lptr p) { return *(const LAS bf16x8*)p; }
__device__ __forceinline__ v4u gld16(const void* base, unsigned off) { return *(const v4u*)((const char*)base + off); }
__device__ __forceinline__ void gst8(void* base, unsigned off, v2u v) { *(v2u*)((char*)base + off) = v; }
typedef short v4i16 __attribute__((ext_vector_type(4)));
__device__ __forceinline__ bf16x8 opr(lptr img, int ldb, int r0, int k0, int c16, int rg) { return lds8(img + (r0 + c16) * ldb + (k0 + 8 * rg) * 2); }
__device__ __forceinline__ bf16x8 opt(lptr img, int ldb, int r0, int k0, int lane) {
    const int g = lane >> 4, q = (lane & 15) >> 2, p = lane & 3;
    lptr a = img + (k0 + 8 * g + q) * ldb + (r0 + 4 * p) * 2;
    const v4i16 lo = __builtin_amdgcn_ds_read_tr16_b64_v4i16((LAS v4i16*)a);
    const v4i16 hi = __builtin_amdgcn_ds_read_tr16_b64_v4i16((LAS v4i16*)(a + 4 * ldb));
    return __builtin_shufflevector(lo, hi, 0, 1, 2, 3, 4, 5, 6, 7);
}

#define XB_TMO      128
#define XB_XCNT(j)  (256  + 64 * (j))
#define XB_XSUB(j)  (1280 + 64 * (j))
#define XB_XGEN(j)  (2304 + 64 * (j))
#define XB_TOP      3328
#define XB_TOPGEN   3392
#define XCD_BAR_WORDS 3456
#define XB_SPIN_CAP (1u << 18)

__device__ __forceinline__ unsigned xb_ld(unsigned* p)              { return __hip_atomic_load(p, __ATOMIC_RELAXED, __HIP_MEMORY_SCOPE_AGENT); }
__device__ __forceinline__ unsigned xb_add(unsigned* p, unsigned v) { return __hip_atomic_fetch_add(p, v, __ATOMIC_RELAXED, __HIP_MEMORY_SCOPE_AGENT); }
__device__ __forceinline__ unsigned xb_xcc_id() { return (unsigned)__builtin_amdgcn_s_getreg((3 << 11) | 20) & 0xFu; }
#define XB_SPIN(cond, bar) do { unsigned _sp = 0; while (cond) { __builtin_amdgcn_s_sleep(1); \
    if ((++_sp & 255u) == 0u) { if (xb_ld(&(bar)[XB_TMO])) break; if (_sp > XB_SPIN_CAP) { atomicAdd(&(bar)[XB_TMO], 1u); break; } } } } while (0)

struct XcdBarrier {
    unsigned* bar; unsigned x;
    volatile LAS unsigned* st;
};

__device__ __forceinline__ XcdBarrier xcd_barrier_post(unsigned* bar, volatile LAS unsigned* st) {
    XcdBarrier b; b.bar = bar; b.x = xb_xcc_id(); b.st = st;
    if (threadIdx.x == 0) (void)xb_add(&bar[XB_XCNT(b.x)], 1u);
    return b;
}
__device__ __forceinline__ void xcd_barrier_complete(unsigned* bar, unsigned x, unsigned& nloc, unsigned& nx) {
    const unsigned G = gridDim.x * gridDim.y * gridDim.z;
    unsigned sum, cnt, mine, sp = 0u;
    for (;;) {
        sum = 0u; cnt = 0u; mine = 0u;
#pragma unroll
        for (unsigned j = 0; j < 16; ++j) { const unsigned c = xb_ld(&bar[XB_XCNT(j)]); sum += c; cnt += (c > 0u) ? 1u : 0u; mine = (j == x) ? c : mine; }
        if (sum == G) break;
        __builtin_amdgcn_s_sleep(1);
        if ((++sp & 255u) == 0u) { if (xb_ld(&bar[XB_TMO])) break; if (sp > XB_SPIN_CAP) { atomicAdd(&bar[XB_TMO], 1u); break; } }
    }
    nloc = mine > 0u ? mine : 1u; nx = cnt > 0u ? cnt : 1u;
}

__device__ __forceinline__ void xcd_barrier(const XcdBarrier& b) {
    asm volatile("s_waitcnt vmcnt(0)" ::: "memory");
    __syncthreads();
    if (threadIdx.x == 0) {
        unsigned* bar = b.bar;
        __builtin_amdgcn_s_waitcnt(0);
        unsigned nloc = b.st[0], nx = b.st[1];
        if (nloc == 0u) { xcd_barrier_complete(bar, b.x, nloc, nx); b.st[0] = nloc; b.st[1] = nx; }
        const unsigned old = xb_add(&bar[XB_XSUB(b.x)], 1u);
        const unsigned gen = old / nloc;
        if (old + 1u == (gen + 1u) * nloc) {
            __builtin_amdgcn_fence(__ATOMIC_RELEASE, "agent");
            asm volatile("s_waitcnt vmcnt(0)" ::: "memory");
            const unsigned og = xb_add(&bar[XB_TOP], 1u);
            const unsigned tg = og / nx;
            if (og + 1u == (tg + 1u) * nx) xb_add(&bar[XB_TOPGEN], 1u);
            else XB_SPIN(xb_ld(&bar[XB_TOPGEN]) == tg, bar);
            __builtin_amdgcn_fence(__ATOMIC_ACQUIRE, "agent");
            xb_add(&bar[XB_XGEN(b.x)], 1u);
            asm volatile("s_waitcnt vmcnt(0)" ::: "memory");
        } else {
            XB_SPIN(xb_ld(&bar[XB_XGEN(b.x)]) == gen, bar);
            __builtin_amdgcn_fence(__ATOMIC_ACQUIRE, "agent");
            asm volatile("s_waitcnt vmcnt(0)" ::: "memory");
        }
    }
    __syncthreads();
}


struct Args { const float* in[22]; float* out; unsigned char* ws; int ph_lo, ph_hi; };
enum { I_X = 0, I_C, I_CTX, I_CCTX, I_WADA, I_BADA, I_GPREMIX, I_GPOSTMIX, I_GPREFFN, I_GPOSTFFN, I_WIN, I_BIN, I_WOUT, I_MLFB, I_MLNORM, I_HGLB, I_HGNORM, I_DALAM, I_DANORM, I_WG, I_WU, I_WD };

__host__ __device__ __forceinline__ int perm_in_col(int n) { if (n < C_DAQ || n >= C_DAV) return n; const int d = (n - C_DAQ) % 48, base = n - d, half = d / 24, e = d % 24; return base + 24 * half + 2 * (e % 12) + (e >= 12 ? 1 : 0); }
__device__ __forceinline__ int wg_pull(unsigned* ctr, volatile LAS int* slot) {
    __syncthreads();
    if (threadIdx.x == 0) *slot = (int)__hip_atomic_fetch_add(ctr, 1u, RLX_AGENT);
    __syncthreads();
    return __builtin_amdgcn_readfirstlane(*slot);
}

typedef __attribute__((address_space(4))) const Args* kargs_p;
__device__ __forceinline__ void p0_phase(lptr lds, kargs_p ap) {
    struct { const float* in[22]; unsigned char* ws; } a; a.in[I_C] = ap->in[I_C]; a.in[I_CCTX] = ap->in[I_CCTX]; a.in[I_WADA] = ap->in[I_WADA]; a.in[I_BADA] = ap->in[I_BADA]; a.in[I_HGLB] = ap->in[I_HGLB]; a.in[I_BIN] = ap->in[I_BIN]; a.in[I_DALAM] = ap->in[I_DALAM]; a.ws = ap->ws;
    const int tid = tid_opaque();
    unsigned char* ws = a.ws;
    LAS float* sil = (LAS float*)lds;
    LAS float* part = (LAS float*)(lds + 69632);
    for (int i = tid; i < 17 * D; i += NTHR) { const int bb = i >> 10, k = i & 1023; const float v = bb < 16 ? a.in[I_C][bb * D + k] : a.in[I_CCTX][k]; sil[i] = v / (1.0f + __expf(-v)); }
    __syncthreads();
    float* mod = (float*)(ws + WS_MOD);
    for (int u = blockIdx.x; u < DEPTH * (NMOD / 32); u += gridDim.x) {
        const int l = u / (NMOD / 32), n0 = (u % (NMOD / 32)) * 32, col = tid & 31, ks = tid >> 5;
        const float* w = a.in[I_WADA] + (size_t)l * D * NMOD + (size_t)(ks * 64) * NMOD + n0 + col;
        float acc[17];
#pragma unroll
        for (int bb = 0; bb < 17; ++bb) acc[bb] = 0.f;
        float wr[64];
#pragma unroll
        for (int k = 0; k < 64; ++k) wr[k] = w[(size_t)k * NMOD];
#pragma unroll
        for (int k = 0; k < 64; k += 4) {
#pragma unroll
            for (int bb = 0; bb < 17; ++bb) { const f32x4 s = *(const LAS f32x4*)(sil + bb * D + ks * 64 + k); acc[bb] += s[0] * wr[k] + s[1] * wr[k + 1] + s[2] * wr[k + 2] + s[3] * wr[k + 3]; }
        }
#pragma unroll
        for (int bb = 0; bb < 17; ++bb) part[(ks * 17 + bb) * 32 + col] = acc[bb];
        __syncthreads();
        for (int i = tid; i < 17 * 32; i += NTHR) { const int bb = i >> 5, cc = i & 31; float s = 0.f;
#pragma unroll
            for (int k2 = 0; k2 < 16; ++k2) s += part[(k2 * 17 + bb) * 32 + cc];
            mod[((size_t)l * 17 + bb) * NMOD + n0 + cc] = s + a.in[I_BADA][l * NMOD + n0 + cc]; }
        __syncthreads();
    }
    const int gt = blockIdx.x * NTHR + tid, GT = gridDim.x * NTHR;
    float* lbs = (float*)(ws + WS_MISC); float* rope = (float*)(ws + WS_MISC + 16384); float* biasp = (float*)(ws + WS_MISC + 32768); float* lamv = (float*)(ws + WS_MISC + 114688);
    for (int j = gt; j < 1024; j += GT) { const float* hl = a.in[I_HGLB];
        const float v0 = hl[j], v1 = hl[1024 + j], v2 = hl[2048 + j], v3 = hl[3072 + j]; const float mx = fmaxf(fmaxf(v0, v1), fmaxf(v2, v3));
        const float e0 = expf(v0 - mx), e1 = expf(v1 - mx), e2 = expf(v2 - mx), e3 = expf(v3 - mx), inv = 1.0f / (e0 + e1 + e2 + e3);
        lbs[j] = 0.f; lbs[1024 + j] = e1 * inv; lbs[2048 + j] = (e1 + e2) * inv; lbs[3072 + j] = (e1 + e2 + e3) * inv; }
    for (int j = gt; j < 64 * 12; j += GT) { const int pos = j / 12, i = j % 12; const float inv = powf(10000.0f, -(float)(2 * i) / 24.0f); const float ang = (float)pos * inv; rope[2 * j] = cosf(ang); rope[2 * j + 1] = sinf(ang); }
    for (int j = gt; j < DEPTH * DINP; j += GT) { const int l = j / DINP, n = j % DINP; biasp[l * DINP + perm_in_col(n)] = n < DIN ? a.in[I_BIN][l * DIN + n] : 0.f; }
    if (gt < DEPTH) { const float* lv = a.in[I_DALAM] + gt * 4 * 48; float s01 = 0.f, s23 = 0.f;
        for (int d = 0; d < 48; ++d) { s01 += lv[d] * lv[48 + d]; s23 += lv[96 + d] * lv[144 + d]; }
        const float lam_init = 0.8f - 0.6f * expf(-0.3f * (float)gt);
        lamv[gt] = expf(s01) - expf(s23) + lam_init; }
}

template <bool RES, bool NORM>
__device__ __forceinline__ void thin_phase(int row_lo, const float* xs_lat, const float* xs_ctx, float* xd_lat, float* xd_ctx, bool write_x,
                                           const bf16* y, const float* mod_r, int goff, const float* gpost,
                                           const float* mod_n, int soff, int aoff, const float* gpre, bf16* hout, int vcu, int G, int probe = 0) {
    const int tid = tid_opaque(); const int lane = tid & 63, wave = __builtin_amdgcn_readfirstlane(tid >> 6);
    const int nrows = MT - row_lo; int rwg = (nrows + G - 1) / G; rwg += rwg & 1;
    const int wbeg = row_lo + vcu * rwg, rend = (wbeg + rwg < MT) ? wbeg + rwg : MT;
    const int rbeg = wbeg + 2 * wave;
    constexpr int RSTEP = 2 * NWAVES;
    int cur_bb = -1;
    f32x4 gp[4], ga[4], sh[4];
#pragma unroll
    for (int j = 0; j < 4; ++j) { gp[j] = (f32x4){0.f, 0.f, 0.f, 0.f}; ga[j] = gp[j]; sh[j] = gp[j]; }
    f32x4 xa[2][4], ya[2][4];
#define TH_LOAD(X, Y, r_) do { _Pragma("unroll") for (int q_ = 0; q_ < 2; ++q_) { const int rr_ = (r_) + q_; const bool ic_ = rr_ < MC; \
        const float* xs_ = ic_ ? xs_ctx + (size_t)rr_ * D : xs_lat + (size_t)(rr_ - MC) * D; \
        _Pragma("unroll") for (int j_ = 0; j_ < 4; ++j_) { X[q_][j_] = *(const f32x4*)(xs_ + 4 * lane + 256 * j_); if (RES) { const v2u yw_ = *(const v2u*)(y + (size_t)rr_ * D + 4 * lane + 256 * j_); Y[q_][j_] = (f32x4){bflo(yw_.x), bfhi(yw_.x), bflo(yw_.y), bfhi(yw_.y)}; } } } } while (0)
    if (rbeg < rend) TH_LOAD(xa, ya, rbeg);
    for (int r = rbeg; r < rend; r += RSTEP) {
        f32x4 xb[2][4], yb[2][4];
        if (r + RSTEP < rend) TH_LOAD(xb, yb, r + RSTEP);
        const bool isctx = r < MC; const int bb = isctx ? 16 : (r - MC) / SEQ;
        if (bb != cur_bb) { cur_bb = bb;
#pragma unroll
            for (int j = 0; j < 4; ++j) { const int e = 4 * lane + 256 * j;
                if (RES) gp[j] = *(const f32x4*)(mod_r + (size_t)bb * NMOD + goff + e) * *(const f32x4*)(gpost + e);
                if (NORM) { ga[j] = *(const f32x4*)(gpre + e) * (*(const f32x4*)(mod_n + (size_t)bb * NMOD + aoff + e) + 1.0f); sh[j] = *(const f32x4*)(mod_n + (size_t)bb * NMOD + soff + e); } } }
        if (RES) { float s0 = 0.f, s1 = 0.f;
#pragma unroll
            for (int j = 0; j < 4; ++j) { s0 += (ya[0][j][0] * ya[0][j][0] + ya[0][j][1] * ya[0][j][1]) + (ya[0][j][2] * ya[0][j][2] + ya[0][j][3] * ya[0][j][3]);
                                          s1 += (ya[1][j][0] * ya[1][j][0] + ya[1][j][1] * ya[1][j][1]) + (ya[1][j][2] * ya[1][j][2] + ya[1][j][3] * ya[1][j][3]); }
#pragma unroll
            for (int o = 1; o < 64; o <<= 1) { s0 += lx_xor(s0, o, lane); s1 += lx_xor(s1, o, lane); }
            const float r0s = 1.0f / sqrtf(s0 * (1.0f / D) + EPS), r1s = 1.0f / sqrtf(s1 * (1.0f / D) + EPS);
#pragma unroll
            for (int j = 0; j < 4; ++j) { xa[0][j] += gp[j] * ya[0][j] * r0s; xa[1][j] += gp[j] * ya[1][j] * r1s; } }
        float* xd0 = isctx ? xd_ctx + (size_t)r * D : xd_lat + (size_t)(r - MC) * D;
        if (write_x && !(probe & 1)) {
#pragma unroll
            for (int j = 0; j < 4; ++j) { *(f32x4*)(xd0 + 4 * lane + 256 * j) = xa[0][j]; *(f32x4*)(xd0 + D + 4 * lane + 256 * j) = xa[1][j]; } }
        if (NORM) { float s0 = 0.f, s1 = 0.f;
#pragma unroll
            for (int j = 0; j < 4; ++j) { s0 += (xa[0][j][0] * xa[0][j][0] + xa[0][j][1] * xa[0][j][1]) + (xa[0][j][2] * xa[0][j][2] + xa[0][j][3] * xa[0][j][3]);
                                          s1 += (xa[1][j][0] * xa[1][j][0] + xa[1][j][1] * xa[1][j][1]) + (xa[1][j][2] * xa[1][j][2] + xa[1][j][3] * xa[1][j][3]); }
#pragma unroll
            for (int o = 1; o < 64; o <<= 1) { s0 += lx_xor(s0, o, lane); s1 += lx_xor(s1, o, lane); }
            const float r0s = 1.0f / sqrtf(s0 * (1.0f / D) + EPS), r1s = 1.0f / sqrtf(s1 * (1.0f / D) + EPS);
#pragma unroll
            for (int j = 0; j < 4; ++j) { const f32x4 h0 = xa[0][j] * r0s * ga[j] + sh[j], h1 = xa[1][j] * r1s * ga[j] + sh[j];
                v2u w0, w1; w0.x = pk2(h0[0], h0[1]); w0.y = pk2(h0[2], h0[3]); w1.x = pk2(h1[0], h1[1]); w1.y = pk2(h1[2], h1[3]);
                if (!(probe & 2)) { *(v2u*)(hout + (size_t)r * D + 4 * lane + 256 * j) = w0; *(v2u*)(hout + (size_t)(r + 1) * D + 4 * lane + 256 * j) = w1; } } }
#pragma unroll
        for (int q = 0; q < 2; ++q)
#pragma unroll
            for (int j = 0; j < 4; ++j) { xa[q][j] = xb[q][j]; if (RES) ya[q][j] = yb[q][j]; }
    }
#undef TH_LOAD
}

template <int MODE>
__device__ __forceinline__ void tr_item(const float* W, int K, int N, int nblk, bf16* WT, LAS float* scr, int item, int lane) {
    const int kb = item / nblk, nb = item % nblk, k0 = 64 * kb, n0 = 32 * nb;
    const int nn = n0 + (lane & 31); const bool ok = nn < N;
#pragma unroll 8
    for (int i = 0; i < 32; ++i) { const int kk = 2 * i + (lane >> 5); scr[kk * 33 + (lane & 31)] = ok ? W[(size_t)(k0 + kk) * N + nn] : 0.f; }
    LDS_WAIT(); asm volatile("" ::: "memory");
    const int c = lane & 7;
#pragma unroll
    for (int j = 0; j < 4; ++j) { const int n = (lane >> 3) + 8 * j; const LAS float* s = scr + (8 * c) * 33 + n;
        v4u o; o.x = pk2(s[0 * 33], s[1 * 33]); o.y = pk2(s[2 * 33], s[3 * 33]); o.z = pk2(s[4 * 33], s[5 * 33]); o.w = pk2(s[6 * 33], s[7 * 33]);
        const int ng = n0 + n; const int drow = MODE == 0 ? ng : MODE == 3 ? perm_in_col(ng) : ((ng >> 7) * 256 + (ng & 127) + (MODE == 2 ? 128 : 0));
        *(v4u*)(WT + (size_t)drow * K + k0 + 8 * c) = o; }
    LDS_WAIT(); asm volatile("" ::: "memory");
}
__device__ __forceinline__ void convert_weights(lptr lds, kargs_p ap, int l, int vcu, int G) {
    const unsigned char* const wsb = ap->ws; const float* const p_win = ap->in[I_WIN]; const float* const p_wout = ap->in[I_WOUT]; const float* const p_wg = ap->in[I_WG]; const float* const p_wu = ap->in[I_WU]; const float* const p_wd = ap->in[I_WD];
    const int tid = tid_opaque(); const int lane = tid & 63, wave = __builtin_amdgcn_readfirstlane(tid >> 6);
    LAS float* scr = (LAS float*)(lds + wave * 8448);
    const int gw = vcu * NWAVES + wave, NGW = G * NWAVES;
    unsigned char* ws = (unsigned char*)wsb;
    constexpr int I_IN = 16 * (DINP / 32), I_OUT = 16 * 32, I_GU = 16 * (DFF / 32), I_DN = (DFF / 64) * 32;
    constexpr int NITEMS = I_IN + I_OUT + 2 * I_GU + I_DN;
    for (int it = gw; it < NITEMS; it += NGW) {
        int r = it;
        if (r < I_IN) { tr_item<3>(p_win + (size_t)l * D * DIN, D, DIN, DINP / 32, (bf16*)(ws + WS_WIN), scr, r, lane); continue; } r -= I_IN;
        if (r < I_OUT) { tr_item<0>(p_wout + (size_t)l * D * D, D, D, 32, (bf16*)(ws + WS_WOUT), scr, r, lane); continue; } r -= I_OUT;
        if (r < I_GU) { tr_item<1>(p_wg + (size_t)l * D * DFF, D, DFF, DFF / 32, (bf16*)(ws + WS_WGU), scr, r, lane); continue; } r -= I_GU;
        if (r < I_GU) { tr_item<2>(p_wu + (size_t)l * D * DFF, D, DFF, DFF / 32, (bf16*)(ws + WS_WGU), scr, r, lane); continue; } r -= I_GU;
        tr_item<0>(p_wd + (size_t)l * DFF * D, DFF, D, 32, (bf16*)(ws + WS_WD), scr, r, lane);
    }
}
constexpr int AT_BUF = 25600, AT_KOFF = 0, AT_VOFF = 13312, AT_QF = 76800;
constexpr float AT_THR = 8.0f;
constexpr float QSCALE = 0.14433756729740643f * 1.4426950408889634f;

__device__ __forceinline__ f32x16 zero16() { f32x16 z; _Pragma("unroll") for (int r = 0; r < 16; ++r) z[r] = 0.f; return z; }
__device__ __forceinline__ float sm_max(const f32x16& S, int lane) {
    float mx = S[0];
#pragma unroll
    for (int r = 1; r < 16; ++r) mx = fmaxf(mx, S[r]);
    return fmaxf(mx, lx_xor(mx, 32, lane));
}
__device__ __forceinline__ void sm_exp(const f32x16& S, float m, float& l, bf16x8& p0, bf16x8& p1) {
    float p[16]; float ps = 0.f;
#pragma unroll
    for (int r = 0; r < 16; ++r) { p[r] = __builtin_amdgcn_exp2f(S[r] - m); ps += p[r]; }
    l += ps;
    v4u a, b;
    a.x = pk2(p[0], p[1]); a.y = pk2(p[2], p[3]); a.z = pk2(p[4], p[5]); a.w = pk2(p[6], p[7]);
    b.x = pk2(p[8], p[9]); b.y = pk2(p[10], p[11]); b.z = pk2(p[12], p[13]); b.w = pk2(p[14], p[15]);
    p0 = __builtin_bit_cast(bf16x8, a); p1 = __builtin_bit_cast(bf16x8, b);
}
__device__ __forceinline__ bf16x8 vt_frag(lptr vt, int ct, int sub, int sp, int lane) {
    const int h = lane >> 5, blk = (lane >> 4) & 1, q = (lane & 15) >> 2, p = lane & 3;
    lptr a = vt + (32 * sub + 16 * sp + 4 * h + q) * 192 + (32 * ct + 16 * blk + 4 * p) * 2;
    const v4i16 lo = __builtin_amdgcn_ds_read_tr16_b64_v4i16((LAS v4i16*)a);
    const v4i16 hi = __builtin_amdgcn_ds_read_tr16_b64_v4i16((LAS v4i16*)(a + 8 * 192));
    return __builtin_shufflevector(lo, hi, 0, 1, 2, 3, 4, 5, 6, 7);
}

__device__ __forceinline__ void attn_item(lptr lds, const bf16* P, bf16* YM, const float* danorm, float lam, float out_scale, int b, int h, int qb, int probe) {
    const int tid = tid_opaque(), lane = tid & 63, r32 = lane & 31, hi = lane >> 5, wave = __builtin_amdgcn_readfirstlane(tid >> 6);
    const bool lat = qb < 8;
    const int qrow0 = lat ? MC + b * SEQ + qb * 256 : b * CTXL;
    const int nt = lat ? 36 : 4;
    v4u cin[2];
    const unsigned kgo0 = (unsigned)(tid / 12) * DAX_LD + 16u * (unsigned)(tid % 12) + 192u, kgo1 = (unsigned)((tid + 512) / 12) * DAX_LD + 16u * (unsigned)((tid + 512) % 12) + 192u;
    const unsigned klo0 = (unsigned)(AT_KOFF + (tid / 12) * 208 + (tid % 12) * 16), klo1 = (unsigned)(AT_KOFF + ((tid + 512) / 12) * 208 + ((tid + 512) % 12) * 16);
    const unsigned vgo0 = (unsigned)((64 * wave + lane) / 12) * DAX_LD + 16u * (unsigned)((64 * wave + lane) % 12) + 384u, vgo1 = (unsigned)((64 * (wave + 8) + lane) / 12) * DAX_LD + 16u * (unsigned)((64 * (wave + 8) + lane) % 12) + 384u;
    const char* DX = (const char*)P + DAX_OFF + (size_t)(b * 4 + h) * NSLOT * DAX_LD;
#define AT_LOAD(tile) do { const char* tb_ = DX + (size_t)(tile) * (64 * DAX_LD); cin[0] = gld16(tb_, kgo0); if (tid < 256) cin[1] = gld16(tb_, kgo1); } while (0)
#define AT_STORE(tile, buf) do { lptr sb_ = lds + (buf) * AT_BUF; *(LAS v4u*)(sb_ + klo0) = cin[0]; if (tid < 256) *(LAS v4u*)(sb_ + klo1) = cin[1]; } while (0)
#define AT_VDMA(tile, buf) do { const char* tb_ = DX + (size_t)(tile) * (64 * DAX_LD); lptr vb_ = lds + (buf) * AT_BUF + AT_VOFF; \
        __builtin_amdgcn_global_load_lds((const unsigned*)(tb_ + vgo0), (LAS unsigned*)(vb_ + wave * 1024), 16, 0, 0); \
        if (wave < 4) __builtin_amdgcn_global_load_lds((const unsigned*)(tb_ + vgo1), (LAS unsigned*)(vb_ + (wave + 8) * 1024), 16, 0, 0); } while (0)
    AT_LOAD(0);
    lptr qfp = lds + AT_QF + (wave * 6 * 64 + lane) * 16;
    { const unsigned qo = (unsigned)((lat ? CTXL + qb * 256 : 0) + wave * 32 + r32) * DAX_LD + 16u * hi;
#pragma unroll
      for (int f = 0; f < 6; ++f) __builtin_amdgcn_global_load_lds((const unsigned*)(DX + qo + (unsigned)((f / 3) * 48 + (f % 3) * 16) * 2u), (LAS unsigned*)(lds + AT_QF + (wave * 6 + f) * 1024), 16, 0, 0); }
    AT_STORE(0, 0); AT_VDMA(0, 0);
    if (nt > 1) { AT_LOAD(1); AT_VDMA(1, 1); }
    __syncthreads();
    f32x16 O0[3], O1[3];
#pragma unroll
    for (int ct = 0; ct < 3; ++ct)
#pragma unroll
        for (int r = 0; r < 16; ++r) { O0[ct][r] = 0.f; O1[ct][r] = 0.f; }
    float m0 = -1e30f, m1 = -1e30f, l0 = 0.f, l1 = 0.f;
#define AT_QK(SX0, SX1, kb, sub) do { \
        _Pragma("unroll") for (int ks = 0; ks < 3; ++ks) { \
            const bf16x8 k0_ = lds8((kb) + (((sub) * 32 + r32) * 104 + ks * 16 + hi * 8) * 2); \
            const bf16x8 k1_ = lds8((kb) + (((sub) * 32 + r32) * 104 + 48 + ks * 16 + hi * 8) * 2); \
            const bf16x8 q0_ = lds8(qfp + ks * 1024), q1_ = lds8(qfp + (3 + ks) * 1024); \
            if (ks == 0) { SX0 = MFMA32(k0_, q0_, zero16()); SX1 = MFMA32(k1_, q1_, zero16()); } \
            else { SX0 = MFMA32(k0_, q0_, SX0); SX1 = MFMA32(k1_, q1_, SX1); } } } while (0)
#define AT_SMPV(SX0, SX1, vb, sub) do { \
        const float mx0_ = sm_max(SX0, lane), mx1_ = sm_max(SX1, lane); \
        if (__any((mx0_ > m0 + AT_THR) || (mx1_ > m1 + AT_THR))) { \
            const float n0_ = fmaxf(m0, mx0_), n1_ = fmaxf(m1, mx1_); \
            const float a0_ = __builtin_amdgcn_exp2f(m0 - n0_), a1_ = __builtin_amdgcn_exp2f(m1 - n1_); \
            m0 = n0_; m1 = n1_; l0 *= a0_; l1 *= a1_; \
            _Pragma("unroll") for (int ct = 0; ct < 3; ++ct) _Pragma("unroll") for (int r = 0; r < 16; ++r) { O0[ct][r] *= a0_; O1[ct][r] *= a1_; } } \
        bf16x8 p00_, p01_, p10_, p11_; \
        sm_exp(SX0, m0, l0, p00_, p01_); sm_exp(SX1, m1, l1, p10_, p11_); \
        _Pragma("unroll") for (int ct = 0; ct < 3; ++ct) { \
            const bf16x8 v0_ = vt_frag((vb), ct, (sub), 0, lane); const bf16x8 v1_ = vt_frag((vb), ct, (sub), 1, lane); \
            O0[ct] = MFMA32(v0_, p00_, O0[ct]); O1[ct] = MFMA32(v0_, p10_, O1[ct]); \
            O0[ct] = MFMA32(v1_, p01_, O0[ct]); O1[ct] = MFMA32(v1_, p11_, O1[ct]); } } while (0)
    f32x16 SA0, SA1, SB0, SB1;
    AT_QK(SA0, SA1, lds + AT_KOFF, 0);
    int cb = 0;
    for (int i = 0; i < nt; ++i) {
        const int nb = (cb == 2) ? 0 : cb + 1;
        lptr kc_ = lds + cb * AT_BUF + AT_KOFF, vc_ = lds + cb * AT_BUF + AT_VOFF;
        AT_QK(SB0, SB1, kc_, 1);
        AT_SMPV(SA0, SA1, vc_, 0);
        if (i + 1 < nt && !(probe & 2)) AT_STORE(i + 1, nb);
        __syncthreads();
        if (i + 2 < nt && !(probe & 1)) { AT_LOAD(i + 2); AT_VDMA(i + 2, (nb == 2) ? 0 : nb + 1); }
        if (i + 1 < nt) AT_QK(SA0, SA1, lds + nb * AT_BUF + AT_KOFF, 0);
        AT_SMPV(SB0, SB1, vc_, 1);
        cb = nb;
    }
#undef AT_LOAD
#undef AT_VDMA
#undef AT_STORE
#undef AT_QK
#undef AT_SMPV
    const float i0 = 1.0f / (l0 + lx_xor(l0, 32, lane)), i1 = lam / (l1 + lx_xor(l1, 32, lane));
    float ss = 0.f;
#pragma unroll
    for (int ct = 0; ct < 3; ++ct)
#pragma unroll
        for (int r = 0; r < 16; ++r) { const float o = O0[ct][r] * i0 - O1[ct][r] * i1; O0[ct][r] = o; ss += o * o; }
    ss += lx_xor(ss, 32, lane);
    const float rs = out_scale / sqrtf(ss * (1.0f / 96.0f) + EPS);
    const unsigned oro = ((unsigned)(qrow0 + wave * 32 + r32) * (unsigned)D + (unsigned)(Y_DA + h * 96)) * 2u;
#pragma unroll
    for (int ct = 0; ct < 3; ++ct)
#pragma unroll
        for (int g = 0; g < 4; ++g) { const int c0 = 32 * ct + 8 * g + 4 * hi; const f32x4 gn = *(const f32x4*)(danorm + c0);
            v2u w; w.x = pk2(O0[ct][4 * g] * rs * gn[0], O0[ct][4 * g + 1] * rs * gn[1]); w.y = pk2(O0[ct][4 * g + 2] * rs * gn[2], O0[ct][4 * g + 3] * rs * gn[3]);
            gst8(YM, oro + 2u * c0, w); }
}
__device__ __forceinline__ int scan_row(int b, int dir, int p) {
    if (p < CTXL) { const int t = dir ? CTXL - 1 - p : p; return b * CTXL + t; }
    const int pl = p - CTXL; const int t = dir ? SEQ - 1 - pl : pl; return MC + b * SEQ + t;
}
__device__ __forceinline__ int scan_slot(int dir, int p) { if (p < CTXL) return dir ? CTXL - 1 - p : p; const int pl = p - CTXL; return CTXL + (dir ? SEQ - 1 - pl : pl); }

constexpr int ML_Q = 0, ML_K = 13312, ML_KW = 26624, ML_VA = 40960, ML_QKM = 55296, ML_ST = 64512, ML_GF = 87808;
constexpr int ML_LDQ = 208, ML_LDW = 224, ML_LDM = 144, ML_LDS = 208;
constexpr float KSCALE = 0.10206207261596577f;

__device__ __forceinline__ void mlstm_stream(lptr lds, const bf16* P, const float* G, bf16* dst, int dst_ld, const float* fbias  , int b, int h, int dir) {
    const int tid = tid_opaque(), lane = tid & 63, c16 = lane & 15, rg = lane >> 4, wave = __builtin_amdgcn_readfirstlane(tid >> 6);
    lptr Qs = lds + ML_Q, Ks = lds + ML_K, Kw = lds + ML_KW, Va = lds + ML_VA, QKM = lds + ML_QKM, ST = lds + ML_ST;
    LAS float* gA = (LAS float*)(lds + ML_GF); LAS float* MxA = gA + 64; LAS float* wA = gA + 128; LAS float* emtA = gA + 192; LAS float* wkA = gA + 256; LAS float* scal = gA + 320;
    if (tid < 128) { const int t = tid >> 1, hh = tid & 1; v4u w; w.x = hh ? 0u : 0x3F80u; w.y = 0u; w.z = 0u; w.w = 0u; *(LAS v4u*)(Va + t * ML_LDW + (96 + 8 * hh) * 2) = w; }
    const float fb = fbias[dir * 4 + h];
    f32x4 acc[6];
#pragma unroll
    for (int i = 0; i < 6; ++i) acc[i] = (f32x4){0.f, 0.f, 0.f, 0.f};
    float m_prev = -1e30f;
    v4u pre[5]; float gi = 0.f, gf = 0.f;
    const char* MLB = (const char*)P + MLX_OFF + (size_t)(b * 4 + h) * NSLOT * MLX_LD;
#define ML_PREFETCH(c) do { const char* cb_ = MLB + (size_t)(dir ? scan_slot(1, 64 * (c) + 63) : scan_slot(0, 64 * (c))) * MLX_LD; \
    _Pragma("unroll") for (int i_ = 0; i_ < 5; ++i_) { const int id_ = tid + NTHR * i_; if (id_ < 2304) { const int t_ = id_ / 36, r_ = id_ % 36; \
        pre[i_] = gld16(cb_, (unsigned)(dir ? 63 - t_ : t_) * MLX_LD + (unsigned)((r_ / 12) * 96 + (r_ % 12) * 8) * 2u); } } \
    if (wave == 0) { const unsigned go_ = (unsigned)scan_row(b, dir, 64 * (c) + lane) * 64u + (unsigned)(dir * 4 + h) * 4u; gi = *(const float*)((const char*)G + go_); gf = *(const float*)((const char*)G + go_ + 32u); } } while (0)
    ML_PREFETCH(0);
    for (int c = 0; c < NTOK / 64; ++c) {
#pragma unroll
        for (int i = 0; i < 5; ++i) { const int id = tid + NTHR * i; if (id < 2304) { const int t = id / 36, r = id % 36, wh = r / 12, cc = r % 12;
            lptr d = (wh == 0) ? Qs + t * ML_LDQ : (wh == 1) ? Ks + t * ML_LDQ : Va + t * ML_LDW;
            *(LAS v4u*)(d + cc * 16) = pre[i]; } }
        if (wave == 0) {
            const float fp = gf + fb;
            const float lf = fminf(fp, 0.f) - log1pf(__expf(-fabsf(fp)));
            const float bs = scan_sum64(lf);
            const float g = gi - bs;
            const float cm = scan_max64(g);
            const float Mx = fmaxf(m_prev, cm);
            const float mt = bs + Mx;
            const float blast = lx_idx(bs, 63), m_new = lx_idx(mt, 63);
            gA[lane] = g; MxA[lane] = Mx; wA[lane] = __expf(m_prev - Mx); emtA[lane] = __expf(-mt); wkA[lane] = __expf(g + blast - m_new) * KSCALE;
            if (lane == 0) scal[0] = __expf(blast + m_prev - m_new);
            m_prev = m_new;
        }
        if (c + 1 < NTOK / 64) ML_PREFETCH(c + 1);
        __syncthreads();
#pragma unroll
        for (int j = 0; j < 2; ++j) { const int idx = 2 * wave + j, si = idx & 3, ti = idx >> 2;
            f32x4 a4 = (f32x4){0.f, 0.f, 0.f, 0.f};
            if (si <= ti) {
#pragma unroll
                for (int ks = 0; ks < 3; ++ks) a4 = MFMA16(opr(Ks, ML_LDQ, 16 * si, 32 * ks, c16, rg), opr(Qs, ML_LDQ, 16 * ti, 32 * ks, c16, rg), a4);
            }
            const int t = 16 * ti + c16, s0 = 16 * si + 4 * rg; const float mxt = MxA[t]; const f32x4 g4 = *(const LAS f32x4*)(gA + s0);
            float v[4];
#pragma unroll
            for (int r = 0; r < 4; ++r) v[r] = (s0 + r <= t) ? a4[r] * KSCALE * __expf(g4[r] - mxt) : 0.f;
            v2u w; w.x = pk2(v[0], v[1]); w.y = pk2(v[2], v[3]); *(LAS v2u*)(QKM + t * ML_LDM + s0 * 2) = w; }
        for (int id = tid; id < 64 * 12; id += NTHR) { const int t = id / 12, cc = id % 12; const v4u w = *(const LAS v4u*)(Ks + t * ML_LDQ + cc * 16); const float sc = wkA[t];
            v4u o; o.x = pk2(bflo(w.x) * sc, bfhi(w.x) * sc); o.y = pk2(bflo(w.y) * sc, bfhi(w.y) * sc); o.z = pk2(bflo(w.z) * sc, bfhi(w.z) * sc); o.w = pk2(bflo(w.w) * sc, bfhi(w.w) * sc);
            *(LAS v4u*)(Kw + t * ML_LDW + cc * 16) = o; }
#pragma unroll
        for (int i = 0; i < 6; ++i) { const int j = wave + 8 * i; if (j < 42) { const int di = j / 7, vi = j % 7;
            v2u w; w.x = pk2(acc[i][0], acc[i][1]); w.y = pk2(acc[i][2], acc[i][3]); *(LAS v2u*)(ST + (16 * vi + c16) * ML_LDS + (16 * di + 4 * rg) * 2) = w; } }
        __syncthreads();
        if (wave < 4) {
            const int ti = wave, t = 16 * ti + c16;
            f32x4 aX[7];
#pragma unroll
            for (int vi = 0; vi < 7; ++vi) aX[vi] = (f32x4){0.f, 0.f, 0.f, 0.f};
#pragma unroll
            for (int ks = 0; ks < 3; ++ks) { const bf16x8 b8 = opr(Qs, ML_LDQ, 16 * ti, 32 * ks, c16, rg);
#pragma unroll
                for (int vi = 0; vi < 7; ++vi) aX[vi] = MFMA16(opr(ST, ML_LDS, 16 * vi, 32 * ks, c16, rg), b8, aX[vi]); }
            { const float wt = wA[t];
#pragma unroll
              for (int vi = 0; vi < 7; ++vi) aX[vi] = aX[vi] * wt; }
#pragma unroll
            for (int ks = 0; ks < 2; ++ks) { const bf16x8 b8 = opr(QKM, ML_LDM, 16 * ti, 32 * ks, c16, rg);
#pragma unroll
                for (int vi = 0; vi < 7; ++vi) aX[vi] = MFMA16(opt(Va, ML_LDW, 16 * vi, 32 * ks, lane), b8, aX[vi]); }
            const float den = lx_idx(aX[6][0], c16);
            const float inv = 1.0f / fmaxf(fabsf(den), emtA[t]);
            const int row = scan_row(b, dir, 64 * c + t);
            const unsigned oo = ((unsigned)row * (unsigned)dst_ld + (unsigned)(h * 96 + 4 * rg)) * 2u;
#pragma unroll
            for (int vi = 0; vi < 6; ++vi) { v2u w; w.x = pk2(aX[vi][0] * inv, aX[vi][1] * inv); w.y = pk2(aX[vi][2] * inv, aX[vi][3] * inv); gst8(dst, oo + 32u * vi, w); }
        }
        { const float decay = scal[0];
#pragma unroll
          for (int i = 0; i < 6; ++i) { const int j = wave + 8 * i; if (j < 42) { const int di = j / 7, vi = j % 7;
              acc[i] = acc[i] * decay;
#pragma unroll
              for (int ks = 0; ks < 2; ++ks) acc[i] = MFMA16(opt(Kw, ML_LDW, 16 * di, 32 * ks, lane), opt(Va, ML_LDW, 16 * vi, 32 * ks, lane), acc[i]); } } }
        __syncthreads();
    }
#undef ML_PREFETCH
}

constexpr int HG_QT = 0, HG_KR = 8704, HG_V = 17920, HG_ATT = 23040, HG_SPT = 25600, HG_ER = 43008, HG_TOT = 43520, HG_OFF = 47616;
constexpr int HG_LDQ = 272, HG_LDK = 288, HG_LDV = 160, HG_LDA = 80, HG_LDS = 272;

__device__ __forceinline__ void hgrn2_stream(lptr lds, const bf16* P, bf16* dst, int dst_ld, const float* lbl  , int b, int h, int dir) {
    const int tid = tid_opaque(), lane = tid & 63, c16 = lane & 15, rg = lane >> 4, wave = __builtin_amdgcn_readfirstlane(tid >> 6);
    lptr QT = lds + HG_QT, KR = lds + HG_KR, Vs = lds + HG_V, ATT = lds + HG_ATT, SPT = lds + HG_SPT;
    LAS float* ER = (LAS float*)(lds + HG_ER); LAS float* TOT = (LAS float*)(lds + HG_TOT); LAS float* OFF = (LAS float*)(lds + HG_OFF);
    const int tt = tid >> 4, kc = tid & 15;
    const int tv = tid >> 3, cv = tid & 7;
    float lb[8];
    { const f32x4 l0 = *(const f32x4*)(lbl + dir * 512 + h * 128 + 8 * kc), l1 = *(const f32x4*)(lbl + dir * 512 + h * 128 + 8 * kc + 4);
#pragma unroll
      for (int j = 0; j < 4; ++j) { lb[j] = l0[j]; lb[4 + j] = l1[j]; } }
    f32x4 acc[4];
#pragma unroll
    for (int i = 0; i < 4; ++i) acc[i] = (f32x4){0.f, 0.f, 0.f, 0.f};
    v4u zr, qr, vr;
#define HG_PREFETCH(c) do { { const unsigned ro_ = (unsigned)((b * 4 + h) * NSLOT + scan_slot(dir, 32 * (c) + tt)) * HGX_LD + 16u * kc; \
        zr = gld16((const char*)P + HGX_OFF, ro_ + (unsigned)dir * 256u); qr = gld16((const char*)P + HGX_OFF, ro_ + 512u); } \
        if (tid < 256) { const unsigned ro_ = (unsigned)((b * 4 + h) * NSLOT + scan_slot(dir, 32 * (c) + tv)) * HGX_LD + 16u * cv; vr = gld16((const char*)P + HGX_OFF, ro_ + 768u); } } while (0)
    HG_PREFETCH(0);
    for (int c = 0; c < NTOK / 32; ++c) {
        float kk[8], cs[8], qv[8];
        { const unsigned zw[4] = {zr.x, zr.y, zr.z, zr.w}, qw[4] = {qr.x, qr.y, qr.z, qr.w};
#pragma unroll
          for (int j = 0; j < 8; ++j) { const float z = (j & 1) ? bfhi(zw[j >> 1]) : bflo(zw[j >> 1]); qv[j] = (j & 1) ? bfhi(qw[j >> 1]) : bflo(qw[j >> 1]);
              const float e = __expf(-fabsf(z)); const float inv = __builtin_amdgcn_rcpf(1.0f + e);
              const float sig = z >= 0.f ? inv : e * inv, nsig = z >= 0.f ? e * inv : inv;
              const float oml = 1.0f - lb[j]; const float f = fmaxf(lb[j], 1e-30f) + oml * sig; kk[j] = oml * nsig;
              float x = __log2f(f);
              float y = lx_up(x, 16, lane); if (lane >= 16) x += y;
              y = lx_up(x, 32, lane); if (lane >= 32) x += y;
              cs[j] = x; } }
        if (tid < 256) *(LAS v4u*)(Vs + tv * HG_LDV + cv * 16) = vr;
        if (lane >= 48) { *(LAS f32x4*)(TOT + wave * 128 + 8 * kc) = (f32x4){cs[0], cs[1], cs[2], cs[3]}; *(LAS f32x4*)(TOT + wave * 128 + 8 * kc + 4) = (f32x4){cs[4], cs[5], cs[6], cs[7]}; }
        __syncthreads();
        if (tid < 128) { f32x4 o0 = (f32x4){0.f, 0.f, 0.f, 0.f}, o1 = o0, s0 = o0, s1 = o0;
#pragma unroll
            for (int w2 = 0; w2 < 8; ++w2) { const f32x4 t0 = *(const LAS f32x4*)(TOT + w2 * 128 + 8 * kc), t1 = *(const LAS f32x4*)(TOT + w2 * 128 + 8 * kc + 4);
                if (w2 == tt) { o0 = s0; o1 = s1; } s0 += t0; s1 += t1; }
            *(LAS f32x4*)(OFF + tt * 128 + 8 * kc) = o0; *(LAS f32x4*)(OFF + tt * 128 + 8 * kc + 4) = o1;
            if (tt == 0) { *(LAS f32x4*)(OFF + 1024 + 8 * kc) = s0; *(LAS f32x4*)(OFF + 1024 + 8 * kc + 4) = s1;
                const f32x4 e0 = {__builtin_amdgcn_exp2f(fmaxf(0.5f * s0[0], -100.f)), __builtin_amdgcn_exp2f(fmaxf(0.5f * s0[1], -100.f)), __builtin_amdgcn_exp2f(fmaxf(0.5f * s0[2], -100.f)), __builtin_amdgcn_exp2f(fmaxf(0.5f * s0[3], -100.f))};
                const f32x4 e1 = {__builtin_amdgcn_exp2f(fmaxf(0.5f * s1[0], -100.f)), __builtin_amdgcn_exp2f(fmaxf(0.5f * s1[1], -100.f)), __builtin_amdgcn_exp2f(fmaxf(0.5f * s1[2], -100.f)), __builtin_amdgcn_exp2f(fmaxf(0.5f * s1[3], -100.f))};
                *(LAS f32x4*)(ER + 8 * kc) = e0; *(LAS f32x4*)(ER + 8 * kc + 4) = e1; } }
        __syncthreads();
        { const f32x4 o0 = *(const LAS f32x4*)(OFF + wave * 128 + 8 * kc), o1 = *(const LAS f32x4*)(OFF + wave * 128 + 8 * kc + 4);
          const f32x4 t0 = *(const LAS f32x4*)(OFF + 1024 + 8 * kc), t1 = *(const LAS f32x4*)(OFF + 1024 + 8 * kc + 4);
          float qt[8], kt[8];
#pragma unroll
          for (int j = 0; j < 8; ++j) { const float rr = 0.5f * (j < 4 ? t0[j & 3] : t1[j & 3]); float x = (j < 4 ? o0[j & 3] : o1[j & 3]) + cs[j] - rr; x = fminf(fmaxf(x, -100.f), 100.f);
              const float q = qv[j]; const float qs = q * __builtin_amdgcn_rcpf(1.0f + __expf(-q));
              qt[j] = qs * __builtin_amdgcn_exp2f(x); kt[j] = kk[j] * __builtin_amdgcn_exp2f(-x); }
          v4u wq, wk; wq.x = pk2(qt[0], qt[1]); wq.y = pk2(qt[2], qt[3]); wq.z = pk2(qt[4], qt[5]); wq.w = pk2(qt[6], qt[7]);
          wk.x = pk2(kt[0], kt[1]); wk.y = pk2(kt[2], kt[3]); wk.z = pk2(kt[4], kt[5]); wk.w = pk2(kt[6], kt[7]);
          *(LAS v4u*)(QT + tt * HG_LDQ + kc * 16) = wq; *(LAS v4u*)(KR + tt * HG_LDK + kc * 16) = wk; }
        if (c + 1 < NTOK / 32) HG_PREFETCH(c + 1);
        __syncthreads();
        if (wave < 4) { const int si = wave & 1, ti = wave >> 1;
            f32x4 a4 = (f32x4){0.f, 0.f, 0.f, 0.f};
            if (si <= ti) {
#pragma unroll
                for (int ks = 0; ks < 4; ++ks) a4 = MFMA16(opr(KR, HG_LDK, 16 * si, 32 * ks, c16, rg), opr(QT, HG_LDQ, 16 * ti, 32 * ks, c16, rg), a4);
            }
            const int t = 16 * ti + c16, s0 = 16 * si + 4 * rg;
            v2u w; w.x = pk2(s0 <= t ? a4[0] : 0.f, s0 + 1 <= t ? a4[1] : 0.f); w.y = pk2(s0 + 2 <= t ? a4[2] : 0.f, s0 + 3 <= t ? a4[3] : 0.f);
            *(LAS v2u*)(ATT + t * HG_LDA + s0 * 2) = w; }
        { const f32x4 er = *(const LAS f32x4*)(ER + 16 * wave + 4 * rg);
#pragma unroll
          for (int ci = 0; ci < 4; ++ci) { acc[ci] = acc[ci] * er; v2u w; w.x = pk2(acc[ci][0], acc[ci][1]); w.y = pk2(acc[ci][2], acc[ci][3]);
              *(LAS v2u*)(SPT + (16 * ci + c16) * HG_LDS + (16 * wave + 4 * rg) * 2) = w; } }
        __syncthreads();
        { const int ci = wave & 3, ti = wave >> 2, t = 16 * ti + c16;
          f32x4 o4 = (f32x4){0.f, 0.f, 0.f, 0.f};
          o4 = MFMA16(opt(Vs, HG_LDV, 16 * ci, 0, lane), opr(ATT, HG_LDA, 16 * ti, 0, c16, rg), o4);
#pragma unroll
          for (int ks = 0; ks < 4; ++ks) o4 = MFMA16(opr(SPT, HG_LDS, 16 * ci, 32 * ks, c16, rg), opr(QT, HG_LDQ, 16 * ti, 32 * ks, c16, rg), o4);
          const int row = scan_row(b, dir, 32 * c + t);
          v2u w; w.x = pk2(o4[0], o4[1]); w.y = pk2(o4[2], o4[3]);
          gst8(dst, ((unsigned)row * (unsigned)dst_ld + (unsigned)(h * 64 + 16 * ci + 4 * rg)) * 2u, w); }
        { const bf16x8 a8 = opt(KR, HG_LDK, 16 * wave, 0, lane); const f32x4 er = *(const LAS f32x4*)(ER + 16 * wave + 4 * rg);
#pragma unroll
          for (int ci = 0; ci < 4; ++ci) { acc[ci] = MFMA16(a8, opt(Vs, HG_LDV, 16 * ci, 0, lane), acc[ci]); acc[ci] = acc[ci] * er; } }
        __syncthreads();
    }
#undef HG_PREFETCH
}

__device__ __forceinline__ void fin_phase(int row_lo, const bf16* P, bf16* YM, const bf16* RAWM, const bf16* RAWH, const float* mlgain  , const float* hggain  , int vcu, int G) {
    const int tid = tid_opaque(); const int lane = tid & 63, wave = __builtin_amdgcn_readfirstlane(tid >> 6);
    const int gw = vcu * NWAVES + wave, NGW = G * NWAVES;
    float gm[6], gh[4];
#pragma unroll
    for (int j = 0; j < 6; ++j) gm[j] = mlgain[6 * lane + j];
#pragma unroll
    for (int j = 0; j < 4; ++j) gh[j] = hggain[4 * lane + j];
    for (int r = row_lo + gw; r < MT; r += NGW) {
        bf16* ym = YM + (size_t)r * D;
        const unsigned* f3 = (const unsigned*)(ym + Y_ML + 6 * lane); const unsigned* b3 = (const unsigned*)(RAWM + (size_t)r * 384 + 6 * lane); const unsigned* o3 = (const unsigned*)((const char*)P + MLO_OFF + (size_t)r * MLO_LD + 12 * lane);
        const unsigned fa = f3[0], fb_ = f3[1], fc = f3[2], ba = b3[0], bb = b3[1], bc = b3[2], oa = o3[0], ob = o3[1], oc = o3[2];
        const v2u f2 = *(const v2u*)(ym + Y_HG + 4 * lane), b2 = *(const v2u*)(RAWH + (size_t)r * 256 + 4 * lane), g2 = *(const v2u*)((const char*)P + HGG_OFF + (size_t)r * HGG_LD + 8 * lane);
        float hm[6] = {bflo(fa) + bflo(ba), bfhi(fa) + bfhi(ba), bflo(fb_) + bflo(bb), bfhi(fb_) + bfhi(bb), bflo(fc) + bflo(bc), bfhi(fc) + bfhi(bc)};
        const float og[6] = {bflo(oa), bfhi(oa), bflo(ob), bfhi(ob), bflo(oc), bfhi(oc)};
        float hh[4] = {bflo(f2.x) + bflo(b2.x), bfhi(f2.x) + bfhi(b2.x), bflo(f2.y) + bflo(b2.y), bfhi(f2.y) + bfhi(b2.y)};
        const float gg[4] = {bflo(g2.x), bfhi(g2.x), bflo(g2.y), bfhi(g2.y)};
        float sm = 0.f, sh = 0.f;
#pragma unroll
        for (int j = 0; j < 6; ++j) sm += hm[j] * hm[j];
#pragma unroll
        for (int j = 0; j < 4; ++j) sh += hh[j] * hh[j];
#pragma unroll
        for (int o = 1; o < 16; o <<= 1) { sm += lx_xor(sm, o, lane); sh += lx_xor(sh, o, lane); }
        const float rm = 1.0f / sqrtf(sm * (1.0f / 96.0f) + EPS), rh = 1.0f / sqrtf(sh * (1.0f / 64.0f) + EPS);
#pragma unroll
        for (int j = 0; j < 6; ++j) hm[j] = hm[j] * rm * gm[j] * __builtin_amdgcn_rcpf(1.0f + __expf(-og[j]));
#pragma unroll
        for (int j = 0; j < 4; ++j) hh[j] = hh[j] * rh * gh[j] * gg[j] * __builtin_amdgcn_rcpf(1.0f + __expf(-gg[j]));
        unsigned* w3 = (unsigned*)(ym + Y_ML + 6 * lane); w3[0] = pk2(hm[0], hm[1]); w3[1] = pk2(hm[2], hm[3]); w3[2] = pk2(hm[4], hm[5]);
        v2u w2; w2.x = pk2(hh[0], hh[1]); w2.y = pk2(hh[2], hh[3]); *(v2u*)(ym + Y_HG + 4 * lane) = w2;
    }
}
#ifndef NO_HG
#define NO_HG 0
#endif
#ifndef NO_ML
#define NO_ML 0
#endif
#ifndef NO_AT
#define NO_AT 0
#endif
#ifndef NO_GEMM
#define NO_GEMM 0
#endif
#ifndef NO_G1
#define NO_G1 0
#endif
#ifndef NO_G2
#define NO_G2 0
#endif
#ifndef NO_G3
#define NO_G3 0
#endif
#ifndef NO_G4
#define NO_G4 0
#endif
#ifndef NO_P0
#define NO_P0 0
#endif
#ifndef STAMP_ON
#define STAMP_ON 0
#endif
#ifndef SA
#define SA 0
#define SB 1
#define SC 0
#define SD 1
#endif
#ifndef THIN_PROBE
#define THIN_PROBE 0
#endif
#ifndef ATT_PROBE
#define ATT_PROBE 0
#endif
#ifndef REPMASK
#define REPMASK 7
#endif
#ifndef REP
#define REP 0
#endif
constexpr int NPHASE = 2 + 8 * DEPTH;

typedef __attribute__((address_space(4))) const Args* kargs_t;
__device__ __forceinline__ kargs_t kargs() { kargs_t p = (kargs_t)__builtin_amdgcn_kernarg_segment_ptr(); asm volatile("" : "+s"(p)); return p; }
#define WSP(T, off) ((T*)(ws + (off)))

__global__ void __launch_bounds__(NTHR, 2) fwd(Args a_unused) {
    extern __shared__ __attribute__((aligned(16))) unsigned char lds_raw[];
    lptr lds = (lptr)lds_raw;
    const int G = gridDim.x; const int bx = blockIdx.x; const int vcu = (G % 8 == 0) ? (bx % 8) * (G / 8) + bx / 8 : bx;
    volatile LAS unsigned* MISC = (volatile LAS unsigned*)(lds + LDSCTL_OFF);
    { const int tid = tid_opaque(); for (int u = tid; u < 256; u += NTHR) ((LAS unsigned*)(lds + LDSCTL_OFF))[u] = 0u; }
    __syncthreads();
    int lo, hi; XcdBarrier bar;
    { kargs_t A = kargs(); lo = A->ph_lo; hi = A->ph_hi; unsigned* bw = (unsigned*)(A->ws + WS_CTL) + CW_BAR;
      bar.bar = bw; bar.x = 0; bar.st = nullptr;
      if (hi - lo > 1) bar = xcd_barrier_post(bw, MISC + 8); }
    volatile LAS int* slot = (volatile LAS int*)(MISC + 16);
#if STAMP_ON
#define STAMP(k) do { if (bx == 0 && tid_opaque() == 0) { kargs_t A_ = kargs(); __hip_atomic_store((unsigned long long*)(A_->ws + WS_MISC + 131072) + (k), (unsigned long long)__builtin_amdgcn_s_memrealtime(), RLX_AGENT); } } while (0)
#else
#define STAMP(k) do { } while (0)
#endif
#define IN(k) (lo <= (k) && (k) < hi)
#define SEAM(k) do { if (IN(k) && IN((k) + 1)) xcd_barrier(bar); STAMP((k) + 1); } while (0)
#define REPEAT(k) for (int rep_ = ((REP == (k) && l == 0) ? 2 : 1); rep_ > 0; --rep_)
#define REPBAR() do { if (rep_ > 1) xcd_barrier(bar); } while (0)

    STAMP(0);
    if (IN(0)) { if (!NO_P0) p0_phase(lds, kargs()); } SEAM(0);

    for (int l = 0; l < DEPTH; ++l) {
        const int pb = 1 + 8 * l;
        const bool with_ctx = l < DEPTH - 1;
        const int r0 = with_ctx ? 0 : MC; const int Mg = MT - r0;
        if (IN(pb)) REPEAT(1) {
            kargs_t A = kargs(); unsigned char* ws = A->ws; const float* modl = WSP(float, WS_MOD) + (size_t)l * 17 * NMOD; float* ctxx = WSP(float, WS_CTXX);
            if (l == 0) thin_phase<false, true>(0, A->in[I_X], A->in[I_CTX], A->out, ctxx, false, (const bf16*)nullptr, nullptr, 0, nullptr, modl, 0, D, A->in[I_GPREMIX] + l * D, WSP(bf16, WS_HB), vcu, G);
            else        thin_phase<true, true>(0, A->out, ctxx, A->out, ctxx, true, WSP(bf16, WS_YD), modl - 17 * NMOD, 5 * D, A->in[I_GPOSTFFN] + (l - 1) * D, modl, 0, D, A->in[I_GPREMIX] + l * D, WSP(bf16, WS_HB), vcu, G);
            convert_weights(lds, kargs(), l, vcu, G); REPBAR();
        }
        SEAM(pb);
        if (IN(pb + 1)) REPEAT(2) {
            kargs_t A = kargs(); unsigned char* ws = A->ws;
            pg8::Gemm g{WSP(bf16, WS_HB), WSP(bf16, WS_WIN), MT, DINP, D}; pg8::StaticOrder S; S.init(MT, DINP, G, bx);
            { const int tid = tid_opaque(); const float* bsrc = WSP(float, WS_MISC + 32768) + l * DINP; const float* rsrc = WSP(float, WS_MISC + 16384);
              for (int i = tid; i < DINP; i += NTHR) ((LAS float*)(lds + LDS_BIAS))[i] = bsrc[i];
              for (int i = tid; i < 64 * 24; i += NTHR) ((LAS float*)(lds + LDS_ROPE))[i] = rsrc[i];
              for (int i = tid; i < DINP / 8; i += NTHR) { unsigned ex, ey; pg8::epi_in_entry(i, ex, ey); ((LAS unsigned*)(lds + LDS_ETAB))[2 * i] = ex; ((LAS unsigned*)(lds + LDS_ETAB))[2 * i + 1] = ey; }
              __syncthreads(); }
            pg8::EpiIn E{ws + WS_P, (const LAS float*)(lds + LDS_BIAS), WSP(float, WS_GATE), (const LAS float*)(lds + LDS_ROPE), (const LAS unsigned*)(lds + LDS_ETAB), MC, QSCALE};
            if (!NO_GEMM && !NO_G1) pg8::gemm_phase<pg8::EpiIn, pg8::StaticOrder, true, true>(lds, g, S, E); REPBAR();
        }
        SEAM(pb + 1);
        if (IN(pb + 2)) REPEAT(3) {
            { kargs_t A = kargs(); unsigned char* ws = A->ws; unsigned* qh = WSP(unsigned, WS_CTL) + CW_Q + 64 * (16 * l + 64 * (rep_ - 1));
              for (;;) { const int it = wg_pull(qh, slot); if (it >= 128) break;
                const int b = it >> 3, h = (it >> 1) & 3, dir = it & 1;
                if (!NO_HG && (rep_ == 1 || (REPMASK & 1))) hgrn2_stream(lds, WSP(bf16, WS_P), dir ? WSP(bf16, WS_RAWH) : WSP(bf16, WS_HB) + Y_HG, dir ? 256 : D, WSP(float, WS_MISC) + l * 1024, b, h, dir); } }
            { kargs_t A = kargs(); unsigned char* ws = A->ws; unsigned* qm = WSP(unsigned, WS_CTL) + CW_Q + 64 * (16 * l + 64 * (rep_ - 1) + 1);
              for (;;) { const int it = wg_pull(qm, slot); if (it >= 128) break;
                const int b = it >> 3, h = (it >> 1) & 3, dir = it & 1;
                if (!NO_ML && (rep_ == 1 || (REPMASK & 2))) mlstm_stream(lds, WSP(bf16, WS_P), WSP(float, WS_GATE), dir ? WSP(bf16, WS_RAWM) : WSP(bf16, WS_HB) + Y_ML, dir ? 384 : D, A->in[I_MLFB] + l * 8, b, h, dir); } }
            { kargs_t A = kargs(); unsigned char* ws = A->ws; unsigned* qa = WSP(unsigned, WS_CTL) + CW_Q + 64 * (16 * l + 64 * (rep_ - 1) + 2);
              const int nq = with_ctx ? 72 : 64;
              const float lam_init = 0.8f - 0.6f * __expf(-0.3f * (float)l);
              const int myx = (int)(xb_xcc_id() & 7u);
              for (int k = 0; k < 8; ++k) { const int qx = (myx + k) & 7;
                for (;;) { const int it = wg_pull(qa + 64 * qx, slot); if (it >= nq) break;
                  const int bh = it < 64 ? (it >> 3) * 8 + qx : (it - 64) * 8 + qx, qb = it < 64 ? it & 7 : 8;
                  if (!NO_AT && (rep_ == 1 || (REPMASK & 4))) attn_item(lds, WSP(bf16, WS_P), WSP(bf16, WS_HB), A->in[I_DANORM] + l * 96, WSP(float, WS_MISC + 114688)[l], 1.0f - lam_init, bh >> 2, bh & 3, qb, rep_ == 2 ? ATT_PROBE : 0); } } }
            __syncthreads(); REPBAR();
        }
        SEAM(pb + 2);
        if (IN(pb + 3)) {
            kargs_t A = kargs(); unsigned char* ws = A->ws;
            fin_phase(r0, WSP(bf16, WS_P), WSP(bf16, WS_HB), WSP(bf16, WS_RAWM), WSP(bf16, WS_RAWH), A->in[I_MLNORM] + l * 384, A->in[I_HGNORM] + l * 256, vcu, G);
        }
        SEAM(pb + 3);
        if (IN(pb + 4)) REPEAT(5) {
            kargs_t A = kargs(); unsigned char* ws = A->ws;
            pg8::Gemm g{WSP(bf16, WS_HB) + (size_t)r0 * D, WSP(bf16, WS_WOUT), Mg, D, D}; pg8::StaticOrder S; S.init(Mg, D, G, bx);
            pg8::EpiBf E{WSP(bf16, WS_P) + (size_t)r0 * D, D};
            if (!NO_GEMM && !NO_G2) pg8::gemm_phase<pg8::EpiBf, pg8::StaticOrder, true, true>(lds, g, S, E); REPBAR();
        }
        SEAM(pb + 4);
        if (IN(pb + 5)) REPEAT(6) {
            kargs_t A = kargs(); unsigned char* ws = A->ws; const float* modl = WSP(float, WS_MOD) + (size_t)l * 17 * NMOD; float* ctxx = WSP(float, WS_CTXX);
            const float* xl = (l == 0) ? A->in[I_X] : A->out; const float* xc = (l == 0) ? A->in[I_CTX] : ctxx;
            thin_phase<true, true>(r0, xl, xc, A->out, ctxx, true, WSP(bf16, WS_P), modl, 2 * D, A->in[I_GPOSTMIX] + l * D, modl, 3 * D, 4 * D, A->in[I_GPREFFN] + l * D, WSP(bf16, WS_HB), vcu, G, rep_ == 2 ? THIN_PROBE : 0); REPBAR();
        }
        SEAM(pb + 5);
        if (IN(pb + 6)) REPEAT(7) {
            kargs_t A = kargs(); unsigned char* ws = A->ws;
            pg8::Gemm g{WSP(bf16, WS_HB) + (size_t)r0 * D, WSP(bf16, WS_WGU), Mg, NGU, D}; pg8::StaticOrder S; S.init(Mg, NGU, G, bx);
            pg8::EpiSwiglu E{WSP(bf16, WS_P) + (size_t)r0 * DFF, DFF};
            if (!NO_GEMM && !NO_G3) pg8::gemm_phase<pg8::EpiSwiglu, pg8::StaticOrder, true, true>(lds, g, S, E); REPBAR();
        }
        SEAM(pb + 6);
        if (IN(pb + 7)) REPEAT(8) {
            kargs_t A = kargs(); unsigned char* ws = A->ws;
            pg8::Gemm g{WSP(bf16, WS_P) + (size_t)r0 * DFF, WSP(bf16, WS_WD), Mg, D, DFF}; pg8::StaticOrder S; S.init(Mg, D, G, bx);
            pg8::EpiBf E{WSP(bf16, WS_YD) + (size_t)r0 * D, D};
            if (!NO_GEMM && !NO_G4) pg8::gemm_phase<pg8::EpiBf, pg8::StaticOrder, true, true>(lds, g, S, E); REPBAR();
        }
        SEAM(pb + 7);
    }
    if (IN(NPHASE - 1)) {
        kargs_t A = kargs(); unsigned char* ws = A->ws; const float* modl = WSP(float, WS_MOD) + (size_t)(DEPTH - 1) * 17 * NMOD; float* ctxx = WSP(float, WS_CTXX);
        thin_phase<true, false>(MC, A->out, ctxx, A->out, ctxx, true, WSP(bf16, WS_YD), modl, 5 * D, A->in[I_GPOSTFFN] + (DEPTH - 1) * D, nullptr, 0, 0, nullptr, nullptr, vcu, G);
#if STAMP_ON
        {
            __syncthreads();
            const unsigned long long* st = (const unsigned long long*)(ws + WS_MISC + 131072);
            const float d1 = (float)(long long)(__hip_atomic_load(st + SB, RLX_AGENT) - __hip_atomic_load(st + SA, RLX_AGENT)) * 1e-5f;
            const float d2 = (float)(long long)(__hip_atomic_load(st + SD, RLX_AGENT) - __hip_atomic_load(st + SC, RLX_AGENT)) * 1e-2f;
            const int tid = tid_opaque(); const int rwg = ML / G; float* o = A->out + (size_t)vcu * rwg * D;
            for (int i = tid; i < rwg * D; i += NTHR) o[i] *= (1.0f + d1);
            __syncthreads();
            if (bx == 0 && tid == 0) A->out[(size_t)vcu * rwg * D] = d2;
        }
#endif
    }
#undef IN
#undef SEAM
}

extern "C" void kernel_launch(void* const* d_in, const int* in_sizes, int n_in, void* d_out, int out_size, void* d_ws, size_t ws_size, hipStream_t stream) {
    static int grid = 0;
    if (grid == 0) {
        if (n_in != 22 || in_sizes[0] != ML * D || out_size != ML * D || ws_size < WS_END) {
            fprintf(stderr, "kernel_launch: unexpected shapes: n_in %d in0 %d out %d ws %zu (need %zu); nothing launched\n", n_in, n_in > 0 ? in_sizes[0] : -1, out_size, ws_size, (size_t)WS_END); grid = -1; return; }
        int dev = 0, cus = 0, per_cu = 0;
        if (hipGetDevice(&dev) != hipSuccess || hipDeviceGetAttribute(&cus, hipDeviceAttributeMultiprocessorCount, dev) != hipSuccess) { fprintf(stderr, "kernel_launch: device query failed\n"); grid = -1; return; }
        if (hipFuncSetAttribute((const void*)fwd, hipFuncAttributeMaxDynamicSharedMemorySize, LDS_BYTES) != hipSuccess) { fprintf(stderr, "kernel_launch: hipFuncSetAttribute failed\n"); grid = -1; return; }
        if (hipOccupancyMaxActiveBlocksPerMultiprocessor(&per_cu, (const void*)fwd, NTHR, LDS_BYTES) != hipSuccess || per_cu < 1)
            fprintf(stderr, "kernel_launch: note: occupancy query reports %d workgroups per CU\n", per_cu);
        (void)hipGetLastError();
        grid = cus;
    }
    if (grid < 0) return;
    if (hipMemsetAsync((char*)d_ws + WS_CTL, 0, CTL_ZERO_BYTES, stream) != hipSuccess) { fprintf(stderr, "kernel_launch: memset failed\n"); return; }
    Args a{};
    for (int i = 0; i < 22; ++i) a.in[i] = (const float*)d_in[i];
    a.out = (float*)d_out; a.ws = (unsigned char*)d_ws;
#if MK_PER_PHASE
    for (int p = 0; p < NPHASE; ++p) { a.ph_lo = p; a.ph_hi = p + 1; hipLaunchKernelGGL(fwd, dim3(grid), dim3(NTHR), LDS_BYTES, stream, a); }
#else
    a.ph_lo = 0; a.ph_hi = NPHASE;
    hipLaunchKernelGGL(fwd, dim3(grid), dim3(NTHR), LDS_BYTES, stream, a);
#endif
    const hipError_t le = hipPeekAtLastError();
    if (le != hipSuccess) fprintf(stderr, "kernel_launch: launch failed: %s\n", hipGetErrorName(le));
}
```

```cpp
#include <hip/hip_runtime.h>
#include <cstdio>
#include <cstdint>
#ifndef MK_PER_PHASE
#define MK_PER_PHASE 0
#endif
namespace pg8 {
#define PG8_LAS __attribute__((address_space(3)))
typedef unsigned short bf16_t;
typedef short bf16x8 __attribute__((ext_vector_type(8)));
typedef float f32x4 __attribute__((ext_vector_type(4)));
typedef unsigned u32x4 __attribute__((ext_vector_type(4)));
constexpr int BM = 256, BK = 64, HALF = 128, HTB = HALF * BK * 2  , STAGE_BYTES = 8 * HTB, NXCD = 8, WGM = 8;

__host__ __device__ __forceinline__ int lds_byte(int r, int c) { const int st = (r >> 4) * 2 + (c >> 5), rr = r & 15, cc = c & 31, ob = rr * 64 + cc * 2; return st * 1024 + (ob ^ (((ob >> 9) & 1) << 5)); }
__host__ __device__ __forceinline__ void stage_rc(int b, int& R, int& C) { const int st = b / 1024, sb = b % 1024, swz = sb ^ (((sb >> 9) & 1) << 5); R = (st >> 1) * 16 + swz / 64; C = (st & 1) * 32 + (swz % 64) / 2; }
__host__ __device__ __forceinline__ int perm32(int rho) { const int n = rho >> 4, i = rho & 15; return 8 * (i >> 2) + 4 * n + (i & 3); }

struct Unit { int pm, pn; };
struct Gemm { const bf16_t* A; const bf16_t* Bt; int M, N, K; };

struct StaticOrder {
    int nM, nN, nwg, G, c;
    __host__ __device__ void init(int M, int N, int G_, int c_) { nM = M / BM; nN = N / BM; nwg = nM * nN; G = G_; c = c_; }
    __host__ __device__ bool next(int i, Unit& u) const {
        const long L = (long)i * G + c; if (L >= nwg) return false;
        int wgid = (int)L; { const int q = nwg / NXCD, r = nwg % NXCD, xcd = wgid % NXCD, off = wgid / NXCD; wgid = (xcd < r ? xcd * (q + 1) : r * (q + 1) + (xcd - r) * q) + off; }
        const int nig = WGM * nN, gid = wgid / nig, fm = gid * WGM, gsz = (nM - fm) < WGM ? (nM - fm) : WGM;
        u.pm = fm + ((wgid % nig) % gsz); u.pn = (wgid % nig) / gsz; return true;
    }
    __device__ __forceinline__ void a_ready(const Unit&) const {}
    __device__ __forceinline__ void done(const Unit&) const {}
};
__device__ __forceinline__ unsigned cvt_pk_bf16(float lo, float hi) { unsigned r; asm volatile("v_cvt_pk_bf16_f32 %0, %1, %2" : "=v"(r) : "v"(lo), "v"(hi)); return r; }
struct EpiF32 {
    static constexpr bool PERM = false, AFTER_DRAIN = false;
    float* C; int ldc;
    __device__ __forceinline__ void operator()(const f32x4 (&acc)[2][2][4][2], const Unit& u, int wr, int wc, int fr, int fq) const {
        const int row0 = u.pm * BM + wr * 64 + fr, col0 = u.pn * BM + wc * 32 + 4 * fq;
#pragma unroll
        for (int ai = 0; ai < 2; ++ai)
#pragma unroll
            for (int m = 0; m < 4; ++m) { float* rowp = C + (size_t)(row0 + ai * HALF + m * 16) * ldc + col0;
#pragma unroll
                for (int bj = 0; bj < 2; ++bj)
#pragma unroll
                    for (int n = 0; n < 2; ++n) *(f32x4*)(rowp + bj * HALF + n * 16) = acc[ai][bj][m][n]; }
    }
};
struct EpiBf {
    static constexpr bool PERM = true, AFTER_DRAIN = false;
    bf16_t* O; int ldc;
    __device__ __forceinline__ void operator()(const f32x4 (&acc)[2][2][4][2], const Unit& u, int wr, int wc, int fr, int fq) const {
        const int row0 = u.pm * BM + wr * 64 + fr; const int col0 = u.pn * BM + wc * 32 + 8 * fq;
#pragma unroll
        for (int ai = 0; ai < 2; ++ai)
#pragma unroll
            for (int m = 0; m < 4; ++m) { bf16_t* rowp = O + (size_t)(row0 + ai * HALF + m * 16) * ldc + col0;
#pragma unroll
                for (int bj = 0; bj < 2; ++bj) { const f32x4 v0 = acc[ai][bj][m][0], v1 = acc[ai][bj][m][1];
                    u32x4 w; w.x = cvt_pk_bf16(v0[0], v0[1]); w.y = cvt_pk_bf16(v0[2], v0[3]); w.z = cvt_pk_bf16(v1[0], v1[1]); w.w = cvt_pk_bf16(v1[2], v1[3]);
                    *(u32x4*)(rowp + bj * HALF) = w; } }
    }
};
constexpr unsigned EI_KIND = 1u << 16, EI_SKIP = 1u << 17, EI_DA = 1u << 18, EI_Q = 1u << 19, EI_HF = 1u << 20;
__host__ __device__ __forceinline__ void epi_in_entry(int g, unsigned& x, unsigned& y) {
    const int c = 8 * g; x = 0u; y = EI_SKIP;
    if (c < 1152)      { const int f = c / 384, hh = (c % 384) / 96, o = c % 96;            x = 0u         + (unsigned)hh * 2304u * 576u + (unsigned)(f * 96 + o) * 2u; y = 576u; }
    else if (c < 1536) { x = 301989888u + (unsigned)(c - 1152) * 2u; y = 768u | EI_KIND; }
    else if (c < 1552) { }
    else if (c < 2064) { const int hh = (c - 1552) / 128, o = (c - 1552) % 128;             x = 84934656u  + (unsigned)hh * 2304u * 896u + (unsigned)(256 + o) * 2u; y = 896u; }
    else if (c < 3088) { const int d = (c - 2064) / 512, hh = ((c - 2064) % 512) / 128, o = (c - 2064) % 128; x = 84934656u + (unsigned)hh * 2304u * 896u + (unsigned)(d * 128 + o) * 2u; y = 896u; }
    else if (c < 3344) { const int hh = (c - 3088) / 64, o = (c - 3088) % 64;               x = 84934656u  + (unsigned)hh * 2304u * 896u + (unsigned)(384 + o) * 2u; y = 896u; }
    else if (c < 3600) { x = 330301440u + (unsigned)(c - 3344) * 2u; y = 512u | EI_KIND; }
    else if (c < 4752) { const int f = (c - 3600) / 384, hh = ((c - 3600) % 384) / 96, o = (c - 3600) % 96; x = 217055232u + (unsigned)hh * 2304u * 576u + (unsigned)(f * 96 + o) * 2u; y = 576u;
                         if (c < 4368) { const int d48 = (c - 3600) % 48, hf = d48 >= 24 ? 1 : 0, i0 = (d48 - 24 * hf) >> 1; y |= EI_DA | (c < 3984 ? EI_Q : 0u) | (hf ? EI_HF : 0u) | ((unsigned)i0 << 24); } }
}
struct EpiIn {
    static constexpr bool PERM = true, AFTER_DRAIN = false;
    unsigned char* PX; const PG8_LAS float* bias; float* G; const PG8_LAS float* rope; const PG8_LAS unsigned* tab; int mc; float qscale;
    __device__ __forceinline__ void operator()(const f32x4 (&acc)[2][2][4][2], const Unit& u, int wr, int wc, int fr, int fq) const {
        const int trow0 = u.pm * BM;
        const int bat = trow0 < mc ? trow0 >> 8 : (trow0 - mc) >> 11; const int slot0 = trow0 < mc ? (trow0 & 255) : 256 + ((trow0 - mc) & 2047);
        const unsigned rc_blk = (unsigned)(bat * 4 * 2304 + slot0), rc_row = (unsigned)trow0;
        const int rin = wr * 64 + fr;
        const int col0 = u.pn * BM + wc * 32 + 8 * fq;
        const bool gate_lane = (u.pn == 6) && (wc == 0) && (fq < 2);
#pragma unroll
        for (int bj = 0; bj < 2; ++bj) {
            const int c = col0 + bj * HALF;
            const f32x4 b0 = *(const PG8_LAS f32x4*)(bias + c), b1 = *(const PG8_LAS f32x4*)(bias + c + 4);
            const unsigned ex = tab[2 * (c >> 3)], ey = tab[2 * (c >> 3) + 1];
            const unsigned ld = ey & 0xffffu;
            const unsigned off = ex + ((ey & EI_KIND) ? rc_row : rc_blk) * ld + (unsigned)rin * ld;
            const bool skip = (ey & EI_SKIP) != 0u, is_da = (ey & EI_DA) != 0u, is_q = (ey & EI_Q) != 0u; const int hf = (ey & EI_HF) ? 1 : 0, i0 = (int)(ey >> 24);
#pragma unroll
            for (int ai = 0; ai < 2; ++ai)
#pragma unroll
                for (int m = 0; m < 4; ++m) { const int row = trow0 + rin + ai * HALF + m * 16;
                    f32x4 v0 = acc[ai][bj][m][0] + b0, v1 = acc[ai][bj][m][1] + b1;
                    if (is_da) {
                        if (row >= mc) { const int t = (row - mc) & 2047; const int pos = hf ? (t & 63) : (t >> 6);
                            const f32x4 cs0 = *(const PG8_LAS f32x4*)(rope + pos * 24 + 2 * i0), cs1 = *(const PG8_LAS f32x4*)(rope + pos * 24 + 2 * i0 + 4);
                            const f32x4 r0 = {v0[0] * cs0[0] - v0[1] * cs0[1], v0[0] * cs0[1] + v0[1] * cs0[0], v0[2] * cs0[2] - v0[3] * cs0[3], v0[2] * cs0[3] + v0[3] * cs0[2]};
                            const f32x4 r1 = {v1[0] * cs1[0] - v1[1] * cs1[1], v1[0] * cs1[1] + v1[1] * cs1[0], v1[2] * cs1[2] - v1[3] * cs1[3], v1[2] * cs1[3] + v1[3] * cs1[2]};
                            v0 = r0; v1 = r1; }
                        if (is_q) { v0 = v0 * qscale; v1 = v1 * qscale; } }
                    if (!skip) { u32x4 w; w.x = cvt_pk_bf16(v0[0], v0[1]); w.y = cvt_pk_bf16(v0[2], v0[3]); w.z = cvt_pk_bf16(v1[0], v1[1]); w.w = cvt_pk_bf16(v1[2], v1[3]);
                        *(u32x4*)(PX + (off + (unsigned)(ai * HALF + m * 16) * ld)) = w; }
                    if (bj == 0 && gate_lane) { float* g = G + (size_t)row * 16 + 8 * fq; *(f32x4*)g = v0; *(f32x4*)(g + 4) = v1; } }
        }
    }
};
struct EpiSwiglu {
    static constexpr bool PERM = true, AFTER_DRAIN = false;
    bf16_t* O; int ldc;
    __device__ __forceinline__ void operator()(const f32x4 (&acc)[2][2][4][2], const Unit& u, int wr, int wc, int fr, int fq) const {
        const int row0 = u.pm * BM + wr * 64 + fr; const int col0 = u.pn * HALF + wc * 32 + 8 * fq;
#pragma unroll
        for (int ai = 0; ai < 2; ++ai)
#pragma unroll
            for (int m = 0; m < 4; ++m) { bf16_t* rowp = O + (size_t)(row0 + ai * HALF + m * 16) * ldc + col0;
                f32x4 r0, r1;
#pragma unroll
                for (int i = 0; i < 4; ++i) { const float g0 = acc[ai][0][m][0][i], g1 = acc[ai][0][m][1][i];
                    r0[i] = g0 * __builtin_amdgcn_rcpf(1.0f + __expf(-g0)) * acc[ai][1][m][0][i];
                    r1[i] = g1 * __builtin_amdgcn_rcpf(1.0f + __expf(-g1)) * acc[ai][1][m][1][i]; }
                u32x4 w; w.x = cvt_pk_bf16(r0[0], r0[1]); w.y = cvt_pk_bf16(r0[2], r0[3]); w.z = cvt_pk_bf16(r1[0], r1[1]); w.w = cvt_pk_bf16(r1[2], r1[3]);
                *(u32x4*)rowp = w; }
    }
};
template <class Epi, class Sched, bool ALIGN_EPI = false, bool SP2 = false>
__device__ __forceinline__ void gemm_phase(PG8_LAS unsigned char* lds, const Gemm g, const Sched& S, const Epi& E) {
    int tid_ = threadIdx.x; asm volatile("" : "+v"(tid_));
    const int tid = tid_, wid = __builtin_amdgcn_readfirstlane(tid >> 6), lane = tid & 63, wr = wid >> 2, wc = wid & 3, fr = lane & 15, fq = lane >> 4;
    const int K = g.K, nt = K / BK;
    unsigned voffA[2], voffB[2];
#pragma unroll
    for (int i = 0; i < 2; ++i) { int R, C; stage_rc(tid * 16 + i * 8192, R, C); const int Rb = Epi::PERM ? ((R & ~31) + perm32(R & 31)) : R;
        voffA[i] = (unsigned)(R * K + C) * 2u; voffB[i] = (unsigned)(Rb * K + C) * 2u; }
    const size_t kstep = (size_t)(BK * 2);
    const size_t hstep = (size_t)HALF * K * 2;
    const size_t tstep = 2 * hstep;
    const unsigned ldsw = (unsigned)wid * 1024u;
    const int aoff = lds_byte(wr * 64 + fr, fq * 8), boff = lds_byte(wc * 32 + fr, fq * 8);
#define PG8_SA(b, h) (((b) * 2 + (h)) * HTB)
#define PG8_SB(b, h) ((4 + (b) * 2 + (h)) * HTB)
#define PG8_STAGE(bufoff, gbase, voff) do { _Pragma("unroll") for (int _i = 0; _i < 2; ++_i) \
        __builtin_amdgcn_global_load_lds((const unsigned*)((const char*)(gbase) + (voff)[_i]), (PG8_LAS unsigned*)(lds + (bufoff) + ldsw + _i * 8192), 16, 0, 0); } while (0)
#define PG8_LDA(dst, b, h) do { _Pragma("unroll") for (int m = 0; m < 4; ++m) _Pragma("unroll") for (int k = 0; k < 2; ++k) dst[m][k] = *(const PG8_LAS bf16x8*)(lds + PG8_SA(b, h) + aoff + m * 2048 + k * 1024); } while (0)
#define PG8_LDB(dst, b, h) do { _Pragma("unroll") for (int n = 0; n < 2; ++n) _Pragma("unroll") for (int k = 0; k < 2; ++k) dst[n][k] = *(const PG8_LAS bf16x8*)(lds + PG8_SB(b, h) + boff + n * 2048 + k * 1024); } while (0)
#define PG8_MMA(ai, bj, At, Bt) do { __builtin_amdgcn_s_setprio(1); _Pragma("unroll") for (int m = 0; m < 4; ++m) _Pragma("unroll") for (int n = 0; n < 2; ++n) _Pragma("unroll") for (int k = 0; k < 2; ++k) \
        acc[ai][bj][m][n] = __builtin_amdgcn_mfma_f32_16x16x32_bf16(Bt[n][k], At[m][k], acc[ai][bj][m][n], 0, 0, 0); __builtin_amdgcn_s_setprio(0); } while (0)
#define PG8_WAIT_V(n) asm volatile("s_waitcnt vmcnt(" #n ")" ::: "memory")
#define PG8_WAIT_L(n) asm volatile("s_waitcnt lgkmcnt(" #n ")" ::: "memory")
#define PG8_BAR __builtin_amdgcn_s_barrier()
#define PG8_SCHED __builtin_amdgcn_sched_barrier(0)
    Unit cur, nxt; int ui = 0;
    if (!S.next(0, cur)) return;
    f32x4 acc[2][2][4][2];
#pragma unroll
    for (int a = 0; a < 2; ++a)
#pragma unroll
        for (int b = 0; b < 2; ++b)
#pragma unroll
            for (int m = 0; m < 4; ++m)
#pragma unroll
                for (int n = 0; n < 2; ++n) acc[a][b][m][n] = (f32x4){0.f, 0.f, 0.f, 0.f};
    bf16x8 At[4][2], B0[2][2], B1[2][2];
    const char* cA = (const char*)g.A + (size_t)cur.pm * tstep; const char* cB = (const char*)g.Bt + (size_t)cur.pn * tstep;
    S.a_ready(cur);
    if constexpr (SP2) {
        PG8_STAGE(PG8_SB(0, 0), cB, voffB); PG8_STAGE(PG8_SB(0, 1), cB + hstep, voffB); PG8_STAGE(PG8_SA(0, 0), cA, voffA); PG8_STAGE(PG8_SA(0, 1), cA + hstep, voffA);
        if (wr == 1) PG8_BAR;
        PG8_WAIT_V(2); PG8_BAR;
        PG8_STAGE(PG8_SB(1, 0), cB + kstep, voffB); PG8_STAGE(PG8_SA(1, 0), cA + kstep, voffA); PG8_STAGE(PG8_SB(1, 1), cB + hstep + kstep, voffB);
        PG8_WAIT_V(6); PG8_BAR;
    } else {
        PG8_STAGE(PG8_SB(0, 0), cB, voffB); PG8_STAGE(PG8_SA(0, 0), cA, voffA); PG8_STAGE(PG8_SB(0, 1), cB + hstep, voffB); PG8_STAGE(PG8_SA(0, 1), cA + hstep, voffA);
        if (wr == 1) PG8_BAR;
        PG8_WAIT_V(4); PG8_BAR;
        PG8_STAGE(PG8_SB(1, 0), cB + kstep, voffB); PG8_STAGE(PG8_SA(1, 0), cA + kstep, voffA); PG8_STAGE(PG8_SB(1, 1), cB + hstep + kstep, voffB);
        PG8_WAIT_V(6); PG8_BAR;
    }
    for (;;) {
        const bool has_next = S.next(ui + 1, nxt);
        const char* nA = has_next ? (const char*)g.A + (size_t)nxt.pm * tstep : cA; const char* nB = has_next ? (const char*)g.Bt + (size_t)nxt.pn * tstep : cB;
        for (int t = 0; t < nt; t += 2) {
            const bool last = (t == nt - 2);
            const char* a1 = cA + (size_t)(t + 1) * kstep;
            const char* a2 = last ? nA : cA + (size_t)(t + 2) * kstep; const char* b2 = last ? nB : cB + (size_t)(t + 2) * kstep;
            const char* a3 = a2 + kstep; const char* b3 = b2 + kstep;
            if (last && has_next) S.a_ready(nxt);
            if constexpr (SP2) {
            PG8_LDB(B0, 0, 0); PG8_LDB(B1, 0, 1); PG8_SCHED; PG8_LDA(At, 0, 0); PG8_STAGE(PG8_SA(1, 1), a1 + hstep, voffA);
            PG8_WAIT_V(8); PG8_WAIT_L(0); PG8_BAR; PG8_MMA(0, 0, At, B0); PG8_MMA(0, 1, At, B1); PG8_BAR; PG8_SCHED;
            PG8_LDA(At, 0, 1); PG8_STAGE(PG8_SB(0, 0), b2, voffB); PG8_STAGE(PG8_SB(0, 1), b2 + hstep, voffB); PG8_STAGE(PG8_SA(0, 0), a2, voffA);
            PG8_WAIT_V(8); PG8_WAIT_L(0); PG8_BAR; PG8_MMA(1, 0, At, B0); PG8_MMA(1, 1, At, B1); PG8_BAR; PG8_SCHED;
            PG8_LDB(B0, 1, 0); PG8_LDB(B1, 1, 1); PG8_SCHED; PG8_LDA(At, 1, 0); PG8_STAGE(PG8_SA(0, 1), a2 + hstep, voffA);
            PG8_WAIT_V(8); PG8_WAIT_L(0); PG8_BAR; PG8_MMA(0, 0, At, B0); PG8_MMA(0, 1, At, B1); PG8_BAR; PG8_SCHED;
            PG8_LDA(At, 1, 1); PG8_STAGE(PG8_SB(1, 0), b3, voffB); PG8_STAGE(PG8_SB(1, 1), b3 + hstep, voffB); PG8_STAGE(PG8_SA(1, 0), a3, voffA);
            PG8_WAIT_V(8); PG8_WAIT_L(0); PG8_BAR; PG8_MMA(1, 0, At, B0); PG8_MMA(1, 1, At, B1); PG8_BAR; PG8_SCHED;
            } else {
            PG8_LDB(B0, 0, 0); PG8_SCHED; PG8_LDA(At, 0, 0); PG8_STAGE(PG8_SA(1, 1), a1 + hstep, voffA);
            PG8_WAIT_L(8); PG8_BAR; PG8_WAIT_L(0); PG8_MMA(0, 0, At, B0); PG8_BAR; PG8_SCHED;
            PG8_LDB(B1, 0, 1); PG8_STAGE(PG8_SB(0, 0), b2, voffB);
            PG8_BAR; PG8_WAIT_L(0); PG8_MMA(0, 1, At, B1); PG8_BAR;
            PG8_LDA(At, 0, 1); PG8_STAGE(PG8_SA(0, 0), a2, voffA);
            PG8_BAR; PG8_WAIT_L(0); PG8_MMA(1, 0, At, B0); PG8_BAR; PG8_SCHED;
            PG8_STAGE(PG8_SB(0, 1), b2 + hstep, voffB);
            PG8_WAIT_V(6); PG8_BAR; PG8_MMA(1, 1, At, B1); PG8_BAR;
            PG8_LDB(B0, 1, 0); PG8_SCHED; PG8_LDA(At, 1, 0); PG8_STAGE(PG8_SA(0, 1), a2 + hstep, voffA);
            PG8_WAIT_L(8); PG8_BAR; PG8_WAIT_L(0); PG8_MMA(0, 0, At, B0); PG8_BAR; PG8_SCHED;
            PG8_LDB(B1, 1, 1); PG8_STAGE(PG8_SB(1, 0), b3, voffB);
            PG8_BAR; PG8_WAIT_L(0); PG8_MMA(0, 1, At, B1); PG8_BAR;
            PG8_LDA(At, 1, 1); PG8_STAGE(PG8_SA(1, 0), a3, voffA);
            PG8_BAR; PG8_WAIT_L(0); PG8_MMA(1, 0, At, B0); PG8_BAR; PG8_SCHED;
            PG8_STAGE(PG8_SB(1, 1), b3 + hstep, voffB);
            PG8_WAIT_V(6); PG8_BAR; PG8_MMA(1, 1, At, B1); PG8_BAR;
            }
        }
        if constexpr (ALIGN_EPI) { if (wr == 0) PG8_BAR; }
        if constexpr (!Epi::AFTER_DRAIN) { E(acc, cur, wr, wc, fr, fq); S.done(cur); }
        if (!has_next) break;
#pragma unroll
        for (int a = 0; a < 2; ++a)
#pragma unroll
            for (int b = 0; b < 2; ++b)
#pragma unroll
                for (int m = 0; m < 4; ++m)
#pragma unroll
                    for (int n = 0; n < 2; ++n) acc[a][b][m][n] = (f32x4){0.f, 0.f, 0.f, 0.f};
        cur = nxt; cA = nA; cB = nB; ++ui;
        if constexpr (ALIGN_EPI) { if (wr == 1) PG8_BAR; }
    }
    PG8_WAIT_V(0);
    if constexpr (!ALIGN_EPI) { if (wr == 0) PG8_BAR; }
    PG8_BAR;
    if constexpr (Epi::AFTER_DRAIN) { E.fused(acc, cur, wr, wc, fr, fq, lds, wid, lane); S.done(cur); }
#undef PG8_SA
#undef PG8_SB
#undef PG8_STAGE
#undef PG8_LDA
#undef PG8_LDB
#undef PG8_MMA
#undef PG8_WAIT_V
#undef PG8_WAIT_L
#undef PG8_BAR
#undef PG8_SCHED
}
}
constexpr int D = 1024, NB = 16, SEQ = 2048, CTXL = 256, DEPTH = 4;
constexpr int MC = NB * CTXL, ML = NB * SEQ, MT = MC + ML;
constexpr int DIN = 4752, DINP = 4864, DFF = 2816, NGU = 2 * DFF, NMOD = 6 * D;
constexpr int C_MLQ = 0, C_MLK = 384, C_MLV = 768, C_MLO = 1152, C_MLI = 1536, C_MLF = 1544, C_HGQ = 1552, C_HGF = 2064, C_HGI = 3088, C_HGG = 3344, C_DAQ = 3600, C_DAK = 3984, C_DAV = 4368;
constexpr int Y_ML = 0, Y_HG = 384, Y_DA = 640;
constexpr float EPS = 1e-6f;
constexpr int NTOK = CTXL + SEQ;
static_assert(C_MLI == 6 * 256, "gate columns must open GEMM tile 6");
constexpr int NSLOT = CTXL + SEQ;
constexpr unsigned MLX_LD = 576, HGX_LD = 896, DAX_LD = 576, MLO_LD = 768, HGG_LD = 512;
constexpr size_t MLX_OFF = 0, HGX_OFF = MLX_OFF + (size_t)64 * NSLOT * MLX_LD, DAX_OFF = HGX_OFF + (size_t)64 * NSLOT * HGX_LD, MLO_OFF = DAX_OFF + (size_t)64 * NSLOT * DAX_LD, HGG_OFF = MLO_OFF + (size_t)MT * MLO_LD, PX_END = HGG_OFF + (size_t)MT * HGG_LD;
static_assert(HGX_OFF == 84934656ull && DAX_OFF == 217055232ull && MLO_OFF == 301989888ull && HGG_OFF == 330301440ull, "EpiIn hard-codes these offsets");

constexpr size_t MiB = 1u << 20;
constexpr size_t KiB = 1u << 10;
constexpr size_t WS_CTL = 0, CTL_ZERO_BYTES = 256 * KiB;
constexpr size_t WS_MOD = 256 * KiB;
constexpr size_t WS_MISC = 2 * MiB;
constexpr size_t WS_GATE = 2 * MiB + 256 * KiB;
constexpr size_t WS_WIN = 4 * MiB + 512 * KiB, WS_WOUT = WS_WIN + (size_t)DINP * D * 2, WS_WGU = WS_WOUT + (size_t)D * D * 2, WS_WD = WS_WGU + (size_t)NGU * D * 2;
constexpr size_t WS_XB = 32 * MiB + 512 * KiB;
constexpr size_t WS_HB = WS_XB + (size_t)MT * D * 2;
constexpr size_t WS_P = WS_HB + (size_t)MT * D * 2;
constexpr size_t WS_YD = WS_P + 198 * MiB, WS_END = WS_P + 333 * MiB + 64 * KiB;
constexpr size_t OUT_RAWM = 0, OUT_RAWH = 27 * MiB;
static_assert(WS_MOD + (size_t)DEPTH * 17 * NMOD * 4 <= WS_MISC && WS_GATE + (size_t)MT * 16 * 4 <= WS_WIN, "small buffers");
static_assert(WS_WD + (size_t)D * DFF * 2 <= WS_XB, "weights fit");
static_assert(OUT_RAWM + (size_t)MT * 384 * 2 <= OUT_RAWH && OUT_RAWH + (size_t)MT * 256 * 2 <= (size_t)ML * D * 4, "raw buffers fit d_out");
static_assert(WS_P + PX_END <= WS_END, "mixer operand blocks fit the P region");
static_assert(WS_YD + (size_t)MT * D * 2 <= WS_END && (size_t)MT * DFF * 2 <= 198 * MiB && WS_END <= 512 * MiB, "P region");
constexpr int CW_BAR = 4096;
constexpr int CW_Q = 16384;

constexpr int RING_BYTES = 131072, LDSCTL_OFF = RING_BYTES, LDS_BYTES = 163840;
constexpr int LDS_BIAS = LDSCTL_OFF + 1024, LDS_ROPE = LDS_BIAS + DINP * 4, LDS_ETAB = LDS_ROPE + 64 * 24 * 4;
static_assert(LDS_ETAB + (DINP / 8) * 8 <= LDS_BYTES, "LDS map");
constexpr int NWAVES = 8, NTHR = 512;

#define GAS __attribute__((address_space(1)))
#define LAS __attribute__((address_space(3)))
typedef unsigned short bf16;
typedef unsigned v4u __attribute__((ext_vector_type(4)));
typedef unsigned v2u __attribute__((ext_vector_type(2)));
typedef float f32x4 __attribute__((ext_vector_type(4)));
typedef float f32x16 __attribute__((ext_vector_type(16)));
typedef short bf16x8 __attribute__((ext_vector_type(8)));
typedef GAS unsigned gu32;
typedef LAS unsigned char* lptr;
#define RLX_AGENT __ATOMIC_RELAXED, __HIP_MEMORY_SCOPE_AGENT
#define LDS_WAIT() asm volatile("s_waitcnt lgkmcnt(0)" ::: "memory")
#define VM_WAIT() asm volatile("s_waitcnt vmcnt(0)" ::: "memory")
__device__ __forceinline__ unsigned f2bf(float f) { unsigned u = __builtin_bit_cast(unsigned, f); return (u + 0x7fffu + ((u >> 16) & 1u)) >> 16; }
typedef float f32x2_t __attribute__((ext_vector_type(2))); typedef __bf16 bf16x2_t __attribute__((ext_vector_type(2)));
__device__ __forceinline__ unsigned pk2(float lo, float hi) { f32x2_t v = {lo, hi}; bf16x2_t b = __builtin_convertvector(v, bf16x2_t); return __builtin_bit_cast(unsigned, b); }
__device__ __forceinline__ float bflo(unsigned w) { return __builtin_bit_cast(float, w << 16); }
__device__ __forceinline__ float bfhi(unsigned w) { return __builtin_bit_cast(float, w & 0xffff0000u); }
__device__ __forceinline__ float bf2f(bf16 v) { return __builtin_bit_cast(float, (unsigned)v << 16); }
__device__ __forceinline__ float lx_idx(float v, int src) { return __builtin_bit_cast(float, __builtin_amdgcn_ds_bpermute(src << 2, __builtin_bit_cast(int, v))); }
__device__ __forceinline__ float lx_xor(float v, int mask, int lane) { return lx_idx(v, lane ^ mask); }
__device__ __forceinline__ float lx_up(float v, int d, int lane) { return lx_idx(v, lane >= d ? lane - d : lane); }
template <int CTRL, int RMASK> __device__ __forceinline__ float dpp_f(float oldv, float v) { return __builtin_bit_cast(float, __builtin_amdgcn_update_dpp(__builtin_bit_cast(int, oldv), __builtin_bit_cast(int, v), CTRL, RMASK, 0xf, false)); }
__device__ __forceinline__ float scan_sum64(float v) {
    v += dpp_f<0x111, 0xf>(0.f, v); v += dpp_f<0x112, 0xf>(0.f, v); v += dpp_f<0x114, 0xf>(0.f, v); v += dpp_f<0x118, 0xf>(0.f, v);
    v += dpp_f<0x142, 0xa>(0.f, v); v += dpp_f<0x143, 0xc>(0.f, v); return v; }
__device__ __forceinline__ float scan_max64(float v) { const float ninf = -3.0e38f;
    v = fmaxf(v, dpp_f<0x111, 0xf>(ninf, v)); v = fmaxf(v, dpp_f<0x112, 0xf>(ninf, v)); v = fmaxf(v, dpp_f<0x114, 0xf>(ninf, v)); v = fmaxf(v, dpp_f<0x118, 0xf>(ninf, v));
    v = fmaxf(v, dpp_f<0x142, 0xa>(ninf, v)); v = fmaxf(v, dpp_f<0x143, 0xc>(ninf, v)); return v; }
__device__ __forceinline__ float wave_sum(float v, int lane) {
#pragma unroll
    for (int o = 1; o < 64; o <<= 1) v += lx_xor(v, o, lane);
    return v;
}
#define MFMA32(a, b, c) __builtin_amdgcn_mfma_f32_32x32x16_bf16((a), (b), (c), 0, 0, 0)
#define MFMA16(a, b, c) __builtin_amdgcn_mfma_f32_16x16x32_bf16((a), (b), (c), 0, 0, 0)
__device__ __forceinline__ int tid_opaque() { int t = threadIdx.x; asm volatile("" : "+v"(t)); return t; }
__device__ __forceinline__ bf16x8 lds8(lptr p) { return *(const LAS bf16x8*)p; }
__device__ __forceinline__ v4u gld16(const void* base, unsigned off) { return *(const v4u*)((const char*)base + off); }
__device__ __forceinline__ void gst8(void* base, unsigned off, v2u v) { *(v2u*)((char*)base + off) = v; }
typedef short v4i16 __attribute__((ext_vector_type(4)));
__device__ __forceinline__ bf16x8 opr(lptr img, int ldb, int r0, int k0, int c16, int rg) { return lds8(img + (r0 + c16) * ldb + (k0 + 8 * rg) * 2); }
__device__ __forceinline__ bf16x8 opt(lptr img, int ldb, int r0, int k0, int lane) {
    const int g = lane >> 4, q = (lane & 15) >> 2, p = lane & 3;
    lptr a = img + (k0 + 8 * g + q) * ldb + (r0 + 4 * p) * 2;
    const v4i16 lo = __builtin_amdgcn_ds_read_tr16_b64_v4i16((LAS v4i16*)a);
    const v4i16 hi = __builtin_amdgcn_ds_read_tr16_b64_v4i16((LAS v4i16*)(a + 4 * ldb));
    return __builtin_shufflevector(lo, hi, 0, 1, 2, 3, 4, 5, 6, 7);
}

#define XB_TMO      128
#define XB_XCNT(j)  (256  + 64 * (j))
#define XB_XSUB(j)  (1280 + 64 * (j))
#define XB_XGEN(j)  (2304 + 64 * (j))
#define XB_TOP      3328
#define XB_TOPGEN   3392
#define XCD_BAR_WORDS 3456
#define XB_SPIN_CAP (1u << 18)

__device__ __forceinline__ unsigned xb_ld(unsigned* p)              { return __hip_atomic_load(p, __ATOMIC_RELAXED, __HIP_MEMORY_SCOPE_AGENT); }
__device__ __forceinline__ unsigned xb_add(unsigned* p, unsigned v) { return __hip_atomic_fetch_add(p, v, __ATOMIC_RELAXED, __HIP_MEMORY_SCOPE_AGENT); }
__device__ __forceinline__ unsigned xb_xcc_id() { return (unsigned)__builtin_amdgcn_s_getreg((3 << 11) | 20) & 0xFu; }
#define XB_SPIN(cond, bar) do { unsigned _sp = 0; while (cond) { __builtin_amdgcn_s_sleep(1); \
    if ((++_sp & 255u) == 0u) { if (xb_ld(&(bar)[XB_TMO])) break; if (_sp > XB_SPIN_CAP) { atomicAdd(&(bar)[XB_TMO], 1u); break; } } } } while (0)

struct XcdBarrier {
    unsigned* bar; unsigned x;
    volatile LAS unsigned* st;
};

__device__ __forceinline__ XcdBarrier xcd_barrier_post(unsigned* bar, volatile LAS unsigned* st) {
    XcdBarrier b; b.bar = bar; b.x = xb_xcc_id(); b.st = st;
    if (threadIdx.x == 0) (void)xb_add(&bar[XB_XCNT(b.x)], 1u);
    return b;
}
__device__ __forceinline__ void xcd_barrier_complete(unsigned* bar, unsigned x, unsigned& nloc, unsigned& nx) {
    const unsigned G = gridDim.x * gridDim.y * gridDim.z;
    unsigned sum, cnt, mine, sp = 0u;
    for (;;) {
        sum = 0u; cnt = 0u; mine = 0u;
#pragma unroll
        for (unsigned j = 0; j < 16; ++j) { const unsigned c = xb_ld(&bar[XB_XCNT(j)]); sum += c; cnt += (c > 0u) ? 1u : 0u; mine = (j == x) ? c : mine; }
        if (sum == G) break;
        __builtin_amdgcn_s_sleep(1);
        if ((++sp & 255u) == 0u) { if (xb_ld(&bar[XB_TMO])) break; if (sp > XB_SPIN_CAP) { atomicAdd(&bar[XB_TMO], 1u); break; } }
    }
    nloc = mine > 0u ? mine : 1u; nx = cnt > 0u ? cnt : 1u;
}

__device__ __forceinline__ void xcd_barrier(const XcdBarrier& b) {
    asm volatile("s_waitcnt vmcnt(0)" ::: "memory");
    __syncthreads();
    if (threadIdx.x == 0) {
        unsigned* bar = b.bar;
        __builtin_amdgcn_s_waitcnt(0);
        unsigned nloc = b.st[0], nx = b.st[1];
        if (nloc == 0u) { xcd_barrier_complete(bar, b.x, nloc, nx); b.st[0] = nloc; b.st[1] = nx; }
        const unsigned old = xb_add(&bar[XB_XSUB(b.x)], 1u);
        const unsigned gen = old / nloc;
        if (old + 1u == (gen + 1u) * nloc) {
            __builtin_amdgcn_fence(__ATOMIC_RELEASE, "agent");
            asm volatile("s_waitcnt vmcnt(0)" ::: "memory");
            const unsigned og = xb_add(&bar[XB_TOP], 1u);
            const unsigned tg = og / nx;
            if (og + 1u == (tg + 1u) * nx) xb_add(&bar[XB_TOPGEN], 1u);
            else XB_SPIN(xb_ld(&bar[XB_TOPGEN]) == tg, bar);
            __builtin_amdgcn_fence(__ATOMIC_ACQUIRE, "agent");
            xb_add(&bar[XB_XGEN(b.x)], 1u);
            asm volatile("s_waitcnt vmcnt(0)" ::: "memory");
        } else {
            XB_SPIN(xb_ld(&bar[XB_XGEN(b.x)]) == gen, bar);
            __builtin_amdgcn_fence(__ATOMIC_ACQUIRE, "agent");
            asm volatile("s_waitcnt vmcnt(0)" ::: "memory");
        }
    }
    __syncthreads();
}


struct Args { const float* in[22]; float* out; unsigned char* ws; int ph_lo, ph_hi; };
enum { I_X = 0, I_C, I_CTX, I_CCTX, I_WADA, I_BADA, I_GPREMIX, I_GPOSTMIX, I_GPREFFN, I_GPOSTFFN, I_WIN, I_BIN, I_WOUT, I_MLFB, I_MLNORM, I_HGLB, I_HGNORM, I_DALAM, I_DANORM, I_WG, I_WU, I_WD };

__host__ __device__ __forceinline__ int perm_in_col(int n) { if (n < C_DAQ || n >= C_DAV) return n; const int d = (n - C_DAQ) % 48, base = n - d, half = d / 24, e = d % 24; return base + 24 * half + 2 * (e % 12) + (e >= 12 ? 1 : 0); }
__device__ __forceinline__ int wg_pull(unsigned* ctr, volatile LAS int* slot) {
    __syncthreads();
    if (threadIdx.x == 0) *slot = (int)__hip_atomic_fetch_add(ctr, 1u, RLX_AGENT);
    __syncthreads();
    return __builtin_amdgcn_readfirstlane(*slot);
}

typedef __attribute__((address_space(4))) const Args* kargs_p;
__device__ __forceinline__ void p0_phase(lptr lds, kargs_p ap) {
    struct { const float* in[22]; unsigned char* ws; } a; a.in[I_C] = ap->in[I_C]; a.in[I_CCTX] = ap->in[I_CCTX]; a.in[I_WADA] = ap->in[I_WADA]; a.in[I_BADA] = ap->in[I_BADA]; a.in[I_HGLB] = ap->in[I_HGLB]; a.in[I_BIN] = ap->in[I_BIN]; a.in[I_DALAM] = ap->in[I_DALAM]; a.ws = ap->ws;
    const int tid = tid_opaque();
    unsigned char* ws = a.ws;
    LAS float* sil = (LAS float*)lds;
    LAS float* part = (LAS float*)(lds + 69632);
    for (int i = tid; i < 17 * D; i += NTHR) { const int bb = i >> 10, k = i & 1023; const float v = bb < 16 ? a.in[I_C][bb * D + k] : a.in[I_CCTX][k]; sil[i] = v / (1.0f + __expf(-v)); }
    __syncthreads();
    float* mod = (float*)(ws + WS_MOD);
    for (int u = blockIdx.x; u < DEPTH * (NMOD / 32); u += gridDim.x) {
        const int l = u / (NMOD / 32), n0 = (u % (NMOD / 32)) * 32, col = tid & 31, ks = tid >> 5;
        const float* w = a.in[I_WADA] + (size_t)l * D * NMOD + (size_t)(ks * 64) * NMOD + n0 + col;
        float acc[17];
#pragma unroll
        for (int bb = 0; bb < 17; ++bb) acc[bb] = 0.f;
        float wr[64];
#pragma unroll
        for (int k = 0; k < 64; ++k) wr[k] = w[(size_t)k * NMOD];
#pragma unroll
        for (int k = 0; k < 64; k += 4) {
#pragma unroll
            for (int bb = 0; bb < 17; ++bb) { const f32x4 s = *(const LAS f32x4*)(sil + bb * D + ks * 64 + k); acc[bb] += s[0] * wr[k] + s[1] * wr[k + 1] + s[2] * wr[k + 2] + s[3] * wr[k + 3]; }
        }
#pragma unroll
        for (int bb = 0; bb < 17; ++bb) part[(ks * 17 + bb) * 32 + col] = acc[bb];
        __syncthreads();
        for (int i = tid; i < 17 * 32; i += NTHR) { const int bb = i >> 5, cc = i & 31; float s = 0.f;
#pragma unroll
            for (int k2 = 0; k2 < 16; ++k2) s += part[(k2 * 17 + bb) * 32 + cc];
            mod[((size_t)l * 17 + bb) * NMOD + n0 + cc] = s + a.in[I_BADA][l * NMOD + n0 + cc]; }
        __syncthreads();
    }
    const int gt = blockIdx.x * NTHR + tid, GT = gridDim.x * NTHR;
    float* lbs = (float*)(ws + WS_MISC); float* rope = (float*)(ws + WS_MISC + 16384); float* biasp = (float*)(ws + WS_MISC + 32768); float* lamv = (float*)(ws + WS_MISC + 114688);
    for (int j = gt; j < 1024; j += GT) { const float* hl = a.in[I_HGLB];
        const float v0 = hl[j], v1 = hl[1024 + j], v2 = hl[2048 + j], v3 = hl[3072 + j]; const float mx = fmaxf(fmaxf(v0, v1), fmaxf(v2, v3));
        const float e0 = expf(v0 - mx), e1 = expf(v1 - mx), e2 = expf(v2 - mx), e3 = expf(v3 - mx), inv = 1.0f / (e0 + e1 + e2 + e3);
        lbs[j] = 0.f; lbs[1024 + j] = e1 * inv; lbs[2048 + j] = (e1 + e2) * inv; lbs[3072 + j] = (e1 + e2 + e3) * inv; }
    for (int j = gt; j < 64 * 12; j += GT) { const int pos = j / 12, i = j % 12; const float inv = powf(10000.0f, -(float)(2 * i) / 24.0f); const float ang = (float)pos * inv; rope[2 * j] = cosf(ang); rope[2 * j + 1] = sinf(ang); }
    for (int j = gt; j < DEPTH * DINP; j += GT) { const int l = j / DINP, n = j % DINP; biasp[l * DINP + perm_in_col(n)] = n < DIN ? a.in[I_BIN][l * DIN + n] : 0.f; }
    if (gt < DEPTH) { const float* lv = a.in[I_DALAM] + gt * 4 * 48; float s01 = 0.f, s23 = 0.f;
        for (int d = 0; d < 48; ++d) { s01 += lv[d] * lv[48 + d]; s23 += lv[96 + d] * lv[144 + d]; }
        const float lam_init = 0.8f - 0.6f * expf(-0.3f * (float)gt);
        lamv[gt] = expf(s01) - expf(s23) + lam_init; }
}

template <bool RES, bool NORM, bool XSF, bool XDF>
__device__ __forceinline__ void thin_phase(int row_lo, const float* xs_lat, const float* xs_ctx, float* xd_lat, bf16* xbuf, bool write_x,
                                           const bf16* y, const float* mod_r, int goff, const float* gpost,
                                           const float* mod_n, int soff, int aoff, const float* gpre, bf16* hout, int vcu, int G, int probe = 0) {
    const int tid = tid_opaque(); const int lane = tid & 63, wave = __builtin_amdgcn_readfirstlane(tid >> 6);
    const int nrows = MT - row_lo; int rwg = (nrows + G - 1) / G; rwg += rwg & 1;
    const int wbeg = row_lo + vcu * rwg, rend = (wbeg + rwg < MT) ? wbeg + rwg : MT;
    const int rbeg = wbeg + 2 * wave;
    constexpr int RSTEP = 2 * NWAVES;
    int cur_bb = -1;
    f32x4 gp[4], ga[4], sh[4];
#pragma unroll
    for (int j = 0; j < 4; ++j) { gp[j] = (f32x4){0.f, 0.f, 0.f, 0.f}; ga[j] = gp[j]; sh[j] = gp[j]; }
    f32x4 xa[2][4], ya[2][4];
#define TH_LOAD(X, Y, r_) do { _Pragma("unroll") for (int q_ = 0; q_ < 2; ++q_) { const int rr_ = (r_) + q_; const bool ic_ = rr_ < MC; \
        const float* xs_ = ic_ ? xs_ctx + (size_t)rr_ * D : xs_lat + (size_t)(rr_ - MC) * D; \
        _Pragma("unroll") for (int j_ = 0; j_ < 4; ++j_) { if (XSF) X[q_][j_] = *(const f32x4*)(xs_ + 4 * lane + 256 * j_); \
            else { const v2u xw_ = *(const v2u*)(xbuf + (size_t)rr_ * D + 4 * lane + 256 * j_); X[q_][j_] = (f32x4){bflo(xw_.x), bfhi(xw_.x), bflo(xw_.y), bfhi(xw_.y)}; } \
            if (RES) { const v2u yw_ = *(const v2u*)(y + (size_t)rr_ * D + 4 * lane + 256 * j_); Y[q_][j_] = (f32x4){bflo(yw_.x), bfhi(yw_.x), bflo(yw_.y), bfhi(yw_.y)}; } } } } while (0)
    if (rbeg < rend) TH_LOAD(xa, ya, rbeg);
    for (int r = rbeg; r < rend; r += RSTEP) {
        f32x4 xb[2][4], yb[2][4];
        if (r + RSTEP < rend) TH_LOAD(xb, yb, r + RSTEP);
        const bool isctx = r < MC; const int bb = isctx ? 16 : (r - MC) / SEQ;
        if (bb != cur_bb) { cur_bb = bb;
#pragma unroll
            for (int j = 0; j < 4; ++j) { const int e = 4 * lane + 256 * j;
                if (RES) gp[j] = *(const f32x4*)(mod_r + (size_t)bb * NMOD + goff + e) * *(const f32x4*)(gpost + e);
                if (NORM) { ga[j] = *(const f32x4*)(gpre + e) * (*(const f32x4*)(mod_n + (size_t)bb * NMOD + aoff + e) + 1.0f); sh[j] = *(const f32x4*)(mod_n + (size_t)bb * NMOD + soff + e); } } }
        if (RES) { float s0 = 0.f, s1 = 0.f;
#pragma unroll
            for (int j = 0; j < 4; ++j) { s0 += (ya[0][j][0] * ya[0][j][0] + ya[0][j][1] * ya[0][j][1]) + (ya[0][j][2] * ya[0][j][2] + ya[0][j][3] * ya[0][j][3]);
                                          s1 += (ya[1][j][0] * ya[1][j][0] + ya[1][j][1] * ya[1][j][1]) + (ya[1][j][2] * ya[1][j][2] + ya[1][j][3] * ya[1][j][3]); }
#pragma unroll
            for (int o = 1; o < 64; o <<= 1) { s0 += lx_xor(s0, o, lane); s1 += lx_xor(s1, o, lane); }
            const float r0s = 1.0f / sqrtf(s0 * (1.0f / D) + EPS), r1s = 1.0f / sqrtf(s1 * (1.0f / D) + EPS);
#pragma unroll
            for (int j = 0; j < 4; ++j) { xa[0][j] += gp[j] * ya[0][j] * r0s; xa[1][j] += gp[j] * ya[1][j] * r1s; } }
        if (write_x && !(probe & 1)) {
            if (XDF) { float* xd0 = xd_lat + (size_t)(r - MC) * D;
#pragma unroll
                for (int j = 0; j < 4; ++j) { *(f32x4*)(xd0 + 4 * lane + 256 * j) = xa[0][j]; *(f32x4*)(xd0 + D + 4 * lane + 256 * j) = xa[1][j]; } }
            else {
#pragma unroll
                for (int j = 0; j < 4; ++j) { v2u w0, w1; w0.x = pk2(xa[0][j][0], xa[0][j][1]); w0.y = pk2(xa[0][j][2], xa[0][j][3]); w1.x = pk2(xa[1][j][0], xa[1][j][1]); w1.y = pk2(xa[1][j][2], xa[1][j][3]);
                    *(v2u*)(xbuf + (size_t)r * D + 4 * lane + 256 * j) = w0; *(v2u*)(xbuf + (size_t)(r + 1) * D + 4 * lane + 256 * j) = w1;
                    if (NORM) { xa[0][j] = (f32x4){bflo(w0.x), bfhi(w0.x), bflo(w0.y), bfhi(w0.y)}; xa[1][j] = (f32x4){bflo(w1.x), bfhi(w1.x), bflo(w1.y), bfhi(w1.y)}; } } } }
        if (NORM) { float s0 = 0.f, s1 = 0.f;
#pragma unroll
            for (int j = 0; j < 4; ++j) { s0 += (xa[0][j][0] * xa[0][j][0] + xa[0][j][1] * xa[0][j][1]) + (xa[0][j][2] * xa[0][j][2] + xa[0][j][3] * xa[0][j][3]);
                                          s1 += (xa[1][j][0] * xa[1][j][0] + xa[1][j][1] * xa[1][j][1]) + (xa[1][j][2] * xa[1][j][2] + xa[1][j][3] * xa[1][j][3]); }
#pragma unroll
            for (int o = 1; o < 64; o <<= 1) { s0 += lx_xor(s0, o, lane); s1 += lx_xor(s1, o, lane); }
            const float r0s = 1.0f / sqrtf(s0 * (1.0f / D) + EPS), r1s = 1.0f / sqrtf(s1 * (1.0f / D) + EPS);
#pragma unroll
            for (int j = 0; j < 4; ++j) { const f32x4 h0 = xa[0][j] * r0s * ga[j] + sh[j], h1 = xa[1][j] * r1s * ga[j] + sh[j];
                v2u w0, w1; w0.x = pk2(h0[0], h0[1]); w0.y = pk2(h0[2], h0[3]); w1.x = pk2(h1[0], h1[1]); w1.y = pk2(h1[2], h1[3]);
                if (!(probe & 2)) { *(v2u*)(hout + (size_t)r * D + 4 * lane + 256 * j) = w0; *(v2u*)(hout + (size_t)(r + 1) * D + 4 * lane + 256 * j) = w1; } } }
#pragma unroll
        for (int q = 0; q < 2; ++q)
#pragma unroll
            for (int j = 0; j < 4; ++j) { xa[q][j] = xb[q][j]; if (RES) ya[q][j] = yb[q][j]; }
    }
#undef TH_LOAD
}

template <int MODE>
__device__ __forceinline__ void tr_item(const float* W, int K, int N, int nblk, bf16* WT, LAS float* scr, int item, int lane) {
    const int kb = item / nblk, nb = item % nblk, k0 = 64 * kb, n0 = 32 * nb;
    const int nn = n0 + (lane & 31); const bool ok = nn < N;
#pragma unroll 8
    for (int i = 0; i < 32; ++i) { const int kk = 2 * i + (lane >> 5); scr[kk * 33 + (lane & 31)] = ok ? W[(size_t)(k0 + kk) * N + nn] : 0.f; }
    LDS_WAIT(); asm volatile("" ::: "memory");
    const int c = lane & 7;
#pragma unroll
    for (int j = 0; j < 4; ++j) { const int n = (lane >> 3) + 8 * j; const LAS float* s = scr + (8 * c) * 33 + n;
        v4u o; o.x = pk2(s[0 * 33], s[1 * 33]); o.y = pk2(s[2 * 33], s[3 * 33]); o.z = pk2(s[4 * 33], s[5 * 33]); o.w = pk2(s[6 * 33], s[7 * 33]);
        const int ng = n0 + n; const int drow = MODE == 0 ? ng : MODE == 3 ? perm_in_col(ng) : ((ng >> 7) * 256 + (ng & 127) + (MODE == 2 ? 128 : 0));
        *(v4u*)(WT + (size_t)drow * K + k0 + 8 * c) = o; }
    LDS_WAIT(); asm volatile("" ::: "memory");
}
__device__ __forceinline__ void convert_weights(lptr lds, kargs_p ap, int l, int vcu, int G) {
    const unsigned char* const wsb = ap->ws; const float* const p_win = ap->in[I_WIN]; const float* const p_wout = ap->in[I_WOUT]; const float* const p_wg = ap->in[I_WG]; const float* const p_wu = ap->in[I_WU]; const float* const p_wd = ap->in[I_WD];
    const int tid = tid_opaque(); const int lane = tid & 63, wave = __builtin_amdgcn_readfirstlane(tid >> 6);
    LAS float* scr = (LAS float*)(lds + wave * 8448);
    const int gw = vcu * NWAVES + wave, NGW = G * NWAVES;
    unsigned char* ws = (unsigned char*)wsb;
    constexpr int I_IN = 16 * (DINP / 32), I_OUT = 16 * 32, I_GU = 16 * (DFF / 32), I_DN = (DFF / 64) * 32;
    constexpr int NITEMS = I_IN + I_OUT + 2 * I_GU + I_DN;
    for (int it = gw; it < NITEMS; it += NGW) {
        int r = it;
        if (r < I_IN) { tr_item<3>(p_win + (size_t)l * D * DIN, D, DIN, DINP / 32, (bf16*)(ws + WS_WIN), scr, r, lane); continue; } r -= I_IN;
        if (r < I_OUT) { tr_item<0>(p_wout + (size_t)l * D * D, D, D, 32, (bf16*)(ws + WS_WOUT), scr, r, lane); continue; } r -= I_OUT;
        if (r < I_GU) { tr_item<1>(p_wg + (size_t)l * D * DFF, D, DFF, DFF / 32, (bf16*)(ws + WS_WGU), scr, r, lane); continue; } r -= I_GU;
        if (r < I_GU) { tr_item<2>(p_wu + (size_t)l * D * DFF, D, DFF, DFF / 32, (bf16*)(ws + WS_WGU), scr, r, lane); continue; } r -= I_GU;
        tr_item<0>(p_wd + (size_t)l * DFF * D, DFF, D, 32, (bf16*)(ws + WS_WD), scr, r, lane);
    }
}
constexpr int AT_BUF = 25600, AT_KOFF = 0, AT_VOFF = 13312, AT_QF = 76800;
constexpr float AT_THR = 8.0f;
constexpr float QSCALE = 0.14433756729740643f * 1.4426950408889634f;

__device__ __forceinline__ f32x16 zero16() { f32x16 z; _Pragma("unroll") for (int r = 0; r < 16; ++r) z[r] = 0.f; return z; }
__device__ __forceinline__ float sm_max(const f32x16& S, int lane) {
    float mx = S[0];
#pragma unroll
    for (int r = 1; r < 16; ++r) mx = fmaxf(mx, S[r]);
    return fmaxf(mx, lx_xor(mx, 32, lane));
}
__device__ __forceinline__ void sm_exp(const f32x16& S, float m, float& l, bf16x8& p0, bf16x8& p1) {
    float p[16]; float ps = 0.f;
#pragma unroll
    for (int r = 0; r < 16; ++r) { p[r] = __builtin_amdgcn_exp2f(S[r] - m); ps += p[r]; }
    l += ps;
    v4u a, b;
    a.x = pk2(p[0], p[1]); a.y = pk2(p[2], p[3]); a.z = pk2(p[4], p[5]); a.w = pk2(p[6], p[7]);
    b.x = pk2(p[8], p[9]); b.y = pk2(p[10], p[11]); b.z = pk2(p[12], p[13]); b.w = pk2(p[14], p[15]);
    p0 = __builtin_bit_cast(bf16x8, a); p1 = __builtin_bit_cast(bf16x8, b);
}
__device__ __forceinline__ bf16x8 vt_frag(lptr vt, int ct, int sub, int sp, int lane) {
    const int h = lane >> 5, blk = (lane >> 4) & 1, q = (lane & 15) >> 2, p = lane & 3;
    lptr a = vt + (32 * sub + 16 * sp + 4 * h + q) * 192 + (32 * ct + 16 * blk + 4 * p) * 2;
    const v4i16 lo = __builtin_amdgcn_ds_read_tr16_b64_v4i16((LAS v4i16*)a);
    const v4i16 hi = __builtin_amdgcn_ds_read_tr16_b64_v4i16((LAS v4i16*)(a + 8 * 192));
    return __builtin_shufflevector(lo, hi, 0, 1, 2, 3, 4, 5, 6, 7);
}

__device__ __forceinline__ void attn_item(lptr lds, const bf16* P, bf16* YM, const float* danorm, float lam, float out_scale, int b, int h, int qb, int probe) {
    const int tid = tid_opaque(), lane = tid & 63, r32 = lane & 31, hi = lane >> 5, wave = __builtin_amdgcn_readfirstlane(tid >> 6);
    const bool lat = qb < 8;
    const int qrow0 = lat ? MC + b * SEQ + qb * 256 : b * CTXL;
    const int nt = lat ? 36 : 4;
    v4u cin[2];
    const unsigned kgo0 = (unsigned)(tid / 12) * DAX_LD + 16u * (unsigned)(tid % 12) + 192u, kgo1 = (unsigned)((tid + 512) / 12) * DAX_LD + 16u * (unsigned)((tid + 512) % 12) + 192u;
    const unsigned klo0 = (unsigned)(AT_KOFF + (tid / 12) * 208 + (tid % 12) * 16), klo1 = (unsigned)(AT_KOFF + ((tid + 512) / 12) * 208 + ((tid + 512) % 12) * 16);
    const unsigned vgo0 = (unsigned)((64 * wave + lane) / 12) * DAX_LD + 16u * (unsigned)((64 * wave + lane) % 12) + 384u, vgo1 = (unsigned)((64 * (wave + 8) + lane) / 12) * DAX_LD + 16u * (unsigned)((64 * (wave + 8) + lane) % 12) + 384u;
    const char* DX = (const char*)P + DAX_OFF + (size_t)(b * 4 + h) * NSLOT * DAX_LD;
#define AT_LOAD(tile) do { const char* tb_ = DX + (size_t)(tile) * (64 * DAX_LD); cin[0] = gld16(tb_, kgo0); if (tid < 256) cin[1] = gld16(tb_, kgo1); } while (0)
#define AT_STORE(tile, buf) do { lptr sb_ = lds + (buf) * AT_BUF; *(LAS v4u*)(sb_ + klo0) = cin[0]; if (tid < 256) *(LAS v4u*)(sb_ + klo1) = cin[1]; } while (0)
#define AT_VDMA(tile, buf) do { const char* tb_ = DX + (size_t)(tile) * (64 * DAX_LD); lptr vb_ = lds + (buf) * AT_BUF + AT_VOFF; \
        __builtin_amdgcn_global_load_lds((const unsigned*)(tb_ + vgo0), (LAS unsigned*)(vb_ + wave * 1024), 16, 0, 0); \
        if (wave < 4) __builtin_amdgcn_global_load_lds((const unsigned*)(tb_ + vgo1), (LAS unsigned*)(vb_ + (wave + 8) * 1024), 16, 0, 0); } while (0)
    AT_LOAD(0);
    lptr qfp = lds + AT_QF + (wave * 6 * 64 + lane) * 16;
    { const unsigned qo = (unsigned)((lat ? CTXL + qb * 256 : 0) + wave * 32 + r32) * DAX_LD + 16u * hi;
#pragma unroll
      for (int f = 0; f < 6; ++f) __builtin_amdgcn_global_load_lds((const unsigned*)(DX + qo + (unsigned)((f / 3) * 48 + (f % 3) * 16) * 2u), (LAS unsigned*)(lds + AT_QF + (wave * 6 + f) * 1024), 16, 0, 0); }
    AT_STORE(0, 0); AT_VDMA(0, 0);
    if (nt > 1) { AT_LOAD(1); AT_VDMA(1, 1); }
    __syncthreads();
    f32x16 O0[3], O1[3];
#pragma unroll
    for (int ct = 0; ct < 3; ++ct)
#pragma unroll
        for (int r = 0; r < 16; ++r) { O0[ct][r] = 0.f; O1[ct][r] = 0.f; }
    float m0 = -1e30f, m1 = -1e30f, l0 = 0.f, l1 = 0.f;
#define AT_QK(SX0, SX1, kb, sub) do { \
        _Pragma("unroll") for (int ks = 0; ks < 3; ++ks) { \
            const bf16x8 k0_ = lds8((kb) + (((sub) * 32 + r32) * 104 + ks * 16 + hi * 8) * 2); \
            const bf16x8 k1_ = lds8((kb) + (((sub) * 32 + r32) * 104 + 48 + ks * 16 + hi * 8) * 2); \
            const bf16x8 q0_ = lds8(qfp + ks * 1024), q1_ = lds8(qfp + (3 + ks) * 1024); \
            if (ks == 0) { SX0 = MFMA32(k0_, q0_, zero16()); SX1 = MFMA32(k1_, q1_, zero16()); } \
            else { SX0 = MFMA32(k0_, q0_, SX0); SX1 = MFMA32(k1_, q1_, SX1); } } } while (0)
#define AT_SMPV(SX0, SX1, vb, sub) do { \
        const float mx0_ = sm_max(SX0, lane), mx1_ = sm_max(SX1, lane); \
        if (__any((mx0_ > m0 + AT_THR) || (mx1_ > m1 + AT_THR))) { \
            const float n0_ = fmaxf(m0, mx0_), n1_ = fmaxf(m1, mx1_); \
            const float a0_ = __builtin_amdgcn_exp2f(m0 - n0_), a1_ = __builtin_amdgcn_exp2f(m1 - n1_); \
            m0 = n0_; m1 = n1_; l0 *= a0_; l1 *= a1_; \
            _Pragma("unroll") for (int ct = 0; ct < 3; ++ct) _Pragma("unroll") for (int r = 0; r < 16; ++r) { O0[ct][r] *= a0_; O1[ct][r] *= a1_; } } \
        bf16x8 p00_, p01_, p10_, p11_; \
        sm_exp(SX0, m0, l0, p00_, p01_); sm_exp(SX1, m1, l1, p10_, p11_); \
        _Pragma("unroll") for (int ct = 0; ct < 3; ++ct) { \
            const bf16x8 v0_ = vt_frag((vb), ct, (sub), 0, lane); const bf16x8 v1_ = vt_frag((vb), ct, (sub), 1, lane); \
            O0[ct] = MFMA32(v0_, p00_, O0[ct]); O1[ct] = MFMA32(v0_, p10_, O1[ct]); \
            O0[ct] = MFMA32(v1_, p01_, O0[ct]); O1[ct] = MFMA32(v1_, p11_, O1[ct]); } } while (0)
    f32x16 SA0, SA1, SB0, SB1;
    AT_QK(SA0, SA1, lds + AT_KOFF, 0);
    int cb = 0;
    for (int i = 0; i < nt; ++i) {
        const int nb = (cb == 2) ? 0 : cb + 1;
        lptr kc_ = lds + cb * AT_BUF + AT_KOFF, vc_ = lds + cb * AT_BUF + AT_VOFF;
        AT_QK(SB0, SB1, kc_, 1);
        AT_SMPV(SA0, SA1, vc_, 0);
        if (i + 1 < nt && !(probe & 2)) AT_STORE(i + 1, nb);
        __syncthreads();
        if (i + 2 < nt && !(probe & 1)) { AT_LOAD(i + 2); AT_VDMA(i + 2, (nb == 2) ? 0 : nb + 1); }
        if (i + 1 < nt) AT_QK(SA0, SA1, lds + nb * AT_BUF + AT_KOFF, 0);
        AT_SMPV(SB0, SB1, vc_, 1);
        cb = nb;
    }
#undef AT_LOAD
#undef AT_VDMA
#undef AT_STORE
#undef AT_QK
#undef AT_SMPV
    const float i0 = 1.0f / (l0 + lx_xor(l0, 32, lane)), i1 = lam / (l1 + lx_xor(l1, 32, lane));
    float ss = 0.f;
#pragma unroll
    for (int ct = 0; ct < 3; ++ct)
#pragma unroll
        for (int r = 0; r < 16; ++r) { const float o = O0[ct][r] * i0 - O1[ct][r] * i1; O0[ct][r] = o; ss += o * o; }
    ss += lx_xor(ss, 32, lane);
    const float rs = out_scale / sqrtf(ss * (1.0f / 96.0f) + EPS);
    const unsigned oro = ((unsigned)(qrow0 + wave * 32 + r32) * (unsigned)D + (unsigned)(Y_DA + h * 96)) * 2u;
#pragma unroll
    for (int ct = 0; ct < 3; ++ct)
#pragma unroll
        for (int g = 0; g < 4; ++g) { const int c0 = 32 * ct + 8 * g + 4 * hi; const f32x4 gn = *(const f32x4*)(danorm + c0);
            v2u w; w.x = pk2(O0[ct][4 * g] * rs * gn[0], O0[ct][4 * g + 1] * rs * gn[1]); w.y = pk2(O0[ct][4 * g + 2] * rs * gn[2], O0[ct][4 * g + 3] * rs * gn[3]);
            gst8(YM, oro + 2u * c0, w); }
}
__device__ __forceinline__ int scan_row(int b, int dir, int p) {
    if (p < CTXL) { const int t = dir ? CTXL - 1 - p : p; return b * CTXL + t; }
    const int pl = p - CTXL; const int t = dir ? SEQ - 1 - pl : pl; return MC + b * SEQ + t;
}
__device__ __forceinline__ int scan_slot(int dir, int p) { if (p < CTXL) return dir ? CTXL - 1 - p : p; const int pl = p - CTXL; return CTXL + (dir ? SEQ - 1 - pl : pl); }

constexpr int ML_Q = 0, ML_K = 13312, ML_KW = 26624, ML_VA = 40960, ML_QKM = 55296, ML_ST = 64512, ML_GF = 87808;
constexpr int ML_LDQ = 208, ML_LDW = 224, ML_LDM = 144, ML_LDS = 208;
constexpr float KSCALE = 0.10206207261596577f;

__device__ __forceinline__ void mlstm_stream(lptr lds, const bf16* P, const float* G, bf16* dst, int dst_ld, const float* fbias  , int b, int h, int dir) {
    const int tid = tid_opaque(), lane = tid & 63, c16 = lane & 15, rg = lane >> 4, wave = __builtin_amdgcn_readfirstlane(tid >> 6);
    lptr Qs = lds + ML_Q, Ks = lds + ML_K, Kw = lds + ML_KW, Va = lds + ML_VA, QKM = lds + ML_QKM, ST = lds + ML_ST;
    LAS float* gA = (LAS float*)(lds + ML_GF); LAS float* MxA = gA + 64; LAS float* wA = gA + 128; LAS float* emtA = gA + 192; LAS float* wkA = gA + 256; LAS float* scal = gA + 320;
    if (tid < 128) { const int t = tid >> 1, hh = tid & 1; v4u w; w.x = hh ? 0u : 0x3F80u; w.y = 0u; w.z = 0u; w.w = 0u; *(LAS v4u*)(Va + t * ML_LDW + (96 + 8 * hh) * 2) = w; }
    const float fb = fbias[dir * 4 + h];
    f32x4 acc[6];
#pragma unroll
    for (int i = 0; i < 6; ++i) acc[i] = (f32x4){0.f, 0.f, 0.f, 0.f};
    float m_prev = -1e30f;
    v4u pre[5]; float gi = 0.f, gf = 0.f;
    const char* MLB = (const char*)P + MLX_OFF + (size_t)(b * 4 + h) * NSLOT * MLX_LD;
#define ML_PREFETCH(c) do { const char* cb_ = MLB + (size_t)(dir ? scan_slot(1, 64 * (c) + 63) : scan_slot(0, 64 * (c))) * MLX_LD; \
    _Pragma("unroll") for (int i_ = 0; i_ < 5; ++i_) { const int id_ = tid + NTHR * i_; if (id_ < 2304) { const int t_ = id_ / 36, r_ = id_ % 36; \
        pre[i_] = gld16(cb_, (unsigned)(dir ? 63 - t_ : t_) * MLX_LD + (unsigned)((r_ / 12) * 96 + (r_ % 12) * 8) * 2u); } } \
    if (wave == 0) { const unsigned go_ = (unsigned)scan_row(b, dir, 64 * (c) + lane) * 64u + (unsigned)(dir * 4 + h) * 4u; gi = *(const float*)((const char*)G + go_); gf = *(const float*)((const char*)G + go_ + 32u); } } while (0)
    ML_PREFETCH(0);
    for (int c = 0; c < NTOK / 64; ++c) {
#pragma unroll
        for (int i = 0; i < 5; ++i) { const int id = tid + NTHR * i; if (id < 2304) { const int t = id / 36, r = id % 36, wh = r / 12, cc = r % 12;
            lptr d = (wh == 0) ? Qs + t * ML_LDQ : (wh == 1) ? Ks + t * ML_LDQ : Va + t * ML_LDW;
            *(LAS v4u*)(d + cc * 16) = pre[i]; } }
        if (wave == 0) {
            const float fp = gf + fb;
            const float lf = fminf(fp, 0.f) - log1pf(__expf(-fabsf(fp)));
            const float bs = scan_sum64(lf);
            const float g = gi - bs;
            const float cm = scan_max64(g);
            const float Mx = fmaxf(m_prev, cm);
            const float mt = bs + Mx;
            const float blast = lx_idx(bs, 63), m_new = lx_idx(mt, 63);
            gA[lane] = g; MxA[lane] = Mx; wA[lane] = __expf(m_prev - Mx); emtA[lane] = __expf(-mt); wkA[lane] = __expf(g + blast - m_new) * KSCALE;
            if (lane == 0) scal[0] = __expf(blast + m_prev - m_new);
            m_prev = m_new;
        }
        if (c + 1 < NTOK / 64) ML_PREFETCH(c + 1);
        __syncthreads();
#pragma unroll
        for (int j = 0; j < 2; ++j) { const int idx = 2 * wave + j, si = idx & 3, ti = idx >> 2;
            f32x4 a4 = (f32x4){0.f, 0.f, 0.f, 0.f};
            if (si <= ti) {
#pragma unroll
                for (int ks = 0; ks < 3; ++ks) a4 = MFMA16(opr(Ks, ML_LDQ, 16 * si, 32 * ks, c16, rg), opr(Qs, ML_LDQ, 16 * ti, 32 * ks, c16, rg), a4);
            }
            const int t = 16 * ti + c16, s0 = 16 * si + 4 * rg; const float mxt = MxA[t]; const f32x4 g4 = *(const LAS f32x4*)(gA + s0);
            float v[4];
#pragma unroll
            for (int r = 0; r < 4; ++r) v[r] = (s0 + r <= t) ? a4[r] * KSCALE * __expf(g4[r] - mxt) : 0.f;
            v2u w; w.x = pk2(v[0], v[1]); w.y = pk2(v[2], v[3]); *(LAS v2u*)(QKM + t * ML_LDM + s0 * 2) = w; }
        for (int id = tid; id < 64 * 12; id += NTHR) { const int t = id / 12, cc = id % 12; const v4u w = *(const LAS v4u*)(Ks + t * ML_LDQ + cc * 16); const float sc = wkA[t];
            v4u o; o.x = pk2(bflo(w.x) * sc, bfhi(w.x) * sc); o.y = pk2(bflo(w.y) * sc, bfhi(w.y) * sc); o.z = pk2(bflo(w.z) * sc, bfhi(w.z) * sc); o.w = pk2(bflo(w.w) * sc, bfhi(w.w) * sc);
            *(LAS v4u*)(Kw + t * ML_LDW + cc * 16) = o; }
#pragma unroll
        for (int i = 0; i < 6; ++i) { const int j = wave + 8 * i; if (j < 42) { const int di = j / 7, vi = j % 7;
            v2u w; w.x = pk2(acc[i][0], acc[i][1]); w.y = pk2(acc[i][2], acc[i][3]); *(LAS v2u*)(ST + (16 * vi + c16) * ML_LDS + (16 * di + 4 * rg) * 2) = w; } }
        __syncthreads();
        if (wave < 4) {
            const int ti = wave, t = 16 * ti + c16;
            f32x4 aX[7];
#pragma unroll
            for (int vi = 0; vi < 7; ++vi) aX[vi] = (f32x4){0.f, 0.f, 0.f, 0.f};
#pragma unroll
            for (int ks = 0; ks < 3; ++ks) { const bf16x8 b8 = opr(Qs, ML_LDQ, 16 * ti, 32 * ks, c16, rg);
#pragma unroll
                for (int vi = 0; vi < 7; ++vi) aX[vi] = MFMA16(opr(ST, ML_LDS, 16 * vi, 32 * ks, c16, rg), b8, aX[vi]); }
            { const float wt = wA[t];
#pragma unroll
              for (int vi = 0; vi < 7; ++vi) aX[vi] = aX[vi] * wt; }
#pragma unroll
            for (int ks = 0; ks < 2; ++ks) { const bf16x8 b8 = opr(QKM, ML_LDM, 16 * ti, 32 * ks, c16, rg);
#pragma unroll
                for (int vi = 0; vi < 7; ++vi) aX[vi] = MFMA16(opt(Va, ML_LDW, 16 * vi, 32 * ks, lane), b8, aX[vi]); }
            const float den = lx_idx(aX[6][0], c16);
            const float inv = 1.0f / fmaxf(fabsf(den), emtA[t]);
            const int row = scan_row(b, dir, 64 * c + t);
            const unsigned oo = ((unsigned)row * (unsigned)dst_ld + (unsigned)(h * 96 + 4 * rg)) * 2u;
#pragma unroll
            for (int vi = 0; vi < 6; ++vi) { v2u w; w.x = pk2(aX[vi][0] * inv, aX[vi][1] * inv); w.y = pk2(aX[vi][2] * inv, aX[vi][3] * inv); gst8(dst, oo + 32u * vi, w); }
        }
        { const float decay = scal[0];
#pragma unroll
          for (int i = 0; i < 6; ++i) { const int j = wave + 8 * i; if (j < 42) { const int di = j / 7, vi = j % 7;
              acc[i] = acc[i] * decay;
#pragma unroll
              for (int ks = 0; ks < 2; ++ks) acc[i] = MFMA16(opt(Kw, ML_LDW, 16 * di, 32 * ks, lane), opt(Va, ML_LDW, 16 * vi, 32 * ks, lane), acc[i]); } } }
        __syncthreads();
    }
#undef ML_PREFETCH
}

constexpr int HG_QT = 0, HG_KR = 8704, HG_V = 17920, HG_ATT = 23040, HG_SPT = 25600, HG_ER = 43008, HG_TOT = 43520, HG_OFF = 47616;
constexpr int HG_LDQ = 272, HG_LDK = 288, HG_LDV = 160, HG_LDA = 80, HG_LDS = 272;

__device__ __forceinline__ void hgrn2_stream(lptr lds, const bf16* P, bf16* dst, int dst_ld, const float* lbl  , int b, int h, int dir) {
    const int tid = tid_opaque(), lane = tid & 63, c16 = lane & 15, rg = lane >> 4, wave = __builtin_amdgcn_readfirstlane(tid >> 6);
    lptr QT = lds + HG_QT, KR = lds + HG_KR, Vs = lds + HG_V, ATT = lds + HG_ATT, SPT = lds + HG_SPT;
    LAS float* ER = (LAS float*)(lds + HG_ER); LAS float* TOT = (LAS float*)(lds + HG_TOT); LAS float* OFF = (LAS float*)(lds + HG_OFF);
    const int tt = tid >> 4, kc = tid & 15;
    const int tv = tid >> 3, cv = tid & 7;
    float lb[8];
    { const f32x4 l0 = *(const f32x4*)(lbl + dir * 512 + h * 128 + 8 * kc), l1 = *(const f32x4*)(lbl + dir * 512 + h * 128 + 8 * kc + 4);
#pragma unroll
      for (int j = 0; j < 4; ++j) { lb[j] = l0[j]; lb[4 + j] = l1[j]; } }
    f32x4 acc[4];
#pragma unroll
    for (int i = 0; i < 4; ++i) acc[i] = (f32x4){0.f, 0.f, 0.f, 0.f};
    v4u zr, qr, vr;
#define HG_PREFETCH(c) do { { const unsigned ro_ = (unsigned)((b * 4 + h) * NSLOT + scan_slot(dir, 32 * (c) + tt)) * HGX_LD + 16u * kc; \
        zr = gld16((const char*)P + HGX_OFF, ro_ + (unsigned)dir * 256u); qr = gld16((const char*)P + HGX_OFF, ro_ + 512u); } \
        if (tid < 256) { const unsigned ro_ = (unsigned)((b * 4 + h) * NSLOT + scan_slot(dir, 32 * (c) + tv)) * HGX_LD + 16u * cv; vr = gld16((const char*)P + HGX_OFF, ro_ + 768u); } } while (0)
    HG_PREFETCH(0);
    for (int c = 0; c < NTOK / 32; ++c) {
        float kk[8], cs[8], qv[8];
        { const unsigned zw[4] = {zr.x, zr.y, zr.z, zr.w}, qw[4] = {qr.x, qr.y, qr.z, qr.w};
#pragma unroll
          for (int j = 0; j < 8; ++j) { const float z = (j & 1) ? bfhi(zw[j >> 1]) : bflo(zw[j >> 1]); qv[j] = (j & 1) ? bfhi(qw[j >> 1]) : bflo(qw[j >> 1]);
              const float e = __expf(-fabsf(z)); const float inv = __builtin_amdgcn_rcpf(1.0f + e);
              const float sig = z >= 0.f ? inv : e * inv, nsig = z >= 0.f ? e * inv : inv;
              const float oml = 1.0f - lb[j]; const float f = fmaxf(lb[j], 1e-30f) + oml * sig; kk[j] = oml * nsig;
              float x = __log2f(f);
              float y = lx_up(x, 16, lane); if (lane >= 16) x += y;
              y = lx_up(x, 32, lane); if (lane >= 32) x += y;
              cs[j] = x; } }
        if (tid < 256) *(LAS v4u*)(Vs + tv * HG_LDV + cv * 16) = vr;
        if (lane >= 48) { *(LAS f32x4*)(TOT + wave * 128 + 8 * kc) = (f32x4){cs[0], cs[1], cs[2], cs[3]}; *(LAS f32x4*)(TOT + wave * 128 + 8 * kc + 4) = (f32x4){cs[4], cs[5], cs[6], cs[7]}; }
        __syncthreads();
        if (tid < 128) { f32x4 o0 = (f32x4){0.f, 0.f, 0.f, 0.f}, o1 = o0, s0 = o0, s1 = o0;
#pragma unroll
            for (int w2 = 0; w2 < 8; ++w2) { const f32x4 t0 = *(const LAS f32x4*)(TOT + w2 * 128 + 8 * kc), t1 = *(const LAS f32x4*)(TOT + w2 * 128 + 8 * kc + 4);
                if (w2 == tt) { o0 = s0; o1 = s1; } s0 += t0; s1 += t1; }
            *(LAS f32x4*)(OFF + tt * 128 + 8 * kc) = o0; *(LAS f32x4*)(OFF + tt * 128 + 8 * kc + 4) = o1;
            if (tt == 0) { *(LAS f32x4*)(OFF + 1024 + 8 * kc) = s0; *(LAS f32x4*)(OFF + 1024 + 8 * kc + 4) = s1;
                const f32x4 e0 = {__builtin_amdgcn_exp2f(fmaxf(0.5f * s0[0], -100.f)), __builtin_amdgcn_exp2f(fmaxf(0.5f * s0[1], -100.f)), __builtin_amdgcn_exp2f(fmaxf(0.5f * s0[2], -100.f)), __builtin_amdgcn_exp2f(fmaxf(0.5f * s0[3], -100.f))};
                const f32x4 e1 = {__builtin_amdgcn_exp2f(fmaxf(0.5f * s1[0], -100.f)), __builtin_amdgcn_exp2f(fmaxf(0.5f * s1[1], -100.f)), __builtin_amdgcn_exp2f(fmaxf(0.5f * s1[2], -100.f)), __builtin_amdgcn_exp2f(fmaxf(0.5f * s1[3], -100.f))};
                *(LAS f32x4*)(ER + 8 * kc) = e0; *(LAS f32x4*)(ER + 8 * kc + 4) = e1; } }
        __syncthreads();
        { const f32x4 o0 = *(const LAS f32x4*)(OFF + wave * 128 + 8 * kc), o1 = *(const LAS f32x4*)(OFF + wave * 128 + 8 * kc + 4);
          const f32x4 t0 = *(const LAS f32x4*)(OFF + 1024 + 8 * kc), t1 = *(const LAS f32x4*)(OFF + 1024 + 8 * kc + 4);
          float qt[8], kt[8];
#pragma unroll
          for (int j = 0; j < 8; ++j) { const float rr = 0.5f * (j < 4 ? t0[j & 3] : t1[j & 3]); float x = (j < 4 ? o0[j & 3] : o1[j & 3]) + cs[j] - rr; x = fminf(fmaxf(x, -100.f), 100.f);
              const float q = qv[j]; const float qs = q * __builtin_amdgcn_rcpf(1.0f + __expf(-q));
              qt[j] = qs * __builtin_amdgcn_exp2f(x); kt[j] = kk[j] * __builtin_amdgcn_exp2f(-x); }
          v4u wq, wk; wq.x = pk2(qt[0], qt[1]); wq.y = pk2(qt[2], qt[3]); wq.z = pk2(qt[4], qt[5]); wq.w = pk2(qt[6], qt[7]);
          wk.x = pk2(kt[0], kt[1]); wk.y = pk2(kt[2], kt[3]); wk.z = pk2(kt[4], kt[5]); wk.w = pk2(kt[6], kt[7]);
          *(LAS v4u*)(QT + tt * HG_LDQ + kc * 16) = wq; *(LAS v4u*)(KR + tt * HG_LDK + kc * 16) = wk; }
        if (c + 1 < NTOK / 32) HG_PREFETCH(c + 1);
        __syncthreads();
        if (wave < 4) { const int si = wave & 1, ti = wave >> 1;
            f32x4 a4 = (f32x4){0.f, 0.f, 0.f, 0.f};
            if (si <= ti) {
#pragma unroll
                for (int ks = 0; ks < 4; ++ks) a4 = MFMA16(opr(KR, HG_LDK, 16 * si, 32 * ks, c16, rg), opr(QT, HG_LDQ, 16 * ti, 32 * ks, c16, rg), a4);
            }
            const int t = 16 * ti + c16, s0 = 16 * si + 4 * rg;
            v2u w; w.x = pk2(s0 <= t ? a4[0] : 0.f, s0 + 1 <= t ? a4[1] : 0.f); w.y = pk2(s0 + 2 <= t ? a4[2] : 0.f, s0 + 3 <= t ? a4[3] : 0.f);
            *(LAS v2u*)(ATT + t * HG_LDA + s0 * 2) = w; }
        { const f32x4 er = *(const LAS f32x4*)(ER + 16 * wave + 4 * rg);
#pragma unroll
          for (int ci = 0; ci < 4; ++ci) { acc[ci] = acc[ci] * er; v2u w; w.x = pk2(acc[ci][0], acc[ci][1]); w.y = pk2(acc[ci][2], acc[ci][3]);
              *(LAS v2u*)(SPT + (16 * ci + c16) * HG_LDS + (16 * wave + 4 * rg) * 2) = w; } }
        __syncthreads();
        { const int ci = wave & 3, ti = wave >> 2, t = 16 * ti + c16;
          f32x4 o4 = (f32x4){0.f, 0.f, 0.f, 0.f};
          o4 = MFMA16(opt(Vs, HG_LDV, 16 * ci, 0, lane), opr(ATT, HG_LDA, 16 * ti, 0, c16, rg), o4);
#pragma unroll
          for (int ks = 0; ks < 4; ++ks) o4 = MFMA16(opr(SPT, HG_LDS, 16 * ci, 32 * ks, c16, rg), opr(QT, HG_LDQ, 16 * ti, 32 * ks, c16, rg), o4);
          const int row = scan_row(b, dir, 32 * c + t);
          v2u w; w.x = pk2(o4[0], o4[1]); w.y = pk2(o4[2], o4[3]);
          gst8(dst, ((unsigned)row * (unsigned)dst_ld + (unsigned)(h * 64 + 16 * ci + 4 * rg)) * 2u, w); }
        { const bf16x8 a8 = opt(KR, HG_LDK, 16 * wave, 0, lane); const f32x4 er = *(const LAS f32x4*)(ER + 16 * wave + 4 * rg);
#pragma unroll
          for (int ci = 0; ci < 4; ++ci) { acc[ci] = MFMA16(a8, opt(Vs, HG_LDV, 16 * ci, 0, lane), acc[ci]); acc[ci] = acc[ci] * er; } }
        __syncthreads();
    }
#undef HG_PREFETCH
}

__device__ __forceinline__ void fin_phase(int row_lo, const bf16* P, bf16* YM, const bf16* RAWM, const bf16* RAWH, const float* mlgain  , const float* hggain  , int vcu, int G) {
    const int tid = tid_opaque(); const int lane = tid & 63, wave = __builtin_amdgcn_readfirstlane(tid >> 6);
    float gm[6], gh[4];
#pragma unroll
    for (int j = 0; j < 6; ++j) gm[j] = mlgain[6 * lane + j];
#pragma unroll
    for (int j = 0; j < 4; ++j) gh[j] = hggain[4 * lane + j];
    const int nrows = MT - row_lo; int rwg = (nrows + G - 1) / G; rwg = (rwg + 15) & ~15;
    const int wbeg = row_lo + vcu * rwg, rend = (wbeg + rwg < MT) ? wbeg + rwg : MT;
    for (int r0 = wbeg + wave; r0 < rend; r0 += 16) {
        unsigned fa[2][3], ba[2][3], oa[2][3]; v2u f2[2], b2[2], g2[2];
#pragma unroll
        for (int q = 0; q < 2; ++q) { const int r = r0 + 8 * q; if (r < rend) {
            const unsigned* f3 = (const unsigned*)(YM + (size_t)r * D + Y_ML + 6 * lane); const unsigned* b3 = (const unsigned*)(RAWM + (size_t)r * 384 + 6 * lane); const unsigned* o3 = (const unsigned*)((const char*)P + MLO_OFF + (size_t)r * MLO_LD + 12 * lane);
#pragma unroll
            for (int j = 0; j < 3; ++j) { fa[q][j] = f3[j]; ba[q][j] = b3[j]; oa[q][j] = o3[j]; }
            f2[q] = *(const v2u*)(YM + (size_t)r * D + Y_HG + 4 * lane); b2[q] = *(const v2u*)(RAWH + (size_t)r * 256 + 4 * lane); g2[q] = *(const v2u*)((const char*)P + HGG_OFF + (size_t)r * HGG_LD + 8 * lane); } }
#pragma unroll
        for (int q = 0; q < 2; ++q) { const int r = r0 + 8 * q; if (r < rend) {
            float hm[6] = {bflo(fa[q][0]) + bflo(ba[q][0]), bfhi(fa[q][0]) + bfhi(ba[q][0]), bflo(fa[q][1]) + bflo(ba[q][1]), bfhi(fa[q][1]) + bfhi(ba[q][1]), bflo(fa[q][2]) + bflo(ba[q][2]), bfhi(fa[q][2]) + bfhi(ba[q][2])};
            const float og[6] = {bflo(oa[q][0]), bfhi(oa[q][0]), bflo(oa[q][1]), bfhi(oa[q][1]), bflo(oa[q][2]), bfhi(oa[q][2])};
            float hh[4] = {bflo(f2[q].x) + bflo(b2[q].x), bfhi(f2[q].x) + bfhi(b2[q].x), bflo(f2[q].y) + bflo(b2[q].y), bfhi(f2[q].y) + bfhi(b2[q].y)};
            const float gg[4] = {bflo(g2[q].x), bfhi(g2[q].x), bflo(g2[q].y), bfhi(g2[q].y)};
            float sm = 0.f, sh = 0.f;
#pragma unroll
            for (int j = 0; j < 6; ++j) sm += hm[j] * hm[j];
#pragma unroll
            for (int j = 0; j < 4; ++j) sh += hh[j] * hh[j];
#pragma unroll
            for (int o = 1; o < 16; o <<= 1) { sm += lx_xor(sm, o, lane); sh += lx_xor(sh, o, lane); }
            const float rm = 1.0f / sqrtf(sm * (1.0f / 96.0f) + EPS), rh = 1.0f / sqrtf(sh * (1.0f / 64.0f) + EPS);
#pragma unroll
            for (int j = 0; j < 6; ++j) hm[j] = hm[j] * rm * gm[j] * __builtin_amdgcn_rcpf(1.0f + __expf(-og[j]));
#pragma unroll
            for (int j = 0; j < 4; ++j) hh[j] = hh[j] * rh * gh[j] * gg[j] * __builtin_amdgcn_rcpf(1.0f + __expf(-gg[j]));
            bf16* ym = YM + (size_t)r * D;
            unsigned* w3 = (unsigned*)(ym + Y_ML + 6 * lane); w3[0] = pk2(hm[0], hm[1]); w3[1] = pk2(hm[2], hm[3]); w3[2] = pk2(hm[4], hm[5]);
            v2u w2; w2.x = pk2(hh[0], hh[1]); w2.y = pk2(hh[2], hh[3]); *(v2u*)(ym + Y_HG + 4 * lane) = w2; } }
    }
}
#ifndef NO_HG
#define NO_HG 0
#endif
#ifndef NO_ML
#define NO_ML 0
#endif
#ifndef NO_AT
#define NO_AT 0
#endif
#ifndef NO_GEMM
#define NO_GEMM 0
#endif
#ifndef NO_G1
#define NO_G1 0
#endif
#ifndef NO_G2
#define NO_G2 0
#endif
#ifndef NO_G3
#define NO_G3 0
#endif
#ifndef NO_G4
#define NO_G4 0
#endif
#ifndef NO_P0
#define NO_P0 0
#endif
#ifndef STAMP_ON
#define STAMP_ON 0
#endif
#ifndef SA
#define SA 0
#define SB 1
#define SC 0
#define SD 1
#endif
#ifndef THIN_PROBE
#define THIN_PROBE 0
#endif
#ifndef ATT_PROBE
#define ATT_PROBE 0
#endif
#ifndef REPMASK
#define REPMASK 7
#endif
#ifndef REP
#define REP 0
#endif
constexpr int NPHASE = 2 + 8 * DEPTH;

typedef __attribute__((address_space(4))) const Args* kargs_t;
__device__ __forceinline__ kargs_t kargs() { kargs_t p = (kargs_t)__builtin_amdgcn_kernarg_segment_ptr(); asm volatile("" : "+s"(p)); return p; }
#define WSP(T, off) ((T*)(ws + (off)))

__global__ void __launch_bounds__(NTHR, 2) fwd(Args a_unused) {
    extern __shared__ __attribute__((aligned(16))) unsigned char lds_raw[];
    lptr lds = (lptr)lds_raw;
    const int G = gridDim.x; const int bx = blockIdx.x; const int vcu = (G % 8 == 0) ? (bx % 8) * (G / 8) + bx / 8 : bx;
    volatile LAS unsigned* MISC = (volatile LAS unsigned*)(lds + LDSCTL_OFF);
    { const int tid = tid_opaque(); for (int u = tid; u < 256; u += NTHR) ((LAS unsigned*)(lds + LDSCTL_OFF))[u] = 0u; }
    __syncthreads();
    int lo, hi; XcdBarrier bar;
    { kargs_t A = kargs(); lo = A->ph_lo; hi = A->ph_hi; unsigned* bw = (unsigned*)(A->ws + WS_CTL) + CW_BAR;
      bar.bar = bw; bar.x = 0; bar.st = nullptr;
      if (hi - lo > 1) bar = xcd_barrier_post(bw, MISC + 8); }
    volatile LAS int* slot = (volatile LAS int*)(MISC + 16);
#if STAMP_ON
#define STAMP(k) do { if (bx == 0 && tid_opaque() == 0) { kargs_t A_ = kargs(); __hip_atomic_store((unsigned long long*)(A_->ws + WS_MISC + 131072) + (k), (unsigned long long)__builtin_amdgcn_s_memrealtime(), RLX_AGENT); } } while (0)
#else
#define STAMP(k) do { } while (0)
#endif
#define IN(k) (lo <= (k) && (k) < hi)
#define SEAM(k) do { if (IN(k) && IN((k) + 1)) xcd_barrier(bar); STAMP((k) + 1); } while (0)
#define REPEAT(k) for (int rep_ = ((REP == (k) && l == 0) ? 2 : 1); rep_ > 0; --rep_)
#define REPBAR() do { if (rep_ > 1) xcd_barrier(bar); } while (0)

    STAMP(0);
    if (IN(0)) { if (!NO_P0) p0_phase(lds, kargs()); } SEAM(0);

    for (int l = 0; l < DEPTH; ++l) {
        const int pb = 1 + 8 * l;
        const bool with_ctx = l < DEPTH - 1;
        const int r0 = with_ctx ? 0 : MC; const int Mg = MT - r0;
        if (IN(pb)) REPEAT(1) {
            kargs_t A = kargs(); unsigned char* ws = A->ws; const float* modl = WSP(float, WS_MOD) + (size_t)l * 17 * NMOD; bf16* xb = WSP(bf16, WS_XB);
            if (l == 0) thin_phase<false, true, true, false>(0, A->in[I_X], A->in[I_CTX], nullptr, xb, false, (const bf16*)nullptr, nullptr, 0, nullptr, modl, 0, D, A->in[I_GPREMIX] + l * D, WSP(bf16, WS_HB), vcu, G);
            else        thin_phase<true, true, false, false>(0, nullptr, nullptr, nullptr, xb, true, WSP(bf16, WS_YD), modl - 17 * NMOD, 5 * D, A->in[I_GPOSTFFN] + (l - 1) * D, modl, 0, D, A->in[I_GPREMIX] + l * D, WSP(bf16, WS_HB), vcu, G);
            convert_weights(lds, kargs(), l, vcu, G); REPBAR();
        }
        SEAM(pb);
        if (IN(pb + 1)) REPEAT(2) {
            kargs_t A = kargs(); unsigned char* ws = A->ws;
            pg8::Gemm g{WSP(bf16, WS_HB), WSP(bf16, WS_WIN), MT, DINP, D}; pg8::StaticOrder S; S.init(MT, DINP, G, bx);
            { const int tid = tid_opaque(); const float* bsrc = WSP(float, WS_MISC + 32768) + l * DINP; const float* rsrc = WSP(float, WS_MISC + 16384);
              for (int i = tid; i < DINP; i += NTHR) ((LAS float*)(lds + LDS_BIAS))[i] = bsrc[i];
              for (int i = tid; i < 64 * 24; i += NTHR) ((LAS float*)(lds + LDS_ROPE))[i] = rsrc[i];
              for (int i = tid; i < DINP / 8; i += NTHR) { unsigned ex, ey; pg8::epi_in_entry(i, ex, ey); ((LAS unsigned*)(lds + LDS_ETAB))[2 * i] = ex; ((LAS unsigned*)(lds + LDS_ETAB))[2 * i + 1] = ey; }
              __syncthreads(); }
            pg8::EpiIn E{ws + WS_P, (const LAS float*)(lds + LDS_BIAS), WSP(float, WS_GATE), (const LAS float*)(lds + LDS_ROPE), (const LAS unsigned*)(lds + LDS_ETAB), MC, QSCALE};
            if (!NO_GEMM && !NO_G1) pg8::gemm_phase<pg8::EpiIn, pg8::StaticOrder, true, true>(lds, g, S, E); REPBAR();
        }
        SEAM(pb + 1);
        if (IN(pb + 2)) REPEAT(3) {
            { kargs_t A = kargs(); unsigned char* ws = A->ws; unsigned* qh = WSP(unsigned, WS_CTL) + CW_Q + 64 * (16 * l + 64 * (rep_ - 1));
              for (;;) { const int it = wg_pull(qh, slot); if (it >= 128) break;
                const int b = it >> 3, h = (it >> 1) & 3, dir = it & 1;
                if (!NO_HG && (rep_ == 1 || (REPMASK & 1))) hgrn2_stream(lds, WSP(bf16, WS_P), dir ? (bf16*)((unsigned char*)A->out + OUT_RAWH) : WSP(bf16, WS_HB) + Y_HG, dir ? 256 : D, WSP(float, WS_MISC) + l * 1024, b, h, dir); } }
            { kargs_t A = kargs(); unsigned char* ws = A->ws; unsigned* qm = WSP(unsigned, WS_CTL) + CW_Q + 64 * (16 * l + 64 * (rep_ - 1) + 1);
              for (;;) { const int it = wg_pull(qm, slot); if (it >= 128) break;
                const int b = it >> 3, h = (it >> 1) & 3, dir = it & 1;
                if (!NO_ML && (rep_ == 1 || (REPMASK & 2))) mlstm_stream(lds, WSP(bf16, WS_P), WSP(float, WS_GATE), dir ? (bf16*)((unsigned char*)A->out + OUT_RAWM) : WSP(bf16, WS_HB) + Y_ML, dir ? 384 : D, A->in[I_MLFB] + l * 8, b, h, dir); } }
            { kargs_t A = kargs(); unsigned char* ws = A->ws; unsigned* qa = WSP(unsigned, WS_CTL) + CW_Q + 64 * (16 * l + 64 * (rep_ - 1) + 2);
              const int nq = with_ctx ? 72 : 64;
              const float lam_init = 0.8f - 0.6f * __expf(-0.3f * (float)l);
              const int myx = (int)(xb_xcc_id() & 7u);
              for (int k = 0; k < 8; ++k) { const int qx = (myx + k) & 7;
                for (;;) { const int it = wg_pull(qa + 64 * qx, slot); if (it >= nq) break;
                  const int bh = it < 64 ? (it >> 3) * 8 + qx : (it - 64) * 8 + qx, qb = it < 64 ? it & 7 : 8;
                  if (!NO_AT && (rep_ == 1 || (REPMASK & 4))) attn_item(lds, WSP(bf16, WS_P), WSP(bf16, WS_HB), A->in[I_DANORM] + l * 96, WSP(float, WS_MISC + 114688)[l], 1.0f - lam_init, bh >> 2, bh & 3, qb, rep_ == 2 ? ATT_PROBE : 0); } } }
            __syncthreads(); REPBAR();
        }
        SEAM(pb + 2);
        if (IN(pb + 3)) {
            kargs_t A = kargs(); unsigned char* ws = A->ws;
            fin_phase(r0, WSP(bf16, WS_P), WSP(bf16, WS_HB), (const bf16*)((const unsigned char*)A->out + OUT_RAWM), (const bf16*)((const unsigned char*)A->out + OUT_RAWH), A->in[I_MLNORM] + l * 384, A->in[I_HGNORM] + l * 256, vcu, G);
        }
        SEAM(pb + 3);
        if (IN(pb + 4)) REPEAT(5) {
            kargs_t A = kargs(); unsigned char* ws = A->ws;
            pg8::Gemm g{WSP(bf16, WS_HB) + (size_t)r0 * D, WSP(bf16, WS_WOUT), Mg, D, D}; pg8::StaticOrder S; S.init(Mg, D, G, bx);
            pg8::EpiBf E{WSP(bf16, WS_P) + (size_t)r0 * D, D};
            if (!NO_GEMM && !NO_G2) pg8::gemm_phase<pg8::EpiBf, pg8::StaticOrder, true, true>(lds, g, S, E); REPBAR();
        }
        SEAM(pb + 4);
        if (IN(pb + 5)) REPEAT(6) {
            kargs_t A = kargs(); unsigned char* ws = A->ws; const float* modl = WSP(float, WS_MOD) + (size_t)l * 17 * NMOD; bf16* xb = WSP(bf16, WS_XB);
            if (l == 0) thin_phase<true, true, true, false>(r0, A->in[I_X], A->in[I_CTX], nullptr, xb, true, WSP(bf16, WS_P), modl, 2 * D, A->in[I_GPOSTMIX] + l * D, modl, 3 * D, 4 * D, A->in[I_GPREFFN] + l * D, WSP(bf16, WS_HB), vcu, G, rep_ == 2 ? THIN_PROBE : 0);
            else        thin_phase<true, true, false, false>(r0, nullptr, nullptr, nullptr, xb, true, WSP(bf16, WS_P), modl, 2 * D, A->in[I_GPOSTMIX] + l * D, modl, 3 * D, 4 * D, A->in[I_GPREFFN] + l * D, WSP(bf16, WS_HB), vcu, G, 0);
            REPBAR();
        }
        SEAM(pb + 5);
        if (IN(pb + 6)) REPEAT(7) {
            kargs_t A = kargs(); unsigned char* ws = A->ws;
            pg8::Gemm g{WSP(bf16, WS_HB) + (size_t)r0 * D, WSP(bf16, WS_WGU), Mg, NGU, D}; pg8::StaticOrder S; S.init(Mg, NGU, G, bx);
            pg8::EpiSwiglu E{WSP(bf16, WS_P) + (size_t)r0 * DFF, DFF};
            if (!NO_GEMM && !NO_G3) pg8::gemm_phase<pg8::EpiSwiglu, pg8::StaticOrder, true, true>(lds, g, S, E); REPBAR();
        }
        SEAM(pb + 6);
        if (IN(pb + 7)) REPEAT(8) {
            kargs_t A = kargs(); unsigned char* ws = A->ws;
            pg8::Gemm g{WSP(bf16, WS_P) + (size_t)r0 * DFF, WSP(bf16, WS_WD), Mg, D, DFF}; pg8::StaticOrder S; S.init(Mg, D, G, bx);
            pg8::EpiBf E{WSP(bf16, WS_YD) + (size_t)r0 * D, D};
            if (!NO_GEMM && !NO_G4) pg8::gemm_phase<pg8::EpiBf, pg8::StaticOrder, true, true>(lds, g, S, E); REPBAR();
        }
        SEAM(pb + 7);
    }
    if (IN(NPHASE - 1)) {
        kargs_t A = kargs(); unsigned char* ws = A->ws; const float* modl = WSP(float, WS_MOD) + (size_t)(DEPTH - 1) * 17 * NMOD;
        thin_phase<true, false, false, true>(MC, nullptr, nullptr, A->out, WSP(bf16, WS_XB), true, WSP(bf16, WS_YD), modl, 5 * D, A->in[I_GPOSTFFN] + (DEPTH - 1) * D, nullptr, 0, 0, nullptr, nullptr, vcu, G);
#if STAMP_ON
        {
            __syncthreads();
            const unsigned long long* st = (const unsigned long long*)(ws + WS_MISC + 131072);
            const float d1 = (float)(long long)(__hip_atomic_load(st + SB, RLX_AGENT) - __hip_atomic_load(st + SA, RLX_AGENT)) * 1e-5f;
            const float d2 = (float)(long long)(__hip_atomic_load(st + SD, RLX_AGENT) - __hip_atomic_load(st + SC, RLX_AGENT)) * 1e-2f;
            const int tid = tid_opaque(); const int rwg = ML / G; float* o = A->out + (size_t)vcu * rwg * D;
            for (int i = tid; i < rwg * D; i += NTHR) o[i] *= (1.0f + d1);
            __syncthreads();
            if (bx == 0 && tid == 0) A->out[(size_t)vcu * rwg * D] = d2;
        }
#endif
    }
#undef IN
#undef SEAM
}

extern "C" void kernel_launch(void* const* d_in, const int* in_sizes, int n_in, void* d_out, int out_size, void* d_ws, size_t ws_size, hipStream_t stream) {
    static int grid = 0;
    if (grid == 0) {
        if (n_in != 22 || in_sizes[0] != ML * D || out_size != ML * D || ws_size < WS_END) {
            fprintf(stderr, "kernel_launch: unexpected shapes: n_in %d in0 %d out %d ws %zu (need %zu); nothing launched\n", n_in, n_in > 0 ? in_sizes[0] : -1, out_size, ws_size, (size_t)WS_END); grid = -1; return; }
        int dev = 0, cus = 0, per_cu = 0;
        if (hipGetDevice(&dev) != hipSuccess || hipDeviceGetAttribute(&cus, hipDeviceAttributeMultiprocessorCount, dev) != hipSuccess) { fprintf(stderr, "kernel_launch: device query failed\n"); grid = -1; return; }
        if (hipFuncSetAttribute((const void*)fwd, hipFuncAttributeMaxDynamicSharedMemorySize, LDS_BYTES) != hipSuccess) { fprintf(stderr, "kernel_launch: hipFuncSetAttribute failed\n"); grid = -1; return; }
        if (hipOccupancyMaxActiveBlocksPerMultiprocessor(&per_cu, (const void*)fwd, NTHR, LDS_BYTES) != hipSuccess || per_cu < 1)
            fprintf(stderr, "kernel_launch: note: occupancy query reports %d workgroups per CU\n", per_cu);
        (void)hipGetLastError();
        grid = cus;
    }
    if (grid < 0) return;
    if (hipMemsetAsync((char*)d_ws + WS_CTL, 0, CTL_ZERO_BYTES, stream) != hipSuccess) { fprintf(stderr, "kernel_launch: memset failed\n"); return; }
    Args a{};
    for (int i = 0; i < 22; ++i) a.in[i] = (const float*)d_in[i];
    a.out = (float*)d_out; a.ws = (unsigned char*)d_ws;
#if MK_PER_PHASE
    for (int p = 0; p < NPHASE; ++p) { a.ph_lo = p; a.ph_hi = p + 1; hipLaunchKernelGGL(fwd, dim3(grid), dim3(NTHR), LDS_BYTES, stream, a); }
#else
    a.ph_lo = 0; a.ph_hi = NPHASE;
    hipLaunchKernelGGL(fwd, dim3(grid), dim3(NTHR), LDS_BYTES, stream, a);
#endif
    const hipError_t le = hipPeekAtLastError();
    if (le != hipSuccess) fprintf(stderr, "kernel_launch: launch failed: %s\n", hipGetErrorName(le));
}
```

```cpp
#include <hip/hip_runtime.h>
#include <cstdio>
#include <cstdint>
#ifndef MK_PER_PHASE
#define MK_PER_PHASE 0
#endif
namespace pg8 {
#define PG8_LAS __attribute__((address_space(3)))
typedef unsigned short bf16_t;
typedef short bf16x8 __attribute__((ext_vector_type(8)));
typedef float f32x4 __attribute__((ext_vector_type(4)));
typedef unsigned u32x4 __attribute__((ext_vector_type(4)));
constexpr int BM = 256, BK = 64, HALF = 128, HTB = HALF * BK * 2  , STAGE_BYTES = 8 * HTB, NXCD = 8, WGM = 8;

__host__ __device__ __forceinline__ int lds_byte(int r, int c) { const int st = (r >> 4) * 2 + (c >> 5), rr = r & 15, cc = c & 31, ob = rr * 64 + cc * 2; return st * 1024 + (ob ^ (((ob >> 9) & 1) << 5)); }
__host__ __device__ __forceinline__ void stage_rc(int b, int& R, int& C) { const int st = b / 1024, sb = b % 1024, swz = sb ^ (((sb >> 9) & 1) << 5); R = (st >> 1) * 16 + swz / 64; C = (st & 1) * 32 + (swz % 64) / 2; }
__host__ __device__ __forceinline__ int perm32(int rho) { const int n = rho >> 4, i = rho & 15; return 8 * (i >> 2) + 4 * n + (i & 3); }

struct Unit { int pm, pn; };
struct Gemm { const bf16_t* A; const bf16_t* Bt; int M, N, K; };

struct StaticOrder {
    int nM, nN, nwg, G, c;
    __host__ __device__ void init(int M, int N, int G_, int c_) { nM = M / BM; nN = N / BM; nwg = nM * nN; G = G_; c = c_; }
    __host__ __device__ bool next(int i, Unit& u) const {
        const long L = (long)i * G + c; if (L >= nwg) return false;
        int wgid = (int)L; { const int q = nwg / NXCD, r = nwg % NXCD, xcd = wgid % NXCD, off = wgid / NXCD; wgid = (xcd < r ? xcd * (q + 1) : r * (q + 1) + (xcd - r) * q) + off; }
        const int nig = WGM * nN, gid = wgid / nig, fm = gid * WGM, gsz = (nM - fm) < WGM ? (nM - fm) : WGM;
        u.pm = fm + ((wgid % nig) % gsz); u.pn = (wgid % nig) / gsz; return true;
    }
    __device__ __forceinline__ void a_ready(const Unit&) const {}
    __device__ __forceinline__ void done(const Unit&) const {}
};
__device__ __forceinline__ unsigned cvt_pk_bf16(float lo, float hi) { unsigned r; asm volatile("v_cvt_pk_bf16_f32 %0, %1, %2" : "=v"(r) : "v"(lo), "v"(hi)); return r; }
struct EpiF32 {
    static constexpr bool PERM = false, AFTER_DRAIN = false;
    float* C; int ldc;
    __device__ __forceinline__ void operator()(const f32x4 (&acc)[2][2][4][2], const Unit& u, int wr, int wc, int fr, int fq) const {
        const int row0 = u.pm * BM + wr * 64 + fr, col0 = u.pn * BM + wc * 32 + 4 * fq;
#pragma unroll
        for (int ai = 0; ai < 2; ++ai)
#pragma unroll
            for (int m = 0; m < 4; ++m) { float* rowp = C + (size_t)(row0 + ai * HALF + m * 16) * ldc + col0;
#pragma unroll
                for (int bj = 0; bj < 2; ++bj)
#pragma unroll
                    for (int n = 0; n < 2; ++n) *(f32x4*)(rowp + bj * HALF + n * 16) = acc[ai][bj][m][n]; }
    }
};
struct EpiBf {
    static constexpr bool PERM = true, AFTER_DRAIN = false;
    bf16_t* O; int ldc;
    __device__ __forceinline__ void operator()(const f32x4 (&acc)[2][2][4][2], const Unit& u, int wr, int wc, int fr, int fq) const {
        const int row0 = u.pm * BM + wr * 64 + fr; const int col0 = u.pn * BM + wc * 32 + 8 * fq;
#pragma unroll
        for (int ai = 0; ai < 2; ++ai)
#pragma unroll
            for (int m = 0; m < 4; ++m) { bf16_t* rowp = O + (size_t)(row0 + ai * HALF + m * 16) * ldc + col0;
#pragma unroll
                for (int bj = 0; bj < 2; ++bj) { const f32x4 v0 = acc[ai][bj][m][0], v1 = acc[ai][bj][m][1];
                    u32x4 w; w.x = cvt_pk_bf16(v0[0], v0[1]); w.y = cvt_pk_bf16(v0[2], v0[3]); w.z = cvt_pk_bf16(v1[0], v1[1]); w.w = cvt_pk_bf16(v1[2], v1[3]);
                    *(u32x4*)(rowp + bj * HALF) = w; } }
    }
};
constexpr unsigned EI_KIND = 1u << 16, EI_SKIP = 1u << 17, EI_DA = 1u << 18, EI_Q = 1u << 19, EI_HF = 1u << 20;
__host__ __device__ __forceinline__ void epi_in_entry(int g, unsigned& x, unsigned& y) {
    const int c = 8 * g; x = 0u; y = EI_SKIP;
    if (c < 1152)      { const int f = c / 384, hh = (c % 384) / 96, o = c % 96;            x = 0u         + (unsigned)hh * 2304u * 576u + (unsigned)(f * 96 + o) * 2u; y = 576u; }
    else if (c < 1536) { x = 301989888u + (unsigned)(c - 1152) * 2u; y = 768u | EI_KIND; }
    else if (c < 1552) { }
    else if (c < 2064) { const int hh = (c - 1552) / 128, o = (c - 1552) % 128;             x = 84934656u  + (unsigned)hh * 2304u * 896u + (unsigned)(256 + o) * 2u; y = 896u; }
    else if (c < 3088) { const int d = (c - 2064) / 512, hh = ((c - 2064) % 512) / 128, o = (c - 2064) % 128; x = 84934656u + (unsigned)hh * 2304u * 896u + (unsigned)(d * 128 + o) * 2u; y = 896u; }
    else if (c < 3344) { const int hh = (c - 3088) / 64, o = (c - 3088) % 64;               x = 84934656u  + (unsigned)hh * 2304u * 896u + (unsigned)(384 + o) * 2u; y = 896u; }
    else if (c < 3600) { x = 330301440u + (unsigned)(c - 3344) * 2u; y = 512u | EI_KIND; }
    else if (c < 4752) { const int f = (c - 3600) / 384, hh = ((c - 3600) % 384) / 96, o = (c - 3600) % 96; x = 217055232u + (unsigned)hh * 2304u * 576u + (unsigned)(f * 96 + o) * 2u; y = 576u;
                         if (c < 4368) { const int d48 = (c - 3600) % 48, hf = d48 >= 24 ? 1 : 0, i0 = (d48 - 24 * hf) >> 1; y |= EI_DA | (c < 3984 ? EI_Q : 0u) | (hf ? EI_HF : 0u) | ((unsigned)i0 << 24); } }
}
struct EpiIn {
    static constexpr bool PERM = true, AFTER_DRAIN = false;
    unsigned char* PX; const PG8_LAS float* bias; float* G; const PG8_LAS float* rope; const PG8_LAS unsigned* tab; int mc; float qscale;
    __device__ __forceinline__ void operator()(const f32x4 (&acc)[2][2][4][2], const Unit& u, int wr, int wc, int fr, int fq) const {
        const int trow0 = u.pm * BM;
        const int bat = trow0 < mc ? trow0 >> 8 : (trow0 - mc) >> 11; const int slot0 = trow0 < mc ? (trow0 & 255) : 256 + ((trow0 - mc) & 2047);
        const unsigned rc_blk = (unsigned)(bat * 4 * 2304 + slot0), rc_row = (unsigned)trow0;
        const int rin = wr * 64 + fr;
        const int col0 = u.pn * BM + wc * 32 + 8 * fq;
        const bool gate_lane = (u.pn == 6) && (wc == 0) && (fq < 2);
#pragma unroll
        for (int bj = 0; bj < 2; ++bj) {
            const int c = col0 + bj * HALF;
            const f32x4 b0 = *(const PG8_LAS f32x4*)(bias + c), b1 = *(const PG8_LAS f32x4*)(bias + c + 4);
            const unsigned ex = tab[2 * (c >> 3)], ey = tab[2 * (c >> 3) + 1];
            const unsigned ld = ey & 0xffffu;
            const unsigned off = ex + ((ey & EI_KIND) ? rc_row : rc_blk) * ld + (unsigned)rin * ld;
            const bool skip = (ey & EI_SKIP) != 0u, is_da = (ey & EI_DA) != 0u, is_q = (ey & EI_Q) != 0u; const int hf = (ey & EI_HF) ? 1 : 0, i0 = (int)(ey >> 24);
#pragma unroll
            for (int ai = 0; ai < 2; ++ai)
#pragma unroll
                for (int m = 0; m < 4; ++m) { const int row = trow0 + rin + ai * HALF + m * 16;
                    f32x4 v0 = acc[ai][bj][m][0] + b0, v1 = acc[ai][bj][m][1] + b1;
                    if (is_da) {
                        if (row >= mc) { const int t = (row - mc) & 2047; const int pos = hf ? (t & 63) : (t >> 6);
                            const f32x4 cs0 = *(const PG8_LAS f32x4*)(rope + pos * 24 + 2 * i0), cs1 = *(const PG8_LAS f32x4*)(rope + pos * 24 + 2 * i0 + 4);
                            const f32x4 r0 = {v0[0] * cs0[0] - v0[1] * cs0[1], v0[0] * cs0[1] + v0[1] * cs0[0], v0[2] * cs0[2] - v0[3] * cs0[3], v0[2] * cs0[3] + v0[3] * cs0[2]};
                            const f32x4 r1 = {v1[0] * cs1[0] - v1[1] * cs1[1], v1[0] * cs1[1] + v1[1] * cs1[0], v1[2] * cs1[2] - v1[3] * cs1[3], v1[2] * cs1[3] + v1[3] * cs1[2]};
                            v0 = r0; v1 = r1; }
                        if (is_q) { v0 = v0 * qscale; v1 = v1 * qscale; } }
                    if (!skip) { u32x4 w; w.x = cvt_pk_bf16(v0[0], v0[1]); w.y = cvt_pk_bf16(v0[2], v0[3]); w.z = cvt_pk_bf16(v1[0], v1[1]); w.w = cvt_pk_bf16(v1[2], v1[3]);
                        *(u32x4*)(PX + (off + (unsigned)(ai * HALF + m * 16) * ld)) = w; }
                    if (bj == 0 && gate_lane) { float* g = G + (size_t)row * 16 + 8 * fq; *(f32x4*)g = v0; *(f32x4*)(g + 4) = v1; } }
        }
    }
};
struct EpiSwiglu {
    static constexpr bool PERM = true, AFTER_DRAIN = false;
    bf16_t* O; int ldc;
    __device__ __forceinline__ void operator()(const f32x4 (&acc)[2][2][4][2], const Unit& u, int wr, int wc, int fr, int fq) const {
        const int row0 = u.pm * BM + wr * 64 + fr; const int col0 = u.pn * HALF + wc * 32 + 8 * fq;
#pragma unroll
        for (int ai = 0; ai < 2; ++ai)
#pragma unroll
            for (int m = 0; m < 4; ++m) { bf16_t* rowp = O + (size_t)(row0 + ai * HALF + m * 16) * ldc + col0;
                f32x4 r0, r1;
#pragma unroll
                for (int i = 0; i < 4; ++i) { const float g0 = acc[ai][0][m][0][i], g1 = acc[ai][0][m][1][i];
                    r0[i] = g0 * __builtin_amdgcn_rcpf(1.0f + __expf(-g0)) * acc[ai][1][m][0][i];
                    r1[i] = g1 * __builtin_amdgcn_rcpf(1.0f + __expf(-g1)) * acc[ai][1][m][1][i]; }
                u32x4 w; w.x = cvt_pk_bf16(r0[0], r0[1]); w.y = cvt_pk_bf16(r0[2], r0[3]); w.z = cvt_pk_bf16(r1[0], r1[1]); w.w = cvt_pk_bf16(r1[2], r1[3]);
                *(u32x4*)rowp = w; }
    }
};
template <class Epi, class Sched, bool ALIGN_EPI = false, bool SP2 = false>
__device__ __forceinline__ void gemm_phase(PG8_LAS unsigned char* lds, const Gemm g, const Sched& S, const Epi& E) {
    int tid_ = threadIdx.x; asm volatile("" : "+v"(tid_));
    const int tid = tid_, wid = __builtin_amdgcn_readfirstlane(tid >> 6), lane = tid & 63, wr = wid >> 2, wc = wid & 3, fr = lane & 15, fq = lane >> 4;
    const int K = g.K, nt = K / BK;
    unsigned voffA[2], voffB[2];
#pragma unroll
    for (int i = 0; i < 2; ++i) { int R, C; stage_rc(tid * 16 + i * 8192, R, C); const int Rb = Epi::PERM ? ((R & ~31) + perm32(R & 31)) : R;
        voffA[i] = (unsigned)(R * K + C) * 2u; voffB[i] = (unsigned)(Rb * K + C) * 2u; }
    const size_t kstep = (size_t)(BK * 2);
    const size_t hstep = (size_t)HALF * K * 2;
    const size_t tstep = 2 * hstep;
    const unsigned ldsw = (unsigned)wid * 1024u;
    const int aoff = lds_byte(wr * 64 + fr, fq * 8), boff = lds_byte(wc * 32 + fr, fq * 8);
#define PG8_SA(b, h) (((b) * 2 + (h)) * HTB)
#define PG8_SB(b, h) ((4 + (b) * 2 + (h)) * HTB)
#define PG8_STAGE(bufoff, gbase, voff) do { _Pragma("unroll") for (int _i = 0; _i < 2; ++_i) \
        __builtin_amdgcn_global_load_lds((const unsigned*)((const char*)(gbase) + (voff)[_i]), (PG8_LAS unsigned*)(lds + (bufoff) + ldsw + _i * 8192), 16, 0, 0); } while (0)
#define PG8_LDA(dst, b, h) do { _Pragma("unroll") for (int m = 0; m < 4; ++m) _Pragma("unroll") for (int k = 0; k < 2; ++k) dst[m][k] = *(const PG8_LAS bf16x8*)(lds + PG8_SA(b, h) + aoff + m * 2048 + k * 1024); } while (0)
#define PG8_LDB(dst, b, h) do { _Pragma("unroll") for (int n = 0; n < 2; ++n) _Pragma("unroll") for (int k = 0; k < 2; ++k) dst[n][k] = *(const PG8_LAS bf16x8*)(lds + PG8_SB(b, h) + boff + n * 2048 + k * 1024); } while (0)
#define PG8_MMA(ai, bj, At, Bt) do { __builtin_amdgcn_s_setprio(1); _Pragma("unroll") for (int m = 0; m < 4; ++m) _Pragma("unroll") for (int n = 0; n < 2; ++n) _Pragma("unroll") for (int k = 0; k < 2; ++k) \
        acc[ai][bj][m][n] = __builtin_amdgcn_mfma_f32_16x16x32_bf16(Bt[n][k], At[m][k], acc[ai][bj][m][n], 0, 0, 0); __builtin_amdgcn_s_setprio(0); } while (0)
#define PG8_WAIT_V(n) asm volatile("s_waitcnt vmcnt(" #n ")" ::: "memory")
#define PG8_WAIT_L(n) asm volatile("s_waitcnt lgkmcnt(" #n ")" ::: "memory")
#define PG8_BAR __builtin_amdgcn_s_barrier()
#define PG8_SCHED __builtin_amdgcn_sched_barrier(0)
    Unit cur, nxt; int ui = 0;
    if (!S.next(0, cur)) return;
    f32x4 acc[2][2][4][2];
#pragma unroll
    for (int a = 0; a < 2; ++a)
#pragma unroll
        for (int b = 0; b < 2; ++b)
#pragma unroll
            for (int m = 0; m < 4; ++m)
#pragma unroll
                for (int n = 0; n < 2; ++n) acc[a][b][m][n] = (f32x4){0.f, 0.f, 0.f, 0.f};
    bf16x8 At[4][2], B0[2][2], B1[2][2];
    const char* cA = (const char*)g.A + (size_t)cur.pm * tstep; const char* cB = (const char*)g.Bt + (size_t)cur.pn * tstep;
    S.a_ready(cur);
    if constexpr (SP2) {
        PG8_STAGE(PG8_SB(0, 0), cB, voffB); PG8_STAGE(PG8_SB(0, 1), cB + hstep, voffB); PG8_STAGE(PG8_SA(0, 0), cA, voffA); PG8_STAGE(PG8_SA(0, 1), cA + hstep, voffA);
        if (wr == 1) PG8_BAR;
        PG8_WAIT_V(2); PG8_BAR;
        PG8_STAGE(PG8_SB(1, 0), cB + kstep, voffB); PG8_STAGE(PG8_SA(1, 0), cA + kstep, voffA); PG8_STAGE(PG8_SB(1, 1), cB + hstep + kstep, voffB);
        PG8_WAIT_V(6); PG8_BAR;
    } else {
        PG8_STAGE(PG8_SB(0, 0), cB, voffB); PG8_STAGE(PG8_SA(0, 0), cA, voffA); PG8_STAGE(PG8_SB(0, 1), cB + hstep, voffB); PG8_STAGE(PG8_SA(0, 1), cA + hstep, voffA);
        if (wr == 1) PG8_BAR;
        PG8_WAIT_V(4); PG8_BAR;
        PG8_STAGE(PG8_SB(1, 0), cB + kstep, voffB); PG8_STAGE(PG8_SA(1, 0), cA + kstep, voffA); PG8_STAGE(PG8_SB(1, 1), cB + hstep + kstep, voffB);
        PG8_WAIT_V(6); PG8_BAR;
    }
    for (;;) {
        const bool has_next = S.next(ui + 1, nxt);
        const char* nA = has_next ? (const char*)g.A + (size_t)nxt.pm * tstep : cA; const char* nB = has_next ? (const char*)g.Bt + (size_t)nxt.pn * tstep : cB;
        for (int t = 0; t < nt; t += 2) {
            const bool last = (t == nt - 2);
            const char* a1 = cA + (size_t)(t + 1) * kstep;
            const char* a2 = last ? nA : cA + (size_t)(t + 2) * kstep; const char* b2 = last ? nB : cB + (size_t)(t + 2) * kstep;
            const char* a3 = a2 + kstep; const char* b3 = b2 + kstep;
            if (last && has_next) S.a_ready(nxt);
            if constexpr (SP2) {
            PG8_LDB(B0, 0, 0); PG8_LDB(B1, 0, 1); PG8_SCHED; PG8_LDA(At, 0, 0); PG8_STAGE(PG8_SA(1, 1), a1 + hstep, voffA);
            PG8_WAIT_V(8); PG8_WAIT_L(0); PG8_BAR; PG8_MMA(0, 0, At, B0); PG8_MMA(0, 1, At, B1); PG8_BAR; PG8_SCHED;
            PG8_LDA(At, 0, 1); PG8_STAGE(PG8_SB(0, 0), b2, voffB); PG8_STAGE(PG8_SB(0, 1), b2 + hstep, voffB); PG8_STAGE(PG8_SA(0, 0), a2, voffA);
            PG8_WAIT_V(8); PG8_WAIT_L(0); PG8_BAR; PG8_MMA(1, 0, At, B0); PG8_MMA(1, 1, At, B1); PG8_BAR; PG8_SCHED;
            PG8_LDB(B0, 1, 0); PG8_LDB(B1, 1, 1); PG8_SCHED; PG8_LDA(At, 1, 0); PG8_STAGE(PG8_SA(0, 1), a2 + hstep, voffA);
            PG8_WAIT_V(8); PG8_WAIT_L(0); PG8_BAR; PG8_MMA(0, 0, At, B0); PG8_MMA(0, 1, At, B1); PG8_BAR; PG8_SCHED;
            PG8_LDA(At, 1, 1); PG8_STAGE(PG8_SB(1, 0), b3, voffB); PG8_STAGE(PG8_SB(1, 1), b3 + hstep, voffB); PG8_STAGE(PG8_SA(1, 0), a3, voffA);
            PG8_WAIT_V(8); PG8_WAIT_L(0); PG8_BAR; PG8_MMA(1, 0, At, B0); PG8_MMA(1, 1, At, B1); PG8_BAR; PG8_SCHED;
            } else {
            PG8_LDB(B0, 0, 0); PG8_SCHED; PG8_LDA(At, 0, 0); PG8_STAGE(PG8_SA(1, 1), a1 + hstep, voffA);
            PG8_WAIT_L(8); PG8_BAR; PG8_WAIT_L(0); PG8_MMA(0, 0, At, B0); PG8_BAR; PG8_SCHED;
            PG8_LDB(B1, 0, 1); PG8_STAGE(PG8_SB(0, 0), b2, voffB);
            PG8_BAR; PG8_WAIT_L(0); PG8_MMA(0, 1, At, B1); PG8_BAR;
            PG8_LDA(At, 0, 1); PG8_STAGE(PG8_SA(0, 0), a2, voffA);
            PG8_BAR; PG8_WAIT_L(0); PG8_MMA(1, 0, At, B0); PG8_BAR; PG8_SCHED;
            PG8_STAGE(PG8_SB(0, 1), b2 + hstep, voffB);
            PG8_WAIT_V(6); PG8_BAR; PG8_MMA(1, 1, At, B1); PG8_BAR;
            PG8_LDB(B0, 1, 0); PG8_SCHED; PG8_LDA(At, 1, 0); PG8_STAGE(PG8_SA(0, 1), a2 + hstep, voffA);
            PG8_WAIT_L(8); PG8_BAR; PG8_WAIT_L(0); PG8_MMA(0, 0, At, B0); PG8_BAR; PG8_SCHED;
            PG8_LDB(B1, 1, 1); PG8_STAGE(PG8_SB(1, 0), b3, voffB);
            PG8_BAR; PG8_WAIT_L(0); PG8_MMA(0, 1, At, B1); PG8_BAR;
            PG8_LDA(At, 1, 1); PG8_STAGE(PG8_SA(1, 0), a3, voffA);
            PG8_BAR; PG8_WAIT_L(0); PG8_MMA(1, 0, At, B0); PG8_BAR; PG8_SCHED;
            PG8_STAGE(PG8_SB(1, 1), b3 + hstep, voffB);
            PG8_WAIT_V(6); PG8_BAR; PG8_MMA(1, 1, At, B1); PG8_BAR;
            }
        }
        if constexpr (ALIGN_EPI) { if (wr == 0) PG8_BAR; }
        if constexpr (!Epi::AFTER_DRAIN) { E(acc, cur, wr, wc, fr, fq); S.done(cur); }
        if (!has_next) break;
#pragma unroll
        for (int a = 0; a < 2; ++a)
#pragma unroll
            for (int b = 0; b < 2; ++b)
#pragma unroll
                for (int m = 0; m < 4; ++m)
#pragma unroll
                    for (int n = 0; n < 2; ++n) acc[a][b][m][n] = (f32x4){0.f, 0.f, 0.f, 0.f};
        cur = nxt; cA = nA; cB = nB; ++ui;
        if constexpr (ALIGN_EPI) { if (wr == 1) PG8_BAR; }
    }
    PG8_WAIT_V(0);
    if constexpr (!ALIGN_EPI) { if (wr == 0) PG8_BAR; }
    PG8_BAR;
    if constexpr (Epi::AFTER_DRAIN) { E.fused(acc, cur, wr, wc, fr, fq, lds, wid, lane); S.done(cur); }
#undef PG8_SA
#undef PG8_SB
#undef PG8_STAGE
#undef PG8_LDA
#undef PG8_LDB
#undef PG8_MMA
#undef PG8_WAIT_V
#undef PG8_WAIT_L
#undef PG8_BAR
#undef PG8_SCHED
}
}
constexpr int D = 1024, NB = 16, SEQ = 2048, CTXL = 256, DEPTH = 4;
constexpr int MC = NB * CTXL, ML = NB * SEQ, MT = MC + ML;
constexpr int DIN = 4752, DINP = 4864, DFF = 2816, NGU = 2 * DFF, NMOD = 6 * D;
constexpr int C_MLQ = 0, C_MLK = 384, C_MLV = 768, C_MLO = 1152, C_MLI = 1536, C_MLF = 1544, C_HGQ = 1552, C_HGF = 2064, C_HGI = 3088, C_HGG = 3344, C_DAQ = 3600, C_DAK = 3984, C_DAV = 4368;
constexpr int Y_ML = 0, Y_HG = 384, Y_DA = 640;
constexpr float EPS = 1e-6f;
constexpr int NTOK = CTXL + SEQ;
static_assert(C_MLI == 6 * 256, "gate columns must open GEMM tile 6");
constexpr int NSLOT = CTXL + SEQ;
constexpr unsigned MLX_LD = 576, HGX_LD = 896, DAX_LD = 576, MLO_LD = 768, HGG_LD = 512;
constexpr size_t MLX_OFF = 0, HGX_OFF = MLX_OFF + (size_t)64 * NSLOT * MLX_LD, DAX_OFF = HGX_OFF + (size_t)64 * NSLOT * HGX_LD, MLO_OFF = DAX_OFF + (size_t)64 * NSLOT * DAX_LD, HGG_OFF = MLO_OFF + (size_t)MT * MLO_LD, PX_END = HGG_OFF + (size_t)MT * HGG_LD;
static_assert(HGX_OFF == 84934656ull && DAX_OFF == 217055232ull && MLO_OFF == 301989888ull && HGG_OFF == 330301440ull, "EpiIn hard-codes these offsets");

constexpr size_t MiB = 1u << 20;
constexpr size_t KiB = 1u << 10;
constexpr size_t WS_CTL = 0, CTL_ZERO_BYTES = 256 * KiB;
constexpr size_t WS_MOD = 256 * KiB;
constexpr size_t WS_MISC = 2 * MiB;
constexpr size_t WS_GATE = 2 * MiB + 256 * KiB;
constexpr size_t WS_WIN = 4 * MiB + 512 * KiB, WS_WOUT = WS_WIN + (size_t)DINP * D * 2, WS_WGU = WS_WOUT + (size_t)D * D * 2, WS_WD = WS_WGU + (size_t)NGU * D * 2;
constexpr size_t WS_XB = 32 * MiB + 512 * KiB;
constexpr size_t WS_HB = WS_XB + (size_t)MT * D * 2;
constexpr size_t WS_P = WS_HB + (size_t)MT * D * 2;
constexpr size_t WS_YD = WS_P + 198 * MiB, WS_END = WS_P + 333 * MiB + 64 * KiB;
constexpr size_t OUT_RAWM = 0, OUT_RAWH = 27 * MiB;
static_assert(WS_MOD + (size_t)DEPTH * 17 * NMOD * 4 <= WS_MISC && WS_GATE + (size_t)MT * 16 * 4 <= WS_WIN, "small buffers");
static_assert(WS_WD + (size_t)D * DFF * 2 <= WS_XB, "weights fit");
static_assert(OUT_RAWM + (size_t)MT * 384 * 2 <= OUT_RAWH && OUT_RAWH + (size_t)MT * 256 * 2 <= (size_t)ML * D * 4, "raw buffers fit d_out");
static_assert(WS_P + PX_END <= WS_END, "mixer operand blocks fit the P region");
static_assert(WS_YD + (size_t)MT * D * 2 <= WS_END && (size_t)MT * DFF * 2 <= 198 * MiB && WS_END <= 512 * MiB, "P region");
constexpr int CW_BAR = 4096;
constexpr int CW_Q = 16384;

constexpr int RING_BYTES = 131072, LDSCTL_OFF = RING_BYTES, LDS_BYTES = 163840;
constexpr int LDS_BIAS = LDSCTL_OFF + 1024, LDS_ROPE = LDS_BIAS + DINP * 4, LDS_ETAB = LDS_ROPE + 64 * 24 * 4;
static_assert(LDS_ETAB + (DINP / 8) * 8 <= LDS_BYTES, "LDS map");
constexpr int NWAVES = 8, NTHR = 512;

#define GAS __attribute__((address_space(1)))
#define LAS __attribute__((address_space(3)))
typedef unsigned short bf16;
typedef unsigned v4u __attribute__((ext_vector_type(4)));
typedef unsigned v2u __attribute__((ext_vector_type(2)));
typedef float f32x4 __attribute__((ext_vector_type(4)));
typedef float f32x16 __attribute__((ext_vector_type(16)));
typedef short bf16x8 __attribute__((ext_vector_type(8)));
typedef GAS unsigned gu32;
typedef LAS unsigned char* lptr;
#define RLX_AGENT __ATOMIC_RELAXED, __HIP_MEMORY_SCOPE_AGENT
#define LDS_WAIT() asm volatile("s_waitcnt lgkmcnt(0)" ::: "memory")
#define VM_WAIT() asm volatile("s_waitcnt vmcnt(0)" ::: "memory")
__device__ __forceinline__ unsigned f2bf(float f) { unsigned u = __builtin_bit_cast(unsigned, f); return (u + 0x7fffu + ((u >> 16) & 1u)) >> 16; }
typedef float f32x2_t __attribute__((ext_vector_type(2))); typedef __bf16 bf16x2_t __attribute__((ext_vector_type(2)));
__device__ __forceinline__ unsigned pk2(float lo, float hi) { f32x2_t v = {lo, hi}; bf16x2_t b = __builtin_convertvector(v, bf16x2_t); return __builtin_bit_cast(unsigned, b); }
__device__ __forceinline__ float bflo(unsigned w) { return __builtin_bit_cast(float, w << 16); }
__device__ __forceinline__ float bfhi(unsigned w) { return __builtin_bit_cast(float, w & 0xffff0000u); }
__device__ __forceinline__ float bf2f(bf16 v) { return __builtin_bit_cast(float, (unsigned)v << 16); }
__device__ __forceinline__ float lx_idx(float v, int src) { return __builtin_bit_cast(float, __builtin_amdgcn_ds_bpermute(src << 2, __builtin_bit_cast(int, v))); }
__device__ __forceinline__ float lx_xor(float v, int mask, int lane) { return lx_idx(v, lane ^ mask); }
__device__ __forceinline__ float lx_up(float v, int d, int lane) { return lx_idx(v, lane >= d ? lane - d : lane); }
template <int CTRL, int RMASK> __device__ __forceinline__ float dpp_f(float oldv, float v) { return __builtin_bit_cast(float, __builtin_amdgcn_update_dpp(__builtin_bit_cast(int, oldv), __builtin_bit_cast(int, v), CTRL, RMASK, 0xf, false)); }
__device__ __forceinline__ float scan_sum64(float v) {
    v += dpp_f<0x111, 0xf>(0.f, v); v += dpp_f<0x112, 0xf>(0.f, v); v += dpp_f<0x114, 0xf>(0.f, v); v += dpp_f<0x118, 0xf>(0.f, v);
    v += dpp_f<0x142, 0xa>(0.f, v); v += dpp_f<0x143, 0xc>(0.f, v); return v; }
__device__ __forceinline__ float scan_max64(float v) { const float ninf = -3.0e38f;
    v = fmaxf(v, dpp_f<0x111, 0xf>(ninf, v)); v = fmaxf(v, dpp_f<0x112, 0xf>(ninf, v)); v = fmaxf(v, dpp_f<0x114, 0xf>(ninf, v)); v = fmaxf(v, dpp_f<0x118, 0xf>(ninf, v));
    v = fmaxf(v, dpp_f<0x142, 0xa>(ninf, v)); v = fmaxf(v, dpp_f<0x143, 0xc>(ninf, v)); return v; }
__device__ __forceinline__ float wave_sum(float v, int lane) {
#pragma unroll
    for (int o = 1; o < 64; o <<= 1) v += lx_xor(v, o, lane);
    return v;
}
#define MFMA32(a, b, c) __builtin_amdgcn_mfma_f32_32x32x16_bf16((a), (b), (c), 0, 0, 0)
#define MFMA16(a, b, c) __builtin_amdgcn_mfma_f32_16x16x32_bf16((a), (b), (c), 0, 0, 0)
__device__ __forceinline__ int tid_opaque() { int t = threadIdx.x; asm volatile("" : "+v"(t)); return t; }
__device__ __forceinline__ bf16x8 lds8(lptr p) { return *(const LAS bf16x8*)p; }
__device__ __forceinline__ v4u gld16(const void* base, unsigned off) { return *(const v4u*)((const char*)base + off); }
__device__ __forceinline__ void gst8(void* base, unsigned off, v2u v) { *(v2u*)((char*)base + off) = v; }
typedef short v4i16 __attribute__((ext_vector_type(4)));
__device__ __forceinline__ bf16x8 opr(lptr img, int ldb, int r0, int k0, int c16, int rg) { return lds8(img + (r0 + c16) * ldb + (k0 + 8 * rg) * 2); }
__device__ __forceinline__ bf16x8 opt(lptr img, int ldb, int r0, int k0, int lane) {
    const int g = lane >> 4, q = (lane & 15) >> 2, p = lane & 3;
    lptr a = img + (k0 + 8 * g + q) * ldb + (r0 + 4 * p) * 2;
    const v4i16 lo = __builtin_amdgcn_ds_read_tr16_b64_v4i16((LAS v4i16*)a);
    const v4i16 hi = __builtin_amdgcn_ds_read_tr16_b64_v4i16((LAS v4i16*)(a + 4 * ldb));
    return __builtin_shufflevector(lo, hi, 0, 1, 2, 3, 4, 5, 6, 7);
}

#define XB_TMO      128
#define XB_XCNT(j)  (256  + 64 * (j))
#define XB_XSUB(j)  (1280 + 64 * (j))
#define XB_XGEN(j)  (2304 + 64 * (j))
#define XB_TOP      3328
#define XB_TOPGEN   3392
#define XCD_BAR_WORDS 3456
#define XB_SPIN_CAP (1u << 18)

__device__ __forceinline__ unsigned xb_ld(unsigned* p)              { return __hip_atomic_load(p, __ATOMIC_RELAXED, __HIP_MEMORY_SCOPE_AGENT); }
__device__ __forceinline__ unsigned xb_add(unsigned* p, unsigned v) { return __hip_atomic_fetch_add(p, v, __ATOMIC_RELAXED, __HIP_MEMORY_SCOPE_AGENT); }
__device__ __forceinline__ unsigned xb_xcc_id() { return (unsigned)__builtin_amdgcn_s_getreg((3 << 11) | 20) & 0xFu; }
#define XB_SPIN(cond, bar) do { unsigned _sp = 0; while (cond) { __builtin_amdgcn_s_sleep(1); \
    if ((++_sp & 255u) == 0u) { if (xb_ld(&(bar)[XB_TMO])) break; if (_sp > XB_SPIN_CAP) { atomicAdd(&(bar)[XB_TMO], 1u); break; } } } } while (0)

struct XcdBarrier {
    unsigned* bar; unsigned x;
    volatile LAS unsigned* st;
};

__device__ __forceinline__ XcdBarrier xcd_barrier_post(unsigned* bar, volatile LAS unsigned* st) {
    XcdBarrier b; b.bar = bar; b.x = xb_xcc_id(); b.st = st;
    if (threadIdx.x == 0) (void)xb_add(&bar[XB_XCNT(b.x)], 1u);
    return b;
}
__device__ __forceinline__ void xcd_barrier_complete(unsigned* bar, unsigned x, unsigned& nloc, unsigned& nx) {
    const unsigned G = gridDim.x * gridDim.y * gridDim.z;
    unsigned sum, cnt, mine, sp = 0u;
    for (;;) {
        sum = 0u; cnt = 0u; mine = 0u;
#pragma unroll
        for (unsigned j = 0; j < 16; ++j) { const unsigned c = xb_ld(&bar[XB_XCNT(j)]); sum += c; cnt += (c > 0u) ? 1u : 0u; mine = (j == x) ? c : mine; }
        if (sum == G) break;
        __builtin_amdgcn_s_sleep(1);
        if ((++sp & 255u) == 0u) { if (xb_ld(&bar[XB_TMO])) break; if (sp > XB_SPIN_CAP) { atomicAdd(&bar[XB_TMO], 1u); break; } }
    }
    nloc = mine > 0u ? mine : 1u; nx = cnt > 0u ? cnt : 1u;
}

__device__ __forceinline__ void xcd_barrier(const XcdBarrier& b) {
    asm volatile("s_waitcnt vmcnt(0)" ::: "memory");
    __syncthreads();
    if (threadIdx.x == 0) {
        unsigned* bar = b.bar;
        __builtin_amdgcn_s_waitcnt(0);
        unsigned nloc = b.st[0], nx = b.st[1];
        if (nloc == 0u) { xcd_barrier_complete(bar, b.x, nloc, nx); b.st[0] = nloc; b.st[1] = nx; }
        const unsigned old = xb_add(&bar[XB_XSUB(b.x)], 1u);
        const unsigned gen = old / nloc;
        if (old + 1u == (gen + 1u) * nloc) {
            __builtin_amdgcn_fence(__ATOMIC_RELEASE, "agent");
            asm volatile("s_waitcnt vmcnt(0)" ::: "memory");
            const unsigned og = xb_add(&bar[XB_TOP], 1u);
            const unsigned tg = og / nx;
            if (og + 1u == (tg + 1u) * nx) xb_add(&bar[XB_TOPGEN], 1u);
            else XB_SPIN(xb_ld(&bar[XB_TOPGEN]) == tg, bar);
            __builtin_amdgcn_fence(__ATOMIC_ACQUIRE, "agent");
            xb_add(&bar[XB_XGEN(b.x)], 1u);
            asm volatile("s_waitcnt vmcnt(0)" ::: "memory");
        } else {
            XB_SPIN(xb_ld(&bar[XB_XGEN(b.x)]) == gen, bar);
            __builtin_amdgcn_fence(__ATOMIC_ACQUIRE, "agent");
            asm volatile("s_waitcnt vmcnt(0)" ::: "memory");
        }
    }
    __syncthreads();
}


struct Args { const float* in[22]; float* out; unsigned char* ws; int ph_lo, ph_hi; };
enum { I_X = 0, I_C, I_CTX, I_CCTX, I_WADA, I_BADA, I_GPREMIX, I_GPOSTMIX, I_GPREFFN, I_GPOSTFFN, I_WIN, I_BIN, I_WOUT, I_MLFB, I_MLNORM, I_HGLB, I_HGNORM, I_DALAM, I_DANORM, I_WG, I_WU, I_WD };

__host__ __device__ __forceinline__ int perm_in_col(int n) { if (n < C_DAQ || n >= C_DAV) return n; const int d = (n - C_DAQ) % 48, base = n - d, half = d / 24, e = d % 24; return base + 24 * half + 2 * (e % 12) + (e >= 12 ? 1 : 0); }
__device__ __forceinline__ int wg_pull(unsigned* ctr, volatile LAS int* slot) {
    __syncthreads();
    if (threadIdx.x == 0) *slot = (int)__hip_atomic_fetch_add(ctr, 1u, RLX_AGENT);
    __syncthreads();
    return __builtin_amdgcn_readfirstlane(*slot);
}

typedef __attribute__((address_space(4))) const Args* kargs_p;
__device__ __forceinline__ void p0_phase(lptr lds, kargs_p ap) {
    struct { const float* in[22]; unsigned char* ws; } a; a.in[I_C] = ap->in[I_C]; a.in[I_CCTX] = ap->in[I_CCTX]; a.in[I_WADA] = ap->in[I_WADA]; a.in[I_BADA] = ap->in[I_BADA]; a.in[I_HGLB] = ap->in[I_HGLB]; a.in[I_BIN] = ap->in[I_BIN]; a.in[I_DALAM] = ap->in[I_DALAM]; a.ws = ap->ws;
    const int tid = tid_opaque();
    unsigned char* ws = a.ws;
    LAS float* sil = (LAS float*)lds;
    LAS float* part = (LAS float*)(lds + 69632);
    for (int i = tid; i < 17 * D; i += NTHR) { const int bb = i >> 10, k = i & 1023; const float v = bb < 16 ? a.in[I_C][bb * D + k] : a.in[I_CCTX][k]; sil[i] = v / (1.0f + __expf(-v)); }
    __syncthreads();
    float* mod = (float*)(ws + WS_MOD);
    for (int u = blockIdx.x; u < DEPTH * (NMOD / 32); u += gridDim.x) {
        const int l = u / (NMOD / 32), n0 = (u % (NMOD / 32)) * 32, col = tid & 31, ks = tid >> 5;
        const float* w = a.in[I_WADA] + (size_t)l * D * NMOD + (size_t)(ks * 64) * NMOD + n0 + col;
        float acc[17];
#pragma unroll
        for (int bb = 0; bb < 17; ++bb) acc[bb] = 0.f;
        float wr[64];
#pragma unroll
        for (int k = 0; k < 64; ++k) wr[k] = w[(size_t)k * NMOD];
#pragma unroll
        for (int k = 0; k < 64; k += 4) {
#pragma unroll
            for (int bb = 0; bb < 17; ++bb) { const f32x4 s = *(const LAS f32x4*)(sil + bb * D + ks * 64 + k); acc[bb] += s[0] * wr[k] + s[1] * wr[k + 1] + s[2] * wr[k + 2] + s[3] * wr[k + 3]; }
        }
#pragma unroll
        for (int bb = 0; bb < 17; ++bb) part[(ks * 17 + bb) * 32 + col] = acc[bb];
        __syncthreads();
        for (int i = tid; i < 17 * 32; i += NTHR) { const int bb = i >> 5, cc = i & 31; float s = 0.f;
#pragma unroll
            for (int k2 = 0; k2 < 16; ++k2) s += part[(k2 * 17 + bb) * 32 + cc];
            mod[((size_t)l * 17 + bb) * NMOD + n0 + cc] = s + a.in[I_BADA][l * NMOD + n0 + cc]; }
        __syncthreads();
    }
    const int gt = blockIdx.x * NTHR + tid, GT = gridDim.x * NTHR;
    float* lbs = (float*)(ws + WS_MISC); float* rope = (float*)(ws + WS_MISC + 16384); float* biasp = (float*)(ws + WS_MISC + 32768); float* lamv = (float*)(ws + WS_MISC + 114688);
    for (int j = gt; j < 1024; j += GT) { const float* hl = a.in[I_HGLB];
        const float v0 = hl[j], v1 = hl[1024 + j], v2 = hl[2048 + j], v3 = hl[3072 + j]; const float mx = fmaxf(fmaxf(v0, v1), fmaxf(v2, v3));
        const float e0 = expf(v0 - mx), e1 = expf(v1 - mx), e2 = expf(v2 - mx), e3 = expf(v3 - mx), inv = 1.0f / (e0 + e1 + e2 + e3);
        lbs[j] = 0.f; lbs[1024 + j] = e1 * inv; lbs[2048 + j] = (e1 + e2) * inv; lbs[3072 + j] = (e1 + e2 + e3) * inv; }
    for (int j = gt; j < 64 * 12; j += GT) { const int pos = j / 12, i = j % 12; const float inv = powf(10000.0f, -(float)(2 * i) / 24.0f); const float ang = (float)pos * inv; rope[2 * j] = cosf(ang); rope[2 * j + 1] = sinf(ang); }
    for (int j = gt; j < DEPTH * DINP; j += GT) { const int l = j / DINP, n = j % DINP; biasp[l * DINP + perm_in_col(n)] = n < DIN ? a.in[I_BIN][l * DIN + n] : 0.f; }
    if (gt < DEPTH) { const float* lv = a.in[I_DALAM] + gt * 4 * 48; float s01 = 0.f, s23 = 0.f;
        for (int d = 0; d < 48; ++d) { s01 += lv[d] * lv[48 + d]; s23 += lv[96 + d] * lv[144 + d]; }
        const float lam_init = 0.8f - 0.6f * expf(-0.3f * (float)gt);
        lamv[gt] = expf(s01) - expf(s23) + lam_init; }
}

template <bool RES, bool NORM, bool XSF, bool XDF>
__device__ __forceinline__ void thin_phase(int row_lo, const float* xs_lat, const float* xs_ctx, float* xd_lat, bf16* xbuf, bool write_x,
                                           const bf16* y, const float* mod_r, int goff, const float* gpost,
                                           const float* mod_n, int soff, int aoff, const float* gpre, bf16* hout, int vcu, int G, int probe = 0) {
    const int tid = tid_opaque(); const int lane = tid & 63, wave = __builtin_amdgcn_readfirstlane(tid >> 6);
    const int nrows = MT - row_lo; int rwg = (nrows + G - 1) / G; rwg += rwg & 1;
    const int wbeg = row_lo + vcu * rwg, rend = (wbeg + rwg < MT) ? wbeg + rwg : MT;
    const int rbeg = wbeg + 2 * wave;
    constexpr int RSTEP = 2 * NWAVES;
    int cur_bb = -1;
    f32x4 gp[4], ga[4], sh[4];
#pragma unroll
    for (int j = 0; j < 4; ++j) { gp[j] = (f32x4){0.f, 0.f, 0.f, 0.f}; ga[j] = gp[j]; sh[j] = gp[j]; }
    f32x4 xa[2][4], ya[2][4];
#define TH_LOAD(X, Y, r_) do { _Pragma("unroll") for (int q_ = 0; q_ < 2; ++q_) { const int rr_ = (r_) + q_; const bool ic_ = rr_ < MC; \
        const float* xs_ = ic_ ? xs_ctx + (size_t)rr_ * D : xs_lat + (size_t)(rr_ - MC) * D; \
        _Pragma("unroll") for (int j_ = 0; j_ < 4; ++j_) { if (XSF) X[q_][j_] = *(const f32x4*)(xs_ + 4 * lane + 256 * j_); \
            else { const v2u xw_ = __builtin_nontemporal_load((const v2u*)(xbuf + (size_t)rr_ * D + 4 * lane + 256 * j_)); X[q_][j_] = (f32x4){bflo(xw_.x), bfhi(xw_.x), bflo(xw_.y), bfhi(xw_.y)}; } \
            if (RES) { const v2u yw_ = __builtin_nontemporal_load((const v2u*)(y + (size_t)rr_ * D + 4 * lane + 256 * j_)); Y[q_][j_] = (f32x4){bflo(yw_.x), bfhi(yw_.x), bflo(yw_.y), bfhi(yw_.y)}; } } } } while (0)
    if (rbeg < rend) TH_LOAD(xa, ya, rbeg);
    for (int r = rbeg; r < rend; r += RSTEP) {
        f32x4 xb[2][4], yb[2][4];
        if (r + RSTEP < rend) TH_LOAD(xb, yb, r + RSTEP);
        const bool isctx = r < MC; const int bb = isctx ? 16 : (r - MC) / SEQ;
        if (bb != cur_bb) { cur_bb = bb;
#pragma unroll
            for (int j = 0; j < 4; ++j) { const int e = 4 * lane + 256 * j;
                if (RES) gp[j] = *(const f32x4*)(mod_r + (size_t)bb * NMOD + goff + e) * *(const f32x4*)(gpost + e);
                if (NORM) { ga[j] = *(const f32x4*)(gpre + e) * (*(const f32x4*)(mod_n + (size_t)bb * NMOD + aoff + e) + 1.0f); sh[j] = *(const f32x4*)(mod_n + (size_t)bb * NMOD + soff + e); } } }
        if (RES) { float s0 = 0.f, s1 = 0.f;
#pragma unroll
            for (int j = 0; j < 4; ++j) { s0 += (ya[0][j][0] * ya[0][j][0] + ya[0][j][1] * ya[0][j][1]) + (ya[0][j][2] * ya[0][j][2] + ya[0][j][3] * ya[0][j][3]);
                                          s1 += (ya[1][j][0] * ya[1][j][0] + ya[1][j][1] * ya[1][j][1]) + (ya[1][j][2] * ya[1][j][2] + ya[1][j][3] * ya[1][j][3]); }
#pragma unroll
            for (int o = 1; o < 64; o <<= 1) { s0 += lx_xor(s0, o, lane); s1 += lx_xor(s1, o, lane); }
            const float r0s = 1.0f / sqrtf(s0 * (1.0f / D) + EPS), r1s = 1.0f / sqrtf(s1 * (1.0f / D) + EPS);
#pragma unroll
            for (int j = 0; j < 4; ++j) { xa[0][j] += gp[j] * ya[0][j] * r0s; xa[1][j] += gp[j] * ya[1][j] * r1s; } }
        if (write_x && !(probe & 1)) {
            if (XDF) { float* xd0 = xd_lat + (size_t)(r - MC) * D;
#pragma unroll
                for (int j = 0; j < 4; ++j) { *(f32x4*)(xd0 + 4 * lane + 256 * j) = xa[0][j]; *(f32x4*)(xd0 + D + 4 * lane + 256 * j) = xa[1][j]; } }
            else {
#pragma unroll
                for (int j = 0; j < 4; ++j) { v2u w0, w1; w0.x = pk2(xa[0][j][0], xa[0][j][1]); w0.y = pk2(xa[0][j][2], xa[0][j][3]); w1.x = pk2(xa[1][j][0], xa[1][j][1]); w1.y = pk2(xa[1][j][2], xa[1][j][3]);
                    __builtin_nontemporal_store(w0, (v2u*)(xbuf + (size_t)r * D + 4 * lane + 256 * j)); __builtin_nontemporal_store(w1, (v2u*)(xbuf + (size_t)(r + 1) * D + 4 * lane + 256 * j));
                    if (NORM) { xa[0][j] = (f32x4){bflo(w0.x), bfhi(w0.x), bflo(w0.y), bfhi(w0.y)}; xa[1][j] = (f32x4){bflo(w1.x), bfhi(w1.x), bflo(w1.y), bfhi(w1.y)}; } } } }
        if (NORM) { float s0 = 0.f, s1 = 0.f;
#pragma unroll
            for (int j = 0; j < 4; ++j) { s0 += (xa[0][j][0] * xa[0][j][0] + xa[0][j][1] * xa[0][j][1]) + (xa[0][j][2] * xa[0][j][2] + xa[0][j][3] * xa[0][j][3]);
                                          s1 += (xa[1][j][0] * xa[1][j][0] + xa[1][j][1] * xa[1][j][1]) + (xa[1][j][2] * xa[1][j][2] + xa[1][j][3] * xa[1][j][3]); }
#pragma unroll
            for (int o = 1; o < 64; o <<= 1) { s0 += lx_xor(s0, o, lane); s1 += lx_xor(s1, o, lane); }
            const float r0s = 1.0f / sqrtf(s0 * (1.0f / D) + EPS), r1s = 1.0f / sqrtf(s1 * (1.0f / D) + EPS);
#pragma unroll
            for (int j = 0; j < 4; ++j) { const f32x4 h0 = xa[0][j] * r0s * ga[j] + sh[j], h1 = xa[1][j] * r1s * ga[j] + sh[j];
                v2u w0, w1; w0.x = pk2(h0[0], h0[1]); w0.y = pk2(h0[2], h0[3]); w1.x = pk2(h1[0], h1[1]); w1.y = pk2(h1[2], h1[3]);
                if (!(probe & 2)) { *(v2u*)(hout + (size_t)r * D + 4 * lane + 256 * j) = w0; *(v2u*)(hout + (size_t)(r + 1) * D + 4 * lane + 256 * j) = w1; } } }
#pragma unroll
        for (int q = 0; q < 2; ++q)
#pragma unroll
            for (int j = 0; j < 4; ++j) { xa[q][j] = xb[q][j]; if (RES) ya[q][j] = yb[q][j]; }
    }
#undef TH_LOAD
}

template <int MODE>
__device__ __forceinline__ void tr_item(const float* W, int K, int N, int nblk, bf16* WT, LAS float* scr, int item, int lane) {
    const int kb = item / nblk, nb = item % nblk, k0 = 64 * kb, n0 = 32 * nb;
    const int nn = n0 + (lane & 31); const bool ok = nn < N;
#pragma unroll 8
    for (int i = 0; i < 32; ++i) { const int kk = 2 * i + (lane >> 5); scr[kk * 33 + (lane & 31)] = ok ? W[(size_t)(k0 + kk) * N + nn] : 0.f; }
    LDS_WAIT(); asm volatile("" ::: "memory");
    const int c = lane & 7;
#pragma unroll
    for (int j = 0; j < 4; ++j) { const int n = (lane >> 3) + 8 * j; const LAS float* s = scr + (8 * c) * 33 + n;
        v4u o; o.x = pk2(s[0 * 33], s[1 * 33]); o.y = pk2(s[2 * 33], s[3 * 33]); o.z = pk2(s[4 * 33], s[5 * 33]); o.w = pk2(s[6 * 33], s[7 * 33]);
        const int ng = n0 + n; const int drow = MODE == 0 ? ng : MODE == 3 ? perm_in_col(ng) : ((ng >> 7) * 256 + (ng & 127) + (MODE == 2 ? 128 : 0));
        *(v4u*)(WT + (size_t)drow * K + k0 + 8 * c) = o; }
    LDS_WAIT(); asm volatile("" ::: "memory");
}
__device__ __forceinline__ void convert_weights(lptr lds, kargs_p ap, int l, int vcu, int G) {
    const unsigned char* const wsb = ap->ws; const float* const p_win = ap->in[I_WIN]; const float* const p_wout = ap->in[I_WOUT]; const float* const p_wg = ap->in[I_WG]; const float* const p_wu = ap->in[I_WU]; const float* const p_wd = ap->in[I_WD];
    const int tid = tid_opaque(); const int lane = tid & 63, wave = __builtin_amdgcn_readfirstlane(tid >> 6);
    LAS float* scr = (LAS float*)(lds + wave * 8448);
    const int gw = vcu * NWAVES + wave, NGW = G * NWAVES;
    unsigned char* ws = (unsigned char*)wsb;
    constexpr int I_IN = 16 * (DINP / 32), I_OUT = 16 * 32, I_GU = 16 * (DFF / 32), I_DN = (DFF / 64) * 32;
    constexpr int NITEMS = I_IN + I_OUT + 2 * I_GU + I_DN;
    for (int it = gw; it < NITEMS; it += NGW) {
        int r = it;
        if (r < I_IN) { tr_item<3>(p_win + (size_t)l * D * DIN, D, DIN, DINP / 32, (bf16*)(ws + WS_WIN), scr, r, lane); continue; } r -= I_IN;
        if (r < I_OUT) { tr_item<0>(p_wout + (size_t)l * D * D, D, D, 32, (bf16*)(ws + WS_WOUT), scr, r, lane); continue; } r -= I_OUT;
        if (r < I_GU) { tr_item<1>(p_wg + (size_t)l * D * DFF, D, DFF, DFF / 32, (bf16*)(ws + WS_WGU), scr, r, lane); continue; } r -= I_GU;
        if (r < I_GU) { tr_item<2>(p_wu + (size_t)l * D * DFF, D, DFF, DFF / 32, (bf16*)(ws + WS_WGU), scr, r, lane); continue; } r -= I_GU;
        tr_item<0>(p_wd + (size_t)l * DFF * D, DFF, D, 32, (bf16*)(ws + WS_WD), scr, r, lane);
    }
}
constexpr int AT_BUF = 25600, AT_KOFF = 0, AT_VOFF = 13312, AT_QF = 76800;
constexpr float AT_THR = 8.0f;
constexpr float QSCALE = 0.14433756729740643f * 1.4426950408889634f;

__device__ __forceinline__ f32x16 zero16() { f32x16 z; _Pragma("unroll") for (int r = 0; r < 16; ++r) z[r] = 0.f; return z; }
__device__ __forceinline__ float sm_max(const f32x16& S, int lane) {
    float mx = S[0];
#pragma unroll
    for (int r = 1; r < 16; ++r) mx = fmaxf(mx, S[r]);
    return fmaxf(mx, lx_xor(mx, 32, lane));
}
__device__ __forceinline__ void sm_exp(const f32x16& S, float m, float& l, bf16x8& p0, bf16x8& p1) {
    float p[16]; float ps = 0.f;
#pragma unroll
    for (int r = 0; r < 16; ++r) { p[r] = __builtin_amdgcn_exp2f(S[r] - m); ps += p[r]; }
    l += ps;
    v4u a, b;
    a.x = pk2(p[0], p[1]); a.y = pk2(p[2], p[3]); a.z = pk2(p[4], p[5]); a.w = pk2(p[6], p[7]);
    b.x = pk2(p[8], p[9]); b.y = pk2(p[10], p[11]); b.z = pk2(p[12], p[13]); b.w = pk2(p[14], p[15]);
    p0 = __builtin_bit_cast(bf16x8, a); p1 = __builtin_bit_cast(bf16x8, b);
}
__device__ __forceinline__ bf16x8 vt_frag(lptr vt, int ct, int sub, int sp, int lane) {
    const int h = lane >> 5, blk = (lane >> 4) & 1, q = (lane & 15) >> 2, p = lane & 3;
    lptr a = vt + (32 * sub + 16 * sp + 4 * h + q) * 192 + (32 * ct + 16 * blk + 4 * p) * 2;
    const v4i16 lo = __builtin_amdgcn_ds_read_tr16_b64_v4i16((LAS v4i16*)a);
    const v4i16 hi = __builtin_amdgcn_ds_read_tr16_b64_v4i16((LAS v4i16*)(a + 8 * 192));
    return __builtin_shufflevector(lo, hi, 0, 1, 2, 3, 4, 5, 6, 7);
}

__device__ __forceinline__ void attn_item(lptr lds, const bf16* P, bf16* YM, const float* danorm, float lam, float out_scale, int b, int h, int qb, int probe) {
    const int tid = tid_opaque(), lane = tid & 63, r32 = lane & 31, hi = lane >> 5, wave = __builtin_amdgcn_readfirstlane(tid >> 6);
    const bool lat = qb < 8;
    const int qrow0 = lat ? MC + b * SEQ + qb * 256 : b * CTXL;
    const int nt = lat ? 36 : 4;
    v4u cin[2];
    const unsigned kgo0 = (unsigned)(tid / 12) * DAX_LD + 16u * (unsigned)(tid % 12) + 192u, kgo1 = (unsigned)((tid + 512) / 12) * DAX_LD + 16u * (unsigned)((tid + 512) % 12) + 192u;
    const unsigned klo0 = (unsigned)(AT_KOFF + (tid / 12) * 208 + (tid % 12) * 16), klo1 = (unsigned)(AT_KOFF + ((tid + 512) / 12) * 208 + ((tid + 512) % 12) * 16);
    const unsigned vgo0 = (unsigned)((64 * wave + lane) / 12) * DAX_LD + 16u * (unsigned)((64 * wave + lane) % 12) + 384u, vgo1 = (unsigned)((64 * (wave + 8) + lane) / 12) * DAX_LD + 16u * (unsigned)((64 * (wave + 8) + lane) % 12) + 384u;
    const char* DX = (const char*)P + DAX_OFF + (size_t)(b * 4 + h) * NSLOT * DAX_LD;
#define AT_LOAD(tile) do { const char* tb_ = DX + (size_t)(tile) * (64 * DAX_LD); cin[0] = gld16(tb_, kgo0); if (tid < 256) cin[1] = gld16(tb_, kgo1); } while (0)
#define AT_STORE(tile, buf) do { lptr sb_ = lds + (buf) * AT_BUF; *(LAS v4u*)(sb_ + klo0) = cin[0]; if (tid < 256) *(LAS v4u*)(sb_ + klo1) = cin[1]; } while (0)
#define AT_VDMA(tile, buf) do { const char* tb_ = DX + (size_t)(tile) * (64 * DAX_LD); lptr vb_ = lds + (buf) * AT_BUF + AT_VOFF; \
        __builtin_amdgcn_global_load_lds((const unsigned*)(tb_ + vgo0), (LAS unsigned*)(vb_ + wave * 1024), 16, 0, 0); \
        if (wave < 4) __builtin_amdgcn_global_load_lds((const unsigned*)(tb_ + vgo1), (LAS unsigned*)(vb_ + (wave + 8) * 1024), 16, 0, 0); } while (0)
    AT_LOAD(0);
    lptr qfp = lds + AT_QF + (wave * 6 * 64 + lane) * 16;
    { const unsigned qo = (unsigned)((lat ? CTXL + qb * 256 : 0) + wave * 32 + r32) * DAX_LD + 16u * hi;
#pragma unroll
      for (int f = 0; f < 6; ++f) __builtin_amdgcn_global_load_lds((const unsigned*)(DX + qo + (unsigned)((f / 3) * 48 + (f % 3) * 16) * 2u), (LAS unsigned*)(lds + AT_QF + (wave * 6 + f) * 1024), 16, 0, 0); }
    AT_STORE(0, 0); AT_VDMA(0, 0);
    if (nt > 1) { AT_LOAD(1); AT_VDMA(1, 1); }
    __syncthreads();
    f32x16 O0[3], O1[3];
#pragma unroll
    for (int ct = 0; ct < 3; ++ct)
#pragma unroll
        for (int r = 0; r < 16; ++r) { O0[ct][r] = 0.f; O1[ct][r] = 0.f; }
    float m0 = -1e30f, m1 = -1e30f, l0 = 0.f, l1 = 0.f;
#define AT_QK(SX0, SX1, kb, sub) do { \
        _Pragma("unroll") for (int ks = 0; ks < 3; ++ks) { \
            const bf16x8 k0_ = lds8((kb) + (((sub) * 32 + r32) * 104 + ks * 16 + hi * 8) * 2); \
            const bf16x8 k1_ = lds8((kb) + (((sub) * 32 + r32) * 104 + 48 + ks * 16 + hi * 8) * 2); \
            const bf16x8 q0_ = lds8(qfp + ks * 1024), q1_ = lds8(qfp + (3 + ks) * 1024); \
            if (ks == 0) { SX0 = MFMA32(k0_, q0_, zero16()); SX1 = MFMA32(k1_, q1_, zero16()); } \
            else { SX0 = MFMA32(k0_, q0_, SX0); SX1 = MFMA32(k1_, q1_, SX1); } } } while (0)
#define AT_SMPV(SX0, SX1, vb, sub) do { \
        const float mx0_ = sm_max(SX0, lane), mx1_ = sm_max(SX1, lane); \
        if (__any((mx0_ > m0 + AT_THR) || (mx1_ > m1 + AT_THR))) { \
            const float n0_ = fmaxf(m0, mx0_), n1_ = fmaxf(m1, mx1_); \
            const float a0_ = __builtin_amdgcn_exp2f(m0 - n0_), a1_ = __builtin_amdgcn_exp2f(m1 - n1_); \
            m0 = n0_; m1 = n1_; l0 *= a0_; l1 *= a1_; \
            _Pragma("unroll") for (int ct = 0; ct < 3; ++ct) _Pragma("unroll") for (int r = 0; r < 16; ++r) { O0[ct][r] *= a0_; O1[ct][r] *= a1_; } } \
        bf16x8 p00_, p01_, p10_, p11_; \
        sm_exp(SX0, m0, l0, p00_, p01_); sm_exp(SX1, m1, l1, p10_, p11_); \
        _Pragma("unroll") for (int ct = 0; ct < 3; ++ct) { \
            const bf16x8 v0_ = vt_frag((vb), ct, (sub), 0, lane); const bf16x8 v1_ = vt_frag((vb), ct, (sub), 1, lane); \
            O0[ct] = MFMA32(v0_, p00_, O0[ct]); O1[ct] = MFMA32(v0_, p10_, O1[ct]); \
            O0[ct] = MFMA32(v1_, p01_, O0[ct]); O1[ct] = MFMA32(v1_, p11_, O1[ct]); } } while (0)
    f32x16 SA0, SA1, SB0, SB1;
    AT_QK(SA0, SA1, lds + AT_KOFF, 0);
    int cb = 0;
    for (int i = 0; i < nt; ++i) {
        const int nb = (cb == 2) ? 0 : cb + 1;
        lptr kc_ = lds + cb * AT_BUF + AT_KOFF, vc_ = lds + cb * AT_BUF + AT_VOFF;
        AT_QK(SB0, SB1, kc_, 1);
        AT_SMPV(SA0, SA1, vc_, 0);
        if (i + 1 < nt && !(probe & 2)) AT_STORE(i + 1, nb);
        __syncthreads();
        if (i + 2 < nt && !(probe & 1)) { AT_LOAD(i + 2); AT_VDMA(i + 2, (nb == 2) ? 0 : nb + 1); }
        if (i + 1 < nt) AT_QK(SA0, SA1, lds + nb * AT_BUF + AT_KOFF, 0);
        AT_SMPV(SB0, SB1, vc_, 1);
        cb = nb;
    }
#undef AT_LOAD
#undef AT_VDMA
#undef AT_STORE
#undef AT_QK
#undef AT_SMPV
    const float i0 = 1.0f / (l0 + lx_xor(l0, 32, lane)), i1 = lam / (l1 + lx_xor(l1, 32, lane));
    float ss = 0.f;
#pragma unroll
    for (int ct = 0; ct < 3; ++ct)
#pragma unroll
        for (int r = 0; r < 16; ++r) { const float o = O0[ct][r] * i0 - O1[ct][r] * i1; O0[ct][r] = o; ss += o * o; }
    ss += lx_xor(ss, 32, lane);
    const float rs = out_scale / sqrtf(ss * (1.0f / 96.0f) + EPS);
    const unsigned oro = ((unsigned)(qrow0 + wave * 32 + r32) * (unsigned)D + (unsigned)(Y_DA + h * 96)) * 2u;
#pragma unroll
    for (int ct = 0; ct < 3; ++ct)
#pragma unroll
        for (int g = 0; g < 4; ++g) { const int c0 = 32 * ct + 8 * g + 4 * hi; const f32x4 gn = *(const f32x4*)(danorm + c0);
            v2u w; w.x = pk2(O0[ct][4 * g] * rs * gn[0], O0[ct][4 * g + 1] * rs * gn[1]); w.y = pk2(O0[ct][4 * g + 2] * rs * gn[2], O0[ct][4 * g + 3] * rs * gn[3]);
            gst8(YM, oro + 2u * c0, w); }
}
__device__ __forceinline__ int scan_row(int b, int dir, int p) {
    if (p < CTXL) { const int t = dir ? CTXL - 1 - p : p; return b * CTXL + t; }
    const int pl = p - CTXL; const int t = dir ? SEQ - 1 - pl : pl; return MC + b * SEQ + t;
}
__device__ __forceinline__ int scan_slot(int dir, int p) { if (p < CTXL) return dir ? CTXL - 1 - p : p; const int pl = p - CTXL; return CTXL + (dir ? SEQ - 1 - pl : pl); }

constexpr int ML_Q = 0, ML_K = 13312, ML_KW = 26624, ML_VA = 40960, ML_QKM = 55296, ML_ST = 64512, ML_GF = 87808;
constexpr int ML_LDQ = 208, ML_LDW = 224, ML_LDM = 144, ML_LDS = 208;
constexpr float KSCALE = 0.10206207261596577f;

__device__ __forceinline__ void mlstm_stream(lptr lds, const bf16* P, const float* G, bf16* dst, int dst_ld, const float* fbias  , int b, int h, int dir) {
    const int tid = tid_opaque(), lane = tid & 63, c16 = lane & 15, rg = lane >> 4, wave = __builtin_amdgcn_readfirstlane(tid >> 6);
    lptr Qs = lds + ML_Q, Ks = lds + ML_K, Kw = lds + ML_KW, Va = lds + ML_VA, QKM = lds + ML_QKM, ST = lds + ML_ST;
    LAS float* gA = (LAS float*)(lds + ML_GF); LAS float* MxA = gA + 64; LAS float* wA = gA + 128; LAS float* emtA = gA + 192; LAS float* wkA = gA + 256; LAS float* scal = gA + 320;
    if (tid < 128) { const int t = tid >> 1, hh = tid & 1; v4u w; w.x = hh ? 0u : 0x3F80u; w.y = 0u; w.z = 0u; w.w = 0u; *(LAS v4u*)(Va + t * ML_LDW + (96 + 8 * hh) * 2) = w; }
    const float fb = fbias[dir * 4 + h];
    f32x4 acc[6];
#pragma unroll
    for (int i = 0; i < 6; ++i) acc[i] = (f32x4){0.f, 0.f, 0.f, 0.f};
    float m_prev = -1e30f;
    v4u pre[5]; float gi = 0.f, gf = 0.f;
    const char* MLB = (const char*)P + MLX_OFF + (size_t)(b * 4 + h) * NSLOT * MLX_LD;
#define ML_PREFETCH(c) do { const char* cb_ = MLB + (size_t)(dir ? scan_slot(1, 64 * (c) + 63) : scan_slot(0, 64 * (c))) * MLX_LD; \
    _Pragma("unroll") for (int i_ = 0; i_ < 5; ++i_) { const int id_ = tid + NTHR * i_; if (id_ < 2304) { const int t_ = id_ / 36, r_ = id_ % 36; \
        pre[i_] = gld16(cb_, (unsigned)(dir ? 63 - t_ : t_) * MLX_LD + (unsigned)((r_ / 12) * 96 + (r_ % 12) * 8) * 2u); } } \
    if (wave == 0) { const unsigned go_ = (unsigned)scan_row(b, dir, 64 * (c) + lane) * 64u + (unsigned)(dir * 4 + h) * 4u; gi = *(const float*)((const char*)G + go_); gf = *(const float*)((const char*)G + go_ + 32u); } } while (0)
    ML_PREFETCH(0);
    for (int c = 0; c < NTOK / 64; ++c) {
#pragma unroll
        for (int i = 0; i < 5; ++i) { const int id = tid + NTHR * i; if (id < 2304) { const int t = id / 36, r = id % 36, wh = r / 12, cc = r % 12;
            lptr d = (wh == 0) ? Qs + t * ML_LDQ : (wh == 1) ? Ks + t * ML_LDQ : Va + t * ML_LDW;
            *(LAS v4u*)(d + cc * 16) = pre[i]; } }
        if (wave == 0) {
            const float fp = gf + fb;
            const float lf = fminf(fp, 0.f) - log1pf(__expf(-fabsf(fp)));
            const float bs = scan_sum64(lf);
            const float g = gi - bs;
            const float cm = scan_max64(g);
            const float Mx = fmaxf(m_prev, cm);
            const float mt = bs + Mx;
            const float blast = lx_idx(bs, 63), m_new = lx_idx(mt, 63);
            gA[lane] = g; MxA[lane] = Mx; wA[lane] = __expf(m_prev - Mx); emtA[lane] = __expf(-mt); wkA[lane] = __expf(g + blast - m_new) * KSCALE;
            if (lane == 0) scal[0] = __expf(blast + m_prev - m_new);
            m_prev = m_new;
        }
        if (c + 1 < NTOK / 64) ML_PREFETCH(c + 1);
        __syncthreads();
#pragma unroll
        for (int j = 0; j < 2; ++j) { const int idx = 2 * wave + j, si = idx & 3, ti = idx >> 2;
            f32x4 a4 = (f32x4){0.f, 0.f, 0.f, 0.f};
            if (si <= ti) {
#pragma unroll
                for (int ks = 0; ks < 3; ++ks) a4 = MFMA16(opr(Ks, ML_LDQ, 16 * si, 32 * ks, c16, rg), opr(Qs, ML_LDQ, 16 * ti, 32 * ks, c16, rg), a4);
            }
            const int t = 16 * ti + c16, s0 = 16 * si + 4 * rg; const float mxt = MxA[t]; const f32x4 g4 = *(const LAS f32x4*)(gA + s0);
            float v[4];
#pragma unroll
            for (int r = 0; r < 4; ++r) v[r] = (s0 + r <= t) ? a4[r] * KSCALE * __expf(g4[r] - mxt) : 0.f;
            v2u w; w.x = pk2(v[0], v[1]); w.y = pk2(v[2], v[3]); *(LAS v2u*)(QKM + t * ML_LDM + s0 * 2) = w; }
        for (int id = tid; id < 64 * 12; id += NTHR) { const int t = id / 12, cc = id % 12; const v4u w = *(const LAS v4u*)(Ks + t * ML_LDQ + cc * 16); const float sc = wkA[t];
            v4u o; o.x = pk2(bflo(w.x) * sc, bfhi(w.x) * sc); o.y = pk2(bflo(w.y) * sc, bfhi(w.y) * sc); o.z = pk2(bflo(w.z) * sc, bfhi(w.z) * sc); o.w = pk2(bflo(w.w) * sc, bfhi(w.w) * sc);
            *(LAS v4u*)(Kw + t * ML_LDW + cc * 16) = o; }
#pragma unroll
        for (int i = 0; i < 6; ++i) { const int j = wave + 8 * i; if (j < 42) { const int di = j / 7, vi = j % 7;
            v2u w; w.x = pk2(acc[i][0], acc[i][1]); w.y = pk2(acc[i][2], acc[i][3]); *(LAS v2u*)(ST + (16 * vi + c16) * ML_LDS + (16 * di + 4 * rg) * 2) = w; } }
        __syncthreads();
        if (wave < 4) {
            const int ti = wave, t = 16 * ti + c16;
            f32x4 aX[7];
#pragma unroll
            for (int vi = 0; vi < 7; ++vi) aX[vi] = (f32x4){0.f, 0.f, 0.f, 0.f};
#pragma unroll
            for (int ks = 0; ks < 3; ++ks) { const bf16x8 b8 = opr(Qs, ML_LDQ, 16 * ti, 32 * ks, c16, rg);
#pragma unroll
                for (int vi = 0; vi < 7; ++vi) aX[vi] = MFMA16(opr(ST, ML_LDS, 16 * vi, 32 * ks, c16, rg), b8, aX[vi]); }
            { const float wt = wA[t];
#pragma unroll
              for (int vi = 0; vi < 7; ++vi) aX[vi] = aX[vi] * wt; }
#pragma unroll
            for (int ks = 0; ks < 2; ++ks) { const bf16x8 b8 = opr(QKM, ML_LDM, 16 * ti, 32 * ks, c16, rg);
#pragma unroll
                for (int vi = 0; vi < 7; ++vi) aX[vi] = MFMA16(opt(Va, ML_LDW, 16 * vi, 32 * ks, lane), b8, aX[vi]); }
            const float den = lx_idx(aX[6][0], c16);
            const float inv = 1.0f / fmaxf(fabsf(den), emtA[t]);
            const int row = scan_row(b, dir, 64 * c + t);
            const unsigned oo = ((unsigned)row * (unsigned)dst_ld + (unsigned)(h * 96 + 4 * rg)) * 2u;
#pragma unroll
            for (int vi = 0; vi < 6; ++vi) { v2u w; w.x = pk2(aX[vi][0] * inv, aX[vi][1] * inv); w.y = pk2(aX[vi][2] * inv, aX[vi][3] * inv); gst8(dst, oo + 32u * vi, w); }
        }
        { const float decay = scal[0];
#pragma unroll
          for (int i = 0; i < 6; ++i) { const int j = wave + 8 * i; if (j < 42) { const int di = j / 7, vi = j % 7;
              acc[i] = acc[i] * decay;
#pragma unroll
              for (int ks = 0; ks < 2; ++ks) acc[i] = MFMA16(opt(Kw, ML_LDW, 16 * di, 32 * ks, lane), opt(Va, ML_LDW, 16 * vi, 32 * ks, lane), acc[i]); } } }
        __syncthreads();
    }
#undef ML_PREFETCH
}

constexpr int HG_QT = 0, HG_KR = 8704, HG_V = 17920, HG_ATT = 23040, HG_SPT = 25600, HG_ER = 43008, HG_TOT = 43520, HG_OFF = 47616;
constexpr int HG_LDQ = 272, HG_LDK = 288, HG_LDV = 160, HG_LDA = 80, HG_LDS = 272;

__device__ __forceinline__ void hgrn2_stream(lptr lds, const bf16* P, bf16* dst, int dst_ld, const float* lbl  , int b, int h, int dir) {
    const int tid = tid_opaque(), lane = tid & 63, c16 = lane & 15, rg = lane >> 4, wave = __builtin_amdgcn_readfirstlane(tid >> 6);
    lptr QT = lds + HG_QT, KR = lds + HG_KR, Vs = lds + HG_V, ATT = lds + HG_ATT, SPT = lds + HG_SPT;
    LAS float* ER = (LAS float*)(lds + HG_ER); LAS float* TOT = (LAS float*)(lds + HG_TOT); LAS float* OFF = (LAS float*)(lds + HG_OFF);
    const int tt = lane & 31, kh = lane >> 5, k0 = 16 * wave + 8 * kh;
    const int tv = tid >> 3, cv = tid & 7;
    float lb[8];
    { const f32x4 l0 = *(const f32x4*)(lbl + dir * 512 + h * 128 + k0), l1 = *(const f32x4*)(lbl + dir * 512 + h * 128 + k0 + 4);
#pragma unroll
      for (int j = 0; j < 4; ++j) { lb[j] = l0[j]; lb[4 + j] = l1[j]; } }
    f32x4 acc[4];
#pragma unroll
    for (int i = 0; i < 4; ++i) acc[i] = (f32x4){0.f, 0.f, 0.f, 0.f};
    v4u zr, qr, vr;
    const char* HB_ = (const char*)P + HGX_OFF + (size_t)(b * 4 + h) * NSLOT * HGX_LD;
#define HG_PREFETCH(c) do { { const unsigned ro_ = (unsigned)scan_slot(dir, 32 * (c) + tt) * HGX_LD + 2u * k0; \
        zr = gld16(HB_, ro_ + (unsigned)dir * 256u); qr = gld16(HB_, ro_ + 512u); } \
        if (tid < 256) { const unsigned ro_ = (unsigned)scan_slot(dir, 32 * (c) + tv) * HGX_LD + 16u * cv; vr = gld16(HB_, ro_ + 768u); } } while (0)
    HG_PREFETCH(0);
    for (int c = 0; c < NTOK / 32; ++c) {
        {
            float qt[8], kt[8], er[8];
            const unsigned zw[4] = {zr.x, zr.y, zr.z, zr.w}, qw[4] = {qr.x, qr.y, qr.z, qr.w};
#pragma unroll
            for (int j = 0; j < 8; ++j) { const float z = (j & 1) ? bfhi(zw[j >> 1]) : bflo(zw[j >> 1]); const float q = (j & 1) ? bfhi(qw[j >> 1]) : bflo(qw[j >> 1]);
                const float e = __expf(-fabsf(z)); const float inv = __builtin_amdgcn_rcpf(1.0f + e);
                const float sig = z >= 0.f ? inv : e * inv, nsig = z >= 0.f ? e * inv : inv;
                const float oml = 1.0f - lb[j]; const float f = fmaxf(lb[j], 1e-30f) + oml * sig; const float kk = oml * nsig;
                float x = __log2f(f);
                x += dpp_f<0x111, 0xf>(0.f, x); x += dpp_f<0x112, 0xf>(0.f, x); x += dpp_f<0x114, 0xf>(0.f, x); x += dpp_f<0x118, 0xf>(0.f, x);
                x += dpp_f<0x142, 0xa>(0.f, x);
                const float rr = 0.5f * lx_idx(x, lane | 31);
                float xx = x - rr; xx = fminf(fmaxf(xx, -100.f), 100.f);
                const float qs = q * __builtin_amdgcn_rcpf(1.0f + __expf(-q));
                qt[j] = qs * __builtin_amdgcn_exp2f(xx); kt[j] = kk * __builtin_amdgcn_exp2f(-xx); er[j] = rr; }
            v4u wq, wk; wq.x = pk2(qt[0], qt[1]); wq.y = pk2(qt[2], qt[3]); wq.z = pk2(qt[4], qt[5]); wq.w = pk2(qt[6], qt[7]);
            wk.x = pk2(kt[0], kt[1]); wk.y = pk2(kt[2], kt[3]); wk.z = pk2(kt[4], kt[5]); wk.w = pk2(kt[6], kt[7]);
            *(LAS v4u*)(QT + tt * HG_LDQ + k0 * 2) = wq; *(LAS v4u*)(KR + tt * HG_LDK + k0 * 2) = wk;
            if (tt == 0) { f32x4 e0, e1;
#pragma unroll
                for (int j = 0; j < 4; ++j) { e0[j] = __builtin_amdgcn_exp2f(fmaxf(er[j], -100.f)); e1[j] = __builtin_amdgcn_exp2f(fmaxf(er[4 + j], -100.f)); }
                *(LAS f32x4*)(ER + k0) = e0; *(LAS f32x4*)(ER + k0 + 4) = e1; }
            if (tid < 256) *(LAS v4u*)(Vs + tv * HG_LDV + cv * 16) = vr;
        }
        if (c + 1 < NTOK / 32) HG_PREFETCH(c + 1);
        __syncthreads();
        if (wave < 4) { const int si = wave & 1, ti = wave >> 1;
            f32x4 a4 = (f32x4){0.f, 0.f, 0.f, 0.f};
            if (si <= ti) {
#pragma unroll
                for (int ks = 0; ks < 4; ++ks) a4 = MFMA16(opr(KR, HG_LDK, 16 * si, 32 * ks, c16, rg), opr(QT, HG_LDQ, 16 * ti, 32 * ks, c16, rg), a4);
            }
            const int t = 16 * ti + c16, s0 = 16 * si + 4 * rg;
            v2u w; w.x = pk2(s0 <= t ? a4[0] : 0.f, s0 + 1 <= t ? a4[1] : 0.f); w.y = pk2(s0 + 2 <= t ? a4[2] : 0.f, s0 + 3 <= t ? a4[3] : 0.f);
            *(LAS v2u*)(ATT + t * HG_LDA + s0 * 2) = w; }
        { const f32x4 er = *(const LAS f32x4*)(ER + 16 * wave + 4 * rg);
#pragma unroll
          for (int ci = 0; ci < 4; ++ci) { acc[ci] = acc[ci] * er; v2u w; w.x = pk2(acc[ci][0], acc[ci][1]); w.y = pk2(acc[ci][2], acc[ci][3]);
              *(LAS v2u*)(SPT + (16 * ci + c16) * HG_LDS + (16 * wave + 4 * rg) * 2) = w; } }
        __syncthreads();
        { const int ci = wave & 3, ti = wave >> 2, t = 16 * ti + c16;
          f32x4 o4 = (f32x4){0.f, 0.f, 0.f, 0.f};
          o4 = MFMA16(opt(Vs, HG_LDV, 16 * ci, 0, lane), opr(ATT, HG_LDA, 16 * ti, 0, c16, rg), o4);
#pragma unroll
          for (int ks = 0; ks < 4; ++ks) o4 = MFMA16(opr(SPT, HG_LDS, 16 * ci, 32 * ks, c16, rg), opr(QT, HG_LDQ, 16 * ti, 32 * ks, c16, rg), o4);
          const int row = scan_row(b, dir, 32 * c + t);
          v2u w; w.x = pk2(o4[0], o4[1]); w.y = pk2(o4[2], o4[3]);
          gst8(dst, ((unsigned)row * (unsigned)dst_ld + (unsigned)(h * 64 + 16 * ci + 4 * rg)) * 2u, w); }
        { const bf16x8 a8 = opt(KR, HG_LDK, 16 * wave, 0, lane); const f32x4 er = *(const LAS f32x4*)(ER + 16 * wave + 4 * rg);
#pragma unroll
          for (int ci = 0; ci < 4; ++ci) { acc[ci] = MFMA16(a8, opt(Vs, HG_LDV, 16 * ci, 0, lane), acc[ci]); acc[ci] = acc[ci] * er; } }
        __syncthreads();
    }
#undef HG_PREFETCH
}

__device__ __forceinline__ void fin_phase(int row_lo, const bf16* P, bf16* YM, const bf16* RAWM, const bf16* RAWH, const float* mlgain  , const float* hggain  , int vcu, int G) {
    const int tid = tid_opaque(); const int lane = tid & 63, wave = __builtin_amdgcn_readfirstlane(tid >> 6);
    float gm[6], gh[4];
#pragma unroll
    for (int j = 0; j < 6; ++j) gm[j] = mlgain[6 * lane + j];
#pragma unroll
    for (int j = 0; j < 4; ++j) gh[j] = hggain[4 * lane + j];
    const int nrows = MT - row_lo; int rwg = (nrows + G - 1) / G; rwg = (rwg + 15) & ~15;
    const int wbeg = row_lo + vcu * rwg, rend = (wbeg + rwg < MT) ? wbeg + rwg : MT;
    for (int r0 = wbeg + wave; r0 < rend; r0 += 16) {
        unsigned fa[2][3], ba[2][3], oa[2][3]; v2u f2[2], b2[2], g2[2];
#pragma unroll
        for (int q = 0; q < 2; ++q) { const int r = r0 + 8 * q; if (r < rend) {
            const unsigned* f3 = (const unsigned*)(YM + (size_t)r * D + Y_ML + 6 * lane); const unsigned* b3 = (const unsigned*)(RAWM + (size_t)r * 384 + 6 * lane); const unsigned* o3 = (const unsigned*)((const char*)P + MLO_OFF + (size_t)r * MLO_LD + 12 * lane);
#pragma unroll
            for (int j = 0; j < 3; ++j) { fa[q][j] = f3[j]; ba[q][j] = __builtin_nontemporal_load(b3 + j); oa[q][j] = __builtin_nontemporal_load(o3 + j); }
            f2[q] = *(const v2u*)(YM + (size_t)r * D + Y_HG + 4 * lane); b2[q] = __builtin_nontemporal_load((const v2u*)(RAWH + (size_t)r * 256 + 4 * lane)); g2[q] = __builtin_nontemporal_load((const v2u*)((const char*)P + HGG_OFF + (size_t)r * HGG_LD + 8 * lane)); } }
#pragma unroll
        for (int q = 0; q < 2; ++q) { const int r = r0 + 8 * q; if (r < rend) {
            float hm[6] = {bflo(fa[q][0]) + bflo(ba[q][0]), bfhi(fa[q][0]) + bfhi(ba[q][0]), bflo(fa[q][1]) + bflo(ba[q][1]), bfhi(fa[q][1]) + bfhi(ba[q][1]), bflo(fa[q][2]) + bflo(ba[q][2]), bfhi(fa[q][2]) + bfhi(ba[q][2])};
            const float og[6] = {bflo(oa[q][0]), bfhi(oa[q][0]), bflo(oa[q][1]), bfhi(oa[q][1]), bflo(oa[q][2]), bfhi(oa[q][2])};
            float hh[4] = {bflo(f2[q].x) + bflo(b2[q].x), bfhi(f2[q].x) + bfhi(b2[q].x), bflo(f2[q].y) + bflo(b2[q].y), bfhi(f2[q].y) + bfhi(b2[q].y)};
            const float gg[4] = {bflo(g2[q].x), bfhi(g2[q].x), bflo(g2[q].y), bfhi(g2[q].y)};
            float sm = 0.f, sh = 0.f;
#pragma unroll
            for (int j = 0; j < 6; ++j) sm += hm[j] * hm[j];
#pragma unroll
            for (int j = 0; j < 4; ++j) sh += hh[j] * hh[j];
#pragma unroll
            for (int o = 1; o < 16; o <<= 1) { sm += lx_xor(sm, o, lane); sh += lx_xor(sh, o, lane); }
            const float rm = 1.0f / sqrtf(sm * (1.0f / 96.0f) + EPS), rh = 1.0f / sqrtf(sh * (1.0f / 64.0f) + EPS);
#pragma unroll
            for (int j = 0; j < 6; ++j) hm[j] = hm[j] * rm * gm[j] * __builtin_amdgcn_rcpf(1.0f + __expf(-og[j]));
#pragma unroll
            for (int j = 0; j < 4; ++j) hh[j] = hh[j] * rh * gh[j] * gg[j] * __builtin_amdgcn_rcpf(1.0f + __expf(-gg[j]));
            bf16* ym = YM + (size_t)r * D;
            unsigned* w3 = (unsigned*)(ym + Y_ML + 6 * lane); w3[0] = pk2(hm[0], hm[1]); w3[1] = pk2(hm[2], hm[3]); w3[2] = pk2(hm[4], hm[5]);
            v2u w2; w2.x = pk2(hh[0], hh[1]); w2.y = pk2(hh[2], hh[3]); *(v2u*)(ym + Y_HG + 4 * lane) = w2; } }
    }
}
#ifndef NO_HG
#define NO_HG 0
#endif
#ifndef NO_ML
#define NO_ML 0
#endif
#ifndef NO_AT
#define NO_AT 0
#endif
#ifndef NO_GEMM
#define NO_GEMM 0
#endif
#ifndef NO_G1
#define NO_G1 0
#endif
#ifndef NO_G2
#define NO_G2 0
#endif
#ifndef NO_G3
#define NO_G3 0
#endif
#ifndef NO_G4
#define NO_G4 0
#endif
#ifndef NO_P0
#define NO_P0 0
#endif
#ifndef STAMP_ON
#define STAMP_ON 0
#endif
#ifndef SA
#define SA 0
#define SB 1
#define SC 0
#define SD 1
#endif
#ifndef THIN_PROBE
#define THIN_PROBE 0
#endif
#ifndef ATT_PROBE
#define ATT_PROBE 0
#endif
#ifndef REPMASK
#define REPMASK 7
#endif
#ifndef REP
#define REP 0
#endif
constexpr int NPHASE = 2 + 8 * DEPTH;

typedef __attribute__((address_space(4))) const Args* kargs_t;
__device__ __forceinline__ kargs_t kargs() { kargs_t p = (kargs_t)__builtin_amdgcn_kernarg_segment_ptr(); asm volatile("" : "+s"(p)); return p; }
#define WSP(T, off) ((T*)(ws + (off)))

__global__ void __launch_bounds__(NTHR, 2) fwd(Args a_unused) {
    extern __shared__ __attribute__((aligned(16))) unsigned char lds_raw[];
    lptr lds = (lptr)lds_raw;
    const int G = gridDim.x; const int bx = blockIdx.x; const int vcu = (G % 8 == 0) ? (bx % 8) * (G / 8) + bx / 8 : bx;
    volatile LAS unsigned* MISC = (volatile LAS unsigned*)(lds + LDSCTL_OFF);
    { const int tid = tid_opaque(); for (int u = tid; u < 256; u += NTHR) ((LAS unsigned*)(lds + LDSCTL_OFF))[u] = 0u; }
    __syncthreads();
    int lo, hi; XcdBarrier bar;
    { kargs_t A = kargs(); lo = A->ph_lo; hi = A->ph_hi; unsigned* bw = (unsigned*)(A->ws + WS_CTL) + CW_BAR;
      bar.bar = bw; bar.x = 0; bar.st = nullptr;
      if (hi - lo > 1) bar = xcd_barrier_post(bw, MISC + 8); }
    volatile LAS int* slot = (volatile LAS int*)(MISC + 16);
#if STAMP_ON
#define STAMP(k) do { if (bx == 0 && tid_opaque() == 0) { kargs_t A_ = kargs(); __hip_atomic_store((unsigned long long*)(A_->ws + WS_MISC + 131072) + (k), (unsigned long long)__builtin_amdgcn_s_memrealtime(), RLX_AGENT); } } while (0)
#else
#define STAMP(k) do { } while (0)
#endif
#define IN(k) (lo <= (k) && (k) < hi)
#define SEAM(k) do { if (IN(k) && IN((k) + 1)) xcd_barrier(bar); STAMP((k) + 1); } while (0)
#define REPEAT(k) for (int rep_ = ((REP == (k) && l == 0) ? 2 : 1); rep_ > 0; --rep_)
#define REPBAR() do { if (rep_ > 1) xcd_barrier(bar); } while (0)

    STAMP(0);
    if (IN(0)) { if (!NO_P0) p0_phase(lds, kargs()); } SEAM(0);

    for (int l = 0; l < DEPTH; ++l) {
        const int pb = 1 + 8 * l;
        const bool with_ctx = l < DEPTH - 1;
        const int r0 = with_ctx ? 0 : MC; const int Mg = MT - r0;
        if (IN(pb)) REPEAT(1) {
            kargs_t A = kargs(); unsigned char* ws = A->ws; const float* modl = WSP(float, WS_MOD) + (size_t)l * 17 * NMOD; bf16* xb = WSP(bf16, WS_XB);
            if (l == 0) thin_phase<false, true, true, false>(0, A->in[I_X], A->in[I_CTX], nullptr, xb, false, (const bf16*)nullptr, nullptr, 0, nullptr, modl, 0, D, A->in[I_GPREMIX] + l * D, WSP(bf16, WS_HB), vcu, G);
            else        thin_phase<true, true, false, false>(0, nullptr, nullptr, nullptr, xb, true, WSP(bf16, WS_YD), modl - 17 * NMOD, 5 * D, A->in[I_GPOSTFFN] + (l - 1) * D, modl, 0, D, A->in[I_GPREMIX] + l * D, WSP(bf16, WS_HB), vcu, G);
            convert_weights(lds, kargs(), l, vcu, G); REPBAR();
        }
        SEAM(pb);
        if (IN(pb + 1)) REPEAT(2) {
            kargs_t A = kargs(); unsigned char* ws = A->ws;
            pg8::Gemm g{WSP(bf16, WS_HB), WSP(bf16, WS_WIN), MT, DINP, D}; pg8::StaticOrder S; S.init(MT, DINP, G, bx);
            { const int tid = tid_opaque(); const float* bsrc = WSP(float, WS_MISC + 32768) + l * DINP; const float* rsrc = WSP(float, WS_MISC + 16384);
              for (int i = tid; i < DINP; i += NTHR) ((LAS float*)(lds + LDS_BIAS))[i] = bsrc[i];
              for (int i = tid; i < 64 * 24; i += NTHR) ((LAS float*)(lds + LDS_ROPE))[i] = rsrc[i];
              for (int i = tid; i < DINP / 8; i += NTHR) { unsigned ex, ey; pg8::epi_in_entry(i, ex, ey); ((LAS unsigned*)(lds + LDS_ETAB))[2 * i] = ex; ((LAS unsigned*)(lds + LDS_ETAB))[2 * i + 1] = ey; }
              __syncthreads(); }
            pg8::EpiIn E{ws + WS_P, (const LAS float*)(lds + LDS_BIAS), WSP(float, WS_GATE), (const LAS float*)(lds + LDS_ROPE), (const LAS unsigned*)(lds + LDS_ETAB), MC, QSCALE};
            if (!NO_GEMM && !NO_G1) pg8::gemm_phase<pg8::EpiIn, pg8::StaticOrder, true, true>(lds, g, S, E); REPBAR();
        }
        SEAM(pb + 1);
        if (IN(pb + 2)) REPEAT(3) {
            { kargs_t A = kargs(); unsigned char* ws = A->ws; unsigned* qh = WSP(unsigned, WS_CTL) + CW_Q + 64 * (16 * l + 64 * (rep_ - 1));
              for (;;) { const int it = wg_pull(qh, slot); if (it >= 128) break;
                const int b = it >> 3, h = (it >> 1) & 3, dir = it & 1;
                if (!NO_HG && (rep_ == 1 || (REPMASK & 1))) hgrn2_stream(lds, WSP(bf16, WS_P), dir ? (bf16*)((unsigned char*)A->out + OUT_RAWH) : WSP(bf16, WS_HB) + Y_HG, dir ? 256 : D, WSP(float, WS_MISC) + l * 1024, b, h, dir); } }
            { kargs_t A = kargs(); unsigned char* ws = A->ws; unsigned* qm = WSP(unsigned, WS_CTL) + CW_Q + 64 * (16 * l + 64 * (rep_ - 1) + 1);
              for (;;) { const int it = wg_pull(qm, slot); if (it >= 128) break;
                const int b = it >> 3, h = (it >> 1) & 3, dir = it & 1;
                if (!NO_ML && (rep_ == 1 || (REPMASK & 2))) mlstm_stream(lds, WSP(bf16, WS_P), WSP(float, WS_GATE), dir ? (bf16*)((unsigned char*)A->out + OUT_RAWM) : WSP(bf16, WS_HB) + Y_ML, dir ? 384 : D, A->in[I_MLFB] + l * 8, b, h, dir); } }
            { kargs_t A = kargs(); unsigned char* ws = A->ws; unsigned* qa = WSP(unsigned, WS_CTL) + CW_Q + 64 * (16 * l + 64 * (rep_ - 1) + 2);
              const int nq = with_ctx ? 72 : 64;
              const float lam_init = 0.8f - 0.6f * __expf(-0.3f * (float)l);
              const int myx = (int)(xb_xcc_id() & 7u);
              for (int k = 0; k < 8; ++k) { const int qx = (myx + k) & 7;
                for (;;) { const int it = wg_pull(qa + 64 * qx, slot); if (it >= nq) break;
                  const int bh = it < 64 ? (it >> 3) * 8 + qx : (it - 64) * 8 + qx, qb = it < 64 ? it & 7 : 8;
                  if (!NO_AT && (rep_ == 1 || (REPMASK & 4))) attn_item(lds, WSP(bf16, WS_P), WSP(bf16, WS_HB), A->in[I_DANORM] + l * 96, WSP(float, WS_MISC + 114688)[l], 1.0f - lam_init, bh >> 2, bh & 3, qb, rep_ == 2 ? ATT_PROBE : 0); } } }
            __syncthreads(); REPBAR();
        }
        SEAM(pb + 2);
        if (IN(pb + 3)) {
            kargs_t A = kargs(); unsigned char* ws = A->ws;
            fin_phase(r0, WSP(bf16, WS_P), WSP(bf16, WS_HB), (const bf16*)((const unsigned char*)A->out + OUT_RAWM), (const bf16*)((const unsigned char*)A->out + OUT_RAWH), A->in[I_MLNORM] + l * 384, A->in[I_HGNORM] + l * 256, vcu, G);
        }
        SEAM(pb + 3);
        if (IN(pb + 4)) REPEAT(5) {
            kargs_t A = kargs(); unsigned char* ws = A->ws;
            pg8::Gemm g{WSP(bf16, WS_HB) + (size_t)r0 * D, WSP(bf16, WS_WOUT), Mg, D, D}; pg8::StaticOrder S; S.init(Mg, D, G, bx);
            pg8::EpiBf E{WSP(bf16, WS_P) + (size_t)r0 * D, D};
            if (!NO_GEMM && !NO_G2) pg8::gemm_phase<pg8::EpiBf, pg8::StaticOrder, true, true>(lds, g, S, E); REPBAR();
        }
        SEAM(pb + 4);
        if (IN(pb + 5)) REPEAT(6) {
            kargs_t A = kargs(); unsigned char* ws = A->ws; const float* modl = WSP(float, WS_MOD) + (size_t)l * 17 * NMOD; bf16* xb = WSP(bf16, WS_XB);
            if (l == 0) thin_phase<true, true, true, false>(r0, A->in[I_X], A->in[I_CTX], nullptr, xb, true, WSP(bf16, WS_P), modl, 2 * D, A->in[I_GPOSTMIX] + l * D, modl, 3 * D, 4 * D, A->in[I_GPREFFN] + l * D, WSP(bf16, WS_HB), vcu, G, rep_ == 2 ? THIN_PROBE : 0);
            else        thin_phase<true, true, false, false>(r0, nullptr, nullptr, nullptr, xb, true, WSP(bf16, WS_P), modl, 2 * D, A->in[I_GPOSTMIX] + l * D, modl, 3 * D, 4 * D, A->in[I_GPREFFN] + l * D, WSP(bf16, WS_HB), vcu, G, 0);
            REPBAR();
        }
        SEAM(pb + 5);
        if (IN(pb + 6)) REPEAT(7) {
            kargs_t A = kargs(); unsigned char* ws = A->ws;
            pg8::Gemm g{WSP(bf16, WS_HB) + (size_t)r0 * D, WSP(bf16, WS_WGU), Mg, NGU, D}; pg8::StaticOrder S; S.init(Mg, NGU, G, bx);
            pg8::EpiSwiglu E{WSP(bf16, WS_P) + (size_t)r0 * DFF, DFF};
            if (!NO_GEMM && !NO_G3) pg8::gemm_phase<pg8::EpiSwiglu, pg8::StaticOrder, true, true>(lds, g, S, E); REPBAR();
        }
        SEAM(pb + 6);
        if (IN(pb + 7)) REPEAT(8) {
            kargs_t A = kargs(); unsigned char* ws = A->ws;
            pg8::Gemm g{WSP(bf16, WS_P) + (size_t)r0 * DFF, WSP(bf16, WS_WD), Mg, D, DFF}; pg8::StaticOrder S; S.init(Mg, D, G, bx);
            pg8::EpiBf E{WSP(bf16, WS_YD) + (size_t)r0 * D, D};
            if (!NO_GEMM && !NO_G4) pg8::gemm_phase<pg8::EpiBf, pg8::StaticOrder, true, true>(lds, g, S, E); REPBAR();
        }
        SEAM(pb + 7);
    }
    if (IN(NPHASE - 1)) {
        kargs_t A = kargs(); unsigned char* ws = A->ws; const float* modl = WSP(float, WS_MOD) + (size_t)(DEPTH - 1) * 17 * NMOD;
        thin_phase<true, false, false, true>(MC, nullptr, nullptr, A->out, WSP(bf16, WS_XB), true, WSP(bf16, WS_YD), modl, 5 * D, A->in[I_GPOSTFFN] + (DEPTH - 1) * D, nullptr, 0, 0, nullptr, nullptr, vcu, G);
#if STAMP_ON
        {
            __syncthreads();
            const unsigned long long* st = (const unsigned long long*)(ws + WS_MISC + 131072);
            const float d1 = (float)(long long)(__hip_atomic_load(st + SB, RLX_AGENT) - __hip_atomic_load(st + SA, RLX_AGENT)) * 1e-5f;
            const float d2 = (float)(long long)(__hip_atomic_load(st + SD, RLX_AGENT) - __hip_atomic_load(st + SC, RLX_AGENT)) * 1e-2f;
            const int tid = tid_opaque(); const int rwg = ML / G; float* o = A->out + (size_t)vcu * rwg * D;
            for (int i = tid; i < rwg * D; i += NTHR) o[i] *= (1.0f + d1);
            __syncthreads();
            if (bx == 0 && tid == 0) A->out[(size_t)vcu * rwg * D] = d2;
        }
#endif
    }
#undef IN
#undef SEAM
}

extern "C" void kernel_launch(void* const* d_in, const int* in_sizes, int n_in, void* d_out, int out_size, void* d_ws, size_t ws_size, hipStream_t stream) {
    static int grid = 0;
    if (grid == 0) {
        if (n_in != 22 || in_sizes[0] != ML * D || out_size != ML * D || ws_size < WS_END) {
            fprintf(stderr, "kernel_launch: unexpected shapes: n_in %d in0 %d out %d ws %zu (need %zu); nothing launched\n", n_in, n_in > 0 ? in_sizes[0] : -1, out_size, ws_size, (size_t)WS_END); grid = -1; return; }
        int dev = 0, cus = 0, per_cu = 0;
        if (hipGetDevice(&dev) != hipSuccess || hipDeviceGetAttribute(&cus, hipDeviceAttributeMultiprocessorCount, dev) != hipSuccess) { fprintf(stderr, "kernel_launch: device query failed\n"); grid = -1; return; }
        if (hipFuncSetAttribute((const void*)fwd, hipFuncAttributeMaxDynamicSharedMemorySize, LDS_BYTES) != hipSuccess) { fprintf(stderr, "kernel_launch: hipFuncSetAttribute failed\n"); grid = -1; return; }
        if (hipOccupancyMaxActiveBlocksPerMultiprocessor(&per_cu, (const void*)fwd, NTHR, LDS_BYTES) != hipSuccess || per_cu < 1)
            fprintf(stderr, "kernel_launch: note: occupancy query reports %d workgroups per CU\n", per_cu);
        (void)hipGetLastError();
        grid = cus;
    }
    if (grid < 0) return;
    if (hipMemsetAsync((char*)d_ws + WS_CTL, 0, CTL_ZERO_BYTES, stream) != hipSuccess) { fprintf(stderr, "kernel_launch: memset failed\n"); return; }
    Args a{};
    for (int i = 0; i < 22; ++i) a.in[i] = (const float*)d_in[i];
    a.out = (float*)d_out; a.ws = (unsigned char*)d_ws;
#if MK_PER_PHASE
    for (int p = 0; p < NPHASE; ++p) { a.ph_lo = p; a.ph_hi = p + 1; hipLaunchKernelGGL(fwd, dim3(grid), dim3(NTHR), LDS_BYTES, stream, a); }
#else
    a.ph_lo = 0; a.ph_hi = NPHASE;
    hipLaunchKernelGGL(fwd, dim3(grid), dim3(NTHR), LDS_BYTES, stream, a);
#endif
    const hipError_t le = hipPeekAtLastError();
    if (le != hipSuccess) fprintf(stderr, "kernel_launch: launch failed: %s\n", hipGetErrorName(le));
}
```

```cpp
#include <hip/hip_runtime.h>
#include <cstdio>
#include <cstdint>
#ifndef MK_PER_PHASE
#define MK_PER_PHASE 0
#endif
namespace pg8 {
#define PG8_LAS __attribute__((address_space(3)))
typedef unsigned short bf16_t;
typedef short bf16x8 __attribute__((ext_vector_type(8)));
typedef float f32x4 __attribute__((ext_vector_type(4)));
typedef unsigned u32x4 __attribute__((ext_vector_type(4)));
constexpr int BM = 256, BK = 64, HALF = 128, HTB = HALF * BK * 2  , STAGE_BYTES = 8 * HTB, NXCD = 8, WGM = 8;

__host__ __device__ __forceinline__ int lds_byte(int r, int c) { const int st = (r >> 4) * 2 + (c >> 5), rr = r & 15, cc = c & 31, ob = rr * 64 + cc * 2; return st * 1024 + (ob ^ (((ob >> 9) & 1) << 5)); }
__host__ __device__ __forceinline__ void stage_rc(int b, int& R, int& C) { const int st = b / 1024, sb = b % 1024, swz = sb ^ (((sb >> 9) & 1) << 5); R = (st >> 1) * 16 + swz / 64; C = (st & 1) * 32 + (swz % 64) / 2; }
__host__ __device__ __forceinline__ int perm32(int rho) { const int n = rho >> 4, i = rho & 15; return 8 * (i >> 2) + 4 * n + (i & 3); }

struct Unit { int pm, pn; };
struct Gemm { const bf16_t* A; const bf16_t* Bt; int M, N, K; };

struct StaticOrder {
    int nM, nN, nwg, G, c;
    __host__ __device__ void init(int M, int N, int G_, int c_) { nM = M / BM; nN = N / BM; nwg = nM * nN; G = G_; c = c_; }
    __host__ __device__ bool next(int i, Unit& u) const {
        const long L = (long)i * G + c; if (L >= nwg) return false;
        int wgid = (int)L; { const int q = nwg / NXCD, r = nwg % NXCD, xcd = wgid % NXCD, off = wgid / NXCD; wgid = (xcd < r ? xcd * (q + 1) : r * (q + 1) + (xcd - r) * q) + off; }
        const int nig = WGM * nN, gid = wgid / nig, fm = gid * WGM, gsz = (nM - fm) < WGM ? (nM - fm) : WGM;
        u.pm = fm + ((wgid % nig) % gsz); u.pn = (wgid % nig) / gsz; return true;
    }
    __device__ __forceinline__ void a_ready(const Unit&) const {}
    __device__ __forceinline__ void done(const Unit&) const {}
};
__device__ __forceinline__ unsigned cvt_pk_bf16(float lo, float hi) { unsigned r; asm volatile("v_cvt_pk_bf16_f32 %0, %1, %2" : "=v"(r) : "v"(lo), "v"(hi)); return r; }
struct EpiF32 {
    static constexpr bool PERM = false, AFTER_DRAIN = false;
    float* C; int ldc;
    __device__ __forceinline__ void operator()(const f32x4 (&acc)[2][2][4][2], const Unit& u, int wr, int wc, int fr, int fq) const {
        const int row0 = u.pm * BM + wr * 64 + fr, col0 = u.pn * BM + wc * 32 + 4 * fq;
#pragma unroll
        for (int ai = 0; ai < 2; ++ai)
#pragma unroll
            for (int m = 0; m < 4; ++m) { float* rowp = C + (size_t)(row0 + ai * HALF + m * 16) * ldc + col0;
#pragma unroll
                for (int bj = 0; bj < 2; ++bj)
#pragma unroll
                    for (int n = 0; n < 2; ++n) *(f32x4*)(rowp + bj * HALF + n * 16) = acc[ai][bj][m][n]; }
    }
};
struct EpiBf {
    static constexpr bool PERM = true, AFTER_DRAIN = false;
    bf16_t* O; int ldc;
    __device__ __forceinline__ void operator()(const f32x4 (&acc)[2][2][4][2], const Unit& u, int wr, int wc, int fr, int fq) const {
        const int row0 = u.pm * BM + wr * 64 + fr; const int col0 = u.pn * BM + wc * 32 + 8 * fq;
#pragma unroll
        for (int ai = 0; ai < 2; ++ai)
#pragma unroll
            for (int m = 0; m < 4; ++m) { bf16_t* rowp = O + (size_t)(row0 + ai * HALF + m * 16) * ldc + col0;
#pragma unroll
                for (int bj = 0; bj < 2; ++bj) { const f32x4 v0 = acc[ai][bj][m][0], v1 = acc[ai][bj][m][1];
                    u32x4 w; w.x = cvt_pk_bf16(v0[0], v0[1]); w.y = cvt_pk_bf16(v0[2], v0[3]); w.z = cvt_pk_bf16(v1[0], v1[1]); w.w = cvt_pk_bf16(v1[2], v1[3]);
                    *(u32x4*)(rowp + bj * HALF) = w; } }
    }
};
constexpr unsigned EI_KIND = 1u << 16, EI_SKIP = 1u << 17, EI_DA = 1u << 18, EI_Q = 1u << 19, EI_HF = 1u << 20;
__host__ __device__ __forceinline__ void epi_in_entry(int g, unsigned& x, unsigned& y) {
    const int c = 8 * g; x = 0u; y = EI_SKIP;
    if (c < 1152)      { const int f = c / 384, hh = (c % 384) / 96, o = c % 96;            x = 0u         + (unsigned)hh * 2304u * 576u + (unsigned)(f * 96 + o) * 2u; y = 576u; }
    else if (c < 1536) { x = 301989888u + (unsigned)(c - 1152) * 2u; y = 768u | EI_KIND; }
    else if (c < 1552) { }
    else if (c < 2064) { const int hh = (c - 1552) / 128, o = (c - 1552) % 128;             x = 84934656u  + (unsigned)hh * 2304u * 896u + (unsigned)(256 + o) * 2u; y = 896u; }
    else if (c < 3088) { const int d = (c - 2064) / 512, hh = ((c - 2064) % 512) / 128, o = (c - 2064) % 128; x = 84934656u + (unsigned)hh * 2304u * 896u + (unsigned)(d * 128 + o) * 2u; y = 896u; }
    else if (c < 3344) { const int hh = (c - 3088) / 64, o = (c - 3088) % 64;               x = 84934656u  + (unsigned)hh * 2304u * 896u + (unsigned)(384 + o) * 2u; y = 896u; }
    else if (c < 3600) { x = 330301440u + (unsigned)(c - 3344) * 2u; y = 512u | EI_KIND; }
    else if (c < 4752) { const int f = (c - 3600) / 384, hh = ((c - 3600) % 384) / 96, o = (c - 3600) % 96; x = 217055232u + (unsigned)hh * 2304u * 576u + (unsigned)(f * 96 + o) * 2u; y = 576u;
                         if (c < 4368) { const int d48 = (c - 3600) % 48, hf = d48 >= 24 ? 1 : 0, i0 = (d48 - 24 * hf) >> 1; y |= EI_DA | (c < 3984 ? EI_Q : 0u) | (hf ? EI_HF : 0u) | ((unsigned)i0 << 24); } }
}
struct EpiIn {
    static constexpr bool PERM = true, AFTER_DRAIN = false;
    unsigned char* PX; const PG8_LAS float* bias; float* G; const PG8_LAS float* rope; const PG8_LAS unsigned* tab; int mc; float qscale;
    __device__ __forceinline__ void operator()(const f32x4 (&acc)[2][2][4][2], const Unit& u, int wr, int wc, int fr, int fq) const {
        const int trow0 = u.pm * BM;
        const int bat = trow0 < mc ? trow0 >> 8 : (trow0 - mc) >> 11; const int slot0 = trow0 < mc ? (trow0 & 255) : 256 + ((trow0 - mc) & 2047);
        const unsigned rc_blk = (unsigned)(bat * 4 * 2304 + slot0), rc_row = (unsigned)trow0;
        const int rin = wr * 64 + fr;
        const int col0 = u.pn * BM + wc * 32 + 8 * fq;
        const bool gate_lane = (u.pn == 6) && (wc == 0) && (fq < 2);
#pragma unroll
        for (int bj = 0; bj < 2; ++bj) {
            const int c = col0 + bj * HALF;
            const f32x4 b0 = *(const PG8_LAS f32x4*)(bias + c), b1 = *(const PG8_LAS f32x4*)(bias + c + 4);
            const unsigned ex = tab[2 * (c >> 3)], ey = tab[2 * (c >> 3) + 1];
            const unsigned ld = ey & 0xffffu;
            const unsigned off = ex + ((ey & EI_KIND) ? rc_row : rc_blk) * ld + (unsigned)rin * ld;
            const bool skip = (ey & EI_SKIP) != 0u, is_da = (ey & EI_DA) != 0u, is_q = (ey & EI_Q) != 0u; const int hf = (ey & EI_HF) ? 1 : 0, i0 = (int)(ey >> 24);
#pragma unroll
            for (int ai = 0; ai < 2; ++ai)
#pragma unroll
                for (int m = 0; m < 4; ++m) { const int row = trow0 + rin + ai * HALF + m * 16;
                    f32x4 v0 = acc[ai][bj][m][0] + b0, v1 = acc[ai][bj][m][1] + b1;
                    if (is_da) {
                        if (row >= mc) { const int t = (row - mc) & 2047; const int pos = hf ? (t & 63) : (t >> 6);
                            const f32x4 cs0 = *(const PG8_LAS f32x4*)(rope + pos * 24 + 2 * i0), cs1 = *(const PG8_LAS f32x4*)(rope + pos * 24 + 2 * i0 + 4);
                            const f32x4 r0 = {v0[0] * cs0[0] - v0[1] * cs0[1], v0[0] * cs0[1] + v0[1] * cs0[0], v0[2] * cs0[2] - v0[3] * cs0[3], v0[2] * cs0[3] + v0[3] * cs0[2]};
                            const f32x4 r1 = {v1[0] * cs1[0] - v1[1] * cs1[1], v1[0] * cs1[1] + v1[1] * cs1[0], v1[2] * cs1[2] - v1[3] * cs1[3], v1[2] * cs1[3] + v1[3] * cs1[2]};
                            v0 = r0; v1 = r1; }
                        if (is_q) { v0 = v0 * qscale; v1 = v1 * qscale; } }
                    if (!skip) { u32x4 w; w.x = cvt_pk_bf16(v0[0], v0[1]); w.y = cvt_pk_bf16(v0[2], v0[3]); w.z = cvt_pk_bf16(v1[0], v1[1]); w.w = cvt_pk_bf16(v1[2], v1[3]);
                        *(u32x4*)(PX + (off + (unsigned)(ai * HALF + m * 16) * ld)) = w; }
                    if (bj == 0 && gate_lane) { float* g = G + (size_t)row * 16 + 8 * fq; *(f32x4*)g = v0; *(f32x4*)(g + 4) = v1; } }
        }
    }
};
struct EpiSwiglu {
    static constexpr bool PERM = true, AFTER_DRAIN = false;
    bf16_t* O; int ldc;
    __device__ __forceinline__ void operator()(const f32x4 (&acc)[2][2][4][2], const Unit& u, int wr, int wc, int fr, int fq) const {
        const int row0 = u.pm * BM + wr * 64 + fr; const int col0 = u.pn * HALF + wc * 32 + 8 * fq;
#pragma unroll
        for (int ai = 0; ai < 2; ++ai)
#pragma unroll
            for (int m = 0; m < 4; ++m) { bf16_t* rowp = O + (size_t)(row0 + ai * HALF + m * 16) * ldc + col0;
                f32x4 r0, r1;
#pragma unroll
                for (int i = 0; i < 4; ++i) { const float g0 = acc[ai][0][m][0][i], g1 = acc[ai][0][m][1][i];
                    r0[i] = g0 * __builtin_amdgcn_rcpf(1.0f + __expf(-g0)) * acc[ai][1][m][0][i];
                    r1[i] = g1 * __builtin_amdgcn_rcpf(1.0f + __expf(-g1)) * acc[ai][1][m][1][i]; }
                u32x4 w; w.x = cvt_pk_bf16(r0[0], r0[1]); w.y = cvt_pk_bf16(r0[2], r0[3]); w.z = cvt_pk_bf16(r1[0], r1[1]); w.w = cvt_pk_bf16(r1[2], r1[3]);
                *(u32x4*)rowp = w; }
    }
};
template <class Epi, class Sched, bool ALIGN_EPI = false, bool SP2 = false>
__device__ __forceinline__ void gemm_phase(PG8_LAS unsigned char* lds, const Gemm g, const Sched& S, const Epi& E, const int wv_) {
    int tid_; { int l_; asm volatile("v_mbcnt_lo_u32_b32 %0, -1, 0\n\tv_mbcnt_hi_u32_b32 %0, -1, %0\n\ts_nop 0" : "=&v"(l_)); tid_ = wv_ * 64 + l_; }
    const int tid = tid_, wid = __builtin_amdgcn_readfirstlane(tid >> 6), lane = tid & 63, wr = wid >> 2, wc = wid & 3, fr = lane & 15, fq = lane >> 4;
    const int K = g.K, nt = K / BK;
    unsigned voffA[2], voffB[2];
#pragma unroll
    for (int i = 0; i < 2; ++i) { int R, C; stage_rc(tid * 16 + i * 8192, R, C); const int Rb = Epi::PERM ? ((R & ~31) + perm32(R & 31)) : R;
        voffA[i] = (unsigned)(R * K + C) * 2u; voffB[i] = (unsigned)(Rb * K + C) * 2u; }
    const size_t kstep = (size_t)(BK * 2);
    const size_t hstep = (size_t)HALF * K * 2;
    const size_t tstep = 2 * hstep;
    const unsigned ldsw = (unsigned)wid * 1024u;
    const int aoff = lds_byte(wr * 64 + fr, fq * 8), boff = lds_byte(wc * 32 + fr, fq * 8);
#define PG8_SA(b, h) (((b) * 2 + (h)) * HTB)
#define PG8_SB(b, h) ((4 + (b) * 2 + (h)) * HTB)
#define PG8_STAGE(bufoff, gbase, voff) do { _Pragma("unroll") for (int _i = 0; _i < 2; ++_i) \
        __builtin_amdgcn_global_load_lds((const unsigned*)((const char*)(gbase) + (voff)[_i]), (PG8_LAS unsigned*)(lds + (bufoff) + ldsw + _i * 8192), 16, 0, 0); } while (0)
#define PG8_LDA(dst, b, h) do { _Pragma("unroll") for (int m = 0; m < 4; ++m) _Pragma("unroll") for (int k = 0; k < 2; ++k) dst[m][k] = *(const PG8_LAS bf16x8*)(lds + PG8_SA(b, h) + aoff + m * 2048 + k * 1024); } while (0)
#define PG8_LDB(dst, b, h) do { _Pragma("unroll") for (int n = 0; n < 2; ++n) _Pragma("unroll") for (int k = 0; k < 2; ++k) dst[n][k] = *(const PG8_LAS bf16x8*)(lds + PG8_SB(b, h) + boff + n * 2048 + k * 1024); } while (0)
#define PG8_MMA(ai, bj, At, Bt) do { __builtin_amdgcn_s_setprio(1); _Pragma("unroll") for (int m = 0; m < 4; ++m) _Pragma("unroll") for (int n = 0; n < 2; ++n) _Pragma("unroll") for (int k = 0; k < 2; ++k) \
        acc[ai][bj][m][n] = __builtin_amdgcn_mfma_f32_16x16x32_bf16(Bt[n][k], At[m][k], acc[ai][bj][m][n], 0, 0, 0); __builtin_amdgcn_s_setprio(0); } while (0)
#define PG8_WAIT_V(n) asm volatile("s_waitcnt vmcnt(" #n ")" ::: "memory")
#define PG8_WAIT_L(n) asm volatile("s_waitcnt lgkmcnt(" #n ")" ::: "memory")
#define PG8_BAR __builtin_amdgcn_s_barrier()
#define PG8_SCHED __builtin_amdgcn_sched_barrier(0)
    Unit cur, nxt; int ui = 0;
    if (!S.next(0, cur)) return;
    f32x4 acc[2][2][4][2];
#pragma unroll
    for (int a = 0; a < 2; ++a)
#pragma unroll
        for (int b = 0; b < 2; ++b)
#pragma unroll
            for (int m = 0; m < 4; ++m)
#pragma unroll
                for (int n = 0; n < 2; ++n) acc[a][b][m][n] = (f32x4){0.f, 0.f, 0.f, 0.f};
    bf16x8 At[4][2], B0[2][2], B1[2][2];
    const char* cA = (const char*)g.A + (size_t)cur.pm * tstep; const char* cB = (const char*)g.Bt + (size_t)cur.pn * tstep;
    S.a_ready(cur);
    if constexpr (SP2) {
        PG8_STAGE(PG8_SB(0, 0), cB, voffB); PG8_STAGE(PG8_SB(0, 1), cB + hstep, voffB); PG8_STAGE(PG8_SA(0, 0), cA, voffA); PG8_STAGE(PG8_SA(0, 1), cA + hstep, voffA);
        if (wr == 1) PG8_BAR;
        PG8_WAIT_V(2); PG8_BAR;
        PG8_STAGE(PG8_SB(1, 0), cB + kstep, voffB); PG8_STAGE(PG8_SA(1, 0), cA + kstep, voffA); PG8_STAGE(PG8_SB(1, 1), cB + hstep + kstep, voffB);
        PG8_WAIT_V(6); PG8_BAR;
    } else {
        PG8_STAGE(PG8_SB(0, 0), cB, voffB); PG8_STAGE(PG8_SA(0, 0), cA, voffA); PG8_STAGE(PG8_SB(0, 1), cB + hstep, voffB); PG8_STAGE(PG8_SA(0, 1), cA + hstep, voffA);
        if (wr == 1) PG8_BAR;
        PG8_WAIT_V(4); PG8_BAR;
        PG8_STAGE(PG8_SB(1, 0), cB + kstep, voffB); PG8_STAGE(PG8_SA(1, 0), cA + kstep, voffA); PG8_STAGE(PG8_SB(1, 1), cB + hstep + kstep, voffB);
        PG8_WAIT_V(6); PG8_BAR;
    }
    for (;;) {
        const bool has_next = S.next(ui + 1, nxt);
        const char* nA = has_next ? (const char*)g.A + (size_t)nxt.pm * tstep : cA; const char* nB = has_next ? (const char*)g.Bt + (size_t)nxt.pn * tstep : cB;
        for (int t = 0; t < nt; t += 2) {
            const bool last = (t == nt - 2);
            const char* a1 = cA + (size_t)(t + 1) * kstep;
            const char* a2 = last ? nA : cA + (size_t)(t + 2) * kstep; const char* b2 = last ? nB : cB + (size_t)(t + 2) * kstep;
            const char* a3 = a2 + kstep; const char* b3 = b2 + kstep;
            if (last && has_next) S.a_ready(nxt);
            if constexpr (SP2) {
            PG8_LDB(B0, 0, 0); PG8_LDB(B1, 0, 1); PG8_SCHED; PG8_LDA(At, 0, 0); PG8_STAGE(PG8_SA(1, 1), a1 + hstep, voffA);
            PG8_WAIT_V(8); PG8_WAIT_L(0); PG8_BAR; PG8_MMA(0, 0, At, B0); PG8_MMA(0, 1, At, B1); PG8_BAR; PG8_SCHED;
            PG8_LDA(At, 0, 1); PG8_STAGE(PG8_SB(0, 0), b2, voffB); PG8_STAGE(PG8_SB(0, 1), b2 + hstep, voffB); PG8_STAGE(PG8_SA(0, 0), a2, voffA);
            PG8_WAIT_V(8); PG8_WAIT_L(0); PG8_BAR; PG8_MMA(1, 0, At, B0); PG8_MMA(1, 1, At, B1); PG8_BAR; PG8_SCHED;
            PG8_LDB(B0, 1, 0); PG8_LDB(B1, 1, 1); PG8_SCHED; PG8_LDA(At, 1, 0); PG8_STAGE(PG8_SA(0, 1), a2 + hstep, voffA);
            PG8_WAIT_V(8); PG8_WAIT_L(0); PG8_BAR; PG8_MMA(0, 0, At, B0); PG8_MMA(0, 1, At, B1); PG8_BAR; PG8_SCHED;
            PG8_LDA(At, 1, 1); PG8_STAGE(PG8_SB(1, 0), b3, voffB); PG8_STAGE(PG8_SB(1, 1), b3 + hstep, voffB); PG8_STAGE(PG8_SA(1, 0), a3, voffA);
            PG8_WAIT_V(8); PG8_WAIT_L(0); PG8_BAR; PG8_MMA(1, 0, At, B0); PG8_MMA(1, 1, At, B1); PG8_BAR; PG8_SCHED;
            } else {
            PG8_LDB(B0, 0, 0); PG8_SCHED; PG8_LDA(At, 0, 0); PG8_STAGE(PG8_SA(1, 1), a1 + hstep, voffA);
            PG8_WAIT_L(8); PG8_BAR; PG8_WAIT_L(0); PG8_MMA(0, 0, At, B0); PG8_BAR; PG8_SCHED;
            PG8_LDB(B1, 0, 1); PG8_STAGE(PG8_SB(0, 0), b2, voffB);
            PG8_BAR; PG8_WAIT_L(0); PG8_MMA(0, 1, At, B1); PG8_BAR;
            PG8_LDA(At, 0, 1); PG8_STAGE(PG8_SA(0, 0), a2, voffA);
            PG8_BAR; PG8_WAIT_L(0); PG8_MMA(1, 0, At, B0); PG8_BAR; PG8_SCHED;
            PG8_STAGE(PG8_SB(0, 1), b2 + hstep, voffB);
            PG8_WAIT_V(6); PG8_BAR; PG8_MMA(1, 1, At, B1); PG8_BAR;
            PG8_LDB(B0, 1, 0); PG8_SCHED; PG8_LDA(At, 1, 0); PG8_STAGE(PG8_SA(0, 1), a2 + hstep, voffA);
            PG8_WAIT_L(8); PG8_BAR; PG8_WAIT_L(0); PG8_MMA(0, 0, At, B0); PG8_BAR; PG8_SCHED;
            PG8_LDB(B1, 1, 1); PG8_STAGE(PG8_SB(1, 0), b3, voffB);
            PG8_BAR; PG8_WAIT_L(0); PG8_MMA(0, 1, At, B1); PG8_BAR;
            PG8_LDA(At, 1, 1); PG8_STAGE(PG8_SA(1, 0), a3, voffA);
            PG8_BAR; PG8_WAIT_L(0); PG8_MMA(1, 0, At, B0); PG8_BAR; PG8_SCHED;
            PG8_STAGE(PG8_SB(1, 1), b3 + hstep, voffB);
            PG8_WAIT_V(6); PG8_BAR; PG8_MMA(1, 1, At, B1); PG8_BAR;
            }
        }
        if constexpr (ALIGN_EPI) { if (wr == 0) PG8_BAR; }
        if constexpr (!Epi::AFTER_DRAIN) { E(acc, cur, wr, wc, fr, fq); S.done(cur); }
        if (!has_next) break;
#pragma unroll
        for (int a = 0; a < 2; ++a)
#pragma unroll
            for (int b = 0; b < 2; ++b)
#pragma unroll
                for (int m = 0; m < 4; ++m)
#pragma unroll
                    for (int n = 0; n < 2; ++n) acc[a][b][m][n] = (f32x4){0.f, 0.f, 0.f, 0.f};
        cur = nxt; cA = nA; cB = nB; ++ui;
        if constexpr (ALIGN_EPI) { if (wr == 1) PG8_BAR; }
    }
    PG8_WAIT_V(0);
    if constexpr (!ALIGN_EPI) { if (wr == 0) PG8_BAR; }
    PG8_BAR;
    if constexpr (Epi::AFTER_DRAIN) { E.fused(acc, cur, wr, wc, fr, fq, lds, wid, lane); S.done(cur); }
#undef PG8_SA
#undef PG8_SB
#undef PG8_STAGE
#undef PG8_LDA
#undef PG8_LDB
#undef PG8_MMA
#undef PG8_WAIT_V
#undef PG8_WAIT_L
#undef PG8_BAR
#undef PG8_SCHED
}
}
constexpr int D = 1024, NB = 16, SEQ = 2048, CTXL = 256, DEPTH = 4;
constexpr int MC = NB * CTXL, ML = NB * SEQ, MT = MC + ML;
constexpr int DIN = 4752, DINP = 4864, DFF = 2816, NGU = 2 * DFF, NMOD = 6 * D;
constexpr int C_MLQ = 0, C_MLK = 384, C_MLV = 768, C_MLO = 1152, C_MLI = 1536, C_MLF = 1544, C_HGQ = 1552, C_HGF = 2064, C_HGI = 3088, C_HGG = 3344, C_DAQ = 3600, C_DAK = 3984, C_DAV = 4368;
constexpr int Y_ML = 0, Y_HG = 384, Y_DA = 640;
constexpr float EPS = 1e-6f;
constexpr int NTOK = CTXL + SEQ;
static_assert(C_MLI == 6 * 256, "gate columns must open GEMM tile 6");
constexpr int NSLOT = CTXL + SEQ;
constexpr unsigned MLX_LD = 576, HGX_LD = 896, DAX_LD = 576, MLO_LD = 768, HGG_LD = 512;
constexpr size_t MLX_OFF = 0, HGX_OFF = MLX_OFF + (size_t)64 * NSLOT * MLX_LD, DAX_OFF = HGX_OFF + (size_t)64 * NSLOT * HGX_LD, MLO_OFF = DAX_OFF + (size_t)64 * NSLOT * DAX_LD, HGG_OFF = MLO_OFF + (size_t)MT * MLO_LD, PX_END = HGG_OFF + (size_t)MT * HGG_LD;
static_assert(HGX_OFF == 84934656ull && DAX_OFF == 217055232ull && MLO_OFF == 301989888ull && HGG_OFF == 330301440ull, "EpiIn hard-codes these offsets");

constexpr size_t MiB = 1u << 20;
constexpr size_t KiB = 1u << 10;
constexpr size_t WS_CTL = 0, CTL_ZERO_BYTES = 256 * KiB;
constexpr size_t WS_MOD = 256 * KiB;
constexpr size_t WS_MISC = 2 * MiB;
constexpr size_t WS_GATE = 2 * MiB + 256 * KiB;
constexpr size_t WS_WIN = 4 * MiB + 512 * KiB, WS_WOUT = WS_WIN + (size_t)DINP * D * 2, WS_WGU = WS_WOUT + (size_t)D * D * 2, WS_WD = WS_WGU + (size_t)NGU * D * 2;
constexpr size_t WS_XB = 32 * MiB + 512 * KiB;
constexpr size_t WS_HB = WS_XB + (size_t)MT * D * 2;
constexpr size_t WS_P = WS_HB + (size_t)MT * D * 2;
constexpr size_t WS_YD = WS_P + 198 * MiB, WS_END = WS_P + 333 * MiB + 64 * KiB;
constexpr size_t OUT_RAWM = 0, OUT_RAWH = 27 * MiB;
static_assert(WS_MOD + (size_t)DEPTH * 17 * NMOD * 4 <= WS_MISC && WS_GATE + (size_t)MT * 16 * 4 <= WS_WIN, "small buffers");
static_assert(WS_WD + (size_t)D * DFF * 2 <= WS_XB, "weights fit");
static_assert(OUT_RAWM + (size_t)MT * 384 * 2 <= OUT_RAWH && OUT_RAWH + (size_t)MT * 256 * 2 <= (size_t)ML * D * 4, "raw buffers fit d_out");
static_assert(WS_P + PX_END <= WS_END, "mixer operand blocks fit the P region");
static_assert(WS_YD + (size_t)MT * D * 2 <= WS_END && (size_t)MT * DFF * 2 <= 198 * MiB && WS_END <= 512 * MiB, "P region");
constexpr int CW_BAR = 4096;
constexpr int CW_Q = 16384;

constexpr int RING_BYTES = 131072, LDSCTL_OFF = RING_BYTES, LDS_BYTES = 163840;
constexpr int LDS_BIAS = LDSCTL_OFF + 1024, LDS_ROPE = LDS_BIAS + DINP * 4, LDS_ETAB = LDS_ROPE + 64 * 24 * 4;
static_assert(LDS_ETAB + (DINP / 8) * 8 <= LDS_BYTES, "LDS map");
constexpr int NWAVES = 8, NTHR = 512;

#define GAS __attribute__((address_space(1)))
#define LAS __attribute__((address_space(3)))
typedef unsigned short bf16;
typedef unsigned v4u __attribute__((ext_vector_type(4)));
typedef unsigned v2u __attribute__((ext_vector_type(2)));
typedef float f32x4 __attribute__((ext_vector_type(4)));
typedef float f32x16 __attribute__((ext_vector_type(16)));
typedef short bf16x8 __attribute__((ext_vector_type(8)));
typedef GAS unsigned gu32;
typedef LAS unsigned char* lptr;
#define RLX_AGENT __ATOMIC_RELAXED, __HIP_MEMORY_SCOPE_AGENT
#define LDS_WAIT() asm volatile("s_waitcnt lgkmcnt(0)" ::: "memory")
#define VM_WAIT() asm volatile("s_waitcnt vmcnt(0)" ::: "memory")
__device__ __forceinline__ unsigned f2bf(float f) { unsigned u = __builtin_bit_cast(unsigned, f); return (u + 0x7fffu + ((u >> 16) & 1u)) >> 16; }
typedef float f32x2_t __attribute__((ext_vector_type(2))); typedef __bf16 bf16x2_t __attribute__((ext_vector_type(2)));
__device__ __forceinline__ unsigned pk2(float lo, float hi) { f32x2_t v = {lo, hi}; bf16x2_t b = __builtin_convertvector(v, bf16x2_t); return __builtin_bit_cast(unsigned, b); }
__device__ __forceinline__ float bflo(unsigned w) { return __builtin_bit_cast(float, w << 16); }
__device__ __forceinline__ float bfhi(unsigned w) { return __builtin_bit_cast(float, w & 0xffff0000u); }
__device__ __forceinline__ float bf2f(bf16 v) { return __builtin_bit_cast(float, (unsigned)v << 16); }
__device__ __forceinline__ float lx_idx(float v, int src) { return __builtin_bit_cast(float, __builtin_amdgcn_ds_bpermute(src << 2, __builtin_bit_cast(int, v))); }
__device__ __forceinline__ float lx_xor(float v, int mask, int lane) { return lx_idx(v, lane ^ mask); }
__device__ __forceinline__ float lx_up(float v, int d, int lane) { return lx_idx(v, lane >= d ? lane - d : lane); }
template <int CTRL, int RMASK> __device__ __forceinline__ float dpp_f(float oldv, float v) { return __builtin_bit_cast(float, __builtin_amdgcn_update_dpp(__builtin_bit_cast(int, oldv), __builtin_bit_cast(int, v), CTRL, RMASK, 0xf, false)); }
__device__ __forceinline__ float scan_sum64(float v) {
    v += dpp_f<0x111, 0xf>(0.f, v); v += dpp_f<0x112, 0xf>(0.f, v); v += dpp_f<0x114, 0xf>(0.f, v); v += dpp_f<0x118, 0xf>(0.f, v);
    v += dpp_f<0x142, 0xa>(0.f, v); v += dpp_f<0x143, 0xc>(0.f, v); return v; }
__device__ __forceinline__ float scan_max64(float v) { const float ninf = -3.0e38f;
    v = fmaxf(v, dpp_f<0x111, 0xf>(ninf, v)); v = fmaxf(v, dpp_f<0x112, 0xf>(ninf, v)); v = fmaxf(v, dpp_f<0x114, 0xf>(ninf, v)); v = fmaxf(v, dpp_f<0x118, 0xf>(ninf, v));
    v = fmaxf(v, dpp_f<0x142, 0xa>(ninf, v)); v = fmaxf(v, dpp_f<0x143, 0xc>(ninf, v)); return v; }
__device__ __forceinline__ float wave_sum(float v, int lane) {
#pragma unroll
    for (int o = 1; o < 64; o <<= 1) v += lx_xor(v, o, lane);
    return v;
}
#define MFMA32(a, b, c) __builtin_amdgcn_mfma_f32_32x32x16_bf16((a), (b), (c), 0, 0, 0)
#define MFMA16(a, b, c) __builtin_amdgcn_mfma_f32_16x16x32_bf16((a), (b), (c), 0, 0, 0)
__device__ __forceinline__ int wave_sgpr() { int w = __builtin_amdgcn_readfirstlane((int)(threadIdx.x >> 6)); asm volatile("" : "+s"(w)); return w; }
__device__ __forceinline__ int lane_raw() { int l; asm volatile("v_mbcnt_lo_u32_b32 %0, -1, 0\n\tv_mbcnt_hi_u32_b32 %0, -1, %0\n\ts_nop 0" : "=&v"(l)); return l; }
__device__ __forceinline__ bool is_t0(int wv) { return wv == 0 && lane_raw() == 0; }
__device__ __forceinline__ int tid_opaque(int wv) { return wv * 64 + lane_raw(); }
__device__ __forceinline__ bf16x8 lds8(lptr p) { return *(const LAS bf16x8*)p; }
__device__ __forceinline__ v4u gld16(const void* base, unsigned off) { return *(const v4u*)((const char*)base + off); }
__device__ __forceinline__ void gst8(void* base, unsigned off, v2u v) { *(v2u*)((char*)base + off) = v; }
typedef short v4i16 __attribute__((ext_vector_type(4)));
__device__ __forceinline__ bf16x8 opr(lptr img, int ldb, int r0, int k0, int c16, int rg) { return lds8(img + (r0 + c16) * ldb + (k0 + 8 * rg) * 2); }
__device__ __forceinline__ bf16x8 opt(lptr img, int ldb, int r0, int k0, int lane) {
    const int g = lane >> 4, q = (lane & 15) >> 2, p = lane & 3;
    lptr a = img + (k0 + 8 * g + q) * ldb + (r0 + 4 * p) * 2;
    const v4i16 lo = __builtin_amdgcn_ds_read_tr16_b64_v4i16((LAS v4i16*)a);
    const v4i16 hi = __builtin_amdgcn_ds_read_tr16_b64_v4i16((LAS v4i16*)(a + 4 * ldb));
    return __builtin_shufflevector(lo, hi, 0, 1, 2, 3, 4, 5, 6, 7);
}

#define XB_TMO      128
#define XB_XCNT(j)  (256  + 64 * (j))
#define XB_XSUB(j)  (1280 + 64 * (j))
#define XB_XGEN(j)  (2304 + 64 * (j))
#define XB_TOP      3328
#define XB_TOPGEN   3392
#define XCD_BAR_WORDS 3456
#define XB_SPIN_CAP (1u << 18)

__device__ __forceinline__ unsigned xb_ld(unsigned* p)              { return __hip_atomic_load(p, __ATOMIC_RELAXED, __HIP_MEMORY_SCOPE_AGENT); }
__device__ __forceinline__ unsigned xb_add(unsigned* p, unsigned v) { return __hip_atomic_fetch_add(p, v, __ATOMIC_RELAXED, __HIP_MEMORY_SCOPE_AGENT); }
__device__ __forceinline__ unsigned xb_xcc_id() { return (unsigned)__builtin_amdgcn_s_getreg((3 << 11) | 20) & 0xFu; }
#define XB_SPIN(cond, bar) do { unsigned _sp = 0; while (cond) { __builtin_amdgcn_s_sleep(1); \
    if ((++_sp & 255u) == 0u) { if (xb_ld(&(bar)[XB_TMO])) break; if (_sp > XB_SPIN_CAP) { atomicAdd(&(bar)[XB_TMO], 1u); break; } } } } while (0)

struct XcdBarrier {
    unsigned* bar; unsigned x;
    volatile LAS unsigned* st;
};

__device__ __forceinline__ XcdBarrier xcd_barrier_post(unsigned* bar, volatile LAS unsigned* st, int wv) {
    XcdBarrier b; b.bar = bar; b.x = xb_xcc_id(); b.st = st;
    if (is_t0(wv)) (void)xb_add(&bar[XB_XCNT(b.x)], 1u);
    return b;
}
__device__ __forceinline__ void xcd_barrier_complete(unsigned* bar, unsigned x, unsigned& nloc, unsigned& nx) {
    const unsigned G = gridDim.x * gridDim.y * gridDim.z;
    unsigned sum, cnt, mine, sp = 0u;
    for (;;) {
        sum = 0u; cnt = 0u; mine = 0u;
#pragma unroll
        for (unsigned j = 0; j < 16; ++j) { const unsigned c = xb_ld(&bar[XB_XCNT(j)]); sum += c; cnt += (c > 0u) ? 1u : 0u; mine = (j == x) ? c : mine; }
        if (sum == G) break;
        __builtin_amdgcn_s_sleep(1);
        if ((++sp & 255u) == 0u) { if (xb_ld(&bar[XB_TMO])) break; if (sp > XB_SPIN_CAP) { atomicAdd(&bar[XB_TMO], 1u); break; } }
    }
    nloc = mine > 0u ? mine : 1u; nx = cnt > 0u ? cnt : 1u;
}

__device__ __forceinline__ void xcd_barrier(const XcdBarrier& b, int wv) {
    asm volatile("s_waitcnt vmcnt(0)" ::: "memory");
    __syncthreads();
    if (is_t0(wv)) {
        unsigned* bar = b.bar;
        __builtin_amdgcn_s_waitcnt(0);
        unsigned nloc = b.st[0], nx = b.st[1];
        if (nloc == 0u) { xcd_barrier_complete(bar, b.x, nloc, nx); b.st[0] = nloc; b.st[1] = nx; }
        const unsigned old = xb_add(&bar[XB_XSUB(b.x)], 1u);
        const unsigned gen = old / nloc;
        if (old + 1u == (gen + 1u) * nloc) {
            __builtin_amdgcn_fence(__ATOMIC_RELEASE, "agent");
            asm volatile("s_waitcnt vmcnt(0)" ::: "memory");
            const unsigned og = xb_add(&bar[XB_TOP], 1u);
            const unsigned tg = og / nx;
            if (og + 1u == (tg + 1u) * nx) xb_add(&bar[XB_TOPGEN], 1u);
            else XB_SPIN(xb_ld(&bar[XB_TOPGEN]) == tg, bar);
            __builtin_amdgcn_fence(__ATOMIC_ACQUIRE, "agent");
            xb_add(&bar[XB_XGEN(b.x)], 1u);
            asm volatile("s_waitcnt vmcnt(0)" ::: "memory");
        } else {
            XB_SPIN(xb_ld(&bar[XB_XGEN(b.x)]) == gen, bar);
            __builtin_amdgcn_fence(__ATOMIC_ACQUIRE, "agent");
            asm volatile("s_waitcnt vmcnt(0)" ::: "memory");
        }
    }
    __syncthreads();
}


struct Args { const float* in[22]; float* out; unsigned char* ws; int ph_lo, ph_hi; };
enum { I_X = 0, I_C, I_CTX, I_CCTX, I_WADA, I_BADA, I_GPREMIX, I_GPOSTMIX, I_GPREFFN, I_GPOSTFFN, I_WIN, I_BIN, I_WOUT, I_MLFB, I_MLNORM, I_HGLB, I_HGNORM, I_DALAM, I_DANORM, I_WG, I_WU, I_WD };

__host__ __device__ __forceinline__ int perm_in_col(int n) { if (n < C_DAQ || n >= C_DAV) return n; const int d = (n - C_DAQ) % 48, base = n - d, half = d / 24, e = d % 24; return base + 24 * half + 2 * (e % 12) + (e >= 12 ? 1 : 0); }
__device__ __forceinline__ int wg_pull(unsigned* ctr, volatile LAS int* slot, int wv) {
    __syncthreads();
    if (is_t0(wv)) *slot = (int)__hip_atomic_fetch_add(ctr, 1u, RLX_AGENT);
    __syncthreads();
    return __builtin_amdgcn_readfirstlane(*slot);
}

typedef __attribute__((address_space(4))) const Args* kargs_p;
__device__ __forceinline__ void p0_phase(lptr lds, kargs_p ap, int wv) {
    struct { const float* in[22]; unsigned char* ws; } a; a.in[I_C] = ap->in[I_C]; a.in[I_CCTX] = ap->in[I_CCTX]; a.in[I_WADA] = ap->in[I_WADA]; a.in[I_BADA] = ap->in[I_BADA]; a.in[I_HGLB] = ap->in[I_HGLB]; a.in[I_BIN] = ap->in[I_BIN]; a.in[I_DALAM] = ap->in[I_DALAM]; a.ws = ap->ws;
    const int tid = tid_opaque(wv);
    unsigned char* ws = a.ws;
    LAS float* sil = (LAS float*)lds;
    LAS float* part = (LAS float*)(lds + 69632);
    for (int i = tid; i < 17 * D; i += NTHR) { const int bb = i >> 10, k = i & 1023; const float v = bb < 16 ? a.in[I_C][bb * D + k] : a.in[I_CCTX][k]; sil[i] = v / (1.0f + __expf(-v)); }
    __syncthreads();
    float* mod = (float*)(ws + WS_MOD);
    for (int u = blockIdx.x; u < DEPTH * (NMOD / 32); u += gridDim.x) {
        const int l = u / (NMOD / 32), n0 = (u % (NMOD / 32)) * 32, col = tid & 31, ks = tid >> 5;
        const float* w = a.in[I_WADA] + (size_t)l * D * NMOD + (size_t)(ks * 64) * NMOD + n0 + col;
        float acc[17];
#pragma unroll
        for (int bb = 0; bb < 17; ++bb) acc[bb] = 0.f;
        float wr[64];
#pragma unroll
        for (int k = 0; k < 64; ++k) wr[k] = w[(size_t)k * NMOD];
#pragma unroll
        for (int k = 0; k < 64; k += 4) {
#pragma unroll
            for (int bb = 0; bb < 17; ++bb) { const f32x4 s = *(const LAS f32x4*)(sil + bb * D + ks * 64 + k); acc[bb] += s[0] * wr[k] + s[1] * wr[k + 1] + s[2] * wr[k + 2] + s[3] * wr[k + 3]; }
        }
#pragma unroll
        for (int bb = 0; bb < 17; ++bb) part[(ks * 17 + bb) * 32 + col] = acc[bb];
        __syncthreads();
        for (int i = tid; i < 17 * 32; i += NTHR) { const int bb = i >> 5, cc = i & 31; float s = 0.f;
#pragma unroll
            for (int k2 = 0; k2 < 16; ++k2) s += part[(k2 * 17 + bb) * 32 + cc];
            mod[((size_t)l * 17 + bb) * NMOD + n0 + cc] = s + a.in[I_BADA][l * NMOD + n0 + cc]; }
        __syncthreads();
    }
    const int gt = blockIdx.x * NTHR + tid, GT = gridDim.x * NTHR;
    float* lbs = (float*)(ws + WS_MISC); float* rope = (float*)(ws + WS_MISC + 16384); float* biasp = (float*)(ws + WS_MISC + 32768); float* lamv = (float*)(ws + WS_MISC + 114688);
    for (int j = gt; j < 1024; j += GT) { const float* hl = a.in[I_HGLB];
        const float v0 = hl[j], v1 = hl[1024 + j], v2 = hl[2048 + j], v3 = hl[3072 + j]; const float mx = fmaxf(fmaxf(v0, v1), fmaxf(v2, v3));
        const float e0 = expf(v0 - mx), e1 = expf(v1 - mx), e2 = expf(v2 - mx), e3 = expf(v3 - mx), inv = 1.0f / (e0 + e1 + e2 + e3);
        lbs[j] = 0.f; lbs[1024 + j] = e1 * inv; lbs[2048 + j] = (e1 + e2) * inv; lbs[3072 + j] = (e1 + e2 + e3) * inv; }
    for (int j = gt; j < 64 * 12; j += GT) { const int pos = j / 12, i = j % 12; const float inv = powf(10000.0f, -(float)(2 * i) / 24.0f); const float ang = (float)pos * inv; rope[2 * j] = cosf(ang); rope[2 * j + 1] = sinf(ang); }
    for (int j = gt; j < DEPTH * DINP; j += GT) { const int l = j / DINP, n = j % DINP; biasp[l * DINP + perm_in_col(n)] = n < DIN ? a.in[I_BIN][l * DIN + n] : 0.f; }
    if (gt < DEPTH) { const float* lv = a.in[I_DALAM] + gt * 4 * 48; float s01 = 0.f, s23 = 0.f;
        for (int d = 0; d < 48; ++d) { s01 += lv[d] * lv[48 + d]; s23 += lv[96 + d] * lv[144 + d]; }
        const float lam_init = 0.8f - 0.6f * expf(-0.3f * (float)gt);
        lamv[gt] = expf(s01) - expf(s23) + lam_init; }
}

template <bool RES, bool NORM, bool XSF, bool XDF>
__device__ __forceinline__ void thin_phase(int row_lo, const float* xs_lat, const float* xs_ctx, float* xd_lat, bf16* xbuf, bool write_x,
                                           const bf16* y, const float* mod_r, int goff, const float* gpost,
                                           const float* mod_n, int soff, int aoff, const float* gpre, bf16* hout, int vcu, int G, int wv, int probe = 0) {
    const int tid = tid_opaque(wv); const int lane = tid & 63, wave = wv;
    const int nrows = MT - row_lo; int rwg = (nrows + G - 1) / G; rwg += rwg & 1;
    const int wbeg = row_lo + vcu * rwg, rend = (wbeg + rwg < MT) ? wbeg + rwg : MT;
    const int rbeg = wbeg + 2 * wave;
    constexpr int RSTEP = 2 * NWAVES;
    int cur_bb = -1;
    f32x4 gp[4], ga[4], sh[4];
#pragma unroll
    for (int j = 0; j < 4; ++j) { gp[j] = (f32x4){0.f, 0.f, 0.f, 0.f}; ga[j] = gp[j]; sh[j] = gp[j]; }
    f32x4 xa[2][4], ya[2][4];
#define TH_LOAD(X, Y, r_) do { _Pragma("unroll") for (int q_ = 0; q_ < 2; ++q_) { const int rr_ = (r_) + q_; const bool ic_ = rr_ < MC; \
        const float* xs_ = ic_ ? xs_ctx + (size_t)rr_ * D : xs_lat + (size_t)(rr_ - MC) * D; \
        _Pragma("unroll") for (int j_ = 0; j_ < 4; ++j_) { if (XSF) X[q_][j_] = *(const f32x4*)(xs_ + 4 * lane + 256 * j_); \
            else { const v2u xw_ = __builtin_nontemporal_load((const v2u*)(xbuf + (size_t)rr_ * D + 4 * lane + 256 * j_)); X[q_][j_] = (f32x4){bflo(xw_.x), bfhi(xw_.x), bflo(xw_.y), bfhi(xw_.y)}; } \
            if (RES) { const v2u yw_ = __builtin_nontemporal_load((const v2u*)(y + (size_t)rr_ * D + 4 * lane + 256 * j_)); Y[q_][j_] = (f32x4){bflo(yw_.x), bfhi(yw_.x), bflo(yw_.y), bfhi(yw_.y)}; } } } } while (0)
    if (rbeg < rend) TH_LOAD(xa, ya, rbeg);
    for (int r = rbeg; r < rend; r += RSTEP) {
        f32x4 xb[2][4], yb[2][4];
        if (r + RSTEP < rend) TH_LOAD(xb, yb, r + RSTEP);
        const bool isctx = r < MC; const int bb = isctx ? 16 : (r - MC) / SEQ;
        if (bb != cur_bb) { cur_bb = bb;
#pragma unroll
            for (int j = 0; j < 4; ++j) { const int e = 4 * lane + 256 * j;
                if (RES) gp[j] = *(const f32x4*)(mod_r + (size_t)bb * NMOD + goff + e) * *(const f32x4*)(gpost + e);
                if (NORM) { ga[j] = *(const f32x4*)(gpre + e) * (*(const f32x4*)(mod_n + (size_t)bb * NMOD + aoff + e) + 1.0f); sh[j] = *(const f32x4*)(mod_n + (size_t)bb * NMOD + soff + e); } } }
        if (RES) { float s0 = 0.f, s1 = 0.f;
#pragma unroll
            for (int j = 0; j < 4; ++j) { s0 += (ya[0][j][0] * ya[0][j][0] + ya[0][j][1] * ya[0][j][1]) + (ya[0][j][2] * ya[0][j][2] + ya[0][j][3] * ya[0][j][3]);
                                          s1 += (ya[1][j][0] * ya[1][j][0] + ya[1][j][1] * ya[1][j][1]) + (ya[1][j][2] * ya[1][j][2] + ya[1][j][3] * ya[1][j][3]); }
#pragma unroll
            for (int o = 1; o < 64; o <<= 1) { s0 += lx_xor(s0, o, lane); s1 += lx_xor(s1, o, lane); }
            const float r0s = 1.0f / sqrtf(s0 * (1.0f / D) + EPS), r1s = 1.0f / sqrtf(s1 * (1.0f / D) + EPS);
#pragma unroll
            for (int j = 0; j < 4; ++j) { xa[0][j] += gp[j] * ya[0][j] * r0s; xa[1][j] += gp[j] * ya[1][j] * r1s; } }
        if (write_x && !(probe & 1)) {
            if (XDF) { float* xd0 = xd_lat + (size_t)(r - MC) * D;
#pragma unroll
                for (int j = 0; j < 4; ++j) { *(f32x4*)(xd0 + 4 * lane + 256 * j) = xa[0][j]; *(f32x4*)(xd0 + D + 4 * lane + 256 * j) = xa[1][j]; } }
            else {
#pragma unroll
                for (int j = 0; j < 4; ++j) { v2u w0, w1; w0.x = pk2(xa[0][j][0], xa[0][j][1]); w0.y = pk2(xa[0][j][2], xa[0][j][3]); w1.x = pk2(xa[1][j][0], xa[1][j][1]); w1.y = pk2(xa[1][j][2], xa[1][j][3]);
                    __builtin_nontemporal_store(w0, (v2u*)(xbuf + (size_t)r * D + 4 * lane + 256 * j)); __builtin_nontemporal_store(w1, (v2u*)(xbuf + (size_t)(r + 1) * D + 4 * lane + 256 * j));
                    if (NORM) { xa[0][j] = (f32x4){bflo(w0.x), bfhi(w0.x), bflo(w0.y), bfhi(w0.y)}; xa[1][j] = (f32x4){bflo(w1.x), bfhi(w1.x), bflo(w1.y), bfhi(w1.y)}; } } } }
        if (NORM) { float s0 = 0.f, s1 = 0.f;
#pragma unroll
            for (int j = 0; j < 4; ++j) { s0 += (xa[0][j][0] * xa[0][j][0] + xa[0][j][1] * xa[0][j][1]) + (xa[0][j][2] * xa[0][j][2] + xa[0][j][3] * xa[0][j][3]);
                                          s1 += (xa[1][j][0] * xa[1][j][0] + xa[1][j][1] * xa[1][j][1]) + (xa[1][j][2] * xa[1][j][2] + xa[1][j][3] * xa[1][j][3]); }
#pragma unroll
            for (int o = 1; o < 64; o <<= 1) { s0 += lx_xor(s0, o, lane); s1 += lx_xor(s1, o, lane); }
            const float r0s = 1.0f / sqrtf(s0 * (1.0f / D) + EPS), r1s = 1.0f / sqrtf(s1 * (1.0f / D) + EPS);
#pragma unroll
            for (int j = 0; j < 4; ++j) { const f32x4 h0 = xa[0][j] * r0s * ga[j] + sh[j], h1 = xa[1][j] * r1s * ga[j] + sh[j];
                v2u w0, w1; w0.x = pk2(h0[0], h0[1]); w0.y = pk2(h0[2], h0[3]); w1.x = pk2(h1[0], h1[1]); w1.y = pk2(h1[2], h1[3]);
                if (!(probe & 2)) { *(v2u*)(hout + (size_t)r * D + 4 * lane + 256 * j) = w0; *(v2u*)(hout + (size_t)(r + 1) * D + 4 * lane + 256 * j) = w1; } } }
#pragma unroll
        for (int q = 0; q < 2; ++q)
#pragma unroll
            for (int j = 0; j < 4; ++j) { xa[q][j] = xb[q][j]; if (RES) ya[q][j] = yb[q][j]; }
    }
#undef TH_LOAD
}

template <int MODE>
__device__ __forceinline__ void tr_item(const float* W, int K, int N, int nblk, bf16* WT, LAS float* scr, int item, int lane) {
    const int kb = item / nblk, nb = item % nblk, k0 = 64 * kb, n0 = 32 * nb;
    const int nn = n0 + (lane & 31); const bool ok = nn < N;
#pragma unroll 8
    for (int i = 0; i < 32; ++i) { const int kk = 2 * i + (lane >> 5); scr[kk * 33 + (lane & 31)] = ok ? W[(size_t)(k0 + kk) * N + nn] : 0.f; }
    LDS_WAIT(); asm volatile("" ::: "memory");
    const int c = lane & 7;
#pragma unroll
    for (int j = 0; j < 4; ++j) { const int n = (lane >> 3) + 8 * j; const LAS float* s = scr + (8 * c) * 33 + n;
        v4u o; o.x = pk2(s[0 * 33], s[1 * 33]); o.y = pk2(s[2 * 33], s[3 * 33]); o.z = pk2(s[4 * 33], s[5 * 33]); o.w = pk2(s[6 * 33], s[7 * 33]);
        const int ng = n0 + n; const int drow = MODE == 0 ? ng : MODE == 3 ? perm_in_col(ng) : ((ng >> 7) * 256 + (ng & 127) + (MODE == 2 ? 128 : 0));
        *(v4u*)(WT + (size_t)drow * K + k0 + 8 * c) = o; }
    LDS_WAIT(); asm volatile("" ::: "memory");
}
__device__ __forceinline__ void convert_weights(lptr lds, kargs_p ap, int l, int vcu, int G, int wv) {
    const unsigned char* const wsb = ap->ws; const float* const p_win = ap->in[I_WIN]; const float* const p_wout = ap->in[I_WOUT]; const float* const p_wg = ap->in[I_WG]; const float* const p_wu = ap->in[I_WU]; const float* const p_wd = ap->in[I_WD];
    const int tid = tid_opaque(wv); const int lane = tid & 63, wave = wv;
    LAS float* scr = (LAS float*)(lds + wave * 8448);
    const int gw = vcu * NWAVES + wave, NGW = G * NWAVES;
    unsigned char* ws = (unsigned char*)wsb;
    constexpr int I_IN = 16 * (DINP / 32), I_OUT = 16 * 32, I_GU = 16 * (DFF / 32), I_DN = (DFF / 64) * 32;
    constexpr int NITEMS = I_IN + I_OUT + 2 * I_GU + I_DN;
    for (int it = gw; it < NITEMS; it += NGW) {
        int r = it;
        if (r < I_IN) { tr_item<3>(p_win + (size_t)l * D * DIN, D, DIN, DINP / 32, (bf16*)(ws + WS_WIN), scr, r, lane); continue; } r -= I_IN;
        if (r < I_OUT) { tr_item<0>(p_wout + (size_t)l * D * D, D, D, 32, (bf16*)(ws + WS_WOUT), scr, r, lane); continue; } r -= I_OUT;
        if (r < I_GU) { tr_item<1>(p_wg + (size_t)l * D * DFF, D, DFF, DFF / 32, (bf16*)(ws + WS_WGU), scr, r, lane); continue; } r -= I_GU;
        if (r < I_GU) { tr_item<2>(p_wu + (size_t)l * D * DFF, D, DFF, DFF / 32, (bf16*)(ws + WS_WGU), scr, r, lane); continue; } r -= I_GU;
        tr_item<0>(p_wd + (size_t)l * DFF * D, DFF, D, 32, (bf16*)(ws + WS_WD), scr, r, lane);
    }
}
constexpr int AT_BUF = 25600, AT_KOFF = 0, AT_VOFF = 13312, AT_QF = 76800;
constexpr float AT_THR = 8.0f;
constexpr float QSCALE = 0.14433756729740643f * 1.4426950408889634f;

__device__ __forceinline__ f32x16 zero16() { f32x16 z; _Pragma("unroll") for (int r = 0; r < 16; ++r) z[r] = 0.f; return z; }
__device__ __forceinline__ float sm_max(const f32x16& S, int lane) {
    float mx = S[0];
#pragma unroll
    for (int r = 1; r < 16; ++r) mx = fmaxf(mx, S[r]);
    return fmaxf(mx, lx_xor(mx, 32, lane));
}
__device__ __forceinline__ void sm_exp(const f32x16& S, float m, float& l, bf16x8& p0, bf16x8& p1) {
    float p[16]; float ps = 0.f;
#pragma unroll
    for (int r = 0; r < 16; ++r) { p[r] = __builtin_amdgcn_exp2f(S[r] - m); ps += p[r]; }
    l += ps;
    v4u a, b;
    a.x = pk2(p[0], p[1]); a.y = pk2(p[2], p[3]); a.z = pk2(p[4], p[5]); a.w = pk2(p[6], p[7]);
    b.x = pk2(p[8], p[9]); b.y = pk2(p[10], p[11]); b.z = pk2(p[12], p[13]); b.w = pk2(p[14], p[15]);
    p0 = __builtin_bit_cast(bf16x8, a); p1 = __builtin_bit_cast(bf16x8, b);
}
__device__ __forceinline__ bf16x8 vt_frag(lptr vt, int ct, int sub, int sp, int lane) {
    const int h = lane >> 5, blk = (lane >> 4) & 1, q = (lane & 15) >> 2, p = lane & 3;
    lptr a = vt + (32 * sub + 16 * sp + 4 * h + q) * 192 + (32 * ct + 16 * blk + 4 * p) * 2;
    const v4i16 lo = __builtin_amdgcn_ds_read_tr16_b64_v4i16((LAS v4i16*)a);
    const v4i16 hi = __builtin_amdgcn_ds_read_tr16_b64_v4i16((LAS v4i16*)(a + 8 * 192));
    return __builtin_shufflevector(lo, hi, 0, 1, 2, 3, 4, 5, 6, 7);
}

__device__ __forceinline__ void attn_item(lptr lds, const bf16* P, bf16* YM, const float* danorm, float lam, float out_scale, int b, int h, int qb, int probe, int wv) {
    const int tid = tid_opaque(wv), lane = tid & 63, r32 = lane & 31, hi = lane >> 5, wave = wv;
    const bool lat = qb < 8;
    const int qrow0 = lat ? MC + b * SEQ + qb * 256 : b * CTXL;
    const int nt = lat ? 36 : 4;
    v4u cin[2];
    const unsigned kgo0 = (unsigned)(tid / 12) * DAX_LD + 16u * (unsigned)(tid % 12) + 192u, kgo1 = (unsigned)((tid + 512) / 12) * DAX_LD + 16u * (unsigned)((tid + 512) % 12) + 192u;
    const unsigned klo0 = (unsigned)(AT_KOFF + (tid / 12) * 208 + (tid % 12) * 16), klo1 = (unsigned)(AT_KOFF + ((tid + 512) / 12) * 208 + ((tid + 512) % 12) * 16);
    const unsigned vgo0 = (unsigned)((64 * wave + lane) / 12) * DAX_LD + 16u * (unsigned)((64 * wave + lane) % 12) + 384u, vgo1 = (unsigned)((64 * (wave + 8) + lane) / 12) * DAX_LD + 16u * (unsigned)((64 * (wave + 8) + lane) % 12) + 384u;
    const char* DX = (const char*)P + DAX_OFF + (size_t)(b * 4 + h) * NSLOT * DAX_LD;
#define AT_LOAD(tile) do { const char* tb_ = DX + (size_t)(tile) * (64 * DAX_LD); cin[0] = gld16(tb_, kgo0); if (tid < 256) cin[1] = gld16(tb_, kgo1); } while (0)
#define AT_STORE(tile, buf) do { lptr sb_ = lds + (buf) * AT_BUF; *(LAS v4u*)(sb_ + klo0) = cin[0]; if (tid < 256) *(LAS v4u*)(sb_ + klo1) = cin[1]; } while (0)
#define AT_VDMA(tile, buf) do { const char* tb_ = DX + (size_t)(tile) * (64 * DAX_LD); lptr vb_ = lds + (buf) * AT_BUF + AT_VOFF; \
        __builtin_amdgcn_global_load_lds((const unsigned*)(tb_ + vgo0), (LAS unsigned*)(vb_ + wave * 1024), 16, 0, 0); \
        if (wave < 4) __builtin_amdgcn_global_load_lds((const unsigned*)(tb_ + vgo1), (LAS unsigned*)(vb_ + (wave + 8) * 1024), 16, 0, 0); } while (0)
    AT_LOAD(0);
    lptr qfp = lds + AT_QF + (wave * 6 * 64 + lane) * 16;
    { const unsigned qo = (unsigned)((lat ? CTXL + qb * 256 : 0) + wave * 32 + r32) * DAX_LD + 16u * hi;
#pragma unroll
      for (int f = 0; f < 6; ++f) __builtin_amdgcn_global_load_lds((const unsigned*)(DX + qo + (unsigned)((f / 3) * 48 + (f % 3) * 16) * 2u), (LAS unsigned*)(lds + AT_QF + (wave * 6 + f) * 1024), 16, 0, 0); }
    AT_STORE(0, 0); AT_VDMA(0, 0);
    if (nt > 1) { AT_LOAD(1); AT_VDMA(1, 1); }
    __syncthreads();
    f32x16 O0[3], O1[3];
#pragma unroll
    for (int ct = 0; ct < 3; ++ct)
#pragma unroll
        for (int r = 0; r < 16; ++r) { O0[ct][r] = 0.f; O1[ct][r] = 0.f; }
    float m0 = -1e30f, m1 = -1e30f, l0 = 0.f, l1 = 0.f;
#define AT_QK(SX0, SX1, kb, sub) do { \
        _Pragma("unroll") for (int ks = 0; ks < 3; ++ks) { \
            const bf16x8 k0_ = lds8((kb) + (((sub) * 32 + r32) * 104 + ks * 16 + hi * 8) * 2); \
            const bf16x8 k1_ = lds8((kb) + (((sub) * 32 + r32) * 104 + 48 + ks * 16 + hi * 8) * 2); \
            const bf16x8 q0_ = lds8(qfp + ks * 1024), q1_ = lds8(qfp + (3 + ks) * 1024); \
            if (ks == 0) { SX0 = MFMA32(k0_, q0_, zero16()); SX1 = MFMA32(k1_, q1_, zero16()); } \
            else { SX0 = MFMA32(k0_, q0_, SX0); SX1 = MFMA32(k1_, q1_, SX1); } } } while (0)
#define AT_SMPV(SX0, SX1, vb, sub) do { \
        const float mx0_ = sm_max(SX0, lane), mx1_ = sm_max(SX1, lane); \
        if (__any((mx0_ > m0 + AT_THR) || (mx1_ > m1 + AT_THR))) { \
            const float n0_ = fmaxf(m0, mx0_), n1_ = fmaxf(m1, mx1_); \
            const float a0_ = __builtin_amdgcn_exp2f(m0 - n0_), a1_ = __builtin_amdgcn_exp2f(m1 - n1_); \
            m0 = n0_; m1 = n1_; l0 *= a0_; l1 *= a1_; \
            _Pragma("unroll") for (int ct = 0; ct < 3; ++ct) _Pragma("unroll") for (int r = 0; r < 16; ++r) { O0[ct][r] *= a0_; O1[ct][r] *= a1_; } } \
        bf16x8 p00_, p01_, p10_, p11_; \
        sm_exp(SX0, m0, l0, p00_, p01_); sm_exp(SX1, m1, l1, p10_, p11_); \
        _Pragma("unroll") for (int ct = 0; ct < 3; ++ct) { \
            const bf16x8 v0_ = vt_frag((vb), ct, (sub), 0, lane); const bf16x8 v1_ = vt_frag((vb), ct, (sub), 1, lane); \
            O0[ct] = MFMA32(v0_, p00_, O0[ct]); O1[ct] = MFMA32(v0_, p10_, O1[ct]); \
            O0[ct] = MFMA32(v1_, p01_, O0[ct]); O1[ct] = MFMA32(v1_, p11_, O1[ct]); } } while (0)
    f32x16 SA0, SA1, SB0, SB1;
    AT_QK(SA0, SA1, lds + AT_KOFF, 0);
    int cb = 0;
    for (int i = 0; i < nt; ++i) {
        const int nb = (cb == 2) ? 0 : cb + 1;
        lptr kc_ = lds + cb * AT_BUF + AT_KOFF, vc_ = lds + cb * AT_BUF + AT_VOFF;
        AT_QK(SB0, SB1, kc_, 1);
        AT_SMPV(SA0, SA1, vc_, 0);
        if (i + 1 < nt && !(probe & 2)) AT_STORE(i + 1, nb);
        __syncthreads();
        if (i + 2 < nt && !(probe & 1)) { AT_LOAD(i + 2); AT_VDMA(i + 2, (nb == 2) ? 0 : nb + 1); }
        if (i + 1 < nt) AT_QK(SA0, SA1, lds + nb * AT_BUF + AT_KOFF, 0);
        AT_SMPV(SB0, SB1, vc_, 1);
        cb = nb;
    }
#undef AT_LOAD
#undef AT_VDMA
#undef AT_STORE
#undef AT_QK
#undef AT_SMPV
    const float i0 = 1.0f / (l0 + lx_xor(l0, 32, lane)), i1 = lam / (l1 + lx_xor(l1, 32, lane));
    float ss = 0.f;
#pragma unroll
    for (int ct = 0; ct < 3; ++ct)
#pragma unroll
        for (int r = 0; r < 16; ++r) { const float o = O0[ct][r] * i0 - O1[ct][r] * i1; O0[ct][r] = o; ss += o * o; }
    ss += lx_xor(ss, 32, lane);
    const float rs = out_scale / sqrtf(ss * (1.0f / 96.0f) + EPS);
    const unsigned oro = ((unsigned)(qrow0 + wave * 32 + r32) * (unsigned)D + (unsigned)(Y_DA + h * 96)) * 2u;
#pragma unroll
    for (int ct = 0; ct < 3; ++ct)
#pragma unroll
        for (int g = 0; g < 4; ++g) { const int c0 = 32 * ct + 8 * g + 4 * hi; const f32x4 gn = *(const f32x4*)(danorm + c0);
            v2u w; w.x = pk2(O0[ct][4 * g] * rs * gn[0], O0[ct][4 * g + 1] * rs * gn[1]); w.y = pk2(O0[ct][4 * g + 2] * rs * gn[2], O0[ct][4 * g + 3] * rs * gn[3]);
            gst8(YM, oro + 2u * c0, w); }
}
__device__ __forceinline__ int scan_row(int b, int dir, int p) {
    if (p < CTXL) { const int t = dir ? CTXL - 1 - p : p; return b * CTXL + t; }
    const int pl = p - CTXL; const int t = dir ? SEQ - 1 - pl : pl; return MC + b * SEQ + t;
}
__device__ __forceinline__ int scan_slot(int dir, int p) { if (p < CTXL) return dir ? CTXL - 1 - p : p; const int pl = p - CTXL; return CTXL + (dir ? SEQ - 1 - pl : pl); }
__device__ __forceinline__ v2u gld8nt(const void* base, unsigned off) { return __builtin_nontemporal_load((const v2u*)((const char*)base + off)); }

constexpr int ML_Q = 0, ML_K = 13312, ML_KW = 26624, ML_VA = 40960, ML_QKM = 55296, ML_ST = 64512, ML_GF = 87808, ML_GN = 89600, ML_OB = 90112;
constexpr int ML_LDQ = 208, ML_LDW = 224, ML_LDM = 144, ML_LDS = 208;
constexpr float KSCALE = 0.10206207261596577f;

__device__ __forceinline__ void mlstm_stream(lptr lds, const bf16* P, const float* G, bf16* YM, bf16* RAW  , const float* fbias  , const float* gain  , int b, int h, int dir, bool with_ctx, int wv) {
    const int tid = tid_opaque(wv), lane = tid & 63, c16 = lane & 15, rg = lane >> 4, wave = wv;
    lptr Qs = lds + ML_Q, Ks = lds + ML_K, Kw = lds + ML_KW, Va = lds + ML_VA, QKM = lds + ML_QKM, ST = lds + ML_ST;
    LAS float* gA = (LAS float*)(lds + ML_GF); LAS float* MxA = gA + 64; LAS float* wA = gA + 128; LAS float* emtA = gA + 192; LAS float* wkA = gA + 256; LAS float* scal = gA + 320;
    if (tid < 128) { const int t = tid >> 1, hh = tid & 1; v4u w; w.x = hh ? 0u : 0x3F80u; w.y = 0u; w.z = 0u; w.w = 0u; *(LAS v4u*)(Va + t * ML_LDW + (96 + 8 * hh) * 2) = w; }
    if (tid < 96) ((LAS float*)(lds + ML_GN))[tid] = gain[h * 96 + tid];
    const float fb = fbias[dir * 4 + h];
    f32x4 acc[6];
#pragma unroll
    for (int i = 0; i < 6; ++i) acc[i] = (f32x4){0.f, 0.f, 0.f, 0.f};
    float m_prev = -1e30f;
    v4u pre[5]; float gi = 0.f, gf = 0.f;
    const char* MLB = (const char*)P + MLX_OFF + (size_t)(b * 4 + h) * NSLOT * MLX_LD;
#define ML_PREFETCH(c) do { const char* cb_ = MLB + (size_t)(dir ? scan_slot(1, 64 * (c) + 63) : scan_slot(0, 64 * (c))) * MLX_LD; \
    _Pragma("unroll") for (int i_ = 0; i_ < 5; ++i_) { const int id_ = tid + NTHR * i_; if (id_ < 2304) { const int t_ = id_ / 36, r_ = id_ % 36; \
        pre[i_] = gld16(cb_, (unsigned)(dir ? 63 - t_ : t_) * MLX_LD + (unsigned)((r_ / 12) * 96 + (r_ % 12) * 8) * 2u); } } \
    if (wave == 0) { const unsigned go_ = (unsigned)scan_row(b, dir, 64 * (c) + lane) * 64u + (unsigned)(dir * 4 + h) * 4u; gi = *(const float*)((const char*)G + go_); gf = *(const float*)((const char*)G + go_ + 32u); } } while (0)
#define ML_FLOAD(cp) do { const int t_ = 16 * (wave - 4) + c16; const int row_ = scan_row(b, 1, 64 * (cp) + t_); const char* ob_ = (const char*)P + MLO_OFF; \
        const unsigned ro_ = ((unsigned)scan_slot(1, 64 * (cp) + t_) * 96u + 4u * rg) * 2u, go_ = (unsigned)row_ * MLO_LD + (unsigned)(h * 96 + 4 * rg) * 2u; \
        fyo = ((unsigned)row_ * (unsigned)D + (unsigned)(Y_ML + h * 96 + 4 * rg)) * 2u; \
        _Pragma("unroll") for (int vi = 0; vi < 6; ++vi) { rawr[vi] = gld8nt(RAW, ro_ + 32u * vi); ogr[vi] = gld8nt(ob_, go_ + 32u * vi); } } while (0)
#define ML_FINISH(cp) do { lptr obr_ = lds + ML_OB + ((cp) & 1) * 12288 + (wave - 4) * 3072 + lane * 8; f32x4 tv_[6]; float ss_ = 0.f; \
        _Pragma("unroll") for (int vi = 0; vi < 6; ++vi) { const v2u o_ = *(const LAS v2u*)(obr_ + vi * 512); \
            tv_[vi] = (f32x4){bflo(o_.x) + bflo(rawr[vi].x), bfhi(o_.x) + bfhi(rawr[vi].x), bflo(o_.y) + bflo(rawr[vi].y), bfhi(o_.y) + bfhi(rawr[vi].y)}; \
            ss_ += tv_[vi][0] * tv_[vi][0] + tv_[vi][1] * tv_[vi][1] + tv_[vi][2] * tv_[vi][2] + tv_[vi][3] * tv_[vi][3]; } \
        ss_ += lx_xor(ss_, 16, lane); ss_ += lx_xor(ss_, 32, lane); \
        const float rs_ = 1.0f / sqrtf(ss_ * (1.0f / 96.0f) + EPS); \
        _Pragma("unroll") for (int vi = 0; vi < 6; ++vi) { const f32x4 gn_ = *(const LAS f32x4*)((LAS float*)(lds + ML_GN) + 16 * vi + 4 * rg); \
            const float o0_ = bflo(ogr[vi].x), o1_ = bfhi(ogr[vi].x), o2_ = bflo(ogr[vi].y), o3_ = bfhi(ogr[vi].y); v2u w_; \
            w_.x = pk2(tv_[vi][0] * rs_ * gn_[0] * __builtin_amdgcn_rcpf(1.0f + __expf(-o0_)), tv_[vi][1] * rs_ * gn_[1] * __builtin_amdgcn_rcpf(1.0f + __expf(-o1_))); \
            w_.y = pk2(tv_[vi][2] * rs_ * gn_[2] * __builtin_amdgcn_rcpf(1.0f + __expf(-o2_)), tv_[vi][3] * rs_ * gn_[3] * __builtin_amdgcn_rcpf(1.0f + __expf(-o3_))); \
            gst8(YM, fyo + 32u * vi, w_); } } while (0)
    ML_PREFETCH(0);
    for (int c = 0; c < NTOK / 64; ++c) {
        const bool pend = dir && c > 0 && (with_ctx || c - 1 >= CTXL / 64);
        v2u rawr[6], ogr[6]; unsigned fyo;
#pragma unroll
        for (int i = 0; i < 5; ++i) { const int id = tid + NTHR * i; if (id < 2304) { const int t = id / 36, r = id % 36, wh = r / 12, cc = r % 12;
            lptr d = (wh == 0) ? Qs + t * ML_LDQ : (wh == 1) ? Ks + t * ML_LDQ : Va + t * ML_LDW;
            *(LAS v4u*)(d + cc * 16) = pre[i]; } }
        if (wave == 0) {
            const float fp = gf + fb;
            const float lf = fminf(fp, 0.f) - log1pf(__expf(-fabsf(fp)));
            const float bs = scan_sum64(lf);
            const float g = gi - bs;
            const float cm = scan_max64(g);
            const float Mx = fmaxf(m_prev, cm);
            const float mt = bs + Mx;
            const float blast = lx_idx(bs, 63), m_new = lx_idx(mt, 63);
            gA[lane] = g; MxA[lane] = Mx; wA[lane] = __expf(m_prev - Mx); emtA[lane] = __expf(-mt); wkA[lane] = __expf(g + blast - m_new) * KSCALE;
            if (lane == 0) scal[0] = __expf(blast + m_prev - m_new);
            m_prev = m_new;
        }
        if (c + 1 < NTOK / 64) ML_PREFETCH(c + 1);
        __syncthreads();
#pragma unroll
        for (int j = 0; j < 2; ++j) { const int idx = 2 * wave + j, si = idx & 3, ti = idx >> 2;
            f32x4 a4 = (f32x4){0.f, 0.f, 0.f, 0.f};
            if (si <= ti) {
#pragma unroll
                for (int ks = 0; ks < 3; ++ks) a4 = MFMA16(opr(Ks, ML_LDQ, 16 * si, 32 * ks, c16, rg), opr(Qs, ML_LDQ, 16 * ti, 32 * ks, c16, rg), a4);
            }
            const int t = 16 * ti + c16, s0 = 16 * si + 4 * rg; const float mxt = MxA[t]; const f32x4 g4 = *(const LAS f32x4*)(gA + s0);
            float v[4];
#pragma unroll
            for (int r = 0; r < 4; ++r) v[r] = (s0 + r <= t) ? a4[r] * KSCALE * __expf(g4[r] - mxt) : 0.f;
            v2u w; w.x = pk2(v[0], v[1]); w.y = pk2(v[2], v[3]); *(LAS v2u*)(QKM + t * ML_LDM + s0 * 2) = w; }
        for (int id = tid; id < 64 * 12; id += NTHR) { const int t = id / 12, cc = id % 12; const v4u w = *(const LAS v4u*)(Ks + t * ML_LDQ + cc * 16); const float sc = wkA[t];
            v4u o; o.x = pk2(bflo(w.x) * sc, bfhi(w.x) * sc); o.y = pk2(bflo(w.y) * sc, bfhi(w.y) * sc); o.z = pk2(bflo(w.z) * sc, bfhi(w.z) * sc); o.w = pk2(bflo(w.w) * sc, bfhi(w.w) * sc);
            *(LAS v4u*)(Kw + t * ML_LDW + cc * 16) = o; }
#pragma unroll
        for (int i = 0; i < 6; ++i) { const int j = wave + 8 * i; if (j < 42) { const int di = j / 7, vi = j % 7;
            v2u w; w.x = pk2(acc[i][0], acc[i][1]); w.y = pk2(acc[i][2], acc[i][3]); *(LAS v2u*)(ST + (16 * vi + c16) * ML_LDS + (16 * di + 4 * rg) * 2) = w; } }
        __syncthreads();
        if (wave < 4) {
            const int ti = wave, t = 16 * ti + c16;
            const bool outp = with_ctx || c >= CTXL / 64;
            const int row = scan_row(b, dir, 64 * c + t);
            const unsigned ro = ((unsigned)scan_slot(dir, 64 * c + t) * 96u + 4u * rg) * 2u;
            f32x4 aX[7];
#pragma unroll
            for (int vi = 0; vi < 7; ++vi) aX[vi] = (f32x4){0.f, 0.f, 0.f, 0.f};
#pragma unroll
            for (int ks = 0; ks < 3; ++ks) { const bf16x8 b8 = opr(Qs, ML_LDQ, 16 * ti, 32 * ks, c16, rg);
#pragma unroll
                for (int vi = 0; vi < 7; ++vi) aX[vi] = MFMA16(opr(ST, ML_LDS, 16 * vi, 32 * ks, c16, rg), b8, aX[vi]); }
            { const float wt = wA[t];
#pragma unroll
              for (int vi = 0; vi < 7; ++vi) aX[vi] = aX[vi] * wt; }
#pragma unroll
            for (int ks = 0; ks < 2; ++ks) { const bf16x8 b8 = opr(QKM, ML_LDM, 16 * ti, 32 * ks, c16, rg);
#pragma unroll
                for (int vi = 0; vi < 7; ++vi) aX[vi] = MFMA16(opt(Va, ML_LDW, 16 * vi, 32 * ks, lane), b8, aX[vi]); }
            const float den = lx_idx(aX[6][0], c16);
            const float inv = 1.0f / fmaxf(fabsf(den), emtA[t]);
            if (outp) {
                if (!dir) {
#pragma unroll
                    for (int vi = 0; vi < 6; ++vi) { v2u w; w.x = pk2(aX[vi][0] * inv, aX[vi][1] * inv); w.y = pk2(aX[vi][2] * inv, aX[vi][3] * inv); gst8(RAW, ro + 32u * vi, w); }
                } else {
                    lptr obw = lds + ML_OB + (c & 1) * 12288 + wave * 3072 + lane * 8;
#pragma unroll
                    for (int vi = 0; vi < 6; ++vi) { v2u w; w.x = pk2(aX[vi][0] * inv, aX[vi][1] * inv); w.y = pk2(aX[vi][2] * inv, aX[vi][3] * inv); *(LAS v2u*)(obw + vi * 512) = w; }
                }
            }
        } else if (pend) ML_FLOAD(c - 1);
        { const float decay = scal[0];
#pragma unroll
          for (int i = 0; i < 6; ++i) { const int j = wave + 8 * i; if (j < 42) { const int di = j / 7, vi = j % 7;
              acc[i] = acc[i] * decay;
#pragma unroll
              for (int ks = 0; ks < 2; ++ks) acc[i] = MFMA16(opt(Kw, ML_LDW, 16 * di, 32 * ks, lane), opt(Va, ML_LDW, 16 * vi, 32 * ks, lane), acc[i]); } } }
        if (wave >= 4 && pend) ML_FINISH(c - 1);
        __syncthreads();
    }
    if (wave >= 4 && dir) { v2u rawr[6], ogr[6]; unsigned fyo; ML_FLOAD(NTOK / 64 - 1); ML_FINISH(NTOK / 64 - 1); }
#undef ML_PREFETCH
#undef ML_FLOAD
#undef ML_FINISH
}

constexpr int HG_QT = 0, HG_KR = 8704, HG_V = 17920, HG_ATT = 23040, HG_SPT = 25600, HG_ER = 43008, HG_TOT = 43520, HG_OFF = 47616, HG_SSQ = 52224;
constexpr int HG_LDQ = 272, HG_LDK = 288, HG_LDV = 160, HG_LDA = 80, HG_LDS = 272;

__device__ __forceinline__ void hgrn2_stream(lptr lds, const bf16* P, bf16* YM, bf16* RAW  , const float* lbl  , const float* gain  , int b, int h, int dir, bool with_ctx, int wv) {
    const int tid = tid_opaque(wv), lane = tid & 63, c16 = lane & 15, rg = lane >> 4, wave = wv;
    lptr QT = lds + HG_QT, KR = lds + HG_KR, Vs = lds + HG_V, ATT = lds + HG_ATT, SPT = lds + HG_SPT;
    LAS float* ER = (LAS float*)(lds + HG_ER); LAS float* TOT = (LAS float*)(lds + HG_TOT); LAS float* OFF = (LAS float*)(lds + HG_OFF);
    const int tt = lane & 31, kh = lane >> 5, k0 = 16 * wave + 8 * kh;
    const int tv = tid >> 3, cv = tid & 7;
    float lb[8];
    { const f32x4 l0 = *(const f32x4*)(lbl + dir * 512 + h * 128 + k0), l1 = *(const f32x4*)(lbl + dir * 512 + h * 128 + k0 + 4);
#pragma unroll
      for (int j = 0; j < 4; ++j) { lb[j] = l0[j]; lb[4 + j] = l1[j]; } }
    f32x4 acc[4];
#pragma unroll
    for (int i = 0; i < 4; ++i) acc[i] = (f32x4){0.f, 0.f, 0.f, 0.f};
    const int oci = wave & 3, oti = wave >> 2, ot = 16 * oti + c16;
    LAS float* SSQ = (LAS float*)(lds + HG_SSQ);
    const f32x4 gn4 = *(const f32x4*)(gain + h * 64 + 16 * oci + 4 * rg);
    f32x4 pt = (f32x4){0.f, 0.f, 0.f, 0.f}; v2u pgg = (v2u){0u, 0u}; unsigned pyo = 0u; bool pend = false;
#define HG_FLUSH() do { const float ss_ = SSQ[ot] + SSQ[32 + ot] + SSQ[64 + ot] + SSQ[96 + ot]; const float rs_ = 1.0f / sqrtf(ss_ * (1.0f / 64.0f) + EPS); \
        const float g0_ = bflo(pgg.x), g1_ = bfhi(pgg.x), g2_ = bflo(pgg.y), g3_ = bfhi(pgg.y); v2u w_; \
        w_.x = pk2(pt[0] * rs_ * gn4[0] * g0_ * __builtin_amdgcn_rcpf(1.0f + __expf(-g0_)), pt[1] * rs_ * gn4[1] * g1_ * __builtin_amdgcn_rcpf(1.0f + __expf(-g1_))); \
        w_.y = pk2(pt[2] * rs_ * gn4[2] * g2_ * __builtin_amdgcn_rcpf(1.0f + __expf(-g2_)), pt[3] * rs_ * gn4[3] * g3_ * __builtin_amdgcn_rcpf(1.0f + __expf(-g3_))); \
        gst8(YM, pyo, w_); } while (0)
    v4u zr, qr, vr;
    const char* HB_ = (const char*)P + HGX_OFF + (size_t)(b * 4 + h) * NSLOT * HGX_LD;
#define HG_PREFETCH(c) do { { const unsigned ro_ = (unsigned)scan_slot(dir, 32 * (c) + tt) * HGX_LD + 2u * k0; \
        zr = gld16(HB_, ro_ + (unsigned)dir * 256u); qr = gld16(HB_, ro_ + 512u); } \
        if (tid < 256) { const unsigned ro_ = (unsigned)scan_slot(dir, 32 * (c) + tv) * HGX_LD + 16u * cv; vr = gld16(HB_, ro_ + 768u); } } while (0)
    HG_PREFETCH(0);
    for (int c = 0; c < NTOK / 32; ++c) {
        const bool outp = with_ctx || c >= CTXL / 32;
        if (pend) HG_FLUSH();
        const unsigned ro = ((unsigned)scan_slot(dir, 32 * c + ot) * 64u + (unsigned)(16 * oci + 4 * rg)) * 2u;
        const int orow = scan_row(b, dir, 32 * c + ot);
        v2u rawr = (v2u){0u, 0u}, ggr = (v2u){0u, 0u};
        if (dir && outp) { rawr = gld8nt(RAW, ro); ggr = gld8nt((const char*)P + HGG_OFF, (unsigned)orow * HGG_LD + (unsigned)(h * 64 + 16 * oci + 4 * rg) * 2u); }
        {
            float qt[8], kt[8], er[8];
            const unsigned zw[4] = {zr.x, zr.y, zr.z, zr.w}, qw[4] = {qr.x, qr.y, qr.z, qr.w};
#pragma unroll
            for (int j = 0; j < 8; ++j) { const float z = (j & 1) ? bfhi(zw[j >> 1]) : bflo(zw[j >> 1]); const float q = (j & 1) ? bfhi(qw[j >> 1]) : bflo(qw[j >> 1]);
                const float e = __expf(-fabsf(z)); const float inv = __builtin_amdgcn_rcpf(1.0f + e);
                const float sig = z >= 0.f ? inv : e * inv, nsig = z >= 0.f ? e * inv : inv;
                const float oml = 1.0f - lb[j]; const float f = fmaxf(lb[j], 1e-30f) + oml * sig; const float kk = oml * nsig;
                float x = __log2f(f);
                x += dpp_f<0x111, 0xf>(0.f, x); x += dpp_f<0x112, 0xf>(0.f, x); x += dpp_f<0x114, 0xf>(0.f, x); x += dpp_f<0x118, 0xf>(0.f, x);
                x += dpp_f<0x142, 0xa>(0.f, x);
                const float rr = 0.5f * lx_idx(x, lane | 31);
                float xx = x - rr; xx = fminf(fmaxf(xx, -100.f), 100.f);
                const float qs = q * __builtin_amdgcn_rcpf(1.0f + __expf(-q));
                qt[j] = qs * __builtin_amdgcn_exp2f(xx); kt[j] = kk * __builtin_amdgcn_exp2f(-xx); er[j] = rr; }
            v4u wq, wk; wq.x = pk2(qt[0], qt[1]); wq.y = pk2(qt[2], qt[3]); wq.z = pk2(qt[4], qt[5]); wq.w = pk2(qt[6], qt[7]);
            wk.x = pk2(kt[0], kt[1]); wk.y = pk2(kt[2], kt[3]); wk.z = pk2(kt[4], kt[5]); wk.w = pk2(kt[6], kt[7]);
            *(LAS v4u*)(QT + tt * HG_LDQ + k0 * 2) = wq; *(LAS v4u*)(KR + tt * HG_LDK + k0 * 2) = wk;
            if (tt == 0) { f32x4 e0, e1;
#pragma unroll
                for (int j = 0; j < 4; ++j) { e0[j] = __builtin_amdgcn_exp2f(fmaxf(er[j], -100.f)); e1[j] = __builtin_amdgcn_exp2f(fmaxf(er[4 + j], -100.f)); }
                *(LAS f32x4*)(ER + k0) = e0; *(LAS f32x4*)(ER + k0 + 4) = e1; }
            if (tid < 256) *(LAS v4u*)(Vs + tv * HG_LDV + cv * 16) = vr;
            asm volatile("" ::: "memory");
            { const f32x4 er4 = *(const LAS f32x4*)(ER + 16 * wave + 4 * rg);
#pragma unroll
              for (int ci = 0; ci < 4; ++ci) { acc[ci] = acc[ci] * er4; v2u w; w.x = pk2(acc[ci][0], acc[ci][1]); w.y = pk2(acc[ci][2], acc[ci][3]);
                  *(LAS v2u*)(SPT + (16 * ci + c16) * HG_LDS + (16 * wave + 4 * rg) * 2) = w; } }
        }
        if (c + 1 < NTOK / 32) HG_PREFETCH(c + 1);
        __syncthreads();
        { const int ci = wave & 3, ti = wave >> 2, t = 16 * ti + c16;
          f32x4 a0 = (f32x4){0.f, 0.f, 0.f, 0.f}, a1 = a0;
#pragma unroll
          for (int ks = 0; ks < 4; ++ks) { const bf16x8 qb8 = opr(QT, HG_LDQ, 16 * ti, 32 * ks, c16, rg);
              a0 = MFMA16(opr(KR, HG_LDK, 0, 32 * ks, c16, rg), qb8, a0);
              if (ti == 1) a1 = MFMA16(opr(KR, HG_LDK, 16, 32 * ks, c16, rg), qb8, a1); }
          const int s0 = 4 * rg;
          v4u pb; pb.x = pk2(s0 <= t ? a0[0] : 0.f, s0 + 1 <= t ? a0[1] : 0.f); pb.y = pk2(s0 + 2 <= t ? a0[2] : 0.f, s0 + 3 <= t ? a0[3] : 0.f);
                  pb.z = pk2(16 + s0 <= t ? a1[0] : 0.f, 17 + s0 <= t ? a1[1] : 0.f); pb.w = pk2(18 + s0 <= t ? a1[2] : 0.f, 19 + s0 <= t ? a1[3] : 0.f);
          bf16x8 vperm; { const int q = (lane & 15) >> 2, p = lane & 3; lptr va = Vs + (4 * rg + q) * HG_LDV + (16 * ci + 4 * p) * 2;
              const v4i16 lo = __builtin_amdgcn_ds_read_tr16_b64_v4i16((LAS v4i16*)va), hi = __builtin_amdgcn_ds_read_tr16_b64_v4i16((LAS v4i16*)(va + 16 * HG_LDV));
              vperm = __builtin_shufflevector(lo, hi, 0, 1, 2, 3, 4, 5, 6, 7); }
          f32x4 o4 = (f32x4){0.f, 0.f, 0.f, 0.f};
          o4 = MFMA16(vperm, __builtin_bit_cast(bf16x8, pb), o4);
#pragma unroll
          for (int ks = 0; ks < 4; ++ks) o4 = MFMA16(opr(SPT, HG_LDS, 16 * ci, 32 * ks, c16, rg), opr(QT, HG_LDQ, 16 * ti, 32 * ks, c16, rg), o4);
          pend = false;
          if (outp) {
              if (!dir) { v2u w; w.x = pk2(o4[0], o4[1]); w.y = pk2(o4[2], o4[3]); gst8(RAW, ro, w); }
              else { const f32x4 fw = {bflo(rawr.x), bfhi(rawr.x), bflo(rawr.y), bfhi(rawr.y)};
                  pt = o4 + fw; float sp = pt[0] * pt[0] + pt[1] * pt[1] + pt[2] * pt[2] + pt[3] * pt[3];
                  sp += lx_xor(sp, 16, lane); sp += lx_xor(sp, 32, lane);
                  if (rg == 0) SSQ[32 * ci + t] = sp;
                  pgg = ggr; pyo = ((unsigned)orow * (unsigned)D + (unsigned)(Y_HG + h * 64 + 16 * ci + 4 * rg)) * 2u; pend = true; } } }
        { const bf16x8 a8 = opt(KR, HG_LDK, 16 * wave, 0, lane); const f32x4 er = *(const LAS f32x4*)(ER + 16 * wave + 4 * rg);
#pragma unroll
          for (int ci = 0; ci < 4; ++ci) { acc[ci] = MFMA16(a8, opt(Vs, HG_LDV, 16 * ci, 0, lane), acc[ci]); acc[ci] = acc[ci] * er; } }
        __syncthreads();
    }
    if (pend) HG_FLUSH();
#undef HG_PREFETCH
#undef HG_FLUSH
}

#ifndef NO_HG
#define NO_HG 0
#endif
#ifndef NO_ML
#define NO_ML 0
#endif
#ifndef NO_AT
#define NO_AT 0
#endif
#ifndef NO_GEMM
#define NO_GEMM 0
#endif
#ifndef NO_G1
#define NO_G1 0
#endif
#ifndef NO_G2
#define NO_G2 0
#endif
#ifndef NO_G3
#define NO_G3 0
#endif
#ifndef NO_G4
#define NO_G4 0
#endif
#ifndef NO_P0
#define NO_P0 0
#endif
#ifndef STAMP_ON
#define STAMP_ON 0
#endif
#ifndef SA
#define SA 0
#define SB 1
#define SC 0
#define SD 1
#endif
#ifndef THIN_PROBE
#define THIN_PROBE 0
#endif
#ifndef ATT_PROBE
#define ATT_PROBE 0
#endif
#ifndef REPMASK
#define REPMASK 7
#endif
#ifndef REP
#define REP 0
#endif
constexpr int NPHASE = 2 + 7 * DEPTH;

typedef __attribute__((address_space(4))) const Args* kargs_t;
__device__ __forceinline__ kargs_t kargs() { kargs_t p = (kargs_t)__builtin_amdgcn_kernarg_segment_ptr(); asm volatile("" : "+s"(p)); return p; }
#define WSP(T, off) ((T*)(ws + (off)))

__global__ void __launch_bounds__(NTHR, 2) fwd(Args a_unused) {
    extern __shared__ __attribute__((aligned(16))) unsigned char lds_raw[];
    lptr lds = (lptr)lds_raw;
    const int G = gridDim.x; const int bx = blockIdx.x; const int vcu = (G % 8 == 0) ? (bx % 8) * (G / 8) + bx / 8 : bx;
    const int wv = wave_sgpr();
    volatile LAS unsigned* MISC = (volatile LAS unsigned*)(lds + LDSCTL_OFF);
    { const int tid = tid_opaque(wv); for (int u = tid; u < 256; u += NTHR) ((LAS unsigned*)(lds + LDSCTL_OFF))[u] = 0u; }
    __syncthreads();
    int lo, hi; XcdBarrier bar;
    { kargs_t A = kargs(); lo = A->ph_lo; hi = A->ph_hi; unsigned* bw = (unsigned*)(A->ws + WS_CTL) + CW_BAR;
      bar.bar = bw; bar.x = 0; bar.st = nullptr;
      if (hi - lo > 1) bar = xcd_barrier_post(bw, MISC + 8, wv); }
    volatile LAS int* slot = (volatile LAS int*)(MISC + 16);
#if STAMP_ON
#define STAMP(k) do { if (bx == 0 && tid_opaque(wv) == 0) { kargs_t A_ = kargs(); __hip_atomic_store((unsigned long long*)(A_->ws + WS_MISC + 131072) + (k), (unsigned long long)__builtin_amdgcn_s_memrealtime(), RLX_AGENT); } } while (0)
#else
#define STAMP(k) do { } while (0)
#endif
#define IN(k) (lo <= (k) && (k) < hi)
#define SEAM(k) do { if (IN(k) && IN((k) + 1)) xcd_barrier(bar, wv); STAMP((k) + 1); } while (0)
#define REPEAT(k) for (int rep_ = ((REP == (k) && l == 0) ? 2 : 1); rep_ > 0; --rep_)
#define REPBAR() do { if (rep_ > 1) xcd_barrier(bar, wv); } while (0)

    STAMP(0);
    if (IN(0)) { if (!NO_P0) p0_phase(lds, kargs(), wv); } SEAM(0);

    for (int l = 0; l < DEPTH; ++l) {
        const int pb = 1 + 7 * l;
        const bool with_ctx = l < DEPTH - 1;
        const int r0 = with_ctx ? 0 : MC; const int Mg = MT - r0;
        if (IN(pb)) REPEAT(1) {
            kargs_t A = kargs(); unsigned char* ws = A->ws; const float* modl = WSP(float, WS_MOD) + (size_t)l * 17 * NMOD; bf16* xb = WSP(bf16, WS_XB);
            if (l == 0) thin_phase<false, true, true, false>(0, A->in[I_X], A->in[I_CTX], nullptr, xb, false, (const bf16*)nullptr, nullptr, 0, nullptr, modl, 0, D, A->in[I_GPREMIX] + l * D, WSP(bf16, WS_HB), vcu, G, wv);
            else        thin_phase<true, true, false, false>(0, nullptr, nullptr, nullptr, xb, true, WSP(bf16, WS_YD), modl - 17 * NMOD, 5 * D, A->in[I_GPOSTFFN] + (l - 1) * D, modl, 0, D, A->in[I_GPREMIX] + l * D, WSP(bf16, WS_HB), vcu, G, wv);
            convert_weights(lds, kargs(), l, vcu, G, wv); REPBAR();
        }
        SEAM(pb);
        if (IN(pb + 1)) REPEAT(2) {
            kargs_t A = kargs(); unsigned char* ws = A->ws;
            pg8::Gemm g{WSP(bf16, WS_HB), WSP(bf16, WS_WIN), MT, DINP, D}; pg8::StaticOrder S; S.init(MT, DINP, G, bx);
            { const int tid = tid_opaque(wv); const float* bsrc = WSP(float, WS_MISC + 32768) + l * DINP; const float* rsrc = WSP(float, WS_MISC + 16384);
              for (int i = tid; i < DINP; i += NTHR) ((LAS float*)(lds + LDS_BIAS))[i] = bsrc[i];
              for (int i = tid; i < 64 * 24; i += NTHR) ((LAS float*)(lds + LDS_ROPE))[i] = rsrc[i];
              for (int i = tid; i < DINP / 8; i += NTHR) { unsigned ex, ey; pg8::epi_in_entry(i, ex, ey); ((LAS unsigned*)(lds + LDS_ETAB))[2 * i] = ex; ((LAS unsigned*)(lds + LDS_ETAB))[2 * i + 1] = ey; }
              __syncthreads(); }
            pg8::EpiIn E{ws + WS_P, (const LAS float*)(lds + LDS_BIAS), WSP(float, WS_GATE), (const LAS float*)(lds + LDS_ROPE), (const LAS unsigned*)(lds + LDS_ETAB), MC, QSCALE};
            if (!NO_GEMM && !NO_G1) pg8::gemm_phase<pg8::EpiIn, pg8::StaticOrder, true, true>(lds, g, S, E, wv); REPBAR();
        }
        SEAM(pb + 1);
        if (IN(pb + 2)) REPEAT(3) {
            { kargs_t A = kargs(); unsigned char* ws = A->ws; unsigned* qh = WSP(unsigned, WS_CTL) + CW_Q + 64 * (16 * l + 64 * (rep_ - 1));
              for (;;) { const int it = wg_pull(qh, slot, wv); if (it >= 64) break;
                if (!NO_HG && (rep_ == 1 || (REPMASK & 1))) for (int dir = 0; dir < 2; ++dir) {
                    hgrn2_stream(lds, WSP(bf16, WS_P), WSP(bf16, WS_HB), (bf16*)((unsigned char*)A->out + OUT_RAWH) + (size_t)it * NSLOT * 64, WSP(float, WS_MISC) + l * 1024, A->in[I_HGNORM] + l * 256, it >> 2, it & 3, dir, with_ctx, wv);
                    VM_WAIT(); __syncthreads(); } } }
            { kargs_t A = kargs(); unsigned char* ws = A->ws; unsigned* qm = WSP(unsigned, WS_CTL) + CW_Q + 64 * (16 * l + 64 * (rep_ - 1) + 1);
              for (;;) { const int it = wg_pull(qm, slot, wv); if (it >= 64) break;
                if (!NO_ML && (rep_ == 1 || (REPMASK & 2))) for (int dir = 0; dir < 2; ++dir) {
                    mlstm_stream(lds, WSP(bf16, WS_P), WSP(float, WS_GATE), WSP(bf16, WS_HB), (bf16*)((unsigned char*)A->out + OUT_RAWM) + (size_t)it * NSLOT * 96, A->in[I_MLFB] + l * 8, A->in[I_MLNORM] + l * 384, it >> 2, it & 3, dir, with_ctx, wv);
                    VM_WAIT(); __syncthreads(); } } }
            { kargs_t A = kargs(); unsigned char* ws = A->ws; unsigned* qa = WSP(unsigned, WS_CTL) + CW_Q + 64 * (16 * l + 64 * (rep_ - 1) + 2);
              const int nq = with_ctx ? 72 : 64;
              const float lam_init = 0.8f - 0.6f * __expf(-0.3f * (float)l);
              const int myx = (int)(xb_xcc_id() & 7u);
              for (int k = 0; k < 8; ++k) { const int qx = (myx + k) & 7;
                for (;;) { const int it = wg_pull(qa + 64 * qx, slot, wv); if (it >= nq) break;
                  const int bh = it < 64 ? (it >> 3) * 8 + qx : (it - 64) * 8 + qx, qb = it < 64 ? it & 7 : 8;
                  if (!NO_AT && (rep_ == 1 || (REPMASK & 4))) attn_item(lds, WSP(bf16, WS_P), WSP(bf16, WS_HB), A->in[I_DANORM] + l * 96, WSP(float, WS_MISC + 114688)[l], 1.0f - lam_init, bh >> 2, bh & 3, qb, rep_ == 2 ? ATT_PROBE : 0, wv); } } }
            __syncthreads(); REPBAR();
        }
        SEAM(pb + 2);
        if (IN(pb + 3)) REPEAT(5) {
            kargs_t A = kargs(); unsigned char* ws = A->ws;
            pg8::Gemm g{WSP(bf16, WS_HB) + (size_t)r0 * D, WSP(bf16, WS_WOUT), Mg, D, D}; pg8::StaticOrder S; S.init(Mg, D, G, bx);
            pg8::EpiBf E{WSP(bf16, WS_P) + (size_t)r0 * D, D};
            if (!NO_GEMM && !NO_G2) pg8::gemm_phase<pg8::EpiBf, pg8::StaticOrder, true, true>(lds, g, S, E, wv); REPBAR();
        }
        SEAM(pb + 3);
        if (IN(pb + 4)) REPEAT(6) {
            kargs_t A = kargs(); unsigned char* ws = A->ws; const float* modl = WSP(float, WS_MOD) + (size_t)l * 17 * NMOD; bf16* xb = WSP(bf16, WS_XB);
            if (l == 0) thin_phase<true, true, true, false>(r0, A->in[I_X], A->in[I_CTX], nullptr, xb, true, WSP(bf16, WS_P), modl, 2 * D, A->in[I_GPOSTMIX] + l * D, modl, 3 * D, 4 * D, A->in[I_GPREFFN] + l * D, WSP(bf16, WS_HB), vcu, G, wv, rep_ == 2 ? THIN_PROBE : 0);
            else        thin_phase<true, true, false, false>(r0, nullptr, nullptr, nullptr, xb, true, WSP(bf16, WS_P), modl, 2 * D, A->in[I_GPOSTMIX] + l * D, modl, 3 * D, 4 * D, A->in[I_GPREFFN] + l * D, WSP(bf16, WS_HB), vcu, G, wv, 0);
            REPBAR();
        }
        SEAM(pb + 4);
        if (IN(pb + 5)) REPEAT(7) {
            kargs_t A = kargs(); unsigned char* ws = A->ws;
            pg8::Gemm g{WSP(bf16, WS_HB) + (size_t)r0 * D, WSP(bf16, WS_WGU), Mg, NGU, D}; pg8::StaticOrder S; S.init(Mg, NGU, G, bx);
            pg8::EpiSwiglu E{WSP(bf16, WS_P) + (size_t)r0 * DFF, DFF};
            if (!NO_GEMM && !NO_G3) pg8::gemm_phase<pg8::EpiSwiglu, pg8::StaticOrder, true, true>(lds, g, S, E, wv); REPBAR();
        }
        SEAM(pb + 5);
        if (IN(pb + 6)) REPEAT(8) {
            kargs_t A = kargs(); unsigned char* ws = A->ws;
            pg8::Gemm g{WSP(bf16, WS_P) + (size_t)r0 * DFF, WSP(bf16, WS_WD), Mg, D, DFF}; pg8::StaticOrder S; S.init(Mg, D, G, bx);
            pg8::EpiBf E{WSP(bf16, WS_YD) + (size_t)r0 * D, D};
            if (!NO_GEMM && !NO_G4) pg8::gemm_phase<pg8::EpiBf, pg8::StaticOrder, true, true>(lds, g, S, E, wv); REPBAR();
        }
        SEAM(pb + 6);
    }
    if (IN(NPHASE - 1)) {
        kargs_t A = kargs(); unsigned char* ws = A->ws; const float* modl = WSP(float, WS_MOD) + (size_t)(DEPTH - 1) * 17 * NMOD;
        thin_phase<true, false, false, true>(MC, nullptr, nullptr, A->out, WSP(bf16, WS_XB), true, WSP(bf16, WS_YD), modl, 5 * D, A->in[I_GPOSTFFN] + (DEPTH - 1) * D, nullptr, 0, 0, nullptr, nullptr, vcu, G, wv);
#if STAMP_ON
        {
            __syncthreads();
            const unsigned long long* st = (const unsigned long long*)(ws + WS_MISC + 131072);
            const float d1 = (float)(long long)(__hip_atomic_load(st + SB, RLX_AGENT) - __hip_atomic_load(st + SA, RLX_AGENT)) * 1e-5f;
            const float d2 = (float)(long long)(__hip_atomic_load(st + SD, RLX_AGENT) - __hip_atomic_load(st + SC, RLX_AGENT)) * 1e-2f;
            const int tid = tid_opaque(wv); const int rwg = ML / G; float* o = A->out + (size_t)vcu * rwg * D;
            for (int i = tid; i < rwg * D; i += NTHR) o[i] *= (1.0f + d1);
            __syncthreads();
            if (bx == 0 && tid == 0) A->out[(size_t)vcu * rwg * D] = d2;
        }
#endif
    }
#undef IN
#undef SEAM
}

extern "C" void kernel_launch(void* const* d_in, const int* in_sizes, int n_in, void* d_out, int out_size, void* d_ws, size_t ws_size, hipStream_t stream) {
    static int grid = 0;
    if (grid == 0) {
        if (n_in != 22 || in_sizes[0] != ML * D || out_size != ML * D || ws_size < WS_END) {
            fprintf(stderr, "kernel_launch: unexpected shapes: n_in %d in0 %d out %d ws %zu (need %zu); nothing launched\n", n_in, n_in > 0 ? in_sizes[0] : -1, out_size, ws_size, (size_t)WS_END); grid = -1; return; }
        int dev = 0, cus = 0, per_cu = 0;
        if (hipGetDevice(&dev) != hipSuccess || hipDeviceGetAttribute(&cus, hipDeviceAttributeMultiprocessorCount, dev) != hipSuccess) { fprintf(stderr, "kernel_launch: device query failed\n"); grid = -1; return; }
        if (hipFuncSetAttribute((const void*)fwd, hipFuncAttributeMaxDynamicSharedMemorySize, LDS_BYTES) != hipSuccess) { fprintf(stderr, "kernel_launch: hipFuncSetAttribute failed\n"); grid = -1; return; }
        if (hipOccupancyMaxActiveBlocksPerMultiprocessor(&per_cu, (const void*)fwd, NTHR, LDS_BYTES) != hipSuccess || per_cu < 1)
            fprintf(stderr, "kernel_launch: note: occupancy query reports %d workgroups per CU\n", per_cu);
        (void)hipGetLastError();
        grid = cus;
    }
    if (grid < 0) return;
    if (hipMemsetAsync((char*)d_ws + WS_CTL, 0, CTL_ZERO_BYTES, stream) != hipSuccess) { fprintf(stderr, "kernel_launch: memset failed\n"); return; }
    Args a{};
    for (int i = 0; i < 22; ++i) a.in[i] = (const float*)d_in[i];
    a.out = (float*)d_out; a.ws = (unsigned char*)d_ws;
#if MK_PER_PHASE
    for (int p = 0; p < NPHASE; ++p) { a.ph_lo = p; a.ph_hi = p + 1; hipLaunchKernelGGL(fwd, dim3(grid), dim3(NTHR), LDS_BYTES, stream, a); }
#else
    a.ph_lo = 0; a.ph_hi = NPHASE;
    hipLaunchKernelGGL(fwd, dim3(grid), dim3(NTHR), LDS_BYTES, stream, a);
#endif
    const hipError_t le = hipPeekAtLastError();
    if (le != hipSuccess) fprintf(stderr, "kernel_launch: launch failed: %s\n", hipGetErrorName(le));
}
```

```cpp
#include <hip/hip_runtime.h>
#include <cstdio>
#include <cstdint>
#ifndef MK_PER_PHASE
#define MK_PER_PHASE 0
#endif
namespace pg8 {
#define PG8_LAS __attribute__((address_space(3)))
typedef unsigned short bf16_t;
typedef short bf16x8 __attribute__((ext_vector_type(8)));
typedef float f32x4 __attribute__((ext_vector_type(4)));
typedef unsigned u32x4 __attribute__((ext_vector_type(4)));
constexpr int BM = 256, BK = 64, HALF = 128, HTB = HALF * BK * 2  , STAGE_BYTES = 8 * HTB, NXCD = 8, WGM = 8;

__host__ __device__ __forceinline__ int lds_byte(int r, int c) { const int st = (r >> 4) * 2 + (c >> 5), rr = r & 15, cc = c & 31, ob = rr * 64 + cc * 2; return st * 1024 + (ob ^ (((ob >> 9) & 1) << 5)); }
__host__ __device__ __forceinline__ void stage_rc(int b, int& R, int& C) { const int st = b / 1024, sb = b % 1024, swz = sb ^ (((sb >> 9) & 1) << 5); R = (st >> 1) * 16 + swz / 64; C = (st & 1) * 32 + (swz % 64) / 2; }
__host__ __device__ __forceinline__ int perm32(int rho) { const int n = rho >> 4, i = rho & 15; return 8 * (i >> 2) + 4 * n + (i & 3); }

struct Unit { int pm, pn; };
struct Gemm { const bf16_t* A; const bf16_t* Bt; int M, N, K; };

struct StaticOrder {
    int nM, nN, nwg, G, c;
    __host__ __device__ void init(int M, int N, int G_, int c_) { nM = M / BM; nN = N / BM; nwg = nM * nN; G = G_; c = c_; }
    __host__ __device__ bool next(int i, Unit& u) const {
        const long L = (long)i * G + c; if (L >= nwg) return false;
        int wgid = (int)L; { const int q = nwg / NXCD, r = nwg % NXCD, xcd = wgid % NXCD, off = wgid / NXCD; wgid = (xcd < r ? xcd * (q + 1) : r * (q + 1) + (xcd - r) * q) + off; }
        const int nig = WGM * nN, gid = wgid / nig, fm = gid * WGM, gsz = (nM - fm) < WGM ? (nM - fm) : WGM;
        u.pm = fm + ((wgid % nig) % gsz); u.pn = (wgid % nig) / gsz; return true;
    }
    __device__ __forceinline__ void a_ready(const Unit&) const {}
    __device__ __forceinline__ void done(const Unit&) const {}
};
__device__ __forceinline__ unsigned cvt_pk_bf16(float lo, float hi) { unsigned r; asm volatile("v_cvt_pk_bf16_f32 %0, %1, %2" : "=v"(r) : "v"(lo), "v"(hi)); return r; }
struct EpiF32 {
    static constexpr bool PERM = false, AFTER_DRAIN = false;
    float* C; int ldc;
    __device__ __forceinline__ void operator()(const f32x4 (&acc)[2][2][4][2], const Unit& u, int wr, int wc, int fr, int fq) const {
        const int row0 = u.pm * BM + wr * 64 + fr, col0 = u.pn * BM + wc * 32 + 4 * fq;
#pragma unroll
        for (int ai = 0; ai < 2; ++ai)
#pragma unroll
            for (int m = 0; m < 4; ++m) { float* rowp = C + (size_t)(row0 + ai * HALF + m * 16) * ldc + col0;
#pragma unroll
                for (int bj = 0; bj < 2; ++bj)
#pragma unroll
                    for (int n = 0; n < 2; ++n) *(f32x4*)(rowp + bj * HALF + n * 16) = acc[ai][bj][m][n]; }
    }
};
struct EpiBf {
    static constexpr bool PERM = true, AFTER_DRAIN = false;
    bf16_t* O; int ldc;
    __device__ __forceinline__ void operator()(const f32x4 (&acc)[2][2][4][2], const Unit& u, int wr, int wc, int fr, int fq) const {
        const int row0 = u.pm * BM + wr * 64 + fr; const int col0 = u.pn * BM + wc * 32 + 8 * fq;
#pragma unroll
        for (int ai = 0; ai < 2; ++ai)
#pragma unroll
            for (int m = 0; m < 4; ++m) { bf16_t* rowp = O + (size_t)(row0 + ai * HALF + m * 16) * ldc + col0;
#pragma unroll
                for (int bj = 0; bj < 2; ++bj) { const f32x4 v0 = acc[ai][bj][m][0], v1 = acc[ai][bj][m][1];
                    u32x4 w; w.x = cvt_pk_bf16(v0[0], v0[1]); w.y = cvt_pk_bf16(v0[2], v0[3]); w.z = cvt_pk_bf16(v1[0], v1[1]); w.w = cvt_pk_bf16(v1[2], v1[3]);
                    *(u32x4*)(rowp + bj * HALF) = w; } }
    }
};
constexpr unsigned EI_KIND = 1u << 16, EI_SKIP = 1u << 17, EI_DA = 1u << 18, EI_Q = 1u << 19, EI_HF = 1u << 20;
__host__ __device__ __forceinline__ void epi_in_entry(int g, unsigned& x, unsigned& y) {
    const int c = 8 * g; x = 0u; y = EI_SKIP;
    if (c < 1152)      { const int f = c / 384, hh = (c % 384) / 96, o = c % 96;            x = 0u         + (unsigned)hh * 2304u * 576u + (unsigned)(f * 96 + o) * 2u; y = 576u; }
    else if (c < 1536) { x = 301989888u + (unsigned)(c - 1152) * 2u; y = 768u | EI_KIND; }
    else if (c < 1552) { }
    else if (c < 2064) { const int hh = (c - 1552) / 128, o = (c - 1552) % 128;             x = 84934656u  + (unsigned)hh * 2304u * 896u + (unsigned)(256 + o) * 2u; y = 896u; }
    else if (c < 3088) { const int d = (c - 2064) / 512, hh = ((c - 2064) % 512) / 128, o = (c - 2064) % 128; x = 84934656u + (unsigned)hh * 2304u * 896u + (unsigned)(d * 128 + o) * 2u; y = 896u; }
    else if (c < 3344) { const int hh = (c - 3088) / 64, o = (c - 3088) % 64;               x = 84934656u  + (unsigned)hh * 2304u * 896u + (unsigned)(384 + o) * 2u; y = 896u; }
    else if (c < 3600) { x = 330301440u + (unsigned)(c - 3344) * 2u; y = 512u | EI_KIND; }
    else if (c < 4752) { const int f = (c - 3600) / 384, hh = ((c - 3600) % 384) / 96, o = (c - 3600) % 96; x = 217055232u + (unsigned)hh * 2304u * 576u + (unsigned)(f * 96 + o) * 2u; y = 576u;
                         if (c < 4368) { const int d48 = (c - 3600) % 48, hf = d48 >= 24 ? 1 : 0, i0 = (d48 - 24 * hf) >> 1; y |= EI_DA | (c < 3984 ? EI_Q : 0u) | (hf ? EI_HF : 0u) | ((unsigned)i0 << 24); } }
}
struct EpiIn {
    static constexpr bool PERM = true, AFTER_DRAIN = false;
    unsigned char* PX; const PG8_LAS float* bias; float* G; const PG8_LAS float* rope; const PG8_LAS unsigned* tab; int mc; float qscale;
    __device__ __forceinline__ void operator()(const f32x4 (&acc)[2][2][4][2], const Unit& u, int wr, int wc, int fr, int fq) const {
        const int trow0 = u.pm * BM;
        const int bat = trow0 < mc ? trow0 >> 8 : (trow0 - mc) >> 11; const int slot0 = trow0 < mc ? (trow0 & 255) : 256 + ((trow0 - mc) & 2047);
        const unsigned rc_blk = (unsigned)(bat * 4 * 2304 + slot0), rc_row = (unsigned)trow0;
        const int rin = wr * 64 + fr;
        const int col0 = u.pn * BM + wc * 32 + 8 * fq;
        const bool gate_lane = (u.pn == 6) && (wc == 0) && (fq < 2);
#pragma unroll
        for (int bj = 0; bj < 2; ++bj) {
            const int c = col0 + bj * HALF;
            const f32x4 b0 = *(const PG8_LAS f32x4*)(bias + c), b1 = *(const PG8_LAS f32x4*)(bias + c + 4);
            const unsigned ex = tab[2 * (c >> 3)], ey = tab[2 * (c >> 3) + 1];
            const unsigned ld = ey & 0xffffu;
            const unsigned off = ex + ((ey & EI_KIND) ? rc_row : rc_blk) * ld + (unsigned)rin * ld;
            const bool skip = (ey & EI_SKIP) != 0u, is_da = (ey & EI_DA) != 0u, is_q = (ey & EI_Q) != 0u; const int hf = (ey & EI_HF) ? 1 : 0, i0 = (int)(ey >> 24);
#pragma unroll
            for (int ai = 0; ai < 2; ++ai)
#pragma unroll
                for (int m = 0; m < 4; ++m) { const int row = trow0 + rin + ai * HALF + m * 16;
                    f32x4 v0 = acc[ai][bj][m][0] + b0, v1 = acc[ai][bj][m][1] + b1;
                    if (is_da) {
                        if (row >= mc) { const int t = (row - mc) & 2047; const int pos = hf ? (t & 63) : (t >> 6);
                            const f32x4 cs0 = *(const PG8_LAS f32x4*)(rope + pos * 24 + 2 * i0), cs1 = *(const PG8_LAS f32x4*)(rope + pos * 24 + 2 * i0 + 4);
                            const f32x4 r0 = {v0[0] * cs0[0] - v0[1] * cs0[1], v0[0] * cs0[1] + v0[1] * cs0[0], v0[2] * cs0[2] - v0[3] * cs0[3], v0[2] * cs0[3] + v0[3] * cs0[2]};
                            const f32x4 r1 = {v1[0] * cs1[0] - v1[1] * cs1[1], v1[0] * cs1[1] + v1[1] * cs1[0], v1[2] * cs1[2] - v1[3] * cs1[3], v1[2] * cs1[3] + v1[3] * cs1[2]};
                            v0 = r0; v1 = r1; }
                        if (is_q) { v0 = v0 * qscale; v1 = v1 * qscale; } }
                    if (!skip) { u32x4 w; w.x = cvt_pk_bf16(v0[0], v0[1]); w.y = cvt_pk_bf16(v0[2], v0[3]); w.z = cvt_pk_bf16(v1[0], v1[1]); w.w = cvt_pk_bf16(v1[2], v1[3]);
                        *(u32x4*)(PX + (off + (unsigned)(ai * HALF + m * 16) * ld)) = w; }
                    if (bj == 0 && gate_lane) { float* g = G + (size_t)row * 16 + 8 * fq; *(f32x4*)g = v0; *(f32x4*)(g + 4) = v1; } }
        }
    }
};
struct EpiSwiglu {
    static constexpr bool PERM = true, AFTER_DRAIN = false;
    bf16_t* O; int ldc;
    __device__ __forceinline__ void operator()(const f32x4 (&acc)[2][2][4][2], const Unit& u, int wr, int wc, int fr, int fq) const {
        const int row0 = u.pm * BM + wr * 64 + fr; const int col0 = u.pn * HALF + wc * 32 + 8 * fq;
#pragma unroll
        for (int ai = 0; ai < 2; ++ai)
#pragma unroll
            for (int m = 0; m < 4; ++m) { bf16_t* rowp = O + (size_t)(row0 + ai * HALF + m * 16) * ldc + col0;
                f32x4 r0, r1;
#pragma unroll
                for (int i = 0; i < 4; ++i) { const float g0 = acc[ai][0][m][0][i], g1 = acc[ai][0][m][1][i];
                    r0[i] = g0 * __builtin_amdgcn_rcpf(1.0f + __expf(-g0)) * acc[ai][1][m][0][i];
                    r1[i] = g1 * __builtin_amdgcn_rcpf(1.0f + __expf(-g1)) * acc[ai][1][m][1][i]; }
                u32x4 w; w.x = cvt_pk_bf16(r0[0], r0[1]); w.y = cvt_pk_bf16(r0[2], r0[3]); w.z = cvt_pk_bf16(r1[0], r1[1]); w.w = cvt_pk_bf16(r1[2], r1[3]);
                *(u32x4*)rowp = w; }
    }
};
template <class Epi, class Sched, bool ALIGN_EPI = false, bool SP2 = false>
__device__ __forceinline__ void gemm_phase(PG8_LAS unsigned char* lds, const Gemm g, const Sched& S, const Epi& E, const int wv_) {
    int tid_; { int l_; asm volatile("v_mbcnt_lo_u32_b32 %0, -1, 0\n\tv_mbcnt_hi_u32_b32 %0, -1, %0\n\ts_nop 0" : "=&v"(l_)); tid_ = wv_ * 64 + l_; }
    const int tid = tid_, wid = __builtin_amdgcn_readfirstlane(tid >> 6), lane = tid & 63, wr = wid >> 2, wc = wid & 3, fr = lane & 15, fq = lane >> 4;
    const int K = g.K, nt = K / BK;
    unsigned voffA[2], voffB[2];
#pragma unroll
    for (int i = 0; i < 2; ++i) { int R, C; stage_rc(tid * 16 + i * 8192, R, C); const int Rb = Epi::PERM ? ((R & ~31) + perm32(R & 31)) : R;
        voffA[i] = (unsigned)(R * K + C) * 2u; voffB[i] = (unsigned)(Rb * K + C) * 2u; }
    const size_t kstep = (size_t)(BK * 2);
    const size_t hstep = (size_t)HALF * K * 2;
    const size_t tstep = 2 * hstep;
    const unsigned ldsw = (unsigned)wid * 1024u;
    const int aoff = lds_byte(wr * 64 + fr, fq * 8), boff = lds_byte(wc * 32 + fr, fq * 8);
#define PG8_SA(b, h) (((b) * 2 + (h)) * HTB)
#define PG8_SB(b, h) ((4 + (b) * 2 + (h)) * HTB)
#define PG8_STAGE(bufoff, gbase, voff) do { _Pragma("unroll") for (int _i = 0; _i < 2; ++_i) \
        __builtin_amdgcn_global_load_lds((const unsigned*)((const char*)(gbase) + (voff)[_i]), (PG8_LAS unsigned*)(lds + (bufoff) + ldsw + _i * 8192), 16, 0, 0); } while (0)
#define PG8_LDA(dst, b, h) do { _Pragma("unroll") for (int m = 0; m < 4; ++m) _Pragma("unroll") for (int k = 0; k < 2; ++k) dst[m][k] = *(const PG8_LAS bf16x8*)(lds + PG8_SA(b, h) + aoff + m * 2048 + k * 1024); } while (0)
#define PG8_LDB(dst, b, h) do { _Pragma("unroll") for (int n = 0; n < 2; ++n) _Pragma("unroll") for (int k = 0; k < 2; ++k) dst[n][k] = *(const PG8_LAS bf16x8*)(lds + PG8_SB(b, h) + boff + n * 2048 + k * 1024); } while (0)
#define PG8_MMA(ai, bj, At, Bt) do { __builtin_amdgcn_s_setprio(1); _Pragma("unroll") for (int m = 0; m < 4; ++m) _Pragma("unroll") for (int n = 0; n < 2; ++n) _Pragma("unroll") for (int k = 0; k < 2; ++k) \
        acc[ai][bj][m][n] = __builtin_amdgcn_mfma_f32_16x16x32_bf16(Bt[n][k], At[m][k], acc[ai][bj][m][n], 0, 0, 0); __builtin_amdgcn_s_setprio(0); } while (0)
#define PG8_WAIT_V(n) asm volatile("s_waitcnt vmcnt(" #n ")" ::: "memory")
#define PG8_WAIT_L(n) asm volatile("s_waitcnt lgkmcnt(" #n ")" ::: "memory")
#define PG8_BAR __builtin_amdgcn_s_barrier()
#define PG8_SCHED __builtin_amdgcn_sched_barrier(0)
    Unit cur, nxt; int ui = 0;
    if (!S.next(0, cur)) return;
    f32x4 acc[2][2][4][2];
#pragma unroll
    for (int a = 0; a < 2; ++a)
#pragma unroll
        for (int b = 0; b < 2; ++b)
#pragma unroll
            for (int m = 0; m < 4; ++m)
#pragma unroll
                for (int n = 0; n < 2; ++n) acc[a][b][m][n] = (f32x4){0.f, 0.f, 0.f, 0.f};
    bf16x8 At[4][2], B0[2][2], B1[2][2];
    const char* cA = (const char*)g.A + (size_t)cur.pm * tstep; const char* cB = (const char*)g.Bt + (size_t)cur.pn * tstep;
    S.a_ready(cur);
    if constexpr (SP2) {
        PG8_STAGE(PG8_SB(0, 0), cB, voffB); PG8_STAGE(PG8_SB(0, 1), cB + hstep, voffB); PG8_STAGE(PG8_SA(0, 0), cA, voffA); PG8_STAGE(PG8_SA(0, 1), cA + hstep, voffA);
        if (wr == 1) PG8_BAR;
        PG8_WAIT_V(2); PG8_BAR;
        PG8_STAGE(PG8_SB(1, 0), cB + kstep, voffB); PG8_STAGE(PG8_SA(1, 0), cA + kstep, voffA); PG8_STAGE(PG8_SB(1, 1), cB + hstep + kstep, voffB);
        PG8_WAIT_V(6); PG8_BAR;
    } else {
        PG8_STAGE(PG8_SB(0, 0), cB, voffB); PG8_STAGE(PG8_SA(0, 0), cA, voffA); PG8_STAGE(PG8_SB(0, 1), cB + hstep, voffB); PG8_STAGE(PG8_SA(0, 1), cA + hstep, voffA);
        if (wr == 1) PG8_BAR;
        PG8_WAIT_V(4); PG8_BAR;
        PG8_STAGE(PG8_SB(1, 0), cB + kstep, voffB); PG8_STAGE(PG8_SA(1, 0), cA + kstep, voffA); PG8_STAGE(PG8_SB(1, 1), cB + hstep + kstep, voffB);
        PG8_WAIT_V(6); PG8_BAR;
    }
    for (;;) {
        const bool has_next = S.next(ui + 1, nxt);
        const char* nA = has_next ? (const char*)g.A + (size_t)nxt.pm * tstep : cA; const char* nB = has_next ? (const char*)g.Bt + (size_t)nxt.pn * tstep : cB;
        for (int t = 0; t < nt; t += 2) {
            const bool last = (t == nt - 2);
            const char* a1 = cA + (size_t)(t + 1) * kstep;
            const char* a2 = last ? nA : cA + (size_t)(t + 2) * kstep; const char* b2 = last ? nB : cB + (size_t)(t + 2) * kstep;
            const char* a3 = a2 + kstep; const char* b3 = b2 + kstep;
            if (last && has_next) S.a_ready(nxt);
            if constexpr (SP2) {
            PG8_LDB(B0, 0, 0); PG8_LDB(B1, 0, 1); PG8_SCHED; PG8_LDA(At, 0, 0); PG8_STAGE(PG8_SA(1, 1), a1 + hstep, voffA);
            PG8_WAIT_V(8); PG8_WAIT_L(0); PG8_BAR; PG8_MMA(0, 0, At, B0); PG8_MMA(0, 1, At, B1); PG8_BAR; PG8_SCHED;
            PG8_LDA(At, 0, 1); PG8_STAGE(PG8_SB(0, 0), b2, voffB); PG8_STAGE(PG8_SB(0, 1), b2 + hstep, voffB); PG8_STAGE(PG8_SA(0, 0), a2, voffA);
            PG8_WAIT_V(8); PG8_WAIT_L(0); PG8_BAR; PG8_MMA(1, 0, At, B0); PG8_MMA(1, 1, At, B1); PG8_BAR; PG8_SCHED;
            PG8_LDB(B0, 1, 0); PG8_LDB(B1, 1, 1); PG8_SCHED; PG8_LDA(At, 1, 0); PG8_STAGE(PG8_SA(0, 1), a2 + hstep, voffA);
            PG8_WAIT_V(8); PG8_WAIT_L(0); PG8_BAR; PG8_MMA(0, 0, At, B0); PG8_MMA(0, 1, At, B1); PG8_BAR; PG8_SCHED;
            PG8_LDA(At, 1, 1); PG8_STAGE(PG8_SB(1, 0), b3, voffB); PG8_STAGE(PG8_SB(1, 1), b3 + hstep, voffB); PG8_STAGE(PG8_SA(1, 0), a3, voffA);
            PG8_WAIT_V(8); PG8_WAIT_L(0); PG8_BAR; PG8_MMA(1, 0, At, B0); PG8_MMA(1, 1, At, B1); PG8_BAR; PG8_SCHED;
            } else {
            PG8_LDB(B0, 0, 0); PG8_SCHED; PG8_LDA(At, 0, 0); PG8_STAGE(PG8_SA(1, 1), a1 + hstep, voffA);
            PG8_WAIT_L(8); PG8_BAR; PG8_WAIT_L(0); PG8_MMA(0, 0, At, B0); PG8_BAR; PG8_SCHED;
            PG8_LDB(B1, 0, 1); PG8_STAGE(PG8_SB(0, 0), b2, voffB);
            PG8_BAR; PG8_WAIT_L(0); PG8_MMA(0, 1, At, B1); PG8_BAR;
            PG8_LDA(At, 0, 1); PG8_STAGE(PG8_SA(0, 0), a2, voffA);
            PG8_BAR; PG8_WAIT_L(0); PG8_MMA(1, 0, At, B0); PG8_BAR; PG8_SCHED;
            PG8_STAGE(PG8_SB(0, 1), b2 + hstep, voffB);
            PG8_WAIT_V(6); PG8_BAR; PG8_MMA(1, 1, At, B1); PG8_BAR;
            PG8_LDB(B0, 1, 0); PG8_SCHED; PG8_LDA(At, 1, 0); PG8_STAGE(PG8_SA(0, 1), a2 + hstep, voffA);
            PG8_WAIT_L(8); PG8_BAR; PG8_WAIT_L(0); PG8_MMA(0, 0, At, B0); PG8_BAR; PG8_SCHED;
            PG8_LDB(B1, 1, 1); PG8_STAGE(PG8_SB(1, 0), b3, voffB);
            PG8_BAR; PG8_WAIT_L(0); PG8_MMA(0, 1, At, B1); PG8_BAR;
            PG8_LDA(At, 1, 1); PG8_STAGE(PG8_SA(1, 0), a3, voffA);
            PG8_BAR; PG8_WAIT_L(0); PG8_MMA(1, 0, At, B0); PG8_BAR; PG8_SCHED;
            PG8_STAGE(PG8_SB(1, 1), b3 + hstep, voffB);
            PG8_WAIT_V(6); PG8_BAR; PG8_MMA(1, 1, At, B1); PG8_BAR;
            }
        }
        if constexpr (ALIGN_EPI) { if (wr == 0) PG8_BAR; }
        if constexpr (!Epi::AFTER_DRAIN) { E(acc, cur, wr, wc, fr, fq); S.done(cur); }
        if (!has_next) break;
#pragma unroll
        for (int a = 0; a < 2; ++a)
#pragma unroll
            for (int b = 0; b < 2; ++b)
#pragma unroll
                for (int m = 0; m < 4; ++m)
#pragma unroll
                    for (int n = 0; n < 2; ++n) acc[a][b][m][n] = (f32x4){0.f, 0.f, 0.f, 0.f};
        cur = nxt; cA = nA; cB = nB; ++ui;
        if constexpr (ALIGN_EPI) { if (wr == 1) PG8_BAR; }
    }
    PG8_WAIT_V(0);
    if constexpr (!ALIGN_EPI) { if (wr == 0) PG8_BAR; }
    PG8_BAR;
    if constexpr (Epi::AFTER_DRAIN) { E.fused(acc, cur, wr, wc, fr, fq, lds, wid, lane); S.done(cur); }
#undef PG8_SA
#undef PG8_SB
#undef PG8_STAGE
#undef PG8_LDA
#undef PG8_LDB
#undef PG8_MMA
#undef PG8_WAIT_V
#undef PG8_WAIT_L
#undef PG8_BAR
#undef PG8_SCHED
}
}
constexpr int D = 1024, NB = 16, SEQ = 2048, CTXL = 256, DEPTH = 4;
constexpr int MC = NB * CTXL, ML = NB * SEQ, MT = MC + ML;
constexpr int DIN = 4752, DINP = 4864, DFF = 2816, NGU = 2 * DFF, NMOD = 6 * D;
constexpr int C_MLQ = 0, C_MLK = 384, C_MLV = 768, C_MLO = 1152, C_MLI = 1536, C_MLF = 1544, C_HGQ = 1552, C_HGF = 2064, C_HGI = 3088, C_HGG = 3344, C_DAQ = 3600, C_DAK = 3984, C_DAV = 4368;
constexpr int Y_ML = 0, Y_HG = 384, Y_DA = 640;
constexpr float EPS = 1e-6f;
constexpr int NTOK = CTXL + SEQ;
static_assert(C_MLI == 6 * 256, "gate columns must open GEMM tile 6");
constexpr int NSLOT = CTXL + SEQ;
constexpr unsigned MLX_LD = 576, HGX_LD = 896, DAX_LD = 576, MLO_LD = 768, HGG_LD = 512;
constexpr size_t MLX_OFF = 0, HGX_OFF = MLX_OFF + (size_t)64 * NSLOT * MLX_LD, DAX_OFF = HGX_OFF + (size_t)64 * NSLOT * HGX_LD, MLO_OFF = DAX_OFF + (size_t)64 * NSLOT * DAX_LD, HGG_OFF = MLO_OFF + (size_t)MT * MLO_LD, PX_END = HGG_OFF + (size_t)MT * HGG_LD;
static_assert(HGX_OFF == 84934656ull && DAX_OFF == 217055232ull && MLO_OFF == 301989888ull && HGG_OFF == 330301440ull, "EpiIn hard-codes these offsets");

constexpr size_t MiB = 1u << 20;
constexpr size_t KiB = 1u << 10;
constexpr size_t WS_CTL = 0, CTL_ZERO_BYTES = 256 * KiB;
constexpr size_t WS_MOD = 256 * KiB;
constexpr size_t WS_MISC = 2 * MiB;
constexpr size_t WS_GATE = 2 * MiB + 256 * KiB;
constexpr size_t WS_WIN = 4 * MiB + 512 * KiB, WS_WOUT = WS_WIN + (size_t)DINP * D * 2, WS_WGU = WS_WOUT + (size_t)D * D * 2, WS_WD = WS_WGU + (size_t)NGU * D * 2;
constexpr size_t WS_XB = 32 * MiB + 512 * KiB;
constexpr size_t WS_HB = WS_XB + (size_t)MT * D * 2;
constexpr size_t WS_P = WS_HB + (size_t)MT * D * 2;
constexpr size_t WS_YD = WS_P + 198 * MiB, WS_END = WS_P + 333 * MiB + 64 * KiB;
constexpr size_t OUT_RAWM = 0, OUT_RAWH = 27 * MiB;
static_assert(WS_MOD + (size_t)DEPTH * 17 * NMOD * 4 <= WS_MISC && WS_GATE + (size_t)MT * 16 * 4 <= WS_WIN, "small buffers");
static_assert(WS_WD + (size_t)D * DFF * 2 <= WS_XB, "weights fit");
static_assert(OUT_RAWM + (size_t)MT * 384 * 2 <= OUT_RAWH && OUT_RAWH + (size_t)MT * 256 * 2 <= (size_t)ML * D * 4, "raw buffers fit d_out");
static_assert(WS_P + PX_END <= WS_END, "mixer operand blocks fit the P region");
static_assert(WS_YD + (size_t)MT * D * 2 <= WS_END && (size_t)MT * DFF * 2 <= 198 * MiB && WS_END <= 512 * MiB, "P region");
constexpr int CW_BAR = 4096;
constexpr int CW_Q = 16384;

constexpr int RING_BYTES = 131072, LDSCTL_OFF = RING_BYTES, LDS_BYTES = 163840;
constexpr int LDS_BIAS = LDSCTL_OFF + 1024, LDS_ROPE = LDS_BIAS + DINP * 4, LDS_ETAB = LDS_ROPE + 64 * 24 * 4;
static_assert(LDS_ETAB + (DINP / 8) * 8 <= LDS_BYTES, "LDS map");
constexpr int NWAVES = 8, NTHR = 512;

#define GAS __attribute__((address_space(1)))
#define LAS __attribute__((address_space(3)))
typedef unsigned short bf16;
typedef unsigned v4u __attribute__((ext_vector_type(4)));
typedef unsigned v2u __attribute__((ext_vector_type(2)));
typedef float f32x4 __attribute__((ext_vector_type(4)));
typedef float f32x16 __attribute__((ext_vector_type(16)));
typedef short bf16x8 __attribute__((ext_vector_type(8)));
typedef GAS unsigned gu32;
typedef LAS unsigned char* lptr;
#define RLX_AGENT __ATOMIC_RELAXED, __HIP_MEMORY_SCOPE_AGENT
#define LDS_WAIT() asm volatile("s_waitcnt lgkmcnt(0)" ::: "memory")
#define VM_WAIT() asm volatile("s_waitcnt vmcnt(0)" ::: "memory")
__device__ __forceinline__ unsigned f2bf(float f) { unsigned u = __builtin_bit_cast(unsigned, f); return (u + 0x7fffu + ((u >> 16) & 1u)) >> 16; }
typedef float f32x2_t __attribute__((ext_vector_type(2))); typedef __bf16 bf16x2_t __attribute__((ext_vector_type(2)));
__device__ __forceinline__ unsigned pk2(float lo, float hi) { f32x2_t v = {lo, hi}; bf16x2_t b = __builtin_convertvector(v, bf16x2_t); return __builtin_bit_cast(unsigned, b); }
__device__ __forceinline__ float bflo(unsigned w) { return __builtin_bit_cast(float, w << 16); }
__device__ __forceinline__ float bfhi(unsigned w) { return __builtin_bit_cast(float, w & 0xffff0000u); }
__device__ __forceinline__ float bf2f(bf16 v) { return __builtin_bit_cast(float, (unsigned)v << 16); }
__device__ __forceinline__ float lx_idx(float v, int src) { return __builtin_bit_cast(float, __builtin_amdgcn_ds_bpermute(src << 2, __builtin_bit_cast(int, v))); }
__device__ __forceinline__ float lx_xor(float v, int mask, int lane) { return lx_idx(v, lane ^ mask); }
__device__ __forceinline__ float lx_up(float v, int d, int lane) { return lx_idx(v, lane >= d ? lane - d : lane); }
template <int CTRL, int RMASK> __device__ __forceinline__ float dpp_f(float oldv, float v) { return __builtin_bit_cast(float, __builtin_amdgcn_update_dpp(__builtin_bit_cast(int, oldv), __builtin_bit_cast(int, v), CTRL, RMASK, 0xf, false)); }
__device__ __forceinline__ float scan_sum64(float v) {
    v += dpp_f<0x111, 0xf>(0.f, v); v += dpp_f<0x112, 0xf>(0.f, v); v += dpp_f<0x114, 0xf>(0.f, v); v += dpp_f<0x118, 0xf>(0.f, v);
    v += dpp_f<0x142, 0xa>(0.f, v); v += dpp_f<0x143, 0xc>(0.f, v); return v; }
__device__ __forceinline__ float scan_max64(float v) { const float ninf = -3.0e38f;
    v = fmaxf(v, dpp_f<0x111, 0xf>(ninf, v)); v = fmaxf(v, dpp_f<0x112, 0xf>(ninf, v)); v = fmaxf(v, dpp_f<0x114, 0xf>(ninf, v)); v = fmaxf(v, dpp_f<0x118, 0xf>(ninf, v));
    v = fmaxf(v, dpp_f<0x142, 0xa>(ninf, v)); v = fmaxf(v, dpp_f<0x143, 0xc>(ninf, v)); return v; }
__device__ __forceinline__ float wave_sum(float v, int lane) {
#pragma unroll
    for (int o = 1; o < 64; o <<= 1) v += lx_xor(v, o, lane);
    return v;
}
#define MFMA32(a, b, c) __builtin_amdgcn_mfma_f32_32x32x16_bf16((a), (b), (c), 0, 0, 0)
#define MFMA16(a, b, c) __builtin_amdgcn_mfma_f32_16x16x32_bf16((a), (b), (c), 0, 0, 0)
__device__ __forceinline__ int wave_sgpr() { int w = __builtin_amdgcn_readfirstlane((int)(threadIdx.x >> 6)); asm volatile("" : "+s"(w)); return w; }
__device__ __forceinline__ int lane_raw() { int l; asm volatile("v_mbcnt_lo_u32_b32 %0, -1, 0\n\tv_mbcnt_hi_u32_b32 %0, -1, %0\n\ts_nop 0" : "=&v"(l)); return l; }
__device__ __forceinline__ bool is_t0(int wv) { return wv == 0 && lane_raw() == 0; }
__device__ __forceinline__ int tid_opaque(int wv) { return wv * 64 + lane_raw(); }
__device__ __forceinline__ bf16x8 lds8(lptr p) { return *(const LAS bf16x8*)p; }
__device__ __forceinline__ v4u gld16(const void* base, unsigned off) { return *(const v4u*)((const char*)base + off); }
__device__ __forceinline__ void gst8(void* base, unsigned off, v2u v) { *(v2u*)((char*)base + off) = v; }
typedef short v4i16 __attribute__((ext_vector_type(4)));
__device__ __forceinline__ bf16x8 opr(lptr img, int ldb, int r0, int k0, int c16, int rg) { return lds8(img + (r0 + c16) * ldb + (k0 + 8 * rg) * 2); }
__device__ __forceinline__ bf16x8 opt(lptr img, int ldb, int r0, int k0, int lane) {
    const int g = lane >> 4, q = (lane & 15) >> 2, p = lane & 3;
    lptr a = img + (k0 + 8 * g + q) * ldb + (r0 + 4 * p) * 2;
    const v4i16 lo = __builtin_amdgcn_ds_read_tr16_b64_v4i16((LAS v4i16*)a);
    const v4i16 hi = __builtin_amdgcn_ds_read_tr16_b64_v4i16((LAS v4i16*)(a + 4 * ldb));
    return __builtin_shufflevector(lo, hi, 0, 1, 2, 3, 4, 5, 6, 7);
}

#define XB_TMO      128
#define XB_XCNT(j)  (256  + 64 * (j))
#define XB_XSUB(j)  (1280 + 64 * (j))
#define XB_XGEN(j)  (2304 + 64 * (j))
#define XB_TOP      3328
#define XB_TOPGEN   3392
#define XCD_BAR_WORDS 3456
#define XB_SPIN_CAP (1u << 18)

__device__ __forceinline__ unsigned xb_ld(unsigned* p)              { return __hip_atomic_load(p, __ATOMIC_RELAXED, __HIP_MEMORY_SCOPE_AGENT); }
__device__ __forceinline__ unsigned xb_add(unsigned* p, unsigned v) { return __hip_atomic_fetch_add(p, v, __ATOMIC_RELAXED, __HIP_MEMORY_SCOPE_AGENT); }
__device__ __forceinline__ unsigned xb_xcc_id() { return (unsigned)__builtin_amdgcn_s_getreg((3 << 11) | 20) & 0xFu; }
#define XB_SPIN(cond, bar) do { unsigned _sp = 0; while (cond) { __builtin_amdgcn_s_sleep(1); \
    if ((++_sp & 255u) == 0u) { if (xb_ld(&(bar)[XB_TMO])) break; if (_sp > XB_SPIN_CAP) { atomicAdd(&(bar)[XB_TMO], 1u); break; } } } } while (0)

struct XcdBarrier {
    unsigned* bar; unsigned x;
    volatile LAS unsigned* st;
};

__device__ __forceinline__ XcdBarrier xcd_barrier_post(unsigned* bar, volatile LAS unsigned* st, int wv) {
    XcdBarrier b; b.bar = bar; b.x = xb_xcc_id(); b.st = st;
    if (is_t0(wv)) (void)xb_add(&bar[XB_XCNT(b.x)], 1u);
    return b;
}
__device__ __forceinline__ void xcd_barrier_complete(unsigned* bar, unsigned x, unsigned& nloc, unsigned& nx) {
    const unsigned G = gridDim.x * gridDim.y * gridDim.z;
    unsigned sum, cnt, mine, sp = 0u;
    for (;;) {
        sum = 0u; cnt = 0u; mine = 0u;
#pragma unroll
        for (unsigned j = 0; j < 16; ++j) { const unsigned c = xb_ld(&bar[XB_XCNT(j)]); sum += c; cnt += (c > 0u) ? 1u : 0u; mine = (j == x) ? c : mine; }
        if (sum == G) break;
        __builtin_amdgcn_s_sleep(1);
        if ((++sp & 255u) == 0u) { if (xb_ld(&bar[XB_TMO])) break; if (sp > XB_SPIN_CAP) { atomicAdd(&bar[XB_TMO], 1u); break; } }
    }
    nloc = mine > 0u ? mine : 1u; nx = cnt > 0u ? cnt : 1u;
}

__device__ __forceinline__ void xcd_barrier(const XcdBarrier& b, int wv) {
    asm volatile("s_waitcnt vmcnt(0)" ::: "memory");
    __syncthreads();
    if (is_t0(wv)) {
        unsigned* bar = b.bar;
        __builtin_amdgcn_s_waitcnt(0);
        unsigned nloc = b.st[0], nx = b.st[1];
        if (nloc == 0u) { xcd_barrier_complete(bar, b.x, nloc, nx); b.st[0] = nloc; b.st[1] = nx; }
        const unsigned old = xb_add(&bar[XB_XSUB(b.x)], 1u);
        const unsigned gen = old / nloc;
        if (old + 1u == (gen + 1u) * nloc) {
            __builtin_amdgcn_fence(__ATOMIC_RELEASE, "agent");
            asm volatile("s_waitcnt vmcnt(0)" ::: "memory");
            const unsigned og = xb_add(&bar[XB_TOP], 1u);
            const unsigned tg = og / nx;
            if (og + 1u == (tg + 1u) * nx) xb_add(&bar[XB_TOPGEN], 1u);
            else XB_SPIN(xb_ld(&bar[XB_TOPGEN]) == tg, bar);
            __builtin_amdgcn_fence(__ATOMIC_ACQUIRE, "agent");
            xb_add(&bar[XB_XGEN(b.x)], 1u);
            asm volatile("s_waitcnt vmcnt(0)" ::: "memory");
        } else {
            XB_SPIN(xb_ld(&bar[XB_XGEN(b.x)]) == gen, bar);
            __builtin_amdgcn_fence(__ATOMIC_ACQUIRE, "agent");
            asm volatile("s_waitcnt vmcnt(0)" ::: "memory");
        }
    }
    __syncthreads();
}


struct Args { const float* in[22]; float* out; unsigned char* ws; int ph_lo, ph_hi; };
enum { I_X = 0, I_C, I_CTX, I_CCTX, I_WADA, I_BADA, I_GPREMIX, I_GPOSTMIX, I_GPREFFN, I_GPOSTFFN, I_WIN, I_BIN, I_WOUT, I_MLFB, I_MLNORM, I_HGLB, I_HGNORM, I_DALAM, I_DANORM, I_WG, I_WU, I_WD };

__host__ __device__ __forceinline__ int perm_in_col(int n) { if (n < C_DAQ || n >= C_DAV) return n; const int d = (n - C_DAQ) % 48, base = n - d, half = d / 24, e = d % 24; return base + 24 * half + 2 * (e % 12) + (e >= 12 ? 1 : 0); }
__device__ __forceinline__ int wg_pull(unsigned* ctr, volatile LAS int* slot, int wv) {
    __syncthreads();
    if (is_t0(wv)) *slot = (int)__hip_atomic_fetch_add(ctr, 1u, RLX_AGENT);
    __syncthreads();
    return __builtin_amdgcn_readfirstlane(*slot);
}

typedef __attribute__((address_space(4))) const Args* kargs_p;
__device__ __forceinline__ void p0_phase(lptr lds, kargs_p ap, int wv) {
    struct { const float* in[22]; unsigned char* ws; } a; a.in[I_C] = ap->in[I_C]; a.in[I_CCTX] = ap->in[I_CCTX]; a.in[I_WADA] = ap->in[I_WADA]; a.in[I_BADA] = ap->in[I_BADA]; a.in[I_HGLB] = ap->in[I_HGLB]; a.in[I_BIN] = ap->in[I_BIN]; a.in[I_DALAM] = ap->in[I_DALAM]; a.ws = ap->ws;
    const int tid = tid_opaque(wv);
    unsigned char* ws = a.ws;
    LAS float* sil = (LAS float*)lds;
    LAS float* part = (LAS float*)(lds + 69632);
    for (int i = tid; i < 17 * D; i += NTHR) { const int bb = i >> 10, k = i & 1023; const float v = bb < 16 ? a.in[I_C][bb * D + k] : a.in[I_CCTX][k]; sil[i] = v / (1.0f + __expf(-v)); }
    __syncthreads();
    float* mod = (float*)(ws + WS_MOD);
    for (int u = blockIdx.x; u < DEPTH * (NMOD / 32); u += gridDim.x) {
        const int l = u / (NMOD / 32), n0 = (u % (NMOD / 32)) * 32, col = tid & 31, ks = tid >> 5;
        const float* w = a.in[I_WADA] + (size_t)l * D * NMOD + (size_t)(ks * 64) * NMOD + n0 + col;
        float acc[17];
#pragma unroll
        for (int bb = 0; bb < 17; ++bb) acc[bb] = 0.f;
        float wr[64];
#pragma unroll
        for (int k = 0; k < 64; ++k) wr[k] = w[(size_t)k * NMOD];
#pragma unroll
        for (int k = 0; k < 64; k += 4) {
#pragma unroll
            for (int bb = 0; bb < 17; ++bb) { const f32x4 s = *(const LAS f32x4*)(sil + bb * D + ks * 64 + k); acc[bb] += s[0] * wr[k] + s[1] * wr[k + 1] + s[2] * wr[k + 2] + s[3] * wr[k + 3]; }
        }
#pragma unroll
        for (int bb = 0; bb < 17; ++bb) part[(ks * 17 + bb) * 32 + col] = acc[bb];
        __syncthreads();
        for (int i = tid; i < 17 * 32; i += NTHR) { const int bb = i >> 5, cc = i & 31; float s = 0.f;
#pragma unroll
            for (int k2 = 0; k2 < 16; ++k2) s += part[(k2 * 17 + bb) * 32 + cc];
            mod[((size_t)l * 17 + bb) * NMOD + n0 + cc] = s + a.in[I_BADA][l * NMOD + n0 + cc]; }
        __syncthreads();
    }
    const int gt = blockIdx.x * NTHR + tid, GT = gridDim.x * NTHR;
    float* lbs = (float*)(ws + WS_MISC); float* rope = (float*)(ws + WS_MISC + 16384); float* biasp = (float*)(ws + WS_MISC + 32768); float* lamv = (float*)(ws + WS_MISC + 114688);
    for (int j = gt; j < 1024; j += GT) { const float* hl = a.in[I_HGLB];
        const float v0 = hl[j], v1 = hl[1024 + j], v2 = hl[2048 + j], v3 = hl[3072 + j]; const float mx = fmaxf(fmaxf(v0, v1), fmaxf(v2, v3));
        const float e0 = expf(v0 - mx), e1 = expf(v1 - mx), e2 = expf(v2 - mx), e3 = expf(v3 - mx), inv = 1.0f / (e0 + e1 + e2 + e3);
        lbs[j] = 0.f; lbs[1024 + j] = e1 * inv; lbs[2048 + j] = (e1 + e2) * inv; lbs[3072 + j] = (e1 + e2 + e3) * inv; }
    for (int j = gt; j < 64 * 12; j += GT) { const int pos = j / 12, i = j % 12; const float inv = powf(10000.0f, -(float)(2 * i) / 24.0f); const float ang = (float)pos * inv; rope[2 * j] = cosf(ang); rope[2 * j + 1] = sinf(ang); }
    for (int j = gt; j < DEPTH * DINP; j += GT) { const int l = j / DINP, n = j % DINP; biasp[l * DINP + perm_in_col(n)] = n < DIN ? a.in[I_BIN][l * DIN + n] : 0.f; }
    if (gt < DEPTH) { const float* lv = a.in[I_DALAM] + gt * 4 * 48; float s01 = 0.f, s23 = 0.f;
        for (int d = 0; d < 48; ++d) { s01 += lv[d] * lv[48 + d]; s23 += lv[96 + d] * lv[144 + d]; }
        const float lam_init = 0.8f - 0.6f * expf(-0.3f * (float)gt);
        lamv[gt] = expf(s01) - expf(s23) + lam_init; }
}

template <bool RES, bool NORM, bool XSF, bool XDF>
__device__ __forceinline__ void thin_phase(int row_lo, const float* xs_lat, const float* xs_ctx, float* xd_lat, bf16* xbuf, bool write_x,
                                           const bf16* y, const float* mod_r, int goff, const float* gpost,
                                           const float* mod_n, int soff, int aoff, const float* gpre, bf16* hout, int vcu, int G, int wv, int probe = 0) {
    const int tid = tid_opaque(wv); const int lane = tid & 63, wave = wv;
    const int nrows = MT - row_lo; int rwg = (nrows + G - 1) / G; rwg += rwg & 1;
    const int wbeg = row_lo + vcu * rwg, rend = (wbeg + rwg < MT) ? wbeg + rwg : MT;
    const int rbeg = wbeg + 2 * wave;
    constexpr int RSTEP = 2 * NWAVES;
    int cur_bb = -1;
    f32x4 gp[4], ga[4], sh[4];
#pragma unroll
    for (int j = 0; j < 4; ++j) { gp[j] = (f32x4){0.f, 0.f, 0.f, 0.f}; ga[j] = gp[j]; sh[j] = gp[j]; }
    f32x4 xa[2][4], ya[2][4];
#define TH_LOAD(X, Y, r_) do { _Pragma("unroll") for (int q_ = 0; q_ < 2; ++q_) { const int rr_ = (r_) + q_; const bool ic_ = rr_ < MC; \
        const float* xs_ = ic_ ? xs_ctx + (size_t)rr_ * D : xs_lat + (size_t)(rr_ - MC) * D; \
        _Pragma("unroll") for (int j_ = 0; j_ < 4; ++j_) { if (XSF) X[q_][j_] = *(const f32x4*)(xs_ + 4 * lane + 256 * j_); \
            else { const v2u xw_ = __builtin_nontemporal_load((const v2u*)(xbuf + (size_t)rr_ * D + 4 * lane + 256 * j_)); X[q_][j_] = (f32x4){bflo(xw_.x), bfhi(xw_.x), bflo(xw_.y), bfhi(xw_.y)}; } \
            if (RES) { const v2u yw_ = __builtin_nontemporal_load((const v2u*)(y + (size_t)rr_ * D + 4 * lane + 256 * j_)); Y[q_][j_] = (f32x4){bflo(yw_.x), bfhi(yw_.x), bflo(yw_.y), bfhi(yw_.y)}; } } } } while (0)
    if (rbeg < rend) TH_LOAD(xa, ya, rbeg);
    for (int r = rbeg; r < rend; r += RSTEP) {
        f32x4 xb[2][4], yb[2][4];
        if (r + RSTEP < rend) TH_LOAD(xb, yb, r + RSTEP);
        const bool isctx = r < MC; const int bb = isctx ? 16 : (r - MC) / SEQ;
        if (bb != cur_bb) { cur_bb = bb;
#pragma unroll
            for (int j = 0; j < 4; ++j) { const int e = 4 * lane + 256 * j;
                if (RES) gp[j] = *(const f32x4*)(mod_r + (size_t)bb * NMOD + goff + e) * *(const f32x4*)(gpost + e);
                if (NORM) { ga[j] = *(const f32x4*)(gpre + e) * (*(const f32x4*)(mod_n + (size_t)bb * NMOD + aoff + e) + 1.0f); sh[j] = *(const f32x4*)(mod_n + (size_t)bb * NMOD + soff + e); } } }
        if (RES) { float s0 = 0.f, s1 = 0.f;
#pragma unroll
            for (int j = 0; j < 4; ++j) { s0 += (ya[0][j][0] * ya[0][j][0] + ya[0][j][1] * ya[0][j][1]) + (ya[0][j][2] * ya[0][j][2] + ya[0][j][3] * ya[0][j][3]);
                                          s1 += (ya[1][j][0] * ya[1][j][0] + ya[1][j][1] * ya[1][j][1]) + (ya[1][j][2] * ya[1][j][2] + ya[1][j][3] * ya[1][j][3]); }
#pragma unroll
            for (int o = 1; o < 64; o <<= 1) { s0 += lx_xor(s0, o, lane); s1 += lx_xor(s1, o, lane); }
            const float r0s = 1.0f / sqrtf(s0 * (1.0f / D) + EPS), r1s = 1.0f / sqrtf(s1 * (1.0f / D) + EPS);
#pragma unroll
            for (int j = 0; j < 4; ++j) { xa[0][j] += gp[j] * ya[0][j] * r0s; xa[1][j] += gp[j] * ya[1][j] * r1s; } }
        if (write_x && !(probe & 1)) {
            if (XDF) { float* xd0 = xd_lat + (size_t)(r - MC) * D;
#pragma unroll
                for (int j = 0; j < 4; ++j) { *(f32x4*)(xd0 + 4 * lane + 256 * j) = xa[0][j]; *(f32x4*)(xd0 + D + 4 * lane + 256 * j) = xa[1][j]; } }
            else {
#pragma unroll
                for (int j = 0; j < 4; ++j) { v2u w0, w1; w0.x = pk2(xa[0][j][0], xa[0][j][1]); w0.y = pk2(xa[0][j][2], xa[0][j][3]); w1.x = pk2(xa[1][j][0], xa[1][j][1]); w1.y = pk2(xa[1][j][2], xa[1][j][3]);
                    __builtin_nontemporal_store(w0, (v2u*)(xbuf + (size_t)r * D + 4 * lane + 256 * j)); __builtin_nontemporal_store(w1, (v2u*)(xbuf + (size_t)(r + 1) * D + 4 * lane + 256 * j));
                    if (NORM) { xa[0][j] = (f32x4){bflo(w0.x), bfhi(w0.x), bflo(w0.y), bfhi(w0.y)}; xa[1][j] = (f32x4){bflo(w1.x), bfhi(w1.x), bflo(w1.y), bfhi(w1.y)}; } } } }
        if (NORM) { float s0 = 0.f, s1 = 0.f;
#pragma unroll
            for (int j = 0; j < 4; ++j) { s0 += (xa[0][j][0] * xa[0][j][0] + xa[0][j][1] * xa[0][j][1]) + (xa[0][j][2] * xa[0][j][2] + xa[0][j][3] * xa[0][j][3]);
                                          s1 += (xa[1][j][0] * xa[1][j][0] + xa[1][j][1] * xa[1][j][1]) + (xa[1][j][2] * xa[1][j][2] + xa[1][j][3] * xa[1][j][3]); }
#pragma unroll
            for (int o = 1; o < 64; o <<= 1) { s0 += lx_xor(s0, o, lane); s1 += lx_xor(s1, o, lane); }
            const float r0s = 1.0f / sqrtf(s0 * (1.0f / D) + EPS), r1s = 1.0f / sqrtf(s1 * (1.0f / D) + EPS);
#pragma unroll
            for (int j = 0; j < 4; ++j) { const f32x4 h0 = xa[0][j] * r0s * ga[j] + sh[j], h1 = xa[1][j] * r1s * ga[j] + sh[j];
                v2u w0, w1; w0.x = pk2(h0[0], h0[1]); w0.y = pk2(h0[2], h0[3]); w1.x = pk2(h1[0], h1[1]); w1.y = pk2(h1[2], h1[3]);
                if (!(probe & 2)) { *(v2u*)(hout + (size_t)r * D + 4 * lane + 256 * j) = w0; *(v2u*)(hout + (size_t)(r + 1) * D + 4 * lane + 256 * j) = w1; } } }
#pragma unroll
        for (int q = 0; q < 2; ++q)
#pragma unroll
            for (int j = 0; j < 4; ++j) { xa[q][j] = xb[q][j]; if (RES) ya[q][j] = yb[q][j]; }
    }
#undef TH_LOAD
}

template <int MODE>
__device__ __forceinline__ void tr_item(const float* W, int K, int N, int nblk, bf16* WT, LAS float* scr, int item, int lane) {
    const int kb = item / nblk, nb = item % nblk, k0 = 64 * kb, n0 = 32 * nb;
    const int nn = n0 + (lane & 31); const bool ok = nn < N;
#pragma unroll 8
    for (int i = 0; i < 32; ++i) { const int kk = 2 * i + (lane >> 5); scr[kk * 33 + (lane & 31)] = ok ? W[(size_t)(k0 + kk) * N + nn] : 0.f; }
    LDS_WAIT(); asm volatile("" ::: "memory");
    const int c = lane & 7;
#pragma unroll
    for (int j = 0; j < 4; ++j) { const int n = (lane >> 3) + 8 * j; const LAS float* s = scr + (8 * c) * 33 + n;
        v4u o; o.x = pk2(s[0 * 33], s[1 * 33]); o.y = pk2(s[2 * 33], s[3 * 33]); o.z = pk2(s[4 * 33], s[5 * 33]); o.w = pk2(s[6 * 33], s[7 * 33]);
        const int ng = n0 + n; const int drow = MODE == 0 ? ng : MODE == 3 ? perm_in_col(ng) : ((ng >> 7) * 256 + (ng & 127) + (MODE == 2 ? 128 : 0));
        *(v4u*)(WT + (size_t)drow * K + k0 + 8 * c) = o; }
    LDS_WAIT(); asm volatile("" ::: "memory");
}
__device__ __forceinline__ void convert_weights(lptr lds, kargs_p ap, int l, int widx, int nw, int wv, int part = 0) {
    const unsigned char* const wsb = ap->ws; const float* const p_win = ap->in[I_WIN]; const float* const p_wout = ap->in[I_WOUT]; const float* const p_wg = ap->in[I_WG]; const float* const p_wu = ap->in[I_WU]; const float* const p_wd = ap->in[I_WD];
    const int tid = tid_opaque(wv); const int lane = tid & 63, wave = wv;
    LAS float* scr = (LAS float*)(lds + wave * 8448);
    const int gw = widx * NWAVES + wave, NGW = nw * NWAVES;
    unsigned char* ws = (unsigned char*)wsb;
    constexpr int I_IN = 16 * (DINP / 32), I_OUT = 16 * 32, I_GU = 16 * (DFF / 32), I_DN = (DFF / 64) * 32;
    constexpr int NITEMS = I_IN + I_OUT + 2 * I_GU + I_DN;
    const int it_lo = part == 2 ? I_IN : part == 3 ? NITEMS - I_DN : 0, it_hi = part == 1 ? I_IN : part == 2 ? NITEMS - I_DN : NITEMS;
    for (int it = it_lo + gw; it < it_hi; it += NGW) {
        int r = it;
        if (r < I_IN) { tr_item<3>(p_win + (size_t)l * D * DIN, D, DIN, DINP / 32, (bf16*)(ws + WS_WIN), scr, r, lane); continue; } r -= I_IN;
        if (r < I_OUT) { tr_item<0>(p_wout + (size_t)l * D * D, D, D, 32, (bf16*)(ws + WS_WOUT), scr, r, lane); continue; } r -= I_OUT;
        if (r < I_GU) { tr_item<1>(p_wg + (size_t)l * D * DFF, D, DFF, DFF / 32, (bf16*)(ws + WS_WGU), scr, r, lane); continue; } r -= I_GU;
        if (r < I_GU) { tr_item<2>(p_wu + (size_t)l * D * DFF, D, DFF, DFF / 32, (bf16*)(ws + WS_WGU), scr, r, lane); continue; } r -= I_GU;
        tr_item<0>(p_wd + (size_t)l * DFF * D, DFF, D, 32, (bf16*)(ws + WS_WD), scr, r, lane);
    }
}
constexpr int AT_BUF = 25600, AT_KOFF = 0, AT_VOFF = 13312, AT_QF = 76800, AT_GN = AT_QF + 8 * 6 * 1024;
constexpr float AT_THR = 8.0f;
constexpr float QSCALE = 0.14433756729740643f * 1.4426950408889634f;

__device__ __forceinline__ f32x16 zero16() { f32x16 z; _Pragma("unroll") for (int r = 0; r < 16; ++r) z[r] = 0.f; return z; }
__device__ __forceinline__ float sm_max(const f32x16& S, int lane) {
    float mx = S[0];
#pragma unroll
    for (int r = 1; r < 16; ++r) mx = fmaxf(mx, S[r]);
    return fmaxf(mx, lx_xor(mx, 32, lane));
}
__device__ __forceinline__ void sm_exp(const f32x16& S, float m, float& l, bf16x8& p0, bf16x8& p1) {
    float p[16]; float ps = 0.f;
#pragma unroll
    for (int r = 0; r < 16; ++r) { p[r] = __builtin_amdgcn_exp2f(S[r] - m); ps += p[r]; }
    l += ps;
    v4u a, b;
    a.x = pk2(p[0], p[1]); a.y = pk2(p[2], p[3]); a.z = pk2(p[4], p[5]); a.w = pk2(p[6], p[7]);
    b.x = pk2(p[8], p[9]); b.y = pk2(p[10], p[11]); b.z = pk2(p[12], p[13]); b.w = pk2(p[14], p[15]);
    p0 = __builtin_bit_cast(bf16x8, a); p1 = __builtin_bit_cast(bf16x8, b);
}
__device__ __forceinline__ bf16x8 vt_frag(lptr vt, int ct, int sub, int sp, int lane) {
    const int h = lane >> 5, blk = (lane >> 4) & 1, q = (lane & 15) >> 2, p = lane & 3;
    lptr a = vt + (32 * sub + 16 * sp + 4 * h + q) * 192 + (32 * ct + 16 * blk + 4 * p) * 2;
    const v4i16 lo = __builtin_amdgcn_ds_read_tr16_b64_v4i16((LAS v4i16*)a);
    const v4i16 hi = __builtin_amdgcn_ds_read_tr16_b64_v4i16((LAS v4i16*)(a + 8 * 192));
    return __builtin_shufflevector(lo, hi, 0, 1, 2, 3, 4, 5, 6, 7);
}

__device__ __forceinline__ void attn_item(lptr lds, const bf16* P, bf16* YM, const float* danorm, float lam, float out_scale, int b, int h, int qb, int probe, int wv, unsigned long long* prb = nullptr) {
    const int tid = tid_opaque(wv), lane = tid & 63, r32 = lane & 31, hi = lane >> 5, wave = wv;
    const bool lat = qb < 8;
    unsigned long long pT0 = 0;
    if (prb) pT0 = __builtin_amdgcn_s_memrealtime();
    const int qrow0 = lat ? MC + b * SEQ + qb * 256 : b * CTXL;
    const int nt = lat ? 36 : 4;
    v4u cin[2];
    const unsigned kgo0 = (unsigned)(tid / 12) * DAX_LD + 16u * (unsigned)(tid % 12) + 192u, kgo1 = (unsigned)((tid + 512) / 12) * DAX_LD + 16u * (unsigned)((tid + 512) % 12) + 192u;
    const unsigned klo0 = (unsigned)(AT_KOFF + (tid / 12) * 208 + (tid % 12) * 16), klo1 = (unsigned)(AT_KOFF + ((tid + 512) / 12) * 208 + ((tid + 512) % 12) * 16);
    const unsigned vgo0 = (unsigned)((64 * wave + lane) / 12) * DAX_LD + 16u * (unsigned)((64 * wave + lane) % 12) + 384u, vgo1 = (unsigned)((64 * (wave + 8) + lane) / 12) * DAX_LD + 16u * (unsigned)((64 * (wave + 8) + lane) % 12) + 384u;
    const char* DX = (const char*)P + DAX_OFF + (size_t)(b * 4 + h) * NSLOT * DAX_LD;
#define AT_LOAD(tile) do { const char* tb_ = DX + (size_t)(tile) * (64 * DAX_LD); cin[0] = gld16(tb_, kgo0); if (tid < 256) cin[1] = gld16(tb_, kgo1); } while (0)
#define AT_STORE(tile, buf) do { lptr sb_ = lds + (buf) * AT_BUF; *(LAS v4u*)(sb_ + klo0) = cin[0]; if (tid < 256) *(LAS v4u*)(sb_ + klo1) = cin[1]; } while (0)
#define AT_VDMA(tile, buf) do { const char* tb_ = DX + (size_t)(tile) * (64 * DAX_LD); lptr vb_ = lds + (buf) * AT_BUF + AT_VOFF; \
        __builtin_amdgcn_global_load_lds((const unsigned*)(tb_ + vgo0), (LAS unsigned*)(vb_ + wave * 1024), 16, 0, 0); \
        if (wave < 4) __builtin_amdgcn_global_load_lds((const unsigned*)(tb_ + vgo1), (LAS unsigned*)(vb_ + (wave + 8) * 1024), 16, 0, 0); } while (0)
    if (tid < 96) ((LAS float*)(lds + AT_GN))[tid] = danorm[tid];
    AT_LOAD(0);
    lptr qfp = lds + AT_QF + (wave * 6 * 64 + lane) * 16;
    { const unsigned qo = (unsigned)((lat ? CTXL + qb * 256 : 0) + wave * 32 + r32) * DAX_LD + 16u * hi;
#pragma unroll
      for (int f = 0; f < 6; ++f) __builtin_amdgcn_global_load_lds((const unsigned*)(DX + qo + (unsigned)((f / 3) * 48 + (f % 3) * 16) * 2u), (LAS unsigned*)(lds + AT_QF + (wave * 6 + f) * 1024), 16, 0, 0); }
    AT_STORE(0, 0); AT_VDMA(0, 0);
    if (nt > 1) { AT_LOAD(1); AT_VDMA(1, 1); }
    __syncthreads();
    f32x16 O0[3], O1[3];
#pragma unroll
    for (int ct = 0; ct < 3; ++ct)
#pragma unroll
        for (int r = 0; r < 16; ++r) { O0[ct][r] = 0.f; O1[ct][r] = 0.f; }
    float m0 = -1e30f, m1 = -1e30f, l0 = 0.f, l1 = 0.f;
#define AT_QK(SX0, SX1, kb, sub) do { \
        _Pragma("unroll") for (int ks = 0; ks < 3; ++ks) { \
            const bf16x8 k0_ = lds8((kb) + (((sub) * 32 + r32) * 104 + ks * 16 + hi * 8) * 2); \
            const bf16x8 k1_ = lds8((kb) + (((sub) * 32 + r32) * 104 + 48 + ks * 16 + hi * 8) * 2); \
            const bf16x8 q0_ = lds8(qfp + ks * 1024), q1_ = lds8(qfp + (3 + ks) * 1024); \
            if (ks == 0) { SX0 = MFMA32(k0_, q0_, zero16()); SX1 = MFMA32(k1_, q1_, zero16()); } \
            else { SX0 = MFMA32(k0_, q0_, SX0); SX1 = MFMA32(k1_, q1_, SX1); } } } while (0)
#define AT_SMPV(SX0, SX1, vb, sub) do { \
        const float mx0_ = sm_max(SX0, lane), mx1_ = sm_max(SX1, lane); \
        if (__any((mx0_ > m0 + AT_THR) || (mx1_ > m1 + AT_THR))) { \
            const float n0_ = fmaxf(m0, mx0_), n1_ = fmaxf(m1, mx1_); \
            const float a0_ = __builtin_amdgcn_exp2f(m0 - n0_), a1_ = __builtin_amdgcn_exp2f(m1 - n1_); \
            m0 = n0_; m1 = n1_; l0 *= a0_; l1 *= a1_; \
            _Pragma("unroll") for (int ct = 0; ct < 3; ++ct) _Pragma("unroll") for (int r = 0; r < 16; ++r) { O0[ct][r] *= a0_; O1[ct][r] *= a1_; } } \
        bf16x8 p00_, p01_, p10_, p11_; \
        sm_exp(SX0, m0, l0, p00_, p01_); sm_exp(SX1, m1, l1, p10_, p11_); \
        _Pragma("unroll") for (int ct = 0; ct < 3; ++ct) { \
            const bf16x8 v0_ = vt_frag((vb), ct, (sub), 0, lane); const bf16x8 v1_ = vt_frag((vb), ct, (sub), 1, lane); \
            O0[ct] = MFMA32(v0_, p00_, O0[ct]); O1[ct] = MFMA32(v0_, p10_, O1[ct]); \
            O0[ct] = MFMA32(v1_, p01_, O0[ct]); O1[ct] = MFMA32(v1_, p11_, O1[ct]); } } while (0)
    f32x16 SA0, SA1, SB0, SB1;
    AT_QK(SA0, SA1, lds + AT_KOFF, 0);
    int cb = 0;
    for (int i = 0; i < nt; ++i) {
        const int nb = (cb == 2) ? 0 : cb + 1;
        lptr kc_ = lds + cb * AT_BUF + AT_KOFF, vc_ = lds + cb * AT_BUF + AT_VOFF;
        AT_QK(SB0, SB1, kc_, 1);
        AT_SMPV(SA0, SA1, vc_, 0);
        if (i + 1 < nt && !(probe & 2)) AT_STORE(i + 1, nb);
        __syncthreads();
        if (i + 2 < nt && !(probe & 1)) { AT_LOAD(i + 2); AT_VDMA(i + 2, (nb == 2) ? 0 : nb + 1); }
        if (i + 1 < nt) AT_QK(SA0, SA1, lds + nb * AT_BUF + AT_KOFF, 0);
        AT_SMPV(SB0, SB1, vc_, 1);
        cb = nb;
    }
#undef AT_LOAD
#undef AT_VDMA
#undef AT_STORE
#undef AT_QK
#undef AT_SMPV
    const float i0 = 1.0f / (l0 + lx_xor(l0, 32, lane)), i1 = lam / (l1 + lx_xor(l1, 32, lane));
    float ss = 0.f;
#pragma unroll
    for (int ct = 0; ct < 3; ++ct)
#pragma unroll
        for (int r = 0; r < 16; ++r) { const float o = O0[ct][r] * i0 - O1[ct][r] * i1; O0[ct][r] = o; ss += o * o; }
    ss += lx_xor(ss, 32, lane);
    const float rs = out_scale / sqrtf(ss * (1.0f / 96.0f) + EPS);
    const unsigned oro = ((unsigned)(qrow0 + wave * 32 + r32) * (unsigned)D + (unsigned)(Y_DA + h * 96)) * 2u;
#pragma unroll
    for (int ct = 0; ct < 3; ++ct)
#pragma unroll
        for (int g = 0; g < 4; ++g) { const int c0 = 32 * ct + 8 * g + 4 * hi; const f32x4 gn = *(const LAS f32x4*)((LAS float*)(lds + AT_GN) + c0);
            v2u w; w.x = pk2(O0[ct][4 * g] * rs * gn[0], O0[ct][4 * g + 1] * rs * gn[1]); w.y = pk2(O0[ct][4 * g + 2] * rs * gn[2], O0[ct][4 * g + 3] * rs * gn[3]);
            gst8(YM, oro + 2u * c0, w); }
    if (prb && tid == 0) { prb[0] = __builtin_amdgcn_s_memrealtime() - pT0; }
}
__device__ __forceinline__ int scan_row(int b, int dir, int p) {
    if (p < CTXL) { const int t = dir ? CTXL - 1 - p : p; return b * CTXL + t; }
    const int pl = p - CTXL; const int t = dir ? SEQ - 1 - pl : pl; return MC + b * SEQ + t;
}
__device__ __forceinline__ int scan_slot(int dir, int p) { if (p < CTXL) return dir ? CTXL - 1 - p : p; const int pl = p - CTXL; return CTXL + (dir ? SEQ - 1 - pl : pl); }

constexpr int ML_Q = 0, ML_K = 13312, ML_KW = 26624, ML_VA = 40960, ML_QKM = 55296, ML_ST = 64512, ML_GF = 87808, ML_DUMMY = 90624;
constexpr int ML_LDQ = 208, ML_LDW = 224, ML_LDM = 144, ML_LDS = 208;
constexpr float KSCALE = 0.10206207261596577f;

__device__ __forceinline__ void mlstm_stream(lptr lds, const bf16* P, const float* G, bf16* dst, int dst_ld, const float* fbias  , int b, int h, int dir, int wv, unsigned long long* prb = nullptr) {
    const int tid = tid_opaque(wv), lane = tid & 63, c16 = lane & 15, rg = lane >> 4, wave = wv;
    lptr Qs = lds + ML_Q, Ks = lds + ML_K, Kw = lds + ML_KW, Va = lds + ML_VA, QKM = lds + ML_QKM, ST = lds + ML_ST;
    LAS float* GB = (LAS float*)(lds + ML_GF);
    if (tid < 128) { const int t = tid >> 1, hh = tid & 1; v4u w; w.x = hh ? 0u : 0x3F80u; w.y = 0u; w.z = 0u; w.w = 0u; *(LAS v4u*)(Va + t * ML_LDW + (96 + 8 * hh) * 2) = w; }
    const float fb = fbias[dir * 4 + h];
    f32x4 acc[6];
#pragma unroll
    for (int i = 0; i < 6; ++i) acc[i] = (f32x4){0.f, 0.f, 0.f, 0.f};
    float m_prev = -1e30f;
    v4u pre[5]; float gi = 0.f, gf = 0.f;
    const char* MLB = (const char*)P + MLX_OFF + (size_t)(b * 4 + h) * NSLOT * MLX_LD;
#define ML_PREFETCH(c) do { const char* cb_ = MLB + (size_t)(dir ? scan_slot(1, 64 * (c) + 63) : scan_slot(0, 64 * (c))) * MLX_LD; \
    _Pragma("unroll") for (int i_ = 0; i_ < 5; ++i_) { const int id_ = (i_ < 4 || tid < 256) ? tid + NTHR * i_ : tid; const int t_ = id_ / 36, r_ = id_ % 36;     \
        pre[i_] = gld16(cb_, (unsigned)(dir ? 63 - t_ : t_) * MLX_LD + (unsigned)((r_ / 12) * 96 + (r_ % 12) * 8) * 2u); } \
    } while (0)
#define ML_GLOAD(c) do { if (wave == 4) { const unsigned go_ = (unsigned)scan_row(b, dir, 64 * (c) + lane) * 64u + (unsigned)(dir * 4 + h) * 4u; gi = *(const float*)((const char*)G + go_); gf = *(const float*)((const char*)G + go_ + 32u); } } while (0)
#define ML_GSCAN(c) do { if (wave == 4) { LAS float* g_ = GB + ((c) & 1) * 336; \
        const float fp = gf + fb; \
        const float lf = fminf(fp, 0.f) - log1pf(__expf(-fabsf(fp))); \
        const float bs = scan_sum64(lf); \
        const float g = gi - bs; \
        const float cm = scan_max64(g); \
        const float Mx = fmaxf(m_prev, cm); \
        const float mt = bs + Mx; \
        const float blast = lx_idx(bs, 63), m_new = lx_idx(mt, 63); \
        g_[lane] = g; g_[64 + lane] = Mx; g_[128 + lane] = __expf(m_prev - Mx); g_[192 + lane] = __expf(-mt); g_[256 + lane] = __expf(g + blast - m_new) * KSCALE; \
        if (lane == 0) g_[320] = __expf(blast + m_prev - m_new); \
        m_prev = m_new; } } while (0)
    ML_GLOAD(0);
    ML_PREFETCH(0);
    ML_GSCAN(0);
    ML_GLOAD(1);
    unsigned long long pa0 = 0, pa1 = 0, pa2 = 0, pa3 = 0, pt0 = 0;
    for (int c = 0; c < NTOK / 64; ++c) {
        if (prb) pt0 = __builtin_amdgcn_s_memrealtime();
        LAS float* gA = GB + (c & 1) * 336; LAS float* MxA = gA + 64; LAS float* wA = gA + 128; LAS float* emtA = gA + 192; LAS float* wkA = gA + 256; LAS float* scal = gA + 320;
#pragma unroll
        for (int i = 0; i < 5; ++i) { const int id = tid + NTHR * i; const int t = id / 36, r = id % 36, wh = r / 12, cc = r % 12;
            lptr d = ((wh == 0) ? Qs + t * ML_LDQ : (wh == 1) ? Ks + t * ML_LDQ : Va + t * ML_LDW) + cc * 16;
            if (i == 4) d = (tid < 256) ? d : lds + ML_DUMMY + (tid - 256) * 16;
            *(LAS v4u*)d = pre[i]; }
        if (prb) { asm volatile("s_waitcnt lgkmcnt(0)" ::: "memory"); const unsigned long long t_ = __builtin_amdgcn_s_memrealtime(); pa3 += t_ - pt0; }
        if (c + 1 < NTOK / 64) ML_PREFETCH(c + 1);
        __syncthreads();
        if (prb) { const unsigned long long t_ = __builtin_amdgcn_s_memrealtime(); pa0 += t_ - pt0; pt0 = t_; }
#pragma unroll
        for (int j = 0; j < 2; ++j) { const int idx = 2 * wave + j, si = idx & 3, ti = idx >> 2;
            f32x4 a4 = (f32x4){0.f, 0.f, 0.f, 0.f};
            if (si <= ti) {
#pragma unroll
                for (int ks = 0; ks < 3; ++ks) a4 = MFMA16(opr(Ks, ML_LDQ, 16 * si, 32 * ks, c16, rg), opr(Qs, ML_LDQ, 16 * ti, 32 * ks, c16, rg), a4);
            }
            const int t = 16 * ti + c16, s0 = 16 * si + 4 * rg; const float mxt = MxA[t]; const f32x4 g4 = *(const LAS f32x4*)(gA + s0);
            float v[4];
#pragma unroll
            for (int r = 0; r < 4; ++r) v[r] = (s0 + r <= t) ? a4[r] * KSCALE * __expf(g4[r] - mxt) : 0.f;
            v2u w; w.x = pk2(v[0], v[1]); w.y = pk2(v[2], v[3]); *(LAS v2u*)(QKM + t * ML_LDM + s0 * 2) = w; }
        for (int id = tid; id < 64 * 12; id += NTHR) { const int t = id / 12, cc = id % 12; const v4u w = *(const LAS v4u*)(Ks + t * ML_LDQ + cc * 16); const float sc = wkA[t];
            v4u o; o.x = pk2(bflo(w.x) * sc, bfhi(w.x) * sc); o.y = pk2(bflo(w.y) * sc, bfhi(w.y) * sc); o.z = pk2(bflo(w.z) * sc, bfhi(w.z) * sc); o.w = pk2(bflo(w.w) * sc, bfhi(w.w) * sc);
            *(LAS v4u*)(Kw + t * ML_LDW + cc * 16) = o; }
#pragma unroll
        for (int i = 0; i < 6; ++i) { const int j = wave + 8 * i; if (j < 42) { const int di = j / 7, vi = j % 7;
            v2u w; w.x = pk2(acc[i][0], acc[i][1]); w.y = pk2(acc[i][2], acc[i][3]); *(LAS v2u*)(ST + (16 * vi + c16) * ML_LDS + (16 * di + 4 * rg) * 2) = w; } }
        __syncthreads();
        if (prb) { const unsigned long long t_ = __builtin_amdgcn_s_memrealtime(); pa1 += t_ - pt0; pt0 = t_; }
        if (wave < 4) {
            const int ti = wave, t = 16 * ti + c16;
            f32x4 aX[7];
#pragma unroll
            for (int vi = 0; vi < 7; ++vi) aX[vi] = (f32x4){0.f, 0.f, 0.f, 0.f};
#pragma unroll
            for (int ks = 0; ks < 3; ++ks) { const bf16x8 b8 = opr(Qs, ML_LDQ, 16 * ti, 32 * ks, c16, rg);
#pragma unroll
                for (int vi = 0; vi < 7; ++vi) aX[vi] = MFMA16(opr(ST, ML_LDS, 16 * vi, 32 * ks, c16, rg), b8, aX[vi]); }
            { const float wt = wA[t];
#pragma unroll
              for (int vi = 0; vi < 7; ++vi) aX[vi] = aX[vi] * wt; }
#pragma unroll
            for (int ks = 0; ks < 2; ++ks) { const bf16x8 b8 = opr(QKM, ML_LDM, 16 * ti, 32 * ks, c16, rg);
#pragma unroll
                for (int vi = 0; vi < 7; ++vi) aX[vi] = MFMA16(opt(Va, ML_LDW, 16 * vi, 32 * ks, lane), b8, aX[vi]); }
            const float den = lx_idx(aX[6][0], c16);
            const float inv = 1.0f / fmaxf(fabsf(den), emtA[t]);
            const int row = scan_row(b, dir, 64 * c + t);
            const unsigned oo = ((unsigned)row * (unsigned)dst_ld + (unsigned)(h * 96 + 4 * rg)) * 2u;
#pragma unroll
            for (int vi = 0; vi < 6; ++vi) { v2u w; w.x = pk2(aX[vi][0] * inv, aX[vi][1] * inv); w.y = pk2(aX[vi][2] * inv, aX[vi][3] * inv); gst8(dst, oo + 32u * vi, w); }
        }
        if (c + 1 < NTOK / 64) { ML_GSCAN(c + 1); if (c + 2 < NTOK / 64) ML_GLOAD(c + 2); }
        { const float decay = scal[0];
#pragma unroll
          for (int i = 0; i < 6; ++i) { const int j = wave + 8 * i; if (j < 42) { const int di = j / 7, vi = j % 7;
              acc[i] = acc[i] * decay;
#pragma unroll
              for (int ks = 0; ks < 2; ++ks) acc[i] = MFMA16(opt(Kw, ML_LDW, 16 * di, 32 * ks, lane), opt(Va, ML_LDW, 16 * vi, 32 * ks, lane), acc[i]); } } }
        __syncthreads();
        if (prb) { const unsigned long long t_ = __builtin_amdgcn_s_memrealtime(); pa2 += t_ - pt0; }
    }
    if (prb && tid == 0) { prb[0] = pa0; prb[1] = pa1; prb[2] = pa2; prb[3] = pa3; }
#undef ML_PREFETCH
#undef ML_GLOAD
#undef ML_GSCAN
}

constexpr int HG_QT = 0, HG_KR = 8704, HG_V = 17920, HG_ATT = 23040, HG_SPT = 25600, HG_ER = 43008, HG_TOT = 43520, HG_OFF = 47616;
constexpr int HG_LDQ = 272, HG_LDK = 288, HG_LDV = 160, HG_LDA = 80, HG_LDS = 272;

__device__ __forceinline__ void hgrn2_stream(lptr lds, const bf16* P, bf16* dst, int dst_ld, const float* lbl  , int b, int h, int dir, int wv, unsigned long long* prb = nullptr) {
    const int tid = tid_opaque(wv), lane = tid & 63, c16 = lane & 15, rg = lane >> 4, wave = wv;
    lptr QT = lds + HG_QT, KR = lds + HG_KR, Vs = lds + HG_V, ATT = lds + HG_ATT, SPT = lds + HG_SPT;
    LAS float* ER = (LAS float*)(lds + HG_ER); LAS float* TOT = (LAS float*)(lds + HG_TOT); LAS float* OFF = (LAS float*)(lds + HG_OFF);
    const int tt = lane & 31, kh = lane >> 5, k0 = 16 * wave + 8 * kh;
    const int tv = tid >> 3, cv = tid & 7;
    float lb[8];
    { const f32x4 l0 = *(const f32x4*)(lbl + dir * 512 + h * 128 + k0), l1 = *(const f32x4*)(lbl + dir * 512 + h * 128 + k0 + 4);
#pragma unroll
      for (int j = 0; j < 4; ++j) { lb[j] = l0[j]; lb[4 + j] = l1[j]; } }
    f32x4 acc[4];
#pragma unroll
    for (int i = 0; i < 4; ++i) acc[i] = (f32x4){0.f, 0.f, 0.f, 0.f};
    v4u zr, qr, vr;
    const char* HB_ = (const char*)P + HGX_OFF + (size_t)(b * 4 + h) * NSLOT * HGX_LD;
#define HG_PREFETCH(c) do { { const unsigned ro_ = (unsigned)scan_slot(dir, 32 * (c) + tt) * HGX_LD + 2u * k0; \
        zr = gld16(HB_, ro_ + (unsigned)dir * 256u); qr = gld16(HB_, ro_ + 512u); } \
        if (tid < 256) { const unsigned ro_ = (unsigned)scan_slot(dir, 32 * (c) + tv) * HGX_LD + 16u * cv; vr = gld16(HB_, ro_ + 768u); } } while (0)
    HG_PREFETCH(0);
    unsigned long long pa0 = 0, pa1 = 0, pt0 = 0;
    for (int c = 0; c < NTOK / 32; ++c) {
        if (prb) pt0 = __builtin_amdgcn_s_memrealtime();
        {
            float qt[8], kt[8], er[8];
            const unsigned zw[4] = {zr.x, zr.y, zr.z, zr.w}, qw[4] = {qr.x, qr.y, qr.z, qr.w};
#pragma unroll
            for (int j = 0; j < 8; ++j) { const float z = (j & 1) ? bfhi(zw[j >> 1]) : bflo(zw[j >> 1]); const float q = (j & 1) ? bfhi(qw[j >> 1]) : bflo(qw[j >> 1]);
                const float e = __expf(-fabsf(z)); const float inv = __builtin_amdgcn_rcpf(1.0f + e);
                const float sig = z >= 0.f ? inv : e * inv, nsig = z >= 0.f ? e * inv : inv;
                const float oml = 1.0f - lb[j]; const float f = fmaxf(lb[j], 1e-30f) + oml * sig; const float kk = oml * nsig;
                float x = __log2f(f);
                x += dpp_f<0x111, 0xf>(0.f, x); x += dpp_f<0x112, 0xf>(0.f, x); x += dpp_f<0x114, 0xf>(0.f, x); x += dpp_f<0x118, 0xf>(0.f, x);
                x += dpp_f<0x142, 0xa>(0.f, x);
                const float rr = 0.5f * lx_idx(x, lane | 31);
                float xx = x - rr; xx = fminf(fmaxf(xx, -100.f), 100.f);
                const float qs = q * __builtin_amdgcn_rcpf(1.0f + __expf(-q));
                qt[j] = qs * __builtin_amdgcn_exp2f(xx); kt[j] = kk * __builtin_amdgcn_exp2f(-xx); er[j] = rr; }
            v4u wq, wk; wq.x = pk2(qt[0], qt[1]); wq.y = pk2(qt[2], qt[3]); wq.z = pk2(qt[4], qt[5]); wq.w = pk2(qt[6], qt[7]);
            wk.x = pk2(kt[0], kt[1]); wk.y = pk2(kt[2], kt[3]); wk.z = pk2(kt[4], kt[5]); wk.w = pk2(kt[6], kt[7]);
            *(LAS v4u*)(QT + tt * HG_LDQ + k0 * 2) = wq; *(LAS v4u*)(KR + tt * HG_LDK + k0 * 2) = wk;
            if (tt == 0) { f32x4 e0, e1;
#pragma unroll
                for (int j = 0; j < 4; ++j) { e0[j] = __builtin_amdgcn_exp2f(fmaxf(er[j], -100.f)); e1[j] = __builtin_amdgcn_exp2f(fmaxf(er[4 + j], -100.f)); }
                *(LAS f32x4*)(ER + k0) = e0; *(LAS f32x4*)(ER + k0 + 4) = e1; }
            if (tid < 256) *(LAS v4u*)(Vs + tv * HG_LDV + cv * 16) = vr;
            asm volatile("" ::: "memory");
            { const f32x4 er4 = *(const LAS f32x4*)(ER + 16 * wave + 4 * rg);
#pragma unroll
              for (int ci = 0; ci < 4; ++ci) { acc[ci] = acc[ci] * er4; v2u w; w.x = pk2(acc[ci][0], acc[ci][1]); w.y = pk2(acc[ci][2], acc[ci][3]);
                  *(LAS v2u*)(SPT + (16 * ci + c16) * HG_LDS + (16 * wave + 4 * rg) * 2) = w; } }
        }
        if (c + 1 < NTOK / 32) HG_PREFETCH(c + 1);
        __syncthreads();
        if (prb) { const unsigned long long t_ = __builtin_amdgcn_s_memrealtime(); pa0 += t_ - pt0; pt0 = t_; }
        { const int ci = wave & 3, ti = wave >> 2, t = 16 * ti + c16;
          f32x4 a0 = (f32x4){0.f, 0.f, 0.f, 0.f}, a1 = a0;
#pragma unroll
          for (int ks = 0; ks < 4; ++ks) { const bf16x8 qb8 = opr(QT, HG_LDQ, 16 * ti, 32 * ks, c16, rg);
              a0 = MFMA16(opr(KR, HG_LDK, 0, 32 * ks, c16, rg), qb8, a0);
              if (ti == 1) a1 = MFMA16(opr(KR, HG_LDK, 16, 32 * ks, c16, rg), qb8, a1); }
          const int s0 = 4 * rg;
          v4u pb; pb.x = pk2(s0 <= t ? a0[0] : 0.f, s0 + 1 <= t ? a0[1] : 0.f); pb.y = pk2(s0 + 2 <= t ? a0[2] : 0.f, s0 + 3 <= t ? a0[3] : 0.f);
                  pb.z = pk2(16 + s0 <= t ? a1[0] : 0.f, 17 + s0 <= t ? a1[1] : 0.f); pb.w = pk2(18 + s0 <= t ? a1[2] : 0.f, 19 + s0 <= t ? a1[3] : 0.f);
          bf16x8 vperm; { const int q = (lane & 15) >> 2, p = lane & 3; lptr va = Vs + (4 * rg + q) * HG_LDV + (16 * ci + 4 * p) * 2;
              const v4i16 lo = __builtin_amdgcn_ds_read_tr16_b64_v4i16((LAS v4i16*)va), hi = __builtin_amdgcn_ds_read_tr16_b64_v4i16((LAS v4i16*)(va + 16 * HG_LDV));
              vperm = __builtin_shufflevector(lo, hi, 0, 1, 2, 3, 4, 5, 6, 7); }
          f32x4 o4 = (f32x4){0.f, 0.f, 0.f, 0.f};
          o4 = MFMA16(vperm, __builtin_bit_cast(bf16x8, pb), o4);
#pragma unroll
          for (int ks = 0; ks < 4; ++ks) o4 = MFMA16(opr(SPT, HG_LDS, 16 * ci, 32 * ks, c16, rg), opr(QT, HG_LDQ, 16 * ti, 32 * ks, c16, rg), o4);
          const int row = scan_row(b, dir, 32 * c + t);
          v2u w; w.x = pk2(o4[0], o4[1]); w.y = pk2(o4[2], o4[3]);
          gst8(dst, ((unsigned)row * (unsigned)dst_ld + (unsigned)(h * 64 + 16 * ci + 4 * rg)) * 2u, w); }
        { const bf16x8 a8 = opt(KR, HG_LDK, 16 * wave, 0, lane); const f32x4 er = *(const LAS f32x4*)(ER + 16 * wave + 4 * rg);
#pragma unroll
          for (int ci = 0; ci < 4; ++ci) { acc[ci] = MFMA16(a8, opt(Vs, HG_LDV, 16 * ci, 0, lane), acc[ci]); acc[ci] = acc[ci] * er; } }
        __syncthreads();
        if (prb) { const unsigned long long t_ = __builtin_amdgcn_s_memrealtime(); pa1 += t_ - pt0; }
    }
    if (prb && tid == 0) { prb[0] = pa0; prb[1] = pa1; }
#undef HG_PREFETCH
}

__device__ __forceinline__ void fin_phase(int row_lo, const bf16* P, bf16* YM, const bf16* RAWM, const bf16* RAWH, const float* mlgain  , const float* hggain  , int vcu, int G, int wv) {
    const int tid = tid_opaque(wv); const int lane = tid & 63, wave = wv;
    float gm[6], gh[4];
#pragma unroll
    for (int j = 0; j < 6; ++j) gm[j] = mlgain[6 * lane + j];
#pragma unroll
    for (int j = 0; j < 4; ++j) gh[j] = hggain[4 * lane + j];
    const int nrows = MT - row_lo; int rwg = (nrows + G - 1) / G; rwg = (rwg + 15) & ~15;
    const int wbeg = row_lo + vcu * rwg, rend = (wbeg + rwg < MT) ? wbeg + rwg : MT;
    for (int r0 = wbeg + wave; r0 < rend; r0 += 16) {
        unsigned fa[2][3], ba[2][3], oa[2][3]; v2u f2[2], b2[2], g2[2];
#pragma unroll
        for (int q = 0; q < 2; ++q) { const int r = r0 + 8 * q; if (r < rend) {
            const unsigned* f3 = (const unsigned*)(YM + (size_t)r * D + Y_ML + 6 * lane); const unsigned* b3 = (const unsigned*)(RAWM + (size_t)r * 384 + 6 * lane); const unsigned* o3 = (const unsigned*)((const char*)P + MLO_OFF + (size_t)r * MLO_LD + 12 * lane);
#pragma unroll
            for (int j = 0; j < 3; ++j) { fa[q][j] = f3[j]; ba[q][j] = __builtin_nontemporal_load(b3 + j); oa[q][j] = __builtin_nontemporal_load(o3 + j); }
            f2[q] = *(const v2u*)(YM + (size_t)r * D + Y_HG + 4 * lane); b2[q] = __builtin_nontemporal_load((const v2u*)(RAWH + (size_t)r * 256 + 4 * lane)); g2[q] = __builtin_nontemporal_load((const v2u*)((const char*)P + HGG_OFF + (size_t)r * HGG_LD + 8 * lane)); } }
#pragma unroll
        for (int q = 0; q < 2; ++q) { const int r = r0 + 8 * q; if (r < rend) {
            float hm[6] = {bflo(fa[q][0]) + bflo(ba[q][0]), bfhi(fa[q][0]) + bfhi(ba[q][0]), bflo(fa[q][1]) + bflo(ba[q][1]), bfhi(fa[q][1]) + bfhi(ba[q][1]), bflo(fa[q][2]) + bflo(ba[q][2]), bfhi(fa[q][2]) + bfhi(ba[q][2])};
            const float og[6] = {bflo(oa[q][0]), bfhi(oa[q][0]), bflo(oa[q][1]), bfhi(oa[q][1]), bflo(oa[q][2]), bfhi(oa[q][2])};
            float hh[4] = {bflo(f2[q].x) + bflo(b2[q].x), bfhi(f2[q].x) + bfhi(b2[q].x), bflo(f2[q].y) + bflo(b2[q].y), bfhi(f2[q].y) + bfhi(b2[q].y)};
            const float gg[4] = {bflo(g2[q].x), bfhi(g2[q].x), bflo(g2[q].y), bfhi(g2[q].y)};
            float sm = 0.f, sh = 0.f;
#pragma unroll
            for (int j = 0; j < 6; ++j) sm += hm[j] * hm[j];
#pragma unroll
            for (int j = 0; j < 4; ++j) sh += hh[j] * hh[j];
#pragma unroll
            for (int o = 1; o < 16; o <<= 1) { sm += lx_xor(sm, o, lane); sh += lx_xor(sh, o, lane); }
            const float rm = 1.0f / sqrtf(sm * (1.0f / 96.0f) + EPS), rh = 1.0f / sqrtf(sh * (1.0f / 64.0f) + EPS);
#pragma unroll
            for (int j = 0; j < 6; ++j) hm[j] = hm[j] * rm * gm[j] * __builtin_amdgcn_rcpf(1.0f + __expf(-og[j]));
#pragma unroll
            for (int j = 0; j < 4; ++j) hh[j] = hh[j] * rh * gh[j] * gg[j] * __builtin_amdgcn_rcpf(1.0f + __expf(-gg[j]));
            bf16* ym = YM + (size_t)r * D;
            unsigned* w3 = (unsigned*)(ym + Y_ML + 6 * lane); w3[0] = pk2(hm[0], hm[1]); w3[1] = pk2(hm[2], hm[3]); w3[2] = pk2(hm[4], hm[5]);
            v2u w2; w2.x = pk2(hh[0], hh[1]); w2.y = pk2(hh[2], hh[3]); *(v2u*)(ym + Y_HG + 4 * lane) = w2; } }
    }
}
#ifndef NO_HG
#define NO_HG 0
#endif
#ifndef NO_ML
#define NO_ML 0
#endif
#ifndef NO_AT
#define NO_AT 0
#endif
#ifndef NO_GEMM
#define NO_GEMM 0
#endif
#ifndef NO_G1
#define NO_G1 0
#endif
#ifndef NO_G2
#define NO_G2 0
#endif
#ifndef NO_G3
#define NO_G3 0
#endif
#ifndef NO_G4
#define NO_G4 0
#endif
#ifndef NO_P0
#define NO_P0 0
#endif
#ifndef STAMP_ON
#define STAMP_ON 0
#endif
#ifndef AMP
#define AMP 8
#endif
#ifndef SBX
#define SBX -1
#endif
#ifndef SA
#define SA 0
#define SB 1
#endif
#ifndef THIN_PROBE
#define THIN_PROBE 0
#endif
#ifndef ATT_PROBE
#define ATT_PROBE 0
#endif
#ifndef REPMASK
#define REPMASK 7
#endif
#ifndef REP
#define REP 0
#endif
constexpr int NPHASE = 2 + 8 * DEPTH;

typedef __attribute__((address_space(4))) const Args* kargs_t;
__device__ __forceinline__ kargs_t kargs() { kargs_t p = (kargs_t)__builtin_amdgcn_kernarg_segment_ptr(); asm volatile("" : "+s"(p)); return p; }
#define WSP(T, off) ((T*)(ws + (off)))

__global__ void __launch_bounds__(NTHR, 2) fwd(Args a_unused) {
    extern __shared__ __attribute__((aligned(16))) unsigned char lds_raw[];
    lptr lds = (lptr)lds_raw;
    const int G = gridDim.x; const int bx = blockIdx.x; const int vcu = (G % 8 == 0) ? (bx % 8) * (G / 8) + bx / 8 : bx;
    const int wv = wave_sgpr();
    volatile LAS unsigned* MISC = (volatile LAS unsigned*)(lds + LDSCTL_OFF);
    { const int tid = tid_opaque(wv); for (int u = tid; u < 256; u += NTHR) ((LAS unsigned*)(lds + LDSCTL_OFF))[u] = 0u; }
    __syncthreads();
    int lo, hi; XcdBarrier bar;
    { kargs_t A = kargs(); lo = A->ph_lo; hi = A->ph_hi; unsigned* bw = (unsigned*)(A->ws + WS_CTL) + CW_BAR;
      bar.bar = bw; bar.x = 0; bar.st = nullptr;
      if (hi - lo > 1) bar = xcd_barrier_post(bw, MISC + 8, wv); }
    volatile LAS int* slot = (volatile LAS int*)(MISC + 16);
#if STAMP_ON
#define STAMP(k) do { if (bx == 0 && tid_opaque(wv) == 0) { kargs_t A_ = kargs(); __hip_atomic_store((unsigned long long*)(A_->ws + WS_MISC + 131072) + (k), (unsigned long long)__builtin_amdgcn_s_memrealtime(), RLX_AGENT); } } while (0)
#else
#define STAMP(k) do { } while (0)
#endif
#define IN(k) (lo <= (k) && (k) < hi)
#define SEAM(k) do { if (IN(k) && IN((k) + 1)) xcd_barrier(bar, wv); STAMP((k) + 1); } while (0)
#define REPEAT(k) for (int rep_ = ((REP == (k) && l == 0) ? 2 : 1); rep_ > 0; --rep_)
#define REPBAR() do { if (rep_ > 1) xcd_barrier(bar, wv); } while (0)

    STAMP(0);
    if (IN(0)) { if (!NO_P0) p0_phase(lds, kargs(), wv); } SEAM(0);

    for (int l = 0; l < DEPTH; ++l) {
        const int pb = 1 + 8 * l;
        const bool with_ctx = l < DEPTH - 1;
        const int cw0 = G > 64 ? 64 : 0;
        const int r0 = with_ctx ? 0 : MC; const int Mg = MT - r0;
        if (IN(pb)) REPEAT(1) {
            kargs_t A = kargs(); unsigned char* ws = A->ws; const float* modl = WSP(float, WS_MOD) + (size_t)l * 17 * NMOD; bf16* xb = WSP(bf16, WS_XB);
            if (l == 0) thin_phase<false, true, true, false>(0, A->in[I_X], A->in[I_CTX], nullptr, xb, false, (const bf16*)nullptr, nullptr, 0, nullptr, modl, 0, D, A->in[I_GPREMIX] + l * D, WSP(bf16, WS_HB), vcu, G, wv);
            else        thin_phase<true, true, false, false>(0, nullptr, nullptr, nullptr, xb, true, WSP(bf16, WS_YD), modl - 17 * NMOD, 5 * D, A->in[I_GPOSTFFN] + (l - 1) * D, modl, 0, D, A->in[I_GPREMIX] + l * D, WSP(bf16, WS_HB), vcu, G, wv);
            convert_weights(lds, kargs(), l, vcu, G, wv, l == 0 ? 0 : 3); REPBAR();
        }
        SEAM(pb);
        if (IN(pb + 1)) REPEAT(2) {
            kargs_t A = kargs(); unsigned char* ws = A->ws;
            pg8::Gemm g{WSP(bf16, WS_HB), WSP(bf16, WS_WIN), MT, DINP, D}; pg8::StaticOrder S; S.init(MT, DINP, G, bx);
            { const int tid = tid_opaque(wv); const float* bsrc = WSP(float, WS_MISC + 32768) + l * DINP; const float* rsrc = WSP(float, WS_MISC + 16384);
              for (int i = tid; i < DINP; i += NTHR) ((LAS float*)(lds + LDS_BIAS))[i] = bsrc[i];
              for (int i = tid; i < 64 * 24; i += NTHR) ((LAS float*)(lds + LDS_ROPE))[i] = rsrc[i];
              for (int i = tid; i < DINP / 8; i += NTHR) { unsigned ex, ey; pg8::epi_in_entry(i, ex, ey); ((LAS unsigned*)(lds + LDS_ETAB))[2 * i] = ex; ((LAS unsigned*)(lds + LDS_ETAB))[2 * i + 1] = ey; }
              __syncthreads(); }
            pg8::EpiIn E{ws + WS_P, (const LAS float*)(lds + LDS_BIAS), WSP(float, WS_GATE), (const LAS float*)(lds + LDS_ROPE), (const LAS unsigned*)(lds + LDS_ETAB), MC, QSCALE};
            if (!NO_GEMM && !NO_G1) pg8::gemm_phase<pg8::EpiIn, pg8::StaticOrder, true, true>(lds, g, S, E, wv); REPBAR();
        }
        SEAM(pb + 1);
        if (IN(pb + 2)) REPEAT(3) {
            { kargs_t A = kargs(); unsigned char* ws = A->ws; unsigned* qh = WSP(unsigned, WS_CTL) + CW_Q + 64 * (16 * l + 64 * (rep_ - 1));
              for (;;) { const int it = wg_pull(qh, slot, wv); if (it >= 128) break;
                const int b = it >> 3, h = (it >> 1) & 3, dir = it & 1;
                if (!NO_HG && (rep_ == 1 || (REPMASK & 1))) hgrn2_stream(lds, WSP(bf16, WS_P), dir ? (bf16*)((unsigned char*)A->out + OUT_RAWH) : WSP(bf16, WS_HB) + Y_HG, dir ? 256 : D, WSP(float, WS_MISC) + l * 1024, b, h, dir, wv, (STAMP_ON && l == 1 && it == 0) ? (unsigned long long*)(ws + WS_CTL + 200 * 1024) : nullptr); } }
            { kargs_t A = kargs(); unsigned char* ws = A->ws; unsigned* qm = WSP(unsigned, WS_CTL) + CW_Q + 64 * (16 * l + 64 * (rep_ - 1) + 1);
              for (;;) { const int it = wg_pull(qm, slot, wv); if (it >= 128) break;
                const int b = it >> 3, h = (it >> 1) & 3, dir = it & 1;
                if (!NO_ML && (rep_ == 1 || (REPMASK & 2))) mlstm_stream(lds, WSP(bf16, WS_P), WSP(float, WS_GATE), dir ? (bf16*)((unsigned char*)A->out + OUT_RAWM) : WSP(bf16, WS_HB) + Y_ML, dir ? 384 : D, A->in[I_MLFB] + l * 8, b, h, dir, wv, (STAMP_ON && l == 1 && it == 0) ? (unsigned long long*)(ws + WS_CTL + 200 * 1024) + 8 : nullptr); } }
            { kargs_t A = kargs(); unsigned char* ws = A->ws; unsigned* qa = WSP(unsigned, WS_CTL) + CW_Q + 64 * (16 * l + 64 * (rep_ - 1) + 2);
              const int nq = with_ctx ? 72 : 64;
              const float lam_init = 0.8f - 0.6f * __expf(-0.3f * (float)l);
              const int myx = (int)(xb_xcc_id() & 7u);
              for (int k = 0; k < 8; ++k) { const int qx = (myx + k) & 7;
                for (;;) { const int it = wg_pull(qa + 64 * qx, slot, wv); if (it >= nq) break;
                  const int bh = it < 64 ? (it >> 3) * 8 + qx : (it - 64) * 8 + qx, qb = it < 64 ? it & 7 : 8;
                  if (!NO_AT && (rep_ == 1 || (REPMASK & 4))) attn_item(lds, WSP(bf16, WS_P), WSP(bf16, WS_HB), A->in[I_DANORM] + l * 96, WSP(float, WS_MISC + 114688)[l], 1.0f - lam_init, bh >> 2, bh & 3, qb, rep_ == 2 ? ATT_PROBE : 0, wv, (STAMP_ON && l == 1 && bh == 0 && qb == 0) ? (unsigned long long*)(ws + WS_CTL + 200 * 1024) + 16 : nullptr); } } }
            __syncthreads(); REPBAR();
        }
        SEAM(pb + 2);
        if (IN(pb + 3)) {
            kargs_t A = kargs(); unsigned char* ws = A->ws;
            fin_phase(r0, WSP(bf16, WS_P), WSP(bf16, WS_HB), (const bf16*)((const unsigned char*)A->out + OUT_RAWM), (const bf16*)((const unsigned char*)A->out + OUT_RAWH), A->in[I_MLNORM] + l * 384, A->in[I_HGNORM] + l * 256, vcu, G, wv);
        }
        SEAM(pb + 3);
        if (IN(pb + 4)) REPEAT(5) {
            kargs_t A = kargs(); unsigned char* ws = A->ws;
            pg8::Gemm g{WSP(bf16, WS_HB) + (size_t)r0 * D, WSP(bf16, WS_WOUT), Mg, D, D}; pg8::StaticOrder S; S.init(Mg, D, G, bx);
            pg8::EpiBf E{WSP(bf16, WS_P) + (size_t)r0 * D, D};
            if (!NO_GEMM && !NO_G2) pg8::gemm_phase<pg8::EpiBf, pg8::StaticOrder, true, true>(lds, g, S, E, wv);
            if (with_ctx && rep_ == 1 && bx >= cw0) { __syncthreads(); convert_weights(lds, kargs(), l + 1, bx - cw0, G - cw0, wv, 1); }
            REPBAR();
        }
        SEAM(pb + 4);
        if (IN(pb + 5)) REPEAT(6) {
            kargs_t A = kargs(); unsigned char* ws = A->ws; const float* modl = WSP(float, WS_MOD) + (size_t)l * 17 * NMOD; bf16* xb = WSP(bf16, WS_XB);
            if (l == 0) thin_phase<true, true, true, false>(r0, A->in[I_X], A->in[I_CTX], nullptr, xb, true, WSP(bf16, WS_P), modl, 2 * D, A->in[I_GPOSTMIX] + l * D, modl, 3 * D, 4 * D, A->in[I_GPREFFN] + l * D, WSP(bf16, WS_HB), vcu, G, wv, rep_ == 2 ? THIN_PROBE : 0);
            else        thin_phase<true, true, false, false>(r0, nullptr, nullptr, nullptr, xb, true, WSP(bf16, WS_P), modl, 2 * D, A->in[I_GPOSTMIX] + l * D, modl, 3 * D, 4 * D, A->in[I_GPREFFN] + l * D, WSP(bf16, WS_HB), vcu, G, wv, 0);
            REPBAR();
        }
        SEAM(pb + 5);
        if (IN(pb + 6)) REPEAT(7) {
            kargs_t A = kargs(); unsigned char* ws = A->ws;
            pg8::Gemm g{WSP(bf16, WS_HB) + (size_t)r0 * D, WSP(bf16, WS_WGU), Mg, NGU, D}; pg8::StaticOrder S; S.init(Mg, NGU, G, bx);
            pg8::EpiSwiglu E{WSP(bf16, WS_P) + (size_t)r0 * DFF, DFF};
            if (!NO_GEMM && !NO_G3) pg8::gemm_phase<pg8::EpiSwiglu, pg8::StaticOrder, true, true>(lds, g, S, E, wv); REPBAR();
        }
        SEAM(pb + 6);
        if (IN(pb + 7)) REPEAT(8) {
            kargs_t A = kargs(); unsigned char* ws = A->ws;
            pg8::Gemm g{WSP(bf16, WS_P) + (size_t)r0 * DFF, WSP(bf16, WS_WD), Mg, D, DFF}; pg8::StaticOrder S; S.init(Mg, D, G, bx);
            pg8::EpiBf E{WSP(bf16, WS_YD) + (size_t)r0 * D, D};
            if (!NO_GEMM && !NO_G4) pg8::gemm_phase<pg8::EpiBf, pg8::StaticOrder, true, true>(lds, g, S, E, wv);
            if (with_ctx && rep_ == 1 && bx >= cw0) { __syncthreads(); convert_weights(lds, kargs(), l + 1, bx - cw0, G - cw0, wv, 2); }
            REPBAR();
        }
        SEAM(pb + 7);
    }
    if (IN(NPHASE - 1)) {
        kargs_t A = kargs(); unsigned char* ws = A->ws; const float* modl = WSP(float, WS_MOD) + (size_t)(DEPTH - 1) * 17 * NMOD;
        thin_phase<true, false, false, true>(MC, nullptr, nullptr, A->out, WSP(bf16, WS_XB), true, WSP(bf16, WS_YD), modl, 5 * D, A->in[I_GPOSTFFN] + (DEPTH - 1) * D, nullptr, 0, 0, nullptr, nullptr, vcu, G, wv);
#if STAMP_ON
        {
            if (bx == 0 && is_t0(wv)) {
                const unsigned long long* st = (const unsigned long long*)(ws + WS_MISC + 131072);
                const unsigned long long d = SBX >= 0 ? __hip_atomic_load((const unsigned long long*)(ws + WS_CTL + 200 * 1024) + (SBX >= 0 ? SBX : 0), RLX_AGENT) : __hip_atomic_load(st + SB, RLX_AGENT) - __hip_atomic_load(st + SA, RLX_AGENT);
                const unsigned long long t0 = __builtin_amdgcn_s_memrealtime();
                while (__builtin_amdgcn_s_memrealtime() - t0 < (unsigned long long)AMP * d) __builtin_amdgcn_s_sleep(32);
            }
        }
#endif
    }
#undef IN
#undef SEAM
}

extern "C" void kernel_launch(void* const* d_in, const int* in_sizes, int n_in, void* d_out, int out_size, void* d_ws, size_t ws_size, hipStream_t stream) {
    static int grid = 0;
    if (grid == 0) {
        if (n_in != 22 || in_sizes[0] != ML * D || out_size != ML * D || ws_size < WS_END) {
            fprintf(stderr, "kernel_launch: unexpected shapes: n_in %d in0 %d out %d ws %zu (need %zu); nothing launched\n", n_in, n_in > 0 ? in_sizes[0] : -1, out_size, ws_size, (size_t)WS_END); grid = -1; return; }
        int dev = 0, cus = 0, per_cu = 0;
        if (hipGetDevice(&dev) != hipSuccess || hipDeviceGetAttribute(&cus, hipDeviceAttributeMultiprocessorCount, dev) != hipSuccess) { fprintf(stderr, "kernel_launch: device query failed\n"); grid = -1; return; }
        if (hipFuncSetAttribute((const void*)fwd, hipFuncAttributeMaxDynamicSharedMemorySize, LDS_BYTES) != hipSuccess) { fprintf(stderr, "kernel_launch: hipFuncSetAttribute failed\n"); grid = -1; return; }
        if (hipOccupancyMaxActiveBlocksPerMultiprocessor(&per_cu, (const void*)fwd, NTHR, LDS_BYTES) != hipSuccess || per_cu < 1)
            fprintf(stderr, "kernel_launch: note: occupancy query reports %d workgroups per CU\n", per_cu);
        (void)hipGetLastError();
        grid = cus;
    }
    if (grid < 0) return;
    if (hipMemsetAsync((char*)d_ws + WS_CTL, 0, CTL_ZERO_BYTES, stream) != hipSuccess) { fprintf(stderr, "kernel_launch: memset failed\n"); return; }
    Args a{};
    for (int i = 0; i < 22; ++i) a.in[i] = (const float*)d_in[i];
    a.out = (float*)d_out; a.ws = (unsigned char*)d_ws;
#if MK_PER_PHASE
    for (int p = 0; p < NPHASE; ++p) { a.ph_lo = p; a.ph_hi = p + 1; hipLaunchKernelGGL(fwd, dim3(grid), dim3(NTHR), LDS_BYTES, stream, a); }
#else
    a.ph_lo = 0; a.ph_hi = NPHASE;
    hipLaunchKernelGGL(fwd, dim3(grid), dim3(NTHR), LDS_BYTES, stream, a);
#endif
    const hipError_t le = hipPeekAtLastError();
    if (le != hipSuccess) fprintf(stderr, "kernel_launch: launch failed: %s\n", hipGetErrorName(le));
}
```
